# Optimizing an MI355X kernel written in HIP

```python
import math
import jax, jax.numpy as jnp
from jax import lax
import numpy as np


D_MODEL = 1024
BATCH = 8
SEQ = 2048
DEPTH = 2

HGRN_HEADS = 4
HGRN_HEAD_DIM = 128
HGRN_WIDTH = HGRN_HEADS * HGRN_HEAD_DIM
HGRN_CHUNK = 64
MLA_HEADS = 8
MLA_NOPE_DIM = 64
MLA_ROPE_DIM = 32
MLA_QK_DIM = MLA_NOPE_DIM + MLA_ROPE_DIM
MLA_V_DIM = 64
MLA_Q_RANK = 384
MLA_KV_RANK = 256
MLA_WIDTH = MLA_HEADS * MLA_V_DIM
ROPE_THETA = 10000.0
Q_BLOCK = 128
POOL_WINDOWS = (2, 4, 8, 16)
POOL_GROUPS = 4
POOL_GROUP_DIM = 128
POOL_WIDTH = POOL_GROUPS * POOL_GROUP_DIM
N_EXPERTS = 32
TOP_K = 4
EXPERT_FF = D_MODEL
SWIGLU_LIMIT = 7.0
SWIGLU_ALPHA = 1.702
NORM_EPS = 1e-6
IN_WIDTHS = (HGRN_WIDTH, HGRN_WIDTH, HGRN_WIDTH, HGRN_WIDTH,
             MLA_Q_RANK, MLA_KV_RANK, MLA_ROPE_DIM, POOL_WIDTH,
             D_MODEL, D_MODEL, D_MODEL)
IN_TOTAL = sum(IN_WIDTHS)

kernel_name = 'hybrid_hgrn2_mla_pool_moe_adaln'


def _rmsnorm(x, g):
    xf = x.astype(jnp.float32)
    y = xf * lax.rsqrt(jnp.mean(xf * xf, axis=-1, keepdims=True) + NORM_EPS)
    return (y * g.astype(jnp.float32)).astype(x.dtype)


def _modulate(xn, shift, scale):
    return xn * (1.0 + scale[:, None, :]) + shift[:, None, :]


def _split_cols(t):
    idx, acc = [], 0
    for w in IN_WIDTHS[:-1]:
        acc += w
        idx.append(acc)
    return jnp.split(t, idx, axis=-1)


def _hgrn2(q, f_logit, i, g, lb, onorm_g):
    B, S, _ = q.shape
    H, Dk, C = HGRN_HEADS, HGRN_HEAD_DIM, HGRN_CHUNK
    f32 = jnp.float32
    z = f_logit.astype(f32).reshape(B, S, H, Dk)
    lbh = lb.astype(f32).reshape(H, Dk)
    log_f = jnp.logaddexp(jnp.log1p(-lbh) + jax.nn.log_sigmoid(z), jnp.log(lbh))
    k = (1.0 - lbh) * jax.nn.sigmoid(-z)
    qf = q.astype(f32).reshape(B, S, H, Dk)
    vf = i.astype(f32).reshape(B, S, H, Dk)
    n = S // C

    def to_chunks(t):
        return t.reshape(B, n, C, H, Dk).transpose(1, 0, 3, 2, 4)

    causal = jnp.tril(jnp.ones((C, C), dtype=bool))

    def step(state, inp):
        qc, kc, vc, lfc = inp
        b = jnp.cumsum(lfc, axis=2)
        diff = b[:, :, :, None, :] - b[:, :, None, :, :]
        decay = jnp.exp(jnp.where(causal[:, :, None], diff, -jnp.inf))
        att = jnp.einsum('bhtd,bhsd,bhtsd->bhts', qc, kc, decay)
        o = jnp.einsum('bhts,bhsv->bhtv', att, vc) + \
            jnp.einsum('bhtd,bhdv->bhtv', qc * jnp.exp(b), state)
        b_last = b[:, :, -1:, :]
        state = jnp.exp(b_last[:, :, 0, :])[..., None] * state + \
            jnp.einsum('bhsd,bhsv->bhdv', kc * jnp.exp(b_last - b), vc)
        return state, o

    state0 = jnp.zeros((B, H, Dk, Dk), f32)
    _, o = lax.scan(step, state0, (to_chunks(qf), to_chunks(k), to_chunks(vf), to_chunks(log_f)))
    o = o.transpose(1, 0, 3, 2, 4).reshape(B, S, H, Dk)
    o = _rmsnorm(o, onorm_g) * jax.nn.silu(g.astype(f32).reshape(B, S, H, Dk))
    return o.reshape(B, S, HGRN_WIDTH).astype(q.dtype)


def _rope(x, cos, sin):
    half = x.shape[-1] // 2
    x1, x2 = x[..., :half], x[..., half:]
    return jnp.concatenate([x1 * cos - x2 * sin, x2 * cos + x1 * sin], axis=-1)


def _causal_attention(q, k, v):
    B, S, H, Dq = q.shape
    Dv = v.shape[-1]
    nb = S // Q_BLOCK
    scale = 1.0 / math.sqrt(Dq)
    qb = q.reshape(B, nb, Q_BLOCK, H, Dq).transpose(1, 0, 3, 2, 4)
    kt = k.transpose(0, 2, 1, 3)
    vt = v.transpose(0, 2, 1, 3)
    key_idx = jnp.arange(S)

    def one_block(args):
        qblk, blk = args
        s = jnp.einsum('bhqd,bhkd->bhqk', qblk, kt).astype(jnp.float32) * scale
        q_idx = blk * Q_BLOCK + jnp.arange(Q_BLOCK)
        s = jnp.where(key_idx[None, :] <= q_idx[:, None], s, -jnp.inf)
        p = jax.nn.softmax(s, axis=-1)
        return jnp.einsum('bhqk,bhkd->bhqd', p.astype(v.dtype), vt)

    out = lax.map(one_block, (qb, jnp.arange(nb)))
    return out.transpose(1, 0, 3, 2, 4).reshape(B, S, H, Dv)


def _mla(q_lat, kv_lat, k_rope, positions, qlat_g, kvlat_g, w_uq, w_ukv, qn_g, kn_g):
    B, S, _ = q_lat.shape
    H = MLA_HEADS
    q = (_rmsnorm(q_lat, qlat_g) @ w_uq).reshape(B, S, H, MLA_QK_DIM)
    kv = (_rmsnorm(kv_lat, kvlat_g) @ w_ukv).reshape(B, S, H, MLA_NOPE_DIM + MLA_V_DIM)
    k_nope, v = kv[..., :MLA_NOPE_DIM], kv[..., MLA_NOPE_DIM:]
    k = jnp.concatenate([k_nope, jnp.broadcast_to(k_rope[:, :, None, :], (B, S, H, MLA_ROPE_DIM))], axis=-1)
    q = _rmsnorm(q, qn_g)
    k = _rmsnorm(k, kn_g)
    inv_freq = 1.0 / (ROPE_THETA ** (jnp.arange(0, MLA_ROPE_DIM, 2, dtype=jnp.float32) / MLA_ROPE_DIM))
    ang = positions.astype(jnp.float32)[..., None] * inv_freq
    cos = jnp.cos(ang)[:, :, None, :].astype(q.dtype)
    sin = jnp.sin(ang)[:, :, None, :].astype(q.dtype)
    q = jnp.concatenate([q[..., :MLA_NOPE_DIM], _rope(q[..., MLA_NOPE_DIM:], cos, sin)], axis=-1)
    k = jnp.concatenate([k[..., :MLA_NOPE_DIM], _rope(k[..., MLA_NOPE_DIM:], cos, sin)], axis=-1)
    return _causal_attention(q, k, v).reshape(B, S, MLA_WIDTH)


def _pool_mixer(u, w_pool, scale):
    B, S, _ = u.shape
    uf = u.astype(jnp.float32).reshape(B, S, POOL_GROUPS, POOL_GROUP_DIM)
    cs = jnp.cumsum(uf, axis=1)
    t = jnp.arange(1, S + 1, dtype=jnp.float32)
    outs = []
    for gi, w in enumerate(POOL_WINDOWS):
        csg = cs[:, :, gi, :]
        lo = jnp.pad(csg, ((0, 0), (w, 0), (0, 0)))[:, :S, :]
        cnt = jnp.minimum(t, float(w))[None, :, None]
        outs.append((csg - lo) / cnt)
    pooled = jnp.stack(outs, axis=2)
    mixed = jnp.einsum('bsgc,gcd->bsgd', pooled - uf, w_pool.astype(jnp.float32))
    return (mixed.reshape(B, S, POOL_WIDTH) * scale.astype(jnp.float32)).astype(u.dtype)


def _moe(h, w_r, b_r, w1, b1, w2, b2):
    B, S, D = h.shape
    hf = h.reshape(B * S, D)
    logits = (hf @ w_r + b_r).astype(jnp.float32)
    vals, idx = lax.top_k(logits, TOP_K)
    wts = jax.nn.softmax(vals, axis=-1)
    combine = jnp.einsum('nk,nke->ne', wts, jax.nn.one_hot(idx, N_EXPERTS, dtype=jnp.float32)).astype(h.dtype)
    y = jnp.zeros_like(hf)
    for e in range(N_EXPERTS):
        a = hf @ w1[e] + b1[e]
        glu = jnp.minimum(a[:, :EXPERT_FF], SWIGLU_LIMIT)
        lin = jnp.clip(a[:, EXPERT_FF:], -SWIGLU_LIMIT, SWIGLU_LIMIT)
        act = glu * jax.nn.sigmoid(SWIGLU_ALPHA * glu) * (lin + 1.0)
        y = y + combine[:, e:e + 1] * (act @ w2[e] + b2[e])
    return y.reshape(B, S, D)


def setup_inputs(seed: int = 0) -> dict:
    key = jax.random.key(seed)
    ks = jax.random.split(key, 32)
    f32 = jnp.float32
    L, D, E, F = DEPTH, D_MODEL, N_EXPERTS, EXPERT_FF

    def nrm(k, shape, fan_in):
        return jax.random.normal(k, shape, f32) * fan_in ** -0.5

    def gain(k, shape):
        return 1.0 + 0.05 * jax.random.normal(k, shape, f32)

    def small(k, shape, s):
        return s * jax.random.normal(k, shape, f32)

    return {
        'x': jax.random.normal(ks[0], (BATCH, SEQ, D), f32),
        'c': jax.random.normal(ks[1], (BATCH, D), f32),
        'positions': jnp.arange(SEQ, dtype=jnp.int32)[None, :] + jax.random.randint(ks[2], (BATCH, 1), 0, 4096, dtype=jnp.int32),
        'ada_w': 0.5 * nrm(ks[3], (L, D, 6 * D), D),
        'ada_b': small(ks[4], (L, 6 * D), 0.02),
        'norm1_g': gain(ks[5], (L, D)),
        'norm2_g': gain(ks[6], (L, D)),
        'w_in': nrm(ks[7], (L, D, IN_TOTAL), D),
        'hgrn_lb': jax.random.normal(ks[8], (L, HGRN_WIDTH), f32),
        'hgrn_onorm_g': gain(ks[9], (L, HGRN_HEAD_DIM)),
        'mla_qlat_g': gain(ks[10], (L, MLA_Q_RANK)),
        'mla_kvlat_g': gain(ks[11], (L, MLA_KV_RANK)),
        'w_uq': nrm(ks[12], (L, MLA_Q_RANK, MLA_HEADS * MLA_QK_DIM), MLA_Q_RANK),
        'w_ukv': nrm(ks[13], (L, MLA_KV_RANK, MLA_HEADS * (MLA_NOPE_DIM + MLA_V_DIM)), MLA_KV_RANK),
        'q_norm_g': gain(ks[14], (L, MLA_QK_DIM)),
        'k_norm_g': gain(ks[15], (L, MLA_QK_DIM)),
        'w_pool': nrm(ks[16], (L, POOL_GROUPS, POOL_GROUP_DIM, POOL_GROUP_DIM), POOL_GROUP_DIM),
        'pool_scale': gain(ks[17], (L, POOL_WIDTH)),
        'w_br_a': nrm(ks[18], (L, HGRN_WIDTH, D), HGRN_WIDTH),
        'w_br_b': nrm(ks[19], (L, MLA_WIDTH, D), MLA_WIDTH),
        'w_br_c': nrm(ks[20], (L, POOL_WIDTH, D), POOL_WIDTH),
        'w_out': nrm(ks[21], (L, D, D), D),
        'w_router': nrm(ks[22], (L, D, E), D),
        'b_router': small(ks[23], (L, E), 0.01),
        'w_exp1': nrm(ks[24], (L, E, D, 2 * F), D),
        'b_exp1': small(ks[25], (L, E, 2 * F), 0.02),
        'w_exp2': nrm(ks[26], (L, E, F, D), F),
        'b_exp2': small(ks[27], (L, E, D), 0.02),
    }


def reference(x, c, positions, ada_w, ada_b, norm1_g, norm2_g, w_in, hgrn_lb, hgrn_onorm_g,
              mla_qlat_g, mla_kvlat_g, w_uq, w_ukv, q_norm_g, k_norm_g, w_pool, pool_scale,
              w_br_a, w_br_b, w_br_c, w_out, w_router, b_router, w_exp1, b_exp1, w_exp2, b_exp2):
    lb_all = jnp.cumsum(jax.nn.softmax(hgrn_lb.astype(jnp.float32), axis=0), axis=0)
    lb_all = lb_all - lb_all[0:1]
    cond = jax.nn.silu(c)
    for l in range(DEPTH):
        mod = cond @ ada_w[l] + ada_b[l]
        sh1, sc1, g1, sh2, sc2, g2 = jnp.split(mod, 6, axis=-1)
        h = _modulate(_rmsnorm(x, norm1_g[l]), sh1, sc1)
        (hq, hf, hi, hg, q_lat, kv_lat, k_rope, pool_in,
         gate_a, gate_b, gate_c) = _split_cols(h @ w_in[l])
        y_a = _hgrn2(hq, hf, hi, hg, lb_all[l], hgrn_onorm_g[l]) @ w_br_a[l]
        y_b = _mla(q_lat, kv_lat, k_rope, positions, mla_qlat_g[l], mla_kvlat_g[l],
                   w_uq[l], w_ukv[l], q_norm_g[l], k_norm_g[l]) @ w_br_b[l]
        y_c = _pool_mixer(pool_in, w_pool[l], pool_scale[l]) @ w_br_c[l]
        merged = jax.nn.sigmoid(gate_a) * y_a + jax.nn.sigmoid(gate_b) * y_b + jax.nn.sigmoid(gate_c) * y_c
        x = x + g1[:, None, :] * (merged @ w_out[l])
        h2 = _modulate(_rmsnorm(x, norm2_g[l]), sh2, sc2)
        x = x + g2[:, None, :] * _moe(h2, w_router[l], b_router[l], w_exp1[l], b_exp1[l], w_exp2[l], b_exp2[l])
    return x
```

```cpp
#include <hip/hip_runtime.h>
#include <stdint.h>
#include <cstdio>
#include <cmath>

typedef unsigned short bf16;
__device__ __forceinline__ float bf2f(bf16 v) { return __uint_as_float(((unsigned)v) << 16); }
__device__ __forceinline__ bf16 f2bf(float f) { unsigned u = __float_as_uint(f); return (bf16)((u + 0x7fffu + ((u >> 16) & 1u)) >> 16); }
__device__ __forceinline__ float sigmoidf_(float x) { return 1.f / (1.f + __expf(-x)); }

constexpr int D = 1024, NB = 8, S = 2048, NT = NB * S, L = 2;
constexpr int HH = 4, HDK = 128, HW = 512, HCH = 64;
constexpr int MH = 8, MNOPE = 64, MROPE = 32, MQK = 96, MV = 64, MQR = 384, MKVR = 256, MW = 512;
constexpr int PW = 512;
constexpr int NE = 32, TOPK = 4, FF = 1024;
constexpr int INW = 6304, INP = 6400;
constexpr int C_HQ = 0, C_HF = 512, C_HI = 1024, C_HG = 1536, C_QLAT = 2048, C_KVLAT = 2432, C_KROPE = 2688, C_POOL = 2720, C_GA = 3232, C_GB = 4256, C_GC = 5280;
constexpr float EPS = 1e-6f;
constexpr int CAP = NT;
constexpr int MAXROWS = NT * TOPK + NE * 256;

constexpr size_t MiB = 1u << 20;
constexpr size_t WS_CTL = 0;
constexpr size_t WS_MOD = 1 * MiB;
constexpr size_t WS_LB = 2 * MiB;
constexpr size_t WS_ROPE = 3 * MiB;
constexpr size_t WS_WINT = 6 * MiB;
constexpr size_t WS_WUQT = 32 * MiB;
constexpr size_t WS_WUKVT = 34 * MiB;
constexpr size_t WS_WBRT = 36 * MiB;
constexpr size_t WS_WOUTT = 42 * MiB;
constexpr size_t WS_W1T = 48 * MiB;
constexpr size_t WS_W2T = 304 * MiB;
constexpr size_t WS_HN = 432 * MiB;
constexpr size_t WS_P = 464 * MiB;
constexpr size_t WS_Q = 664 * MiB;
constexpr size_t WS_K = 688 * MiB;
constexpr size_t WS_V = 712 * MiB;
constexpr size_t WS_BR = 728 * MiB;
constexpr size_t WS_MERGF = 776 * MiB;
constexpr size_t WS_MERGB = 840 * MiB;
constexpr size_t WS_XA = 872 * MiB;
constexpr size_t WS_XB = 936 * MiB;
constexpr size_t WS_HN2 = 1000 * MiB;
constexpr size_t WS_LIST = 1032 * MiB;
constexpr size_t WS_TOK = 1034 * MiB;
constexpr size_t WS_ACT = 1036 * MiB;
constexpr size_t WS_EO = 1180 * MiB;
constexpr size_t WS_ORAW = 1324 * MiB;
constexpr size_t WS_QLN = 1356 * MiB;
constexpr size_t WS_KVN = 1368 * MiB;
constexpr size_t WS_QRAW = 1376 * MiB;
constexpr size_t WS_KVRAW = 1424 * MiB;
constexpr size_t WS_SLOC = 1488 * MiB;
constexpr size_t WS_ST = 1552 * MiB;
constexpr size_t WS_DEC = 1584 * MiB;
constexpr size_t WS_GT = 1585 * MiB;
constexpr size_t WS_END = 1681 * MiB;
constexpr int CW_CNT = 64;
constexpr int CW_OFF = 256;

template <int MODE>
__global__ void k_transpose(const float* __restrict__ in, bf16* __restrict__ out, int K, int N, int NP, int rowoff, size_t ibs, size_t obs) {
    __shared__ float t[32][33];
    const int n0 = blockIdx.x * 32, k0 = blockIdx.y * 32, tx = threadIdx.x & 31, ty = threadIdx.x >> 5;
    const float* ip = in + (size_t)blockIdx.z * ibs; bf16* op = out + (size_t)blockIdx.z * obs;
#pragma unroll
    for (int j = 0; j < 4; ++j) t[ty + 8 * j][tx] = ip[(size_t)(k0 + ty + 8 * j) * N + n0 + tx];
    __syncthreads();
#pragma unroll
    for (int j = 0; j < 4; ++j) {
        int n = n0 + ty + 8 * j; int r = n;
        if (MODE == 1) { const int half = n >> 10, c = n & 1023; r = (c >> 7) * 256 + half * 128 + (c & 127); }
        op[(size_t)(rowoff + r) * K + k0 + tx] = f2bf(t[tx][ty + 8 * j]);
    }
}
__global__ void k_zero_bf16(bf16* p, size_t n) { size_t i = (size_t)blockIdx.x * blockDim.x + threadIdx.x; if (i < n) p[i] = 0; }

__global__ void k_fold_pool(const float* __restrict__ w_pool, const float* __restrict__ scale, const float* __restrict__ w_br_c, bf16* __restrict__ wbrt) {
    const int l = blockIdx.z, k = blockIdx.y, n = blockIdx.x * 256 + threadIdx.x, g = k >> 7, c = k & 127;
    const float* wp = w_pool + ((size_t)l * 4 + g) * 128 * 128 + (size_t)c * 128; const float* sc = scale + l * 512 + g * 128; const float* wb = w_br_c + (size_t)l * 512 * 1024 + (size_t)g * 128 * 1024;
    float a = 0.f;
    for (int d = 0; d < 128; ++d) a += wp[d] * sc[d] * wb[(size_t)d * 1024 + n];
    wbrt[(size_t)l * 3072 * 512 + (size_t)(2048 + n) * 512 + k] = f2bf(a);
}
__global__ void k_adaln(const float* __restrict__ c, const float* __restrict__ ada_w, const float* __restrict__ ada_b, float* __restrict__ mod) {
    __shared__ float cs[8][1024];
    for (int i = threadIdx.x; i < 8192; i += 256) { float v = c[i]; cs[i >> 10][i & 1023] = v / (1.f + __expf(-v)); }
    __syncthreads();
    const int l = blockIdx.y, j = blockIdx.x * 256 + threadIdx.x;
    const float* w = ada_w + (size_t)l * 1024 * 6144 + j;
    float a0 = 0, a1 = 0, a2 = 0, a3 = 0, a4 = 0, a5 = 0, a6 = 0, a7 = 0;
    for (int k = 0; k < 1024; ++k) { const float wv = w[(size_t)k * 6144];
        a0 += cs[0][k] * wv; a1 += cs[1][k] * wv; a2 += cs[2][k] * wv; a3 += cs[3][k] * wv; a4 += cs[4][k] * wv; a5 += cs[5][k] * wv; a6 += cs[6][k] * wv; a7 += cs[7][k] * wv; }
    const float bb = ada_b[l * 6144 + j]; float* m = mod + (size_t)l * 8 * 6144 + j;
    m[0 * 6144] = a0 + bb; m[1 * 6144] = a1 + bb; m[2 * 6144] = a2 + bb; m[3 * 6144] = a3 + bb; m[4 * 6144] = a4 + bb; m[5 * 6144] = a5 + bb; m[6 * 6144] = a6 + bb; m[7 * 6144] = a7 + bb;
}
struct InvF { float f[16]; };
__global__ void k_misc(const float* __restrict__ hgrn_lb, const int* __restrict__ pos, float* __restrict__ lb, float* __restrict__ rope, InvF invf) {
    const int i = blockIdx.x * 256 + threadIdx.x;
    if (i < 512) { const float a = hgrn_lb[i], b = hgrn_lb[512 + i]; const float m = fmaxf(a, b); const float ea = __expf(a - m), eb = __expf(b - m); lb[i] = 0.f; lb[512 + i] = eb / (ea + eb); }
    if (i < NT * 16) { const int t = i >> 4, j = i & 15; float fv = invf.f[0];
#pragma unroll
        for (int q = 1; q < 16; ++q) if (j == q) fv = invf.f[q];
        const double ang = (double)pos[t] * (double)fv;
        double r = ang * 0.15915494309189535; r -= floor(r + 0.5); const float a = (float)(r * 6.283185307179586);
        rope[i] = __cosf(a); rope[NT * 16 + i] = __sinf(a); }
}

__global__ void k_norm_mod(const float* __restrict__ x, const float* __restrict__ g, const float* __restrict__ mod_sh, const float* __restrict__ mod_sc, bf16* __restrict__ out) {
    const int row = blockIdx.x * 4 + (threadIdx.x >> 6), lane = threadIdx.x & 63, b = row / S;
    const float4* xr = (const float4*)(x + (size_t)row * D);
    float4 v[4]; float ss = 0.f;
#pragma unroll
    for (int j = 0; j < 4; ++j) { v[j] = xr[lane + 64 * j]; ss += v[j].x * v[j].x + v[j].y * v[j].y + v[j].z * v[j].z + v[j].w * v[j].w; }
#pragma unroll
    for (int o = 1; o < 64; o <<= 1) ss += __shfl_xor(ss, o);
    const float rstd = rsqrtf(ss * (1.f / D) + EPS);
#pragma unroll
    for (int j = 0; j < 4; ++j) { const int c = (lane + 64 * j) * 4; const float4 gg = *(const float4*)(g + c), sh = *(const float4*)(mod_sh + b * 6144 + c), sc = *(const float4*)(mod_sc + b * 6144 + c);
        ushort4 o; o.x = f2bf(v[j].x * rstd * gg.x * (1.f + sc.x) + sh.x); o.y = f2bf(v[j].y * rstd * gg.y * (1.f + sc.y) + sh.y); o.z = f2bf(v[j].z * rstd * gg.z * (1.f + sc.z) + sh.z); o.w = f2bf(v[j].w * rstd * gg.w * (1.f + sc.w) + sh.w);
        *(ushort4*)(out + (size_t)row * D + c) = o; }
}

struct GemmArgs { const bf16* A; const bf16* Bt; const int* rowlist; const int* cnt; const int* off; float* outf; bf16* outb; const bf16* gate; const float* xin; const float* gvec; const float* bias;
    int lda, ldb, K, ldc, pad0, pad1; };
template <int MODE, int BRI>
__global__ void __launch_bounds__(256) k_gemm(GemmArgs g) {
    __shared__ float As[16][65], Bs[16][65], Bs2[16][65];
    const int tid = threadIdx.x, tx = tid & 15, ty = tid >> 4;
    int m0 = blockIdx.y * 64, n0 = blockIdx.x * 64; int e = 0, cnt = 1 << 30, orow0 = m0;
    const bf16* Bt = g.Bt;
    if (MODE == 4 || MODE == 5) { e = blockIdx.z; cnt = g.cnt[e]; if (m0 >= cnt) return; orow0 = g.off[e] + m0; Bt += (size_t)e * (MODE == 4 ? 2048 : 1024) * g.ldb; }
    const int lr = tid >> 2, lk = (tid & 3) * 4;
    size_t arow;
    if (MODE == 4) { const int slot = m0 + lr; arow = (slot < cnt) ? (size_t)g.rowlist[(size_t)e * CAP + slot] : 0; }
    else if (MODE == 5) arow = (size_t)(orow0 + lr);
    else arow = (size_t)(m0 + lr);
    const bf16* ap = g.A + arow * g.lda + lk;
    int bn = n0 + lr;
    if (MODE == 4) { const int t = n0 >> 6;     const int col = n0 + lr; bn = (col >> 7) * 256 + (col & 127); (void)t; }
    const bf16* bp = Bt + (size_t)bn * g.ldb + lk;
    const bf16* bp2 = bp + (size_t)128 * g.ldb;
    float acc[4][4], acc2[4][4];
#pragma unroll
    for (int i = 0; i < 4; ++i)
#pragma unroll
        for (int j = 0; j < 4; ++j) { acc[i][j] = 0.f; acc2[i][j] = 0.f; }
    for (int k0 = 0; k0 < g.K; k0 += 16) {
        const ushort4 av = *(const ushort4*)(ap + k0), bv = *(const ushort4*)(bp + k0);
        As[lk + 0][lr] = bf2f(av.x); As[lk + 1][lr] = bf2f(av.y); As[lk + 2][lr] = bf2f(av.z); As[lk + 3][lr] = bf2f(av.w);
        Bs[lk + 0][lr] = bf2f(bv.x); Bs[lk + 1][lr] = bf2f(bv.y); Bs[lk + 2][lr] = bf2f(bv.z); Bs[lk + 3][lr] = bf2f(bv.w);
        if (MODE == 4) { const ushort4 cv = *(const ushort4*)(bp2 + k0); Bs2[lk + 0][lr] = bf2f(cv.x); Bs2[lk + 1][lr] = bf2f(cv.y); Bs2[lk + 2][lr] = bf2f(cv.z); Bs2[lk + 3][lr] = bf2f(cv.w); }
        __syncthreads();
#pragma unroll
        for (int kk = 0; kk < 16; ++kk) {
            float a[4], b[4], b2[4];
#pragma unroll
            for (int i = 0; i < 4; ++i) { a[i] = As[kk][ty * 4 + i]; b[i] = Bs[kk][tx * 4 + i]; if (MODE == 4) b2[i] = Bs2[kk][tx * 4 + i]; }
#pragma unroll
            for (int i = 0; i < 4; ++i)
#pragma unroll
                for (int j = 0; j < 4; ++j) { acc[i][j] += a[i] * b[j]; if (MODE == 4) acc2[i][j] += a[i] * b2[j]; }
        }
        __syncthreads();
    }
#pragma unroll
    for (int i = 0; i < 4; ++i) {
        const int rl = ty * 4 + i;
        if ((MODE == 4 || MODE == 5) && m0 + rl >= cnt) continue;
        const size_t row = (MODE == 4 || MODE == 5) ? (size_t)(orow0 + rl) : (size_t)(m0 + rl);
#pragma unroll
        for (int j = 0; j < 4; ++j) {
            const int col = n0 + tx * 4 + j; const float v = acc[i][j];
            if (MODE == 0) g.outb[row * g.ldc + col] = f2bf(v);
            else if (MODE == 1) g.outf[row * g.ldc + col] = v;
            else if (MODE == 2) { const float gt = sigmoidf_(bf2f(g.gate[row * INP + col])) * v; float* o = g.outf + row * g.ldc + col;
                if (BRI == 0) *o = gt; else if (BRI == 1) *o += gt; else { const float s = *o + gt; *o = s; g.outb[row * g.ldc + col] = f2bf(s); } }
            else if (MODE == 3) { const int b = (int)(row / S); g.outf[row * g.ldc + col] = g.xin[row * g.ldc + col] + g.gvec[b * 6144 + col] * v; }
            else if (MODE == 4) { float glu = v + g.bias[e * 2048 + col], lin = acc2[i][j] + g.bias[e * 2048 + 1024 + col];
                glu = fminf(glu, 7.f); lin = fminf(fmaxf(lin, -7.f), 7.f);
                g.outb[row * g.ldc + col] = f2bf(glu * sigmoidf_(1.702f * glu) * (lin + 1.f)); }
            else if (MODE == 5) g.outb[row * g.ldc + col] = f2bf(v + g.bias[e * 1024 + col]);
        }
    }
}

__global__ void __launch_bounds__(128) k_hgrn_naive(const bf16* __restrict__ P, const float* __restrict__ lb, float* __restrict__ oraw) {
    __shared__ float qs[16][128], ks[16][128], fs[16][128];
    const int b = blockIdx.x >> 2, h = blockIdx.x & 3, v = threadIdx.x;
    const float lbv = lb[h * 128 + v];
    float st[128];
#pragma unroll
    for (int d = 0; d < 128; ++d) st[d] = 0.f;
    for (int t0 = 0; t0 < S; t0 += 16) {
        __syncthreads();
        for (int tt = 0; tt < 16; ++tt) { const bf16* pr = P + (size_t)(b * S + t0 + tt) * INP;
            const float z = bf2f(pr[C_HF + h * 128 + v]); const float sg = sigmoidf_(z);
            qs[tt][v] = bf2f(pr[C_HQ + h * 128 + v]); fs[tt][v] = lbv + (1.f - lbv) * sg; ks[tt][v] = (1.f - lbv) * (1.f - sg); }
        __syncthreads();
        for (int tt = 0; tt < 16; ++tt) {
            const float vv = bf2f(P[(size_t)(b * S + t0 + tt) * INP + C_HI + h * 128 + v]);
            float o = 0.f;
#pragma unroll
            for (int d = 0; d < 128; ++d) { st[d] = fs[tt][d] * st[d] + ks[tt][d] * vv; o += qs[tt][d] * st[d]; }
            oraw[(size_t)(b * S + t0 + tt) * 512 + h * 128 + v] = o;
        }
    }
}
__global__ void k_hgrn_out(const float* __restrict__ oraw, const bf16* __restrict__ P, const float* __restrict__ og, bf16* __restrict__ BR) {
    const int idx = blockIdx.x * 4 + (threadIdx.x >> 6), lane = threadIdx.x & 63, t = idx >> 2, h = idx & 3;
    const float o0 = oraw[(size_t)t * 512 + h * 128 + lane], o1 = oraw[(size_t)t * 512 + h * 128 + 64 + lane];
    float ss = o0 * o0 + o1 * o1;
#pragma unroll
    for (int o = 1; o < 64; o <<= 1) ss += __shfl_xor(ss, o);
    const float rstd = rsqrtf(ss * (1.f / 128.f) + EPS);
    const float g0 = bf2f(P[(size_t)t * INP + C_HG + h * 128 + lane]), g1 = bf2f(P[(size_t)t * INP + C_HG + h * 128 + 64 + lane]);
    BR[(size_t)t * 1536 + h * 128 + lane] = f2bf(o0 * rstd * og[lane] * g0 * sigmoidf_(g0));
    BR[(size_t)t * 1536 + h * 128 + 64 + lane] = f2bf(o1 * rstd * og[64 + lane] * g1 * sigmoidf_(g1));
}
__global__ void k_mla_prep(const bf16* __restrict__ P, const float* __restrict__ qg, const float* __restrict__ kvg, bf16* __restrict__ qln, bf16* __restrict__ kvn) {
    const int t = blockIdx.x * 4 + (threadIdx.x >> 6), lane = threadIdx.x & 63; const bf16* pr = P + (size_t)t * INP;
    float q[6], kv[4], s1 = 0.f, s2 = 0.f;
#pragma unroll
    for (int j = 0; j < 6; ++j) { q[j] = bf2f(pr[C_QLAT + lane + 64 * j]); s1 += q[j] * q[j]; }
#pragma unroll
    for (int j = 0; j < 4; ++j) { kv[j] = bf2f(pr[C_KVLAT + lane + 64 * j]); s2 += kv[j] * kv[j]; }
#pragma unroll
    for (int o = 1; o < 64; o <<= 1) { s1 += __shfl_xor(s1, o); s2 += __shfl_xor(s2, o); }
    const float r1 = rsqrtf(s1 * (1.f / 384.f) + EPS), r2 = rsqrtf(s2 * (1.f / 256.f) + EPS);
#pragma unroll
    for (int j = 0; j < 6; ++j) qln[(size_t)t * 384 + lane + 64 * j] = f2bf(q[j] * r1 * qg[lane + 64 * j]);
#pragma unroll
    for (int j = 0; j < 4; ++j) kvn[(size_t)t * 256 + lane + 64 * j] = f2bf(kv[j] * r2 * kvg[lane + 64 * j]);
}
__global__ void k_mla_post(const float* __restrict__ qraw, const float* __restrict__ kvraw, const bf16* __restrict__ P, const float* __restrict__ qng, const float* __restrict__ kng,
                           const float* __restrict__ rope, bf16* __restrict__ Q, bf16* __restrict__ K, bf16* __restrict__ V) {
    const int idx = blockIdx.x * 4 + (threadIdx.x >> 6), lane = threadIdx.x & 63, t = idx >> 3, h = idx & 7, b = t / S, s = t % S;
    const float qa = qraw[(size_t)t * 768 + h * 96 + lane], qb = qraw[(size_t)t * 768 + h * 96 + 64 + (lane & 31)];
    const float ka = kvraw[(size_t)t * 1024 + h * 128 + lane], kb = bf2f(P[(size_t)t * INP + C_KROPE + (lane & 31)]);
    const float va = kvraw[(size_t)t * 1024 + h * 128 + 64 + lane];
    float sq = qa * qa + (lane < 32 ? qb * qb : 0.f), sk = ka * ka + (lane < 32 ? kb * kb : 0.f);
#pragma unroll
    for (int o = 1; o < 64; o <<= 1) { sq += __shfl_xor(sq, o); sk += __shfl_xor(sk, o); }
    const float rq = rsqrtf(sq * (1.f / 96.f) + EPS), rk = rsqrtf(sk * (1.f / 96.f) + EPS);
    const size_t ob = ((size_t)(b * MH + h) * S + s);
    Q[ob * 96 + lane] = f2bf(qa * rq * qng[lane]); K[ob * 96 + lane] = f2bf(ka * rk * kng[lane]); V[((size_t)(b * MH + h) * 64 + lane) * S + s] = f2bf(va);
    const float qn = qb * rq * qng[64 + (lane & 31)], kn = kb * rk * kng[64 + (lane & 31)];
    const float qo = __shfl_xor(qn, 16), ko = __shfl_xor(kn, 16);
    const int i = lane & 15; const float cs = rope[(size_t)t * 16 + i], sn = rope[(size_t)NT * 16 + (size_t)t * 16 + i];
    if (lane < 32) { float qr, kr; if (lane < 16) { qr = qn * cs - qo * sn; kr = kn * cs - ko * sn; } else { qr = qn * cs + qo * sn; kr = kn * cs + ko * sn; }
        Q[ob * 96 + 64 + lane] = f2bf(qr); K[ob * 96 + 64 + lane] = f2bf(kr); }
}
__global__ void __launch_bounds__(64) k_attn_naive(const bf16* __restrict__ Q, const bf16* __restrict__ K, const bf16* __restrict__ V, bf16* __restrict__ BR) {
    __shared__ float ks[16][96], vs[16][64];
    const int bh = blockIdx.y, q0 = blockIdx.x * 64, qi = q0 + threadIdx.x, b = bh >> 3, h = bh & 7;
    float q[96], o[64]; float m = -INFINITY, l = 0.f;
    const bf16* qp = Q + ((size_t)bh * S + qi) * 96;
#pragma unroll
    for (int d = 0; d < 96; ++d) q[d] = bf2f(qp[d]) * 0.10206207261596575f;
#pragma unroll
    for (int d = 0; d < 64; ++d) o[d] = 0.f;
    for (int k0 = 0; k0 < q0 + 64; k0 += 16) {
        __syncthreads();
        for (int i = threadIdx.x; i < 16 * 96; i += 64) ks[i / 96][i % 96] = bf2f(K[((size_t)bh * S + k0) * 96 + i]);
        for (int i = threadIdx.x; i < 16 * 64; i += 64) vs[i & 15][i >> 4] = bf2f(V[((size_t)bh * 64 + (i >> 4)) * S + k0 + (i & 15)]);
        __syncthreads();
        for (int j = 0; j < 16; ++j) {
            if (k0 + j > qi) break;
            float sc = 0.f;
#pragma unroll
            for (int d = 0; d < 96; ++d) sc += q[d] * ks[j][d];
            const float mn = fmaxf(m, sc), corr = __expf(m - mn), p = __expf(sc - mn);
            l = l * corr + p; m = mn;
#pragma unroll
            for (int d = 0; d < 64; ++d) o[d] = o[d] * corr + p * vs[j][d];
        }
    }
    const float inv = 1.f / l; bf16* op = BR + (size_t)(b * S + qi) * 1536 + 512 + h * 64;
#pragma unroll
    for (int d = 0; d < 64; ++d) op[d] = f2bf(o[d] * inv);
}
__global__ void k_pool(const bf16* __restrict__ P, bf16* __restrict__ BR) {
    const int i = blockIdx.x * 256 + threadIdx.x, t = i >> 9, c = i & 511, g = c >> 7, s = t % S, w = 2 << g;
    const int n = (s + 1 < w) ? s + 1 : w; float sum = 0.f;
    for (int j = 0; j < n; ++j) sum += bf2f(P[(size_t)(t - j) * INP + C_POOL + c]);
    const float u = bf2f(P[(size_t)t * INP + C_POOL + c]);
    BR[(size_t)t * 1536 + 1024 + c] = f2bf(sum / (float)n - u);
}
__global__ void k_router(const float* __restrict__ x, const float* __restrict__ g, const float* __restrict__ mod_sh, const float* __restrict__ mod_sc, const float* __restrict__ wr, const float* __restrict__ br,
                         bf16* __restrict__ hn2, int* __restrict__ cnt, int* __restrict__ list, int* __restrict__ tokE, int* __restrict__ tokS, float* __restrict__ tokW) {
    __shared__ float hs[4][1024];
    const int w = threadIdx.x >> 6, row = blockIdx.x * 4 + w, lane = threadIdx.x & 63, b = row / S;
    const float4* xr = (const float4*)(x + (size_t)row * D);
    float4 v[4]; float ss = 0.f;
#pragma unroll
    for (int j = 0; j < 4; ++j) { v[j] = xr[lane + 64 * j]; ss += v[j].x * v[j].x + v[j].y * v[j].y + v[j].z * v[j].z + v[j].w * v[j].w; }
#pragma unroll
    for (int o = 1; o < 64; o <<= 1) ss += __shfl_xor(ss, o);
    const float rstd = rsqrtf(ss * (1.f / D) + EPS);
#pragma unroll
    for (int j = 0; j < 4; ++j) { const int c = (lane + 64 * j) * 4; const float4 gg = *(const float4*)(g + c), sh = *(const float4*)(mod_sh + b * 6144 + c), sc = *(const float4*)(mod_sc + b * 6144 + c);
        float4 hv; hv.x = v[j].x * rstd * gg.x * (1.f + sc.x) + sh.x; hv.y = v[j].y * rstd * gg.y * (1.f + sc.y) + sh.y; hv.z = v[j].z * rstd * gg.z * (1.f + sc.z) + sh.z; hv.w = v[j].w * rstd * gg.w * (1.f + sc.w) + sh.w;
        ushort4 o; o.x = f2bf(hv.x); o.y = f2bf(hv.y); o.z = f2bf(hv.z); o.w = f2bf(hv.w);
        *(ushort4*)(hn2 + (size_t)row * D + c) = o; *(float4*)&hs[w][c] = hv; }
    __syncthreads();
    const int e = lane & 31, half = lane >> 5; float a = 0.f;
    for (int k = half * 512; k < half * 512 + 512; ++k) a += hs[w][k] * wr[k * 32 + e];
    a += __shfl_xor(a, 32); a += br[e];
    float cur = a; float tv[4]; int ti[4];
#pragma unroll
    for (int k = 0; k < 4; ++k) { float mv = cur; int mi = e;
#pragma unroll
        for (int o = 1; o < 32; o <<= 1) { const float ov = __shfl_xor(mv, o); const int oi = __shfl_xor(mi, o); if (ov > mv || (ov == mv && oi < mi)) { mv = ov; mi = oi; } }
        tv[k] = mv; ti[k] = mi; if (e == mi) cur = -INFINITY; }
    const float e1 = __expf(tv[1] - tv[0]), e2 = __expf(tv[2] - tv[0]), e3 = __expf(tv[3] - tv[0]), inv = 1.f / (1.f + e1 + e2 + e3);
    if (lane == 0) {
        const float ww[4] = {inv, e1 * inv, e2 * inv, e3 * inv};
#pragma unroll
        for (int k = 0; k < 4; ++k) { const int slot = atomicAdd(&cnt[ti[k]], 1); list[(size_t)ti[k] * CAP + slot] = row; tokE[row * 4 + k] = ti[k]; tokS[row * 4 + k] = slot; tokW[row * 4 + k] = ww[k]; }
    }
}
__global__ void k_offsets(const int* __restrict__ cnt, int* __restrict__ off) { if (threadIdx.x == 0) { int a = 0; for (int e = 0; e < 32; ++e) { off[e] = a; a += (cnt[e] + 255) & ~255; } off[32] = a; } }
__global__ void k_combine(const float* __restrict__ x1, const float* __restrict__ mod_g2, const bf16* __restrict__ EO, const int* __restrict__ off, const int* __restrict__ tokE, const int* __restrict__ tokS, const float* __restrict__ tokW, float* __restrict__ out) {
    const int row = blockIdx.x, b = row / S, c = threadIdx.x * 4;
    float4 acc = {0.f, 0.f, 0.f, 0.f};
#pragma unroll
    for (int k = 0; k < 4; ++k) { const int e = tokE[row * 4 + k]; const size_t r = (size_t)off[e] + tokS[row * 4 + k]; const float w = tokW[row * 4 + k];
        const ushort4 ev = *(const ushort4*)(EO + r * 1024 + c); acc.x += w * bf2f(ev.x); acc.y += w * bf2f(ev.y); acc.z += w * bf2f(ev.z); acc.w += w * bf2f(ev.w); }
    const float4 xv = *(const float4*)(x1 + (size_t)row * D + c), gg = *(const float4*)(mod_g2 + b * 6144 + c);
    float4 o; o.x = xv.x + gg.x * acc.x; o.y = xv.y + gg.y * acc.y; o.z = xv.z + gg.z * acc.z; o.w = xv.w + gg.w * acc.w;
    *(float4*)(out + (size_t)row * D + c) = o;
}

#define MK_HYBRID 0
#define MK_POOL_IN 1
#define MK_MLA_IN 1
#define MK_ATTN_IN 1
#define MK_HGRN_IN 1
__device__ __forceinline__ unsigned mk_lane_id() { unsigned l; asm volatile("v_mbcnt_lo_u32_b32 %0, -1, 0\n\tv_mbcnt_hi_u32_b32 %0, -1, %0" : "=v"(l)); return l; }
#define GAS __attribute__((address_space(1)))
#define LAS __attribute__((address_space(3)))
#define XB_TMO      128
#define XB_XCNT(j)  (256  + 64 * (j))
#define XB_XSUB(j)  (1280 + 64 * (j))
#define XB_XGEN(j)  (2304 + 64 * (j))
#define XB_TOP      3328
#define XB_TOPGEN   3392
#define XCD_BAR_WORDS 3456
#define XB_SPIN_CAP (1u << 18)

__device__ __forceinline__ unsigned xb_ld(unsigned* p)              { return __hip_atomic_load(p, __ATOMIC_RELAXED, __HIP_MEMORY_SCOPE_AGENT); }
__device__ __forceinline__ unsigned xb_add(unsigned* p, unsigned v) { return __hip_atomic_fetch_add(p, v, __ATOMIC_RELAXED, __HIP_MEMORY_SCOPE_AGENT); }
__device__ __forceinline__ unsigned xb_xcc_id() { return (unsigned)__builtin_amdgcn_s_getreg((3 << 11) | 20) & 0xFu; }
#define XB_SPIN(cond, bar) do { unsigned _sp = 0; while (cond) { __builtin_amdgcn_s_sleep(1); \
    if ((++_sp & 255u) == 0u) { if (xb_ld(&(bar)[XB_TMO])) break; if (_sp > XB_SPIN_CAP) { atomicAdd(&(bar)[XB_TMO], 1u); break; } } } } while (0)

struct XcdBarrier {
    unsigned* bar; unsigned x; int wv;
    volatile LAS unsigned* st;
};

__device__ __forceinline__ bool xb_thread0(int wv) { return wv == 0 && mk_lane_id() == 0u; }
__device__ __forceinline__ XcdBarrier xcd_barrier_post(unsigned* bar, volatile LAS unsigned* st, int wv) {
    XcdBarrier b; b.bar = bar; b.x = xb_xcc_id(); b.st = st; b.wv = wv;
    if (xb_thread0(wv)) (void)xb_add(&bar[XB_XCNT(b.x)], 1u);
    return b;
}
__device__ __forceinline__ void xcd_barrier_complete(unsigned* bar, unsigned x, unsigned& nloc, unsigned& nx) {
    const unsigned G = gridDim.x * gridDim.y * gridDim.z;
    unsigned sum, cnt, mine, sp = 0u;
    for (;;) {
        sum = 0u; cnt = 0u; mine = 0u;
#pragma unroll
        for (unsigned j = 0; j < 16; ++j) { const unsigned c = xb_ld(&bar[XB_XCNT(j)]); sum += c; cnt += (c > 0u) ? 1u : 0u; mine = (j == x) ? c : mine; }
        if (sum == G) break;
        __builtin_amdgcn_s_sleep(1);
        if ((++sp & 255u) == 0u) { if (xb_ld(&bar[XB_TMO])) break; if (sp > XB_SPIN_CAP) { atomicAdd(&bar[XB_TMO], 1u); break; } }
    }
    nloc = mine > 0u ? mine : 1u; nx = cnt > 0u ? cnt : 1u;
}

__device__ __forceinline__ void xcd_barrier(const XcdBarrier& b) {
    asm volatile("s_waitcnt vmcnt(0)" ::: "memory");
    __syncthreads();
    if (xb_thread0(b.wv)) {
        unsigned* bar = b.bar;
        __builtin_amdgcn_s_waitcnt(0);
        unsigned nloc = b.st[0], nx = b.st[1];
        if (nloc == 0u) { xcd_barrier_complete(bar, b.x, nloc, nx); b.st[0] = nloc; b.st[1] = nx; }
        const unsigned old = xb_add(&bar[XB_XSUB(b.x)], 1u);
        const unsigned gen = old / nloc;
        if (old + 1u == (gen + 1u) * nloc) {
            __builtin_amdgcn_fence(__ATOMIC_RELEASE, "agent");
            asm volatile("s_waitcnt vmcnt(0)" ::: "memory");
            const unsigned og = xb_add(&bar[XB_TOP], 1u);
            const unsigned tg = og / nx;
            if (og + 1u == (tg + 1u) * nx) xb_add(&bar[XB_TOPGEN], 1u);
            else XB_SPIN(xb_ld(&bar[XB_TOPGEN]) == tg, bar);
            __builtin_amdgcn_fence(__ATOMIC_ACQUIRE, "agent");
            xb_add(&bar[XB_XGEN(b.x)], 1u);
            asm volatile("s_waitcnt vmcnt(0)" ::: "memory");
        } else {
            XB_SPIN(xb_ld(&bar[XB_XGEN(b.x)]) == gen, bar);
            __builtin_amdgcn_fence(__ATOMIC_ACQUIRE, "agent");
            asm volatile("s_waitcnt vmcnt(0)" ::: "memory");
        }
    }
    __syncthreads();
}
namespace pg8 {
#define PG8_LAS __attribute__((address_space(3)))
typedef unsigned short bf16_t;
typedef short bf16x8 __attribute__((ext_vector_type(8)));
typedef float f32x4 __attribute__((ext_vector_type(4)));
typedef unsigned u32x4 __attribute__((ext_vector_type(4)));
constexpr int BM = 256, BK = 64, HALF = 128, HTB = HALF * BK * 2  , STAGE_BYTES = 8 * HTB, NXCD = 8, WGM = 8;

__host__ __device__ __forceinline__ int lds_byte(int r, int c) { const int st = (r >> 4) * 2 + (c >> 5), rr = r & 15, cc = c & 31, ob = rr * 64 + cc * 2; return st * 1024 + (ob ^ (((ob >> 9) & 1) << 5)); }
__host__ __device__ __forceinline__ void stage_rc(int b, int& R, int& C) { const int st = b / 1024, sb = b % 1024, swz = sb ^ (((sb >> 9) & 1) << 5); R = (st >> 1) * 16 + swz / 64; C = (st & 1) * 32 + (swz % 64) / 2; }
__host__ __device__ __forceinline__ int perm32(int rho) { const int n = rho >> 4, i = rho & 15; return 8 * (i >> 2) + 4 * n + (i & 3); }

struct Unit { int pm, pn, ka, aux, e, gbase, gcnt, pad; };
struct Gemm { const bf16_t* A; const bf16_t* Bt; const int* rowlist; int lda, ldb, K, pad; };

struct StaticOrder {
    int nM, nN, nwg, G, c;
    __host__ __device__ void init(int M, int N, int G_, int c_) { nM = M / BM; nN = N / BM; nwg = nM * nN; G = G_; c = c_; }
    __host__ __device__ bool next(int i, Unit& u) const {
        const long L = (long)i * G + c; if (L >= nwg) return false;
        int wgid = (int)L; { const int q = nwg / NXCD, r = nwg % NXCD, xcd = wgid % NXCD, off = wgid / NXCD; wgid = (xcd < r ? xcd * (q + 1) : r * (q + 1) + (xcd - r) * q) + off; }
        const int nig = WGM * nN, gid = wgid / nig, fm = gid * WGM, gsz = (nM - fm) < WGM ? (nM - fm) : WGM;
        u.pm = fm + ((wgid % nig) % gsz); u.pn = (wgid % nig) / gsz; u.ka = 0; u.aux = 0; u.e = 0; u.gbase = 0; u.gcnt = 0; u.pad = 0; return true;
    }
};

typedef float cvt_f32x2 __attribute__((ext_vector_type(2)));
typedef __bf16 cvt_bf16x2 __attribute__((ext_vector_type(2)));
__device__ __forceinline__ unsigned cvt_pk_bf16(float lo, float hi) { const cvt_f32x2 v = {lo, hi}; return __builtin_bit_cast(unsigned, __builtin_convertvector(v, cvt_bf16x2)); }

template <class Epi, class Sched, bool ALIGN_EPI, bool SP2, bool GATHER, int HOOK = 0>
__device__ __forceinline__ void gemm_phase(PG8_LAS unsigned char* lds, const Gemm g, const Sched& S, const Epi& E, int wave_in) {
    int tid_ = wave_in * 64 + (int)mk_lane_id(); asm volatile("" : "+v"(tid_));
    const int tid = tid_, wid = __builtin_amdgcn_readfirstlane(tid >> 6), lane = tid & 63, wr = wid >> 2, wc = wid & 3, fr = lane & 15, fq = lane >> 4;
    const int K = g.K, nt = K / BK;
    const unsigned ldaB = (unsigned)g.lda * 2u, ldbB = (unsigned)g.ldb * 2u;
    unsigned voffA[2], voffB[2]; int rowA[2];
#pragma unroll
    for (int i = 0; i < 2; ++i) { int R, C; stage_rc(tid * 16 + i * 8192, R, C); const int Rb = Epi::PERM ? ((R & ~31) + perm32(R & 31)) : R;
        rowA[i] = R; voffA[i] = GATHER ? (unsigned)C * 2u : (unsigned)R * ldaB + (unsigned)C * 2u; voffB[i] = (unsigned)Rb * ldbB + (unsigned)C * 2u; }
    const size_t kstep = (size_t)(BK * 2);
    const size_t hstepA = GATHER ? 0 : (size_t)HALF * ldaB, hstepB = (size_t)HALF * ldbB;
    const size_t tstepA = 2 * (size_t)HALF * ldaB, tstepB = 2 * hstepB;
    const unsigned ldsw = (unsigned)wid * 1024u;
    const int aoff = lds_byte(wr * 64 + fr, fq * 8), boff = lds_byte(wc * 32 + fr, fq * 8);
    unsigned gvc[2][2], gvn[2][2];
#define PG8_SA(b, h) (((b) * 2 + (h)) * HTB)
#define PG8_SB(b, h) ((4 + (b) * 2 + (h)) * HTB)
#define PG8_STAGE(bufoff, gbase, voff) do { _Pragma("unroll") for (int _i = 0; _i < 2; ++_i) \
        __builtin_amdgcn_global_load_lds((const unsigned*)((const char*)(gbase) + (voff)[_i]), (PG8_LAS unsigned*)(lds + (bufoff) + ldsw + _i * 8192), 16, 0, 0); } while (0)
#define PG8_STAGEA(bufoff, gbase, h, nx) do { if constexpr (GATHER) { unsigned _vo[2]; _vo[0] = ((nx) ? gvn[h][0] : gvc[h][0]) + voffA[0]; _vo[1] = ((nx) ? gvn[h][1] : gvc[h][1]) + voffA[1]; PG8_STAGE(bufoff, gbase, _vo); } \
        else { PG8_STAGE(bufoff, (const char*)(gbase) + (h) * hstepA, voffA); } } while (0)
#define PG8_GLOAD(dst, u) do { _Pragma("unroll") for (int _h = 0; _h < 2; ++_h) _Pragma("unroll") for (int _i = 0; _i < 2; ++_i) { const int _r = _h * HALF + rowA[_i]; \
        const int _row = (_r < (u).gcnt) ? g.rowlist[(u).gbase + _r] : 0; dst[_h][_i] = (unsigned)_row * ldaB; } } while (0)
#define PG8_LDA(dst, b, h) do { _Pragma("unroll") for (int m = 0; m < 4; ++m) _Pragma("unroll") for (int k = 0; k < 2; ++k) dst[m][k] = *(const PG8_LAS bf16x8*)(lds + PG8_SA(b, h) + aoff + m * 2048 + k * 1024); } while (0)
#define PG8_LDB(dst, b, h) do { _Pragma("unroll") for (int n = 0; n < 2; ++n) _Pragma("unroll") for (int k = 0; k < 2; ++k) dst[n][k] = *(const PG8_LAS bf16x8*)(lds + PG8_SB(b, h) + boff + n * 2048 + k * 1024); } while (0)
#define PG8_MMA(ai, bj, At, Bt) do { __builtin_amdgcn_s_setprio(1); _Pragma("unroll") for (int m = 0; m < 4; ++m) _Pragma("unroll") for (int n = 0; n < 2; ++n) _Pragma("unroll") for (int k = 0; k < 2; ++k) \
        acc[ai][bj][m][n] = __builtin_amdgcn_mfma_f32_16x16x32_bf16(Bt[n][k], At[m][k], acc[ai][bj][m][n], 0, 0, 0); __builtin_amdgcn_s_setprio(0); } while (0)
#define PG8_WAIT_V(n) asm volatile("s_waitcnt vmcnt(" #n ")" ::: "memory")
#define PG8_WAIT_L(n) asm volatile("s_waitcnt lgkmcnt(" #n ")" ::: "memory")
#define PG8_BAR __builtin_amdgcn_s_barrier()
#define PG8_SCHED __builtin_amdgcn_sched_barrier(0)
    Unit cur, nxt; int ui = 0;
    if (!S.next(0, cur)) return;
    f32x4 acc[2][2][4][2];
#pragma unroll
    for (int a = 0; a < 2; ++a)
#pragma unroll
        for (int b = 0; b < 2; ++b)
#pragma unroll
            for (int m = 0; m < 4; ++m)
#pragma unroll
                for (int n = 0; n < 2; ++n) acc[a][b][m][n] = (f32x4){0.f, 0.f, 0.f, 0.f};
    bf16x8 At[4][2], B0[2][2], B1[2][2];
    const char* cA = (const char*)g.A + (GATHER ? (size_t)0 : (size_t)cur.pm * tstepA) + (size_t)cur.ka * 2; const char* cB = (const char*)g.Bt + (size_t)cur.pn * tstepB;
    if constexpr (GATHER) { PG8_GLOAD(gvc, cur); }
#pragma unroll
    for (int h = 0; h < 2; ++h)
#pragma unroll
        for (int i = 0; i < 2; ++i) gvn[h][i] = GATHER ? gvc[h][i] : 0u;
    {
        PG8_STAGE(PG8_SB(0, 0), cB, voffB); PG8_STAGE(PG8_SB(0, 1), cB + hstepB, voffB); PG8_STAGEA(PG8_SA(0, 0), cA, 0, false); PG8_STAGEA(PG8_SA(0, 1), cA, 1, false);
        if (wr == 1) PG8_BAR;
        PG8_WAIT_V(2); PG8_BAR;
        PG8_STAGE(PG8_SB(1, 0), cB + kstep, voffB); PG8_STAGEA(PG8_SA(1, 0), cA + kstep, 0, false); PG8_STAGE(PG8_SB(1, 1), cB + hstepB + kstep, voffB);
        PG8_WAIT_V(6); PG8_BAR;
    }
    for (;;) {
        const bool has_next = S.next(ui + 1, nxt);
        const char* nA = has_next ? (const char*)g.A + (GATHER ? (size_t)0 : (size_t)nxt.pm * tstepA) + (size_t)nxt.ka * 2 : cA; const char* nB = has_next ? (const char*)g.Bt + (size_t)nxt.pn * tstepB : cB;
        if constexpr (GATHER) { if (has_next) { PG8_GLOAD(gvn, nxt); } }
        E.prefetch(cur, wid, lane);
        for (int t = 0; t < nt; t += 2) {
            const bool last = (t == nt - 2);
            if constexpr (HOOK > 0) { if (t > 0 && (t % HOOK) == 0) E.mid(acc, cur, wr, wc, fr, fq, t); }
            const char* a1 = cA + (size_t)(t + 1) * kstep;
            const char* a2 = last ? nA : cA + (size_t)(t + 2) * kstep; const char* b2 = last ? nB : cB + (size_t)(t + 2) * kstep;
            const char* a3 = a2 + kstep; const char* b3 = b2 + kstep;
            PG8_LDB(B0, 0, 0); PG8_LDB(B1, 0, 1); PG8_SCHED; PG8_LDA(At, 0, 0); PG8_STAGEA(PG8_SA(1, 1), a1, 1, false);
            PG8_WAIT_V(8); PG8_WAIT_L(0); PG8_BAR; PG8_MMA(0, 0, At, B0); PG8_MMA(0, 1, At, B1); PG8_BAR; PG8_SCHED;
            PG8_LDA(At, 0, 1); PG8_STAGE(PG8_SB(0, 0), b2, voffB); PG8_STAGE(PG8_SB(0, 1), b2 + hstepB, voffB); PG8_STAGEA(PG8_SA(0, 0), a2, 0, last);
            PG8_WAIT_V(8); PG8_WAIT_L(0); PG8_BAR; PG8_MMA(1, 0, At, B0); PG8_MMA(1, 1, At, B1); PG8_BAR; PG8_SCHED;
            PG8_LDB(B0, 1, 0); PG8_LDB(B1, 1, 1); PG8_SCHED; PG8_LDA(At, 1, 0); PG8_STAGEA(PG8_SA(0, 1), a2, 1, last);
            PG8_WAIT_V(8); PG8_WAIT_L(0); PG8_BAR; PG8_MMA(0, 0, At, B0); PG8_MMA(0, 1, At, B1); PG8_BAR; PG8_SCHED;
            PG8_LDA(At, 1, 1); PG8_STAGE(PG8_SB(1, 0), b3, voffB); PG8_STAGE(PG8_SB(1, 1), b3 + hstepB, voffB); PG8_STAGEA(PG8_SA(1, 0), a3, 0, last);
            PG8_WAIT_V(8); PG8_WAIT_L(0); PG8_BAR; PG8_MMA(1, 0, At, B0); PG8_MMA(1, 1, At, B1); PG8_BAR; PG8_SCHED;
        }
        if constexpr (ALIGN_EPI) { if (wr == 0) PG8_BAR; }
        E(acc, cur, wr, wc, fr, fq);
        if (!has_next) break;
#pragma unroll
        for (int a = 0; a < 2; ++a)
#pragma unroll
            for (int b = 0; b < 2; ++b)
#pragma unroll
                for (int m = 0; m < 4; ++m)
#pragma unroll
                    for (int n = 0; n < 2; ++n) acc[a][b][m][n] = (f32x4){0.f, 0.f, 0.f, 0.f};
        cur = nxt; cA = nA; cB = nB; ++ui;
#pragma unroll
        for (int h = 0; h < 2; ++h)
#pragma unroll
            for (int i = 0; i < 2; ++i) gvc[h][i] = gvn[h][i];
        if constexpr (ALIGN_EPI) { if (wr == 1) PG8_BAR; }
    }
    PG8_WAIT_V(0);
    if constexpr (!ALIGN_EPI) { if (wr == 0) PG8_BAR; }
    PG8_BAR;
#undef PG8_SA
#undef PG8_SB
#undef PG8_STAGE
#undef PG8_STAGEA
#undef PG8_GLOAD
#undef PG8_LDA
#undef PG8_LDB
#undef PG8_MMA
#undef PG8_WAIT_V
#undef PG8_WAIT_L
#undef PG8_BAR
#undef PG8_SCHED
}
}
#ifndef MK_P5PROBE
#define MK_P5PROBE 0
#endif
#ifndef MK_HOOKPROBE
#define MK_HOOKPROBE 0
#endif
typedef unsigned v4u __attribute__((ext_vector_type(4)));
typedef unsigned v2u __attribute__((ext_vector_type(2)));
typedef float f32x4 __attribute__((ext_vector_type(4)));
typedef float f32x16 __attribute__((ext_vector_type(16)));
typedef short bf16x8 __attribute__((ext_vector_type(8)));
#define LDS_WAIT() asm volatile("s_waitcnt lgkmcnt(0)" ::: "memory")
#define VM_WAIT() asm volatile("s_waitcnt vmcnt(0)" ::: "memory")
__device__ __forceinline__ unsigned pk2(float lo, float hi) { return pg8::cvt_pk_bf16(lo, hi); }
__device__ __forceinline__ bf16 f2bf_hw(float x) { return (bf16)(pk2(x, 0.f) & 0xffffu); }
__device__ __forceinline__ float wave_sum(float v) {
#pragma unroll
    for (int o = 1; o < 64; o <<= 1) v += __shfl_xor(v, o);
    return v;
}

__device__ __forceinline__ float bflo(unsigned w) { return __uint_as_float(w << 16); }
__device__ __forceinline__ float bfhi(unsigned w) { return __uint_as_float(w & 0xffff0000u); }
#define MFMA32(a, b, c) __builtin_amdgcn_mfma_f32_32x32x16_bf16((a), (b), (c), 0, 0, 0)
typedef float f32x2 __attribute__((ext_vector_type(2)));
__device__ __forceinline__ f32x2 sq16(const f32x16& a, f32x2 s) {
#pragma unroll
    for (int r = 0; r < 16; r += 2) { const f32x2 p = {a[r], a[r + 1]}; s += p * p; }
    return s;
}

__device__ __forceinline__ void pool_unit(const bf16* __restrict__ P, bf16* __restrict__ BR, int unit, int tid) {
    asm volatile("" : "+v"(tid));
    const int tr = tid >> 6, tc = tid & 63, g = tc >> 4, w = 2 << g;
#pragma unroll 1
    for (int rr = 0; rr < 8; ++rr) {
        const int row = unit * 64 + rr * 8 + tr, s = row & (S - 1), n = (s + 1 < w) ? s + 1 : w;
        const bf16* p = P + (size_t)row * INP + C_POOL + 8 * tc;
        float a[8];
#pragma unroll
        for (int q = 0; q < 8; ++q) a[q] = 0.f;
        v4u wv[16];
#pragma unroll
        for (int j = 0; j < 16; ++j) wv[j] = (j < n) ? *(const GAS v4u*)(p - (size_t)j * INP) : (v4u){0u, 0u, 0u, 0u};
        const v4u u0 = wv[0];
#pragma unroll
        for (int j = 0; j < 16; ++j) { const v4u v = wv[j];
            a[0] += bflo(v.x); a[1] += bfhi(v.x); a[2] += bflo(v.y); a[3] += bfhi(v.y); a[4] += bflo(v.z); a[5] += bfhi(v.z); a[6] += bflo(v.w); a[7] += bfhi(v.w); }
        const float inv = __builtin_amdgcn_rcpf((float)n);
        v4u o; o.x = pk2(a[0] * inv - bflo(u0.x), a[1] * inv - bfhi(u0.x)); o.y = pk2(a[2] * inv - bflo(u0.y), a[3] * inv - bfhi(u0.y));
        o.z = pk2(a[4] * inv - bflo(u0.z), a[5] * inv - bfhi(u0.z)); o.w = pk2(a[6] * inv - bflo(u0.w), a[7] * inv - bfhi(u0.w));
        *(GAS v4u*)(BR + (size_t)row * 1536 + 1024 + 8 * tc) = o;
    }
}

constexpr int MLA_QS = 784, MLA_KS = 528;
__device__ __forceinline__ void mla_unit(const bf16* __restrict__ P, const float* __restrict__ qlat_g, const float* __restrict__ kvlat_g, const bf16* __restrict__ WuqT, const bf16* __restrict__ WukvT,
                                         const float* __restrict__ qn_g, const float* __restrict__ kn_g, const float* __restrict__ rope, bf16* __restrict__ Q, bf16* __restrict__ K, bf16* __restrict__ VT,
                                         LAS unsigned char* lds, int unit, int lane, int wave) {
    asm volatile("" : "+v"(lane));
    LAS unsigned char* qn = lds; LAS unsigned char* kvn = lds + 64 * MLA_QS;
    const int t0 = unit * 64;
#pragma unroll 1
    for (int rb = 0; rb < 2; ++rb) {
        unsigned qv[4][3], kv[4][2];
#pragma unroll
        for (int rr = 0; rr < 4; ++rr) { const bf16* pr = P + (size_t)(t0 + wave * 8 + rb * 4 + rr) * INP;
#pragma unroll
            for (int j = 0; j < 3; ++j) qv[rr][j] = *(const GAS unsigned*)(pr + C_QLAT + 2 * lane + 128 * j);
#pragma unroll
            for (int j = 0; j < 2; ++j) kv[rr][j] = *(const GAS unsigned*)(pr + C_KVLAT + 2 * lane + 128 * j); }
#pragma unroll
        for (int rr = 0; rr < 4; ++rr) {
            const int lr = wave * 8 + rb * 4 + rr; float s1 = 0.f, s2 = 0.f;
#pragma unroll
            for (int j = 0; j < 3; ++j) s1 += bflo(qv[rr][j]) * bflo(qv[rr][j]) + bfhi(qv[rr][j]) * bfhi(qv[rr][j]);
#pragma unroll
            for (int j = 0; j < 2; ++j) s2 += bflo(kv[rr][j]) * bflo(kv[rr][j]) + bfhi(kv[rr][j]) * bfhi(kv[rr][j]);
            s1 = wave_sum(s1); s2 = wave_sum(s2);
            const float r1 = rsqrtf(s1 * (1.f / 384.f) + EPS), r2 = rsqrtf(s2 * (1.f / 256.f) + EPS);
#pragma unroll
            for (int j = 0; j < 3; ++j) { const int c = 2 * lane + 128 * j; *(LAS unsigned*)(qn + lr * MLA_QS + c * 2) = pk2(bflo(qv[rr][j]) * r1 * qlat_g[c], bfhi(qv[rr][j]) * r1 * qlat_g[c + 1]); }
#pragma unroll
            for (int j = 0; j < 2; ++j) { const int c = 2 * lane + 128 * j; *(LAS unsigned*)(kvn + lr * MLA_KS + c * 2) = pk2(bflo(kv[rr][j]) * r2 * kvlat_g[c], bfhi(kv[rr][j]) * r2 * kvlat_g[c + 1]); }
        }
    }
    __syncthreads();
    const int l31 = lane & 31, h5 = lane >> 5;
    {
        f32x16 acc[3][2];
#pragma unroll
        for (int mt = 0; mt < 3; ++mt)
#pragma unroll
            for (int nt = 0; nt < 2; ++nt)
#pragma unroll
                for (int r = 0; r < 16; ++r) acc[mt][nt][r] = 0.f;
        const bf16* wp = WuqT + (size_t)(wave * 96 + l31) * 384 + 8 * h5;
        bf16x8 ar[4][3];
#pragma unroll
        for (int p = 0; p < 3; ++p)
#pragma unroll
            for (int mt = 0; mt < 3; ++mt) ar[p][mt] = *(const GAS bf16x8*)(wp + (size_t)mt * 32 * 384 + 16 * p);
#pragma unroll
        for (int ks = 0; ks < 24; ++ks) {
            if (ks + 3 < 24) {
#pragma unroll
                for (int mt = 0; mt < 3; ++mt) ar[(ks + 3) & 3][mt] = *(const GAS bf16x8*)(wp + (size_t)mt * 32 * 384 + 16 * (ks + 3)); }
            bf16x8 b[2];
#pragma unroll
            for (int nt = 0; nt < 2; ++nt) b[nt] = *(const LAS bf16x8*)(qn + (32 * nt + l31) * MLA_QS + (16 * ks + 8 * h5) * 2);
#pragma unroll
            for (int mt = 0; mt < 3; ++mt)
#pragma unroll
                for (int nt = 0; nt < 2; ++nt) acc[mt][nt] = MFMA32(ar[ks & 3][mt], b[nt], acc[mt][nt]);
        }
#pragma unroll
        for (int nt = 0; nt < 2; ++nt) {
            const int tok = t0 + 32 * nt + l31, b = tok / S, s = tok & (S - 1);
            f32x2 s2 = {0.f, 0.f};
#pragma unroll
            for (int mt = 0; mt < 3; ++mt) s2 = sq16(acc[mt][nt], s2);
            float ss = s2.x + s2.y;
            ss += __shfl_xor(ss, 32);
            const float rstd = rsqrtf(ss * (1.f / 96.f) + EPS);
            bf16* qo = Q + ((size_t)(b * MH + wave) * S + s) * 96;
#pragma unroll
            for (int mt = 0; mt < 2; ++mt)
#pragma unroll
                for (int g = 0; g < 4; ++g) { const int d0 = 32 * mt + 8 * g + 4 * h5; const f32x4 gn = *(const GAS f32x4*)(qn_g + d0);
                    v2u o; o.x = pk2(acc[mt][nt][4 * g] * rstd * gn[0], acc[mt][nt][4 * g + 1] * rstd * gn[1]); o.y = pk2(acc[mt][nt][4 * g + 2] * rstd * gn[2], acc[mt][nt][4 * g + 3] * rstd * gn[3]);
                    *(GAS v2u*)(qo + d0) = o; }
#pragma unroll
            for (int g = 0; g < 2; ++g) { const int i0 = 8 * g + 4 * h5;
                const f32x4 cs = *(const GAS f32x4*)(rope + (size_t)tok * 16 + i0), sn = *(const GAS f32x4*)(rope + (size_t)NT * 16 + (size_t)tok * 16 + i0);
                const f32x4 g1 = *(const GAS f32x4*)(qn_g + 64 + i0), g2 = *(const GAS f32x4*)(qn_g + 80 + i0);
                float o1[4], o2[4];
#pragma unroll
                for (int j = 0; j < 4; ++j) { const float x1 = acc[2][nt][4 * g + j] * rstd * g1[j], x2 = acc[2][nt][8 + 4 * g + j] * rstd * g2[j]; o1[j] = x1 * cs[j] - x2 * sn[j]; o2[j] = x2 * cs[j] + x1 * sn[j]; }
                v2u w1, w2; w1.x = pk2(o1[0], o1[1]); w1.y = pk2(o1[2], o1[3]); w2.x = pk2(o2[0], o2[1]); w2.y = pk2(o2[2], o2[3]);
                *(GAS v2u*)(qo + 64 + i0) = w1; *(GAS v2u*)(qo + 80 + i0) = w2; }
        }
    }
#pragma unroll 1
    for (int pass = 0; pass < 2; ++pass) {
        f32x16 acc[2][2];
#pragma unroll
        for (int mt = 0; mt < 2; ++mt)
#pragma unroll
            for (int nt = 0; nt < 2; ++nt)
#pragma unroll
                for (int r = 0; r < 16; ++r) acc[mt][nt][r] = 0.f;
        const bf16* wp = WukvT + (size_t)(wave * 128 + pass * 64 + l31) * 256 + 8 * h5;
        bf16x8 ar[4][2];
#pragma unroll
        for (int p = 0; p < 3; ++p)
#pragma unroll
            for (int mt = 0; mt < 2; ++mt) ar[p][mt] = *(const GAS bf16x8*)(wp + (size_t)mt * 32 * 256 + 16 * p);
#pragma unroll
        for (int ks = 0; ks < 16; ++ks) {
            if (ks + 3 < 16) {
#pragma unroll
                for (int mt = 0; mt < 2; ++mt) ar[(ks + 3) & 3][mt] = *(const GAS bf16x8*)(wp + (size_t)mt * 32 * 256 + 16 * (ks + 3)); }
            bf16x8 b[2];
#pragma unroll
            for (int nt = 0; nt < 2; ++nt) b[nt] = *(const LAS bf16x8*)(kvn + (32 * nt + l31) * MLA_KS + (16 * ks + 8 * h5) * 2);
#pragma unroll
            for (int mt = 0; mt < 2; ++mt)
#pragma unroll
                for (int nt = 0; nt < 2; ++nt) acc[mt][nt] = MFMA32(ar[ks & 3][mt], b[nt], acc[mt][nt]);
        }
        if (pass == 0) {
#pragma unroll
          for (int nt = 0; nt < 2; ++nt) {
            const int tok = t0 + 32 * nt + l31, b = tok / S, s = tok & (S - 1);
            float kr[16];
#pragma unroll
            for (int g = 0; g < 4; ++g) { const v2u kv = *(const GAS v2u*)(P + (size_t)tok * INP + C_KROPE + 8 * g + 4 * h5); kr[4 * g] = bflo(kv.x); kr[4 * g + 1] = bfhi(kv.x); kr[4 * g + 2] = bflo(kv.y); kr[4 * g + 3] = bfhi(kv.y); }
            f32x2 s2 = {0.f, 0.f};
#pragma unroll
            for (int mt = 0; mt < 2; ++mt) s2 = sq16(acc[mt][nt], s2);
            float ss = s2.x + s2.y;
#pragma unroll
            for (int r = 0; r < 16; ++r) ss += kr[r] * kr[r];
            ss += __shfl_xor(ss, 32);
            const float rstd = rsqrtf(ss * (1.f / 96.f) + EPS);
            bf16* ko = K + ((size_t)(b * MH + wave) * S + s) * 96;
#pragma unroll
            for (int mt = 0; mt < 2; ++mt)
#pragma unroll
                for (int g = 0; g < 4; ++g) { const int d0 = 32 * mt + 8 * g + 4 * h5; const f32x4 gn = *(const GAS f32x4*)(kn_g + d0);
                    v2u o; o.x = pk2(acc[mt][nt][4 * g] * rstd * gn[0], acc[mt][nt][4 * g + 1] * rstd * gn[1]); o.y = pk2(acc[mt][nt][4 * g + 2] * rstd * gn[2], acc[mt][nt][4 * g + 3] * rstd * gn[3]);
                    *(GAS v2u*)(ko + d0) = o; }
#pragma unroll
            for (int g = 0; g < 4; ++g) { const f32x4 gn = *(const GAS f32x4*)(kn_g + 64 + 8 * g + 4 * h5);
#pragma unroll
                for (int j = 0; j < 4; ++j) kr[4 * g + j] *= rstd * gn[j]; }
#pragma unroll
            for (int g = 0; g < 2; ++g) { const f32x4 cs = *(const GAS f32x4*)(rope + (size_t)tok * 16 + 8 * g + 4 * h5), sn = *(const GAS f32x4*)(rope + (size_t)NT * 16 + (size_t)tok * 16 + 8 * g + 4 * h5);
                float o1[4], o2[4];
#pragma unroll
                for (int j = 0; j < 4; ++j) { const float x1 = kr[4 * g + j], x2 = kr[8 + 4 * g + j]; o1[j] = x1 * cs[j] - x2 * sn[j]; o2[j] = x2 * cs[j] + x1 * sn[j]; }
                v2u w1, w2; w1.x = pk2(o1[0], o1[1]); w1.y = pk2(o1[2], o1[3]); w2.x = pk2(o2[0], o2[1]); w2.y = pk2(o2[2], o2[3]);
                *(GAS v2u*)(ko + 64 + 8 * g + 4 * h5) = w1; *(GAS v2u*)(ko + 80 + 8 * g + 4 * h5) = w2; }
          }
        } else {
#pragma unroll
          for (int nt = 0; nt < 2; ++nt) {
            int hq = h5; asm volatile("" : "+v"(hq));
            const int tok = t0 + 32 * nt + l31, b = tok / S, s = tok & (S - 1);
            bf16* vo = VT + ((size_t)(b * MH + wave) * 64 + 4 * hq) * S + s;
#pragma unroll
            for (int mt = 0; mt < 2; ++mt)
#pragma unroll
                for (int r = 0; r < 16; ++r) { const int dv = 32 * mt + (r & 3) + 8 * (r >> 2); vo[(size_t)dv * S] = f2bf_hw(acc[mt][nt][r]); }
          }
        }
    }
    __syncthreads();
}

constexpr int AT_KS = 208, AT_VS = 136;
constexpr int AT_KB = 64 * AT_KS, AT_VB = 64 * AT_VS;
constexpr float AT_C = 0.10206207261596575f * 1.4426950408889634f;
__device__ __forceinline__ void attn_unit(const bf16* __restrict__ Q, const bf16* __restrict__ K, const bf16* __restrict__ VT, bf16* __restrict__ BR, LAS unsigned char* lds, int bh, int qb, int tid, int lane, int wave) {
    asm volatile("" : "+v"(lane), "+v"(tid));
    const int l31 = lane & 31, h5 = lane >> 5;
    const int qw0 = 256 * qb + 32 * wave, ntile = 4 * qb + 4, mytiles = 4 * qb + (wave >> 1) + 1;
    const bf16* Kg = K + (size_t)bh * S * 96; const bf16* Vg = VT + (size_t)bh * 64 * S;
    LAS unsigned char* kbuf = lds; LAS unsigned char* vbuf = lds + 2 * AT_KB;
    bf16x8 qf[6];
    { const bf16* qp = Q + ((size_t)bh * S + qw0 + l31) * 96 + 8 * h5;
#pragma unroll
      for (int ks = 0; ks < 6; ++ks) qf[ks] = *(const GAS bf16x8*)(qp + 16 * ks); }
    f32x16 o[2];
#pragma unroll
    for (int r = 0; r < 16; ++r) { o[0][r] = 0.f; o[1][r] = 0.f; }
    float mrow = -INFINITY, lrow = 0.f;
    const int kc0 = tid, kc1 = tid + 512; const bool k1 = kc1 < 768;
    const unsigned kl0 = (unsigned)((kc0 / 12) * AT_KS + (kc0 % 12) * 16), kl1 = (unsigned)((kc1 / 12) * AT_KS + (kc1 % 12) * 16), vl = (unsigned)((tid >> 3) * AT_VS + (tid & 7) * 16);
    v4u sk0, sk1 = (v4u){0u, 0u, 0u, 0u}, sv;
#define AT_GLOADK(j) do { const bf16* kp = Kg + (size_t)(j) * 64 * 96; sk0 = *(const GAS v4u*)(kp + (size_t)kc0 * 8); if (k1) sk1 = *(const GAS v4u*)(kp + (size_t)kc1 * 8); } while (0)
#define AT_GLOADV(j) do { sv = *(const GAS v4u*)(Vg + (size_t)(tid >> 3) * S + (size_t)(j) * 64 + (tid & 7) * 8); } while (0)
#define AT_LSTOREK(buf) do { LAS unsigned char* kb = kbuf + (buf) * AT_KB; *(LAS v4u*)(kb + kl0) = sk0; if (k1) *(LAS v4u*)(kb + kl1) = sk1; } while (0)
#define AT_LSTOREV(buf) do { LAS unsigned char* vb = vbuf + (buf) * AT_VB + vl; *(LAS v2u*)(vb) = (v2u){sv.x, sv.y}; *(LAS v2u*)(vb + 8) = (v2u){sv.z, sv.w}; } while (0)
#define AT_QK(dst, buf) do { const LAS unsigned char* kb = kbuf + (buf) * AT_KB; _Pragma("unroll") for (int kt = 0; kt < 2; ++kt) { _Pragma("unroll") for (int r = 0; r < 16; ++r) dst[kt][r] = 0.f; \
        _Pragma("unroll") for (int ks = 0; ks < 6; ++ks) { const bf16x8 kf = *(const LAS bf16x8*)(kb + (32 * kt + l31) * AT_KS + (16 * ks + 8 * h5) * 2); dst[kt] = MFMA32(kf, qf[ks], dst[kt]); } } } while (0)
    AT_GLOADK(0); AT_GLOADV(0); AT_LSTOREK(0); AT_LSTOREV(0);
    AT_GLOADK(1); AT_LSTOREK(1);
    __syncthreads();
    f32x16 sa[2], sb[2];
    AT_QK(sa, 0);
    __syncthreads();
#define AT_BODY(SC, SN, J) do { const int j = (J); \
        if (j + 2 < ntile) AT_GLOADK(j + 2); \
        if (j + 1 < ntile) AT_GLOADV(j + 1); \
        if (j + 1 < mytiles) AT_QK(SN, (j + 1) & 1); \
        if (j < mytiles) { \
            const LAS unsigned char* vb = vbuf + (j & 1) * AT_VB; \
            if (j == mytiles - 1) { const int qq = qw0 + l31 - 64 * j; asm volatile("; diagonal tile" ::: "memory");     \
                _Pragma("unroll") for (int kt = 0; kt < 2; ++kt) _Pragma("unroll") for (int r = 0; r < 16; ++r) { const int kk = 32 * kt + (r & 3) + 8 * (r >> 2) + 4 * h5; if (kk > qq) SC[kt][r] = -INFINITY; } } \
            float mx = SC[0][0]; \
            _Pragma("unroll") for (int kt = 0; kt < 2; ++kt) _Pragma("unroll") for (int r = 0; r < 16; ++r) mx = fmaxf(mx, SC[kt][r]); \
            mx = fmaxf(mx, __shfl_xor(mx, 32)); \
            const float mnew = fmaxf(mrow, mx * AT_C), alpha = __builtin_amdgcn_exp2f(mrow - mnew); \
            mrow = mnew; \
            f32x2 ls2 = {0.f, 0.f}; const f32x2 c2 = {AT_C, AT_C}, m2 = {mnew, mnew}; \
            _Pragma("unroll") for (int kt = 0; kt < 2; ++kt) _Pragma("unroll") for (int r = 0; r < 16; r += 2) { f32x2 x = {SC[kt][r], SC[kt][r + 1]}; x = x * c2 - m2; \
                f32x2 pp; pp.x = __builtin_amdgcn_exp2f(x.x); pp.y = __builtin_amdgcn_exp2f(x.y); SC[kt][r] = pp.x; SC[kt][r + 1] = pp.y; ls2 += pp; } \
            lrow = lrow * alpha + (ls2.x + ls2.y); \
            _Pragma("unroll") for (int r = 0; r < 16; ++r) { o[0][r] *= alpha; o[1][r] *= alpha; } \
            _Pragma("unroll") for (int kt = 0; kt < 2; ++kt) _Pragma("unroll") for (int s2 = 0; s2 < 2; ++s2) { \
                union { bf16x8 v; unsigned u[4]; } pf; \
                _Pragma("unroll") for (int q = 0; q < 4; ++q) pf.u[q] = pk2(SC[kt][8 * s2 + 2 * q], SC[kt][8 * s2 + 2 * q + 1]); \
                _Pragma("unroll") for (int dvt = 0; dvt < 2; ++dvt) { union { bf16x8 v; v2u h[2]; } vf; \
                    const LAS unsigned char* vp = vb + (32 * dvt + l31) * AT_VS + (32 * kt + 16 * s2 + 4 * h5) * 2; \
                    vf.h[0] = *(const LAS v2u*)(vp); vf.h[1] = *(const LAS v2u*)(vp + 16); \
                    o[dvt] = MFMA32(vf.v, pf.v, o[dvt]); } } \
        } \
        if (j + 2 < ntile) AT_LSTOREK(j & 1); \
        if (j + 1 < ntile) AT_LSTOREV((j + 1) & 1); \
        __syncthreads(); } while (0)
#pragma unroll 1
    for (int jj = 0; jj < ntile; jj += 2) { AT_BODY(sa, sb, jj); AT_BODY(sb, sa, jj + 1); }
#undef AT_BODY
#undef AT_GLOADK
#undef AT_GLOADV
#undef AT_LSTOREK
#undef AT_LSTOREV
#undef AT_QK
    lrow += __shfl_xor(lrow, 32);
    const float inv = __builtin_amdgcn_rcpf(lrow);
    const int b = bh >> 3, h = bh & 7;
    bf16* op = BR + (size_t)(b * S + qw0 + l31) * 1536 + 512 + h * 64;
#pragma unroll
    for (int dvt = 0; dvt < 2; ++dvt)
#pragma unroll
        for (int g = 0; g < 4; ++g) { v2u w; w.x = pk2(o[dvt][4 * g] * inv, o[dvt][4 * g + 1] * inv); w.y = pk2(o[dvt][4 * g + 2] * inv, o[dvt][4 * g + 3] * inv);
            *(GAS v2u*)(op + 32 * dvt + 8 * g + 4 * h5) = w; }
}
#define MFMA16(a, b, c) __builtin_amdgcn_mfma_f32_16x16x32_bf16((a), (b), (c), 0, 0, 0)
constexpr int HG_VS = 144;
constexpr int HG_QS = 272;
__device__ __forceinline__ void hgrn_gate(float z, float lbv, float l1, float l2, float& lf, float& kv) {
    const float e = __expf(-fabsf(z)), ls = fminf(z, 0.f) - __logf(1.f + e);
    const float rc = __builtin_amdgcn_rcpf(1.f + e), sg = (z >= 0.f) ? rc : e * rc;
    kv = (1.f - lbv) * (1.f - sg);
    const float a = l1 + ls;
    if (lbv > 0.f) { const float mx = fmaxf(a, l2), dd = -fabsf(a - l2); lf = mx + __logf(1.f + __expf(dd)); } else lf = a;
}
struct HgA { unsigned zz[8]; unsigned vp[8]; };
__device__ __forceinline__ void hgrn_a_load(const bf16* __restrict__ P, int unit, int tid, HgA& r) {
    asm volatile("" : "+v"(tid));
    const int bh = unit >> 5, c = unit & 31, b = bh >> 2, h = bh & 3, tok0 = b * S + c * 64, d = tid & 127, seg = tid >> 7;
    const bf16* pz = P + (size_t)(tok0 + seg * 16) * INP + C_HF + h * 128 + d;
    const bf16* pv = P + (size_t)(tok0 + seg * 16) * INP + C_HI + h * 128 + d;
#pragma unroll
    for (int t = 0; t < 8; ++t) { r.zz[t] = (unsigned)pz[(size_t)(2 * t) * INP] | ((unsigned)pz[(size_t)(2 * t + 1) * INP] << 16); r.vp[t] = (unsigned)pv[(size_t)(2 * t) * INP] | ((unsigned)pv[(size_t)(2 * t + 1) * INP] << 16); }
}
__device__ __forceinline__ void hgrn_a_compute(const HgA& r, const float* __restrict__ lb, float* __restrict__ SLOC, float* __restrict__ DEC, LAS unsigned char* lds, int unit, int tid, int lane, int wave) {
    asm volatile("" : "+v"(tid), "+v"(lane));
    const int bh = unit >> 5, h = bh & 3;
    LAS float* tot = (LAS float*)lds;
    LAS unsigned char* vT = lds + 2048;
    LAS unsigned char* kT = vT + 128 * HG_VS;
    const int d = tid & 127, seg = tid >> 7;
    const float lbv = lb[h * 128 + d], l1 = __logf(1.f - lbv), l2 = (lbv > 0.f) ? __logf(lbv) : -INFINITY;
    float cs[16], kv[16]; float run = 0.f;
#pragma unroll
    for (int t = 0; t < 16; ++t) { float lf; hgrn_gate((t & 1) ? bfhi(r.zz[t >> 1]) : bflo(r.zz[t >> 1]), lbv, l1, l2, lf, kv[t]); run += lf; cs[t] = run; }
    tot[seg * 128 + d] = run;
#pragma unroll
    for (int t = 0; t < 8; ++t) *(LAS unsigned*)(vT + d * HG_VS + (seg * 16 + 2 * t) * 2) = r.vp[t];
    __syncthreads();
    float off = 0.f, bl = 0.f;
#pragma unroll
    for (int s = 0; s < 4; ++s) { const float tv = tot[s * 128 + d]; bl += tv; if (s < seg) off += tv; }
#pragma unroll
    for (int t = 0; t < 8; ++t) { const float k0 = kv[2 * t] * __expf(bl - (cs[2 * t] + off)), k1 = kv[2 * t + 1] * __expf(bl - (cs[2 * t + 1] + off));
        *(LAS unsigned*)(kT + d * HG_VS + (seg * 16 + 2 * t) * 2) = pk2(k0, k1); }
    if (seg == 0) DEC[(size_t)unit * 128 + d] = __expf(bl);
    __syncthreads();
    const int l31 = lane & 31, h5 = lane >> 5, mt = wave >> 1;
    f32x16 acc[2];
#pragma unroll
    for (int r2 = 0; r2 < 16; ++r2) { acc[0][r2] = 0.f; acc[1][r2] = 0.f; }
#pragma unroll
    for (int ks = 0; ks < 4; ++ks) {
        const bf16x8 a = *(const LAS bf16x8*)(vT + (32 * mt + l31) * HG_VS + (16 * ks + 8 * h5) * 2);
#pragma unroll
        for (int q = 0; q < 2; ++q) { const int nt = 2 * (wave & 1) + q; const bf16x8 bb = *(const LAS bf16x8*)(kT + (32 * nt + l31) * HG_VS + (16 * ks + 8 * h5) * 2); acc[q] = MFMA32(a, bb, acc[q]); }
    }
    float* so = SLOC + (size_t)unit * 16384;
#pragma unroll
    for (int q = 0; q < 2; ++q) { const int nt = 2 * (wave & 1) + q;
#pragma unroll
        for (int r2 = 0; r2 < 16; ++r2) { const int v = 32 * mt + (r2 & 3) + 8 * (r2 >> 2) + 4 * h5; so[(size_t)v * 128 + 32 * nt + l31] = acc[q][r2]; } }
    __syncthreads();
}
__device__ __forceinline__ void hgrn_a_all(const bf16* __restrict__ P, const float* __restrict__ lb, float* __restrict__ SLOC, float* __restrict__ DEC, LAS unsigned char* lds, int bx, int G, int tid, int lane, int wave) {
    HgA ra, rb; int u = bx;
    if (u < 1024) hgrn_a_load(P, u, tid, ra);
    while (u < 1024) {
        const int u2 = u + G, u3 = u2 + G;
        if (u2 < 1024) hgrn_a_load(P, u2, tid, rb);
        hgrn_a_compute(ra, lb, SLOC, DEC, lds, u, tid, lane, wave);
        if (u2 >= 1024) break;
        if (u3 < 1024) hgrn_a_load(P, u3, tid, ra);
        hgrn_a_compute(rb, lb, SLOC, DEC, lds, u2, tid, lane, wave);
        u = u3;
    }
}
__device__ __forceinline__ void hgrn_scan_unit(const float* __restrict__ SLOC, const float* __restrict__ DEC, bf16* __restrict__ ST, int unit, int tid) {
    asm volatile("" : "+v"(tid));
    const int bh = unit >> 3, idx = (unit & 7) * 2048 + tid * 4, d = idx & 127;
    f32x4 st = {0.f, 0.f, 0.f, 0.f};
    const float* sp = SLOC + (size_t)bh * 32 * 16384 + idx; const float* dp = DEC + (size_t)bh * 32 * 128 + d; bf16* op = ST + (size_t)bh * 32 * 16384 + idx;
#pragma unroll 1
    for (int cb = 0; cb < 32; cb += 16) {
        f32x4 sl[16], dc[16];
#pragma unroll
        for (int c = 0; c < 16; ++c) { sl[c] = *(const GAS f32x4*)(sp + (size_t)(cb + c) * 16384); dc[c] = *(const GAS f32x4*)(dp + (cb + c) * 128); }
#pragma unroll
        for (int c = 0; c < 16; ++c) {
            v2u o; o.x = pk2(st[0], st[1]); o.y = pk2(st[2], st[3]);
            *(GAS v2u*)(op + (size_t)(cb + c) * 16384) = o;
            st = dc[c] * st + sl[c];
        }
    }
}
__device__ __forceinline__ void hgrn_c_unit(const bf16* __restrict__ P, const float* __restrict__ lb, const bf16* __restrict__ ST, const float* __restrict__ og, bf16* __restrict__ BR, LAS unsigned char* lds, int unit, int tid, int lane, int wave) {
    asm volatile("" : "+v"(tid), "+v"(lane));
    const int bh = unit >> 5, c = unit & 31, b = bh >> 2, h = bh & 3, tok0 = b * S + c * 64;
    LAS float* bcum = (LAS float*)lds;
    LAS unsigned char* q0 = lds + 32768;
    LAS unsigned char* qi = q0 + 64 * HG_QS;
    LAS unsigned char* kr = qi + 64 * HG_QS;
    LAS unsigned char* vT = kr + 64 * HG_QS;
    LAS unsigned char* at = vT + 128 * HG_VS;
    LAS float* tot = (LAS float*)(at + 64 * HG_VS);
    LAS float* ob = (LAS float*)lds;
    const int d = tid & 127, seg = tid >> 7;
    const int l31 = lane & 31, h5 = lane >> 5, mtw = wave >> 2, ntw = wave & 3;
    unsigned zq[16], vp[8]; v4u gq0, gq1; bf16x8 stf[8];
    {
        const bf16* pz = P + (size_t)(tok0 + seg * 16) * INP + C_HF + h * 128 + d;
        const bf16* pq = P + (size_t)(tok0 + seg * 16) * INP + C_HQ + h * 128 + d;
        const bf16* pv = P + (size_t)(tok0 + seg * 16) * INP + C_HI + h * 128 + d;
#pragma unroll
        for (int t = 0; t < 16; ++t) zq[t] = (unsigned)pz[(size_t)t * INP] | ((unsigned)pq[(size_t)t * INP] << 16);
#pragma unroll
        for (int t = 0; t < 8; ++t) vp[t] = (unsigned)pv[(size_t)(2 * t) * INP] | ((unsigned)pv[(size_t)(2 * t + 1) * INP] << 16);
        const bf16* pg = P + (size_t)(tok0 + (tid >> 3)) * INP + C_HG + h * 128 + (tid & 7) * 16;
        gq0 = *(const GAS v4u*)pg; gq1 = *(const GAS v4u*)(pg + 8);
        if (c > 0) { const bf16* sp = ST + (size_t)unit * 16384 + (size_t)(32 * ntw + l31) * 128 + 8 * h5;
#pragma unroll
            for (int ks = 0; ks < 8; ++ks) stf[ks] = *(const GAS bf16x8*)(sp + 16 * ks); }
        else {
#pragma unroll
            for (int ks = 0; ks < 8; ++ks) stf[ks] = (bf16x8){0, 0, 0, 0, 0, 0, 0, 0}; }
    }
    {
        const float lbv = lb[h * 128 + d], l1 = __logf(1.f - lbv), l2 = (lbv > 0.f) ? __logf(lbv) : -INFINITY;
        float cs[16], kv[16]; float run = 0.f;
#pragma unroll
        for (int t = 0; t < 16; ++t) { float lf; hgrn_gate(bflo(zq[t]), lbv, l1, l2, lf, kv[t]); run += lf; cs[t] = run; }
        tot[seg * 128 + d] = run;
#pragma unroll
        for (int t = 0; t < 8; ++t) *(LAS unsigned*)(vT + d * HG_VS + (seg * 16 + 2 * t) * 2) = vp[t];
        for (int i = tid; i < 64 * HG_VS / 4; i += 512) ((LAS unsigned*)at)[i] = 0u;
        __syncthreads();
        float off = 0.f;
#pragma unroll
        for (int s = 0; s < 4; ++s) { const float tv = tot[s * 128 + d]; if (s < seg) off += tv; }
#pragma unroll
        for (int t = 0; t < 16; ++t) { const int tt = seg * 16 + t; const float qv = bfhi(zq[t]);
            bcum[tt * 128 + d] = cs[t] + off;
            *(LAS bf16*)(q0 + tt * HG_QS + d * 2) = f2bf_hw(qv * __expf(cs[t] + off));
            *(LAS bf16*)(qi + tt * HG_QS + d * 2) = f2bf_hw(qv * __expf(cs[t]));
            *(LAS bf16*)(kr + tt * HG_QS + d * 2) = f2bf_hw(kv[t]); }
    }
    __syncthreads();
    {
        const int l15 = lane & 15, g4 = lane >> 4;
#pragma unroll 1
        for (int blk = wave; blk < 10; blk += 8) {
            const int i = (blk >= 6) ? 3 : (blk >= 3) ? 2 : (blk >= 1) ? 1 : 0, j = blk - ((i * (i + 1)) >> 1);
            f32x4 acc = {0.f, 0.f, 0.f, 0.f};
#pragma unroll
            for (int ks = 0; ks < 4; ++ks) {
                const int dd = 32 * ks + 8 * g4;
                const bf16x8 a = *(const LAS bf16x8*)(qi + (16 * i + l15) * HG_QS + dd * 2);
                const v4u kw = *(const LAS v4u*)(kr + (16 * j + l15) * HG_QS + dd * 2);
                const f32x4 b0 = *(const LAS f32x4*)(bcum + (16 * j + l15) * 128 + dd), b1 = *(const LAS f32x4*)(bcum + (16 * j + l15) * 128 + dd + 4);
                f32x4 r0 = {0.f, 0.f, 0.f, 0.f}, r1 = {0.f, 0.f, 0.f, 0.f};
                if (i > 0) { r0 = *(const LAS f32x4*)(bcum + (16 * i - 1) * 128 + dd); r1 = *(const LAS f32x4*)(bcum + (16 * i - 1) * 128 + dd + 4); }
                union { bf16x8 v; unsigned u[4]; } kf;
                kf.u[0] = pk2(bflo(kw.x) * __expf(r0[0] - b0[0]), bfhi(kw.x) * __expf(r0[1] - b0[1])); kf.u[1] = pk2(bflo(kw.y) * __expf(r0[2] - b0[2]), bfhi(kw.y) * __expf(r0[3] - b0[3]));
                kf.u[2] = pk2(bflo(kw.z) * __expf(r1[0] - b1[0]), bfhi(kw.z) * __expf(r1[1] - b1[1])); kf.u[3] = pk2(bflo(kw.w) * __expf(r1[2] - b1[2]), bfhi(kw.w) * __expf(r1[3] - b1[3]));
                acc = MFMA16(a, kf.v, acc);
            }
#pragma unroll
            for (int r = 0; r < 4; ++r) { const int tl = 4 * g4 + r; float v = acc[r]; if (i == j && l15 > tl) v = 0.f; *(LAS bf16*)(at + (16 * i + tl) * HG_VS + (16 * j + l15) * 2) = f2bf_hw(v); }
        }
    }
    __syncthreads();
    {
        const int mt = mtw, nt = ntw;
        f32x16 acc;
#pragma unroll
        for (int r = 0; r < 16; ++r) acc[r] = 0.f;
#pragma unroll
        for (int ks = 0; ks < 4; ++ks) { const bf16x8 a = *(const LAS bf16x8*)(at + (32 * mt + l31) * HG_VS + (16 * ks + 8 * h5) * 2), bb = *(const LAS bf16x8*)(vT + (32 * nt + l31) * HG_VS + (16 * ks + 8 * h5) * 2); acc = MFMA32(a, bb, acc); }
        if (c > 0) {
#pragma unroll
            for (int ks = 0; ks < 8; ++ks) { const bf16x8 a = *(const LAS bf16x8*)(q0 + (32 * mt + l31) * HG_QS + (16 * ks + 8 * h5) * 2); acc = MFMA32(a, stf[ks], acc); } }
        __syncthreads();
#pragma unroll
        for (int r = 0; r < 16; ++r) { const int t = 32 * mt + (r & 3) + 8 * (r >> 2) + 4 * h5; ob[t * 132 + 32 * nt + l31] = acc[r]; }
    }
    __syncthreads();
    {
        const int t = tid >> 3, v0 = (tid & 7) * 16;
        f32x4 o4[4]; float ss = 0.f;
#pragma unroll
        for (int q = 0; q < 4; ++q) { o4[q] = *(const LAS f32x4*)(ob + t * 132 + v0 + 4 * q); ss += (o4[q][0] * o4[q][0] + o4[q][1] * o4[q][1]) + (o4[q][2] * o4[q][2] + o4[q][3] * o4[q][3]); }
        ss += __shfl_xor(ss, 1); ss += __shfl_xor(ss, 2); ss += __shfl_xor(ss, 4);
        const float rstd = rsqrtf(ss * (1.f / 128.f) + EPS);
        const v4u g0 = gq0, g1 = gq1;
        float gv[16]; gv[0] = bflo(g0.x); gv[1] = bfhi(g0.x); gv[2] = bflo(g0.y); gv[3] = bfhi(g0.y); gv[4] = bflo(g0.z); gv[5] = bfhi(g0.z); gv[6] = bflo(g0.w); gv[7] = bfhi(g0.w);
        gv[8] = bflo(g1.x); gv[9] = bfhi(g1.x); gv[10] = bflo(g1.y); gv[11] = bfhi(g1.y); gv[12] = bflo(g1.z); gv[13] = bfhi(g1.z); gv[14] = bflo(g1.w); gv[15] = bfhi(g1.w);
        float ov[16];
#pragma unroll
        for (int q = 0; q < 4; ++q) { const f32x4 gn = *(const GAS f32x4*)(og + v0 + 4 * q);
#pragma unroll
            for (int jj = 0; jj < 4; ++jj) { const float gg = gv[4 * q + jj]; ov[4 * q + jj] = o4[q][jj] * rstd * gn[jj] * gg * __builtin_amdgcn_rcpf(1.f + __expf(-gg)); } }
        v4u w0, w1; w0.x = pk2(ov[0], ov[1]); w0.y = pk2(ov[2], ov[3]); w0.z = pk2(ov[4], ov[5]); w0.w = pk2(ov[6], ov[7]); w1.x = pk2(ov[8], ov[9]); w1.y = pk2(ov[10], ov[11]); w1.z = pk2(ov[12], ov[13]); w1.w = pk2(ov[14], ov[15]);
        bf16* po = BR + (size_t)(tok0 + t) * 1536 + h * 128 + v0;
        *(GAS v4u*)po = w0; *(GAS v4u*)(po + 8) = w1;
    }
    __syncthreads();
}
constexpr int NWAVES = 8, NTHR = 512;
constexpr int RING_OFF = 0, RING_BYTES = 131072, LDSCTL_OFF = RING_BYTES, LDS_BYTES = 147456;
constexpr int LW_BAR = 0, LW_TP = 16, LW_CNT = 64, LW_LCNT = 96, LW_BASE = 128, LW_ENTE = 256, LW_ENTW = 512, LW_RANK = 768, LW_BIAS = 1024;
constexpr int CW_Q = 1024, CW_PD = 1088;
constexpr int LW_CONV = 8;
constexpr int CW_BAR = 4096;
constexpr int NPH_L = 10, PH_FINAL = 1 + L * NPH_L, NPH = PH_FINAL + 1;

struct MkArgs { const void* in[28]; float* out; unsigned char* ws; float invf[16]; int ph_lo, ph_hi, li, pad; };
typedef const MkArgs __attribute__((address_space(4))) CMkArgs;
#define KA_PTR(name) CMkArgs* name = (CMkArgs*)__builtin_amdgcn_kernarg_segment_ptr(); asm volatile("" : "+s"(name))

using pg8::Unit; using pg8::u32x4; using pg8::cvt_pk_bf16;
constexpr int GATE_TILE0 = 13;
__device__ __forceinline__ size_t gt_off(int g, int pm, int pn4, int chunk, int tid) { return ((((size_t)(g * 64 + pm) * 4 + pn4) * 16 + chunk) * 512 + tid) * 8; }
struct EpiP {
    static constexpr bool PERM = true; bf16* O; int ldc; bf16* GT;
    __device__ __forceinline__ void prefetch(const Unit&, int, int) const {}
    __device__ __forceinline__ void operator()(const f32x4 (&acc)[2][2][4][2], const Unit& u, int wr, int wc, int fr, int fq) const {
        const int row0 = u.pm * 256 + wr * 64 + fr, col0 = u.pn * 256 + wc * 32 + 8 * fq;
        const bool gate = (GT != nullptr) && u.pn >= GATE_TILE0; const int gi = (u.pn - GATE_TILE0) >> 2, pn4 = (u.pn - GATE_TILE0) & 3, tid = (wr * 4 + wc) * 64 + fq * 16 + fr;
#pragma unroll
        for (int ai = 0; ai < 2; ++ai)
#pragma unroll
            for (int m = 0; m < 4; ++m) { bf16* rowp = O + (size_t)(row0 + ai * 128 + m * 16) * ldc + col0;
#pragma unroll
                for (int bj = 0; bj < 2; ++bj) { f32x4 v0 = acc[ai][bj][m][0], v1 = acc[ai][bj][m][1];
                    u32x4 w; w.x = cvt_pk_bf16(v0[0], v0[1]); w.y = cvt_pk_bf16(v0[2], v0[3]); w.z = cvt_pk_bf16(v1[0], v1[1]); w.w = cvt_pk_bf16(v1[2], v1[3]);
                    if (gate) *(u32x4*)(GT + gt_off(gi, u.pm, pn4, (ai * 4 + m) * 2 + bj, tid)) = w; else *(u32x4*)(rowp + bj * 128) = w; } }
    }
};
struct EpiBranch {
    static constexpr bool PERM = true; const bf16* GT; bf16* MB;
    __device__ __forceinline__ void prefetch(const Unit&, int, int) const {}
    __device__ __forceinline__ static void unpack8(const u32x4 w, float (&g)[8]) { g[0] = __uint_as_float(w.x << 16); g[1] = __uint_as_float(w.x & 0xffff0000u); g[2] = __uint_as_float(w.y << 16); g[3] = __uint_as_float(w.y & 0xffff0000u);
        g[4] = __uint_as_float(w.z << 16); g[5] = __uint_as_float(w.z & 0xffff0000u); g[6] = __uint_as_float(w.w << 16); g[7] = __uint_as_float(w.w & 0xffff0000u); }
    __device__ __forceinline__ static float em(float x) { return __expf(-fminf(fmaxf(x, -30.f), 30.f)); }
    __device__ __forceinline__ void mid(f32x4 (&acc)[2][2][4][2], const Unit& u, int wr, int wc, int fr, int fq, int t) const {
        asm volatile("" : "+v"(fr), "+v"(fq));
        const int gnum = (t == 8) ? 0 : 1, tid = (wr * 4 + wc) * 64 + fq * 16 + fr;
        const bf16* gn0 = GT + gt_off(gnum, u.pm, u.pn, 0, tid); const bf16* gd0 = GT + gt_off(gnum + 1, u.pm, u.pn, 0, tid);
#pragma unroll
        for (int ai = 0; ai < 2; ++ai)
#pragma unroll
            for (int m = 0; m < 4; ++m)
#pragma unroll
                for (int bj = 0; bj < 2; ++bj) { const int ch = (ai * 4 + m) * 2 + bj; float gn[8], gd[8]; unpack8(*(const u32x4*)(gn0 + (size_t)ch * 4096), gn); unpack8(*(const u32x4*)(gd0 + (size_t)ch * 4096), gd);
#pragma unroll
                    for (int j = 0; j < 4; ++j) { acc[ai][bj][m][0][j] *= (1.f + em(gd[j])) * __builtin_amdgcn_rcpf(1.f + em(gn[j])); acc[ai][bj][m][1][j] *= (1.f + em(gd[4 + j])) * __builtin_amdgcn_rcpf(1.f + em(gn[4 + j])); } }
    }
    __device__ __forceinline__ void operator()(const f32x4 (&acc)[2][2][4][2], const Unit& u, int wr, int wc, int fr, int fq) const {
        const int row0 = u.pm * 256 + wr * 64 + fr, col0 = u.pn * 256 + wc * 32 + 8 * fq, tid = (wr * 4 + wc) * 64 + fq * 16 + fr;
        const bf16* gc0 = GT + gt_off(2, u.pm, u.pn, 0, tid);
#pragma unroll
        for (int ai = 0; ai < 2; ++ai)
#pragma unroll
            for (int m = 0; m < 4; ++m) { const size_t row = (size_t)(row0 + ai * 128 + m * 16);
#pragma unroll
                for (int bj = 0; bj < 2; ++bj) { const int col = col0 + bj * 128; float gc[8]; unpack8(*(const u32x4*)(gc0 + (size_t)((ai * 4 + m) * 2 + bj) * 4096), gc);
                    f32x4 v0 = acc[ai][bj][m][0], v1 = acc[ai][bj][m][1];
#pragma unroll
                    for (int j = 0; j < 4; ++j) { v0[j] *= __builtin_amdgcn_rcpf(1.f + em(gc[j])); v1[j] *= __builtin_amdgcn_rcpf(1.f + em(gc[4 + j])); }
                    u32x4 w; w.x = cvt_pk_bf16(v0[0], v0[1]); w.y = cvt_pk_bf16(v0[2], v0[3]); w.z = cvt_pk_bf16(v1[0], v1[1]); w.w = cvt_pk_bf16(v1[2], v1[3]); *(u32x4*)(MB + row * 1024 + col) = w; } }
    }
};
struct EpiOut {
    static constexpr bool PERM = false; const float* xin; const float* gvec; float* out;
    __device__ __forceinline__ void prefetch(const Unit&, int, int) const {}
    __device__ __forceinline__ void operator()(const f32x4 (&acc)[2][2][4][2], const Unit& u, int wr, int wc, int fr, int fq) const {
        const int row0 = u.pm * 256 + wr * 64 + fr, col0 = u.pn * 256 + wc * 32 + 4 * fq;
#pragma unroll
        for (int ai = 0; ai < 2; ++ai)
#pragma unroll
            for (int m = 0; m < 4; ++m) { const size_t row = (size_t)(row0 + ai * 128 + m * 16); const int b = (int)(row / S);
#pragma unroll
                for (int bj = 0; bj < 2; ++bj)
#pragma unroll
                    for (int n = 0; n < 2; ++n) { const int col = col0 + bj * 128 + 16 * n;
                        const f32x4 xv = *(const f32x4*)(xin + row * 1024 + col), gv = *(const f32x4*)(gvec + b * 6144 + col);
                        *(f32x4*)(out + row * 1024 + col) = xv + gv * acc[ai][bj][m][n]; } }
    }
};
struct EpiMoe1 {
    static constexpr bool PERM = true; const float* b1; bf16* ACT; LAS float* bl;
    typedef float f2 __attribute__((ext_vector_type(2)));
    __device__ __forceinline__ void prefetch(const Unit& u, int wid, int lane) const {
        if (wid < 4) { const float* src = b1 + u.e * 2048 + (wid >> 1) * 1024 + u.aux * 128 + (wid & 1) * 64 + lane;
            __builtin_amdgcn_global_load_lds((const unsigned*)src, (LAS unsigned*)(bl + wid * 64), 4, 0, 0); } }
    __device__ __forceinline__ static f2 act2(f2 g, f2 l) {
        const f2 c7 = {7.f, 7.f}, cm7 = {-7.f, -7.f}, one = {1.f, 1.f}, ck = {-1.702f * 1.4426950408889634f, -1.702f * 1.4426950408889634f};
        g = __builtin_elementwise_min(g, c7); l = __builtin_elementwise_min(__builtin_elementwise_max(l, cm7), c7);
        const f2 x = g * ck; f2 ex; ex.x = __builtin_amdgcn_exp2f(x.x); ex.y = __builtin_amdgcn_exp2f(x.y);
        const f2 d = ex + one; f2 r; r.x = __builtin_amdgcn_rcpf(d.x); r.y = __builtin_amdgcn_rcpf(d.y);
        return (g * r) * (l + one);
    }
    __device__ __forceinline__ void operator()(const f32x4 (&acc)[2][2][4][2], const Unit& u, int wr, int wc, int fr, int fq) const {
        const int row0 = u.pm * 256 + wr * 64 + fr, lc = wc * 32 + 8 * fq, ccol = u.aux * 128 + lc;
        const f32x4 bg0 = *(const LAS f32x4*)(bl + lc), bg1 = *(const LAS f32x4*)(bl + lc + 4), bl0 = *(const LAS f32x4*)(bl + 128 + lc), bl1 = *(const LAS f32x4*)(bl + 128 + lc + 4);
#pragma unroll
        for (int ai = 0; ai < 2; ++ai)
#pragma unroll
            for (int m = 0; m < 4; ++m) { const size_t row = (size_t)(row0 + ai * 128 + m * 16);
                const f32x4 g0 = acc[ai][0][m][0] + bg0, g1 = acc[ai][0][m][1] + bg1, l0 = acc[ai][1][m][0] + bl0, l1 = acc[ai][1][m][1] + bl1;
                const f2 o0 = act2((f2){g0[0], g0[1]}, (f2){l0[0], l0[1]}), o1 = act2((f2){g0[2], g0[3]}, (f2){l0[2], l0[3]}), o2 = act2((f2){g1[0], g1[1]}, (f2){l1[0], l1[1]}), o3 = act2((f2){g1[2], g1[3]}, (f2){l1[2], l1[3]});
                u32x4 w; w.x = cvt_pk_bf16(o0.x, o0.y); w.y = cvt_pk_bf16(o1.x, o1.y); w.z = cvt_pk_bf16(o2.x, o2.y); w.w = cvt_pk_bf16(o3.x, o3.y);
                *(u32x4*)(ACT + row * 1024 + ccol) = w; }
    }
};
struct EpiMoe2 {
    static constexpr bool PERM = true; const float* b2; bf16* EO; LAS float* bl;
    __device__ __forceinline__ void prefetch(const Unit& u, int wid, int lane) const {
        if (wid < 4) __builtin_amdgcn_global_load_lds((const unsigned*)(b2 + u.e * 1024 + u.aux * 256 + wid * 64 + lane), (LAS unsigned*)(bl + wid * 64), 4, 0, 0); }
    __device__ __forceinline__ void operator()(const f32x4 (&acc)[2][2][4][2], const Unit& u, int wr, int wc, int fr, int fq) const {
        const int row0 = u.pm * 256 + wr * 64 + fr, lc = wc * 32 + 8 * fq, col0 = u.aux * 256 + lc;
        f32x4 bv[2][2];
#pragma unroll
        for (int bj = 0; bj < 2; ++bj) { bv[bj][0] = *(const LAS f32x4*)(bl + lc + bj * 128); bv[bj][1] = *(const LAS f32x4*)(bl + lc + bj * 128 + 4); }
#pragma unroll
        for (int ai = 0; ai < 2; ++ai)
#pragma unroll
            for (int m = 0; m < 4; ++m) { bf16* rowp = EO + (size_t)(row0 + ai * 128 + m * 16) * 1024 + col0;
#pragma unroll
                for (int bj = 0; bj < 2; ++bj) { const f32x4 v0 = acc[ai][bj][m][0] + bv[bj][0], v1 = acc[ai][bj][m][1] + bv[bj][1];
                    u32x4 w; w.x = cvt_pk_bf16(v0[0], v0[1]); w.y = cvt_pk_bf16(v0[2], v0[3]); w.z = cvt_pk_bf16(v1[0], v1[1]); w.w = cvt_pk_bf16(v1[2], v1[3]);
                    *(u32x4*)(rowp + bj * 128) = w; } }
    }
};
struct MoeOrder {
    const LAS int* tp; const LAS int* cn; int NTn, G, c, rev;
    __device__ __forceinline__ bool next(int i, Unit& u) const {
        const int total = tp[32] * NTn; int Lx;
        if ((G & 7) == 0) { const int x = c & 7, j = c >> 3, lo = (int)(((long)total * x) >> 3), hi = (int)(((long)total * (x + 1)) >> 3); Lx = lo + i * (G >> 3) + j; if (Lx >= hi) return false;
            if (rev) Lx = hi - 1 - (Lx - lo); }
        else { Lx = i * G + c; if (Lx >= total) return false; }
        int e = 0;
        for (int q = 1; q < 32; ++q) if (Lx >= tp[q] * NTn) e = q;
        const int t0 = tp[e], r = Lx - t0 * NTn, mt = r / NTn, nt = r - mt * NTn;
        u.pm = __builtin_amdgcn_readfirstlane(t0 + mt); u.pn = __builtin_amdgcn_readfirstlane(e * NTn + nt); u.ka = 0; u.aux = __builtin_amdgcn_readfirstlane(nt); u.e = __builtin_amdgcn_readfirstlane(e);
        u.gbase = __builtin_amdgcn_readfirstlane(e * CAP + mt * 256); u.gcnt = __builtin_amdgcn_readfirstlane(cn[e] - mt * 256); u.pad = 0;
        return true;
    }
};
struct TrItem { const float* W; bf16* WT; int K, N, mode, row_off, ldk, koff, k0, n0; };
__device__ __forceinline__ void tr_load(const TrItem& t, float (&wv)[32], int lane) {
#pragma unroll
    for (int i = 0; i < 32; ++i) wv[i] = t.W[(size_t)(t.k0 + 2 * i + (lane >> 5)) * t.N + t.n0 + (lane & 31)];
}
__device__ __forceinline__ void tr_store(const TrItem& t, const float (&wv)[32], LAS float* scr, int lane) {
#pragma unroll
    for (int i = 0; i < 32; ++i) scr[(2 * i + (lane >> 5)) * 33 + (lane & 31)] = wv[i];
    LDS_WAIT(); asm volatile("" ::: "memory");
    const int c = lane & 7;
#pragma unroll
    for (int j = 0; j < 4; ++j) { const int n = (lane >> 3) + 8 * j; const LAS float* s = scr + (8 * c) * 33 + n;
        v4u o; o.x = pk2(s[0 * 33], s[1 * 33]); o.y = pk2(s[2 * 33], s[3 * 33]); o.z = pk2(s[4 * 33], s[5 * 33]); o.w = pk2(s[6 * 33], s[7 * 33]);
        const int nn = t.n0 + n; int r = nn; if (t.mode == 1) { const int half = nn >> 10, cc = nn & 1023; r = (cc >> 7) * 256 + half * 128 + (cc & 127); }
        if (t.mode == 2) r = (nn < 3232) ? nn : nn + 96;
        *(GAS v4u*)(t.WT + (size_t)(t.row_off + r) * t.ldk + t.koff + t.k0 + 8 * c) = o; }
    LDS_WAIT(); asm volatile("" ::: "memory");
}
constexpr int TI_IN = 16 * 197, TI_UQ = 6 * 24, TI_UKV = 4 * 32, TI_BR = 8 * 32, TI_OUT = 16 * 32, TI_E1 = 16 * 64, TI_E2 = 16 * 32;
constexpr int TA0 = TI_IN, TA1 = TA0 + TI_UQ, TA2 = TA1 + TI_UKV, TA3 = TA2 + TI_BR, TA4 = TA3 + TI_BR, TA5 = TA4 + TI_OUT, TA6 = TA5 + NE * TI_E1, TA7 = TA6 + NE * TI_E2, TR_NTOT = L * TA7, CONV_B = 16;
static_assert(L == 2 && TR_NTOT % CONV_B == 0 && TA5 % CONV_B == 0 && TA6 % CONV_B == 0 && TA7 % CONV_B == 0, "conversion queue layout");
__device__ __forceinline__ void tr_setup(CMkArgs* ap, int it, TrItem& t) {
    unsigned char* ws = ap->ws;
    const int l = it >= TA7 ? 1 : 0; int r = it - l * TA7, q;
    if (r < TA0) { q = r; t = TrItem{(const float*)ap->in[7] + (size_t)l * 1024 * INW, (bf16*)(ws + WS_WINT) + (size_t)l * INP * 1024, 1024, INW, 2, 0, 1024, 0, 0, 0}; }
    else if (r < TA1) { q = r - TA0; t = TrItem{(const float*)ap->in[12] + (size_t)l * 384 * 768, (bf16*)(ws + WS_WUQT) + (size_t)l * 768 * 384, 384, 768, 0, 0, 384, 0, 0, 0}; }
    else if (r < TA2) { q = r - TA1; t = TrItem{(const float*)ap->in[13] + (size_t)l * 256 * 1024, (bf16*)(ws + WS_WUKVT) + (size_t)l * 1024 * 256, 256, 1024, 0, 0, 256, 0, 0, 0}; }
    else if (r < TA3) { q = r - TA2; t = TrItem{(const float*)ap->in[18] + (size_t)l * 512 * 1024, (bf16*)(ws + WS_WBRT) + (size_t)l * 1024 * 1536, 512, 1024, 0, 0, 1536, 0, 0, 0}; }
    else if (r < TA4) { q = r - TA3; t = TrItem{(const float*)ap->in[19] + (size_t)l * 512 * 1024, (bf16*)(ws + WS_WBRT) + (size_t)l * 1024 * 1536, 512, 1024, 0, 0, 1536, 512, 0, 0}; }
    else if (r < TA5) { q = r - TA4; t = TrItem{(const float*)ap->in[21] + (size_t)l * 1024 * 1024, (bf16*)(ws + WS_WOUTT) + (size_t)l * 1024 * 1024, 1024, 1024, 0, 0, 1024, 0, 0, 0}; }
    else if (r < TA6) { r -= TA5; const int e = r / TI_E1; q = r - e * TI_E1; const int b = l * NE + e; t = TrItem{(const float*)ap->in[24] + (size_t)b * 1024 * 2048, (bf16*)(ws + WS_W1T) + (size_t)b * 2048 * 1024, 1024, 2048, 1, 0, 1024, 0, 0, 0}; }
    else { r -= TA6; const int e = r / TI_E2; q = r - e * TI_E2; const int b = l * NE + e; t = TrItem{(const float*)ap->in[26] + (size_t)b * 1024 * 1024, (bf16*)(ws + WS_W2T) + (size_t)b * 1024 * 1024, 1024, 1024, 0, 0, 1024, 0, 0, 0}; }
    const int nblk = t.N / 32, kb = q / nblk; t.k0 = 64 * kb; t.n0 = 32 * (q - kb * nblk);
}
__device__ __forceinline__ void conv_service(CMkArgs* ap, LAS unsigned char* lds, int tid, int lane, int wave, unsigned need, const unsigned* stop, unsigned stop_val) {
    asm volatile("" : "+v"(tid), "+v"(lane));
    unsigned* qh = (unsigned*)(ap->ws + WS_CTL) + CW_Q;
    LAS unsigned* slot = (LAS unsigned*)(lds + LDSCTL_OFF) + LW_CONV;
    LAS float* scr = (LAS float*)(lds + wave * 8448);
#if defined(MK_NOBG) && MK_NOBG
    stop = nullptr;
#endif
    const bool pre = (stop == nullptr);
    unsigned nxt = 0xFFFFFFFFu;
#define CONV_CLAIM() do { nxt = 0xFFFFFFFFu; \
        const bool go_ = stop != nullptr && __hip_atomic_load(stop, __ATOMIC_RELAXED, __HIP_MEMORY_SCOPE_AGENT) < stop_val; \
        if (go_ || __hip_atomic_load(qh, __ATOMIC_RELAXED, __HIP_MEMORY_SCOPE_AGENT) < need) { const unsigned i_ = __hip_atomic_fetch_add(qh, (unsigned)CONV_B, __ATOMIC_RELAXED, __HIP_MEMORY_SCOPE_AGENT); if (i_ < (unsigned)TR_NTOT) nxt = i_; } } while (0)
#define CONV_NEXT(dst, n_) do { if (tid == 0) { if (pre) { slot[(n_) & 1] = nxt; if (nxt != 0xFFFFFFFFu) CONV_CLAIM(); } else { CONV_CLAIM(); slot[(n_) & 1] = nxt; } } \
        __syncthreads(); dst = __builtin_amdgcn_readfirstlane(slot[(n_) & 1]); } while (0)
#define CONV_LOAD(idx_, t0, t1, v0, v1) do { tr_setup(ap, (int)(idx_) + wave, t0); tr_load(t0, v0, lane); tr_setup(ap, (int)(idx_) + 8 + wave, t1); tr_load(t1, v1, lane); } while (0)
    if (pre && tid == 0) CONV_CLAIM();
    unsigned ia, ib; TrItem ta0, ta1, tb0, tb1; float va0[32], va1[32], vb0[32], vb1[32];
    CONV_NEXT(ia, 0);
    if (ia != 0xFFFFFFFFu) {
        CONV_LOAD(ia, ta0, ta1, va0, va1);
        for (int n = 1;; n += 2) {
            CONV_NEXT(ib, n);
            if (ib != 0xFFFFFFFFu) CONV_LOAD(ib, tb0, tb1, vb0, vb1);
            tr_store(ta0, va0, scr, lane); tr_store(ta1, va1, scr, lane);
            if (ib == 0xFFFFFFFFu) break;
            CONV_NEXT(ia, n + 1);
            if (ia != 0xFFFFFFFFu) CONV_LOAD(ia, ta0, ta1, va0, va1);
            tr_store(tb0, vb0, scr, lane); tr_store(tb1, vb1, scr, lane);
            if (ia == 0xFFFFFFFFu) break;
        }
    }
#undef CONV_NEXT
#undef CONV_LOAD
#undef CONV_CLAIM
}
__device__ __forceinline__ void phase_prologue(CMkArgs* ap, LAS unsigned char* lds, int tid, int lane, int wave, int G, int bx) {
    asm volatile("" : "+v"(tid), "+v"(lane));
    unsigned char* ws = ap->ws;
    const float* c = (const float*)ap->in[1]; const int* pos = (const int*)ap->in[2]; const float* ada_w = (const float*)ap->in[3]; const float* ada_b = (const float*)ap->in[4];
    const float* w_in = (const float*)ap->in[7]; const float* hgrn_lb = (const float*)ap->in[8]; const float* w_uq = (const float*)ap->in[12]; const float* w_ukv = (const float*)ap->in[13];
    const float* w_pool = (const float*)ap->in[16]; const float* pool_scale = (const float*)ap->in[17]; const float* w_br_a = (const float*)ap->in[18]; const float* w_br_b = (const float*)ap->in[19]; const float* w_br_c = (const float*)ap->in[20];
    const float* w_out = (const float*)ap->in[21]; const float* w_exp1 = (const float*)ap->in[24]; const float* w_exp2 = (const float*)ap->in[26];
    float* mod = (float*)(ws + WS_MOD); float* lb = (float*)(ws + WS_LB); float* rope = (float*)(ws + WS_ROPE);
    bf16 *WinT = (bf16*)(ws + WS_WINT), *WuqT = (bf16*)(ws + WS_WUQT), *WukvT = (bf16*)(ws + WS_WUKVT), *WbrT = (bf16*)(ws + WS_WBRT), *WoutT = (bf16*)(ws + WS_WOUTT), *W1T = (bf16*)(ws + WS_W1T), *W2T = (bf16*)(ws + WS_W2T);
    if (bx < 192) {
        LAS float* cs = (LAS float*)(lds + 67584);
        LAS float* part = (LAS float*)(lds + 100352);
        for (int i = tid; i < 8192; i += NTHR) { const float v = c[i]; cs[i] = v / (1.f + __expf(-v)); }
        __syncthreads();
        for (int u = bx; u < 192; u += G) {
            const int l = u / 96, j = (u - l * 96) * 64 + lane;
            const float* w = ada_w + (size_t)l * 1024 * 6144 + (size_t)(wave * 128) * 6144 + j;
            float acc[8];
#pragma unroll
            for (int b = 0; b < 8; ++b) acc[b] = 0.f;
#pragma unroll 16
            for (int k = 0; k < 128; ++k) { const float wv = w[(size_t)k * 6144];
#pragma unroll
                for (int b = 0; b < 8; ++b) acc[b] += cs[b * 1024 + wave * 128 + k] * wv; }
#pragma unroll
            for (int b = 0; b < 8; ++b) part[(wave * 8 + b) * 64 + lane] = acc[b];
            __syncthreads();
            { const int b = tid >> 6; float s = 0.f;
#pragma unroll
              for (int w8 = 0; w8 < 8; ++w8) s += part[(w8 * 8 + b) * 64 + lane];
              mod[(size_t)l * 8 * 6144 + b * 6144 + j] = s + ada_b[l * 6144 + j]; }
            __syncthreads();
        }
        if (tid == 0) __hip_atomic_fetch_add((unsigned*)(ws + WS_CTL) + CW_PD, 1u, __ATOMIC_RELAXED, __HIP_MEMORY_SCOPE_AGENT);
    }
    const int gw = bx * NWAVES + wave, NGW = G * NWAVES, gt = bx * NTHR + tid, NGT = G * NTHR;
    for (int i = gt; i < 512; i += NGT) { const float p = hgrn_lb[i], q = hgrn_lb[512 + i]; const float m = fmaxf(p, q); const float ea = __expf(p - m), eb = __expf(q - m); lb[i] = 0.f; lb[512 + i] = eb / (ea + eb); }
    for (int i = gt; i < NT * 16; i += NGT) { const int t = i >> 4, j = i & 15; float fv = ap->invf[0];
#pragma unroll
        for (int q = 1; q < 16; ++q) if (j == q) fv = ap->invf[q];
        const double ang = (double)pos[t] * (double)fv; double r = ang * 0.15915494309189535; r -= floor(r + 0.5); const float an = (float)(r * 6.283185307179586);
        rope[i] = __cosf(an); rope[NT * 16 + i] = __sinf(an); }
    for (int i = gt; i < L * 96 * 128; i += NGT) { const int l = i / (96 * 128), r = i - l * 96 * 128; *(GAS v4u*)(WinT + (size_t)l * INP * 1024 + (size_t)3232 * 1024 + (size_t)r * 8) = (v4u){0u, 0u, 0u, 0u}; }
    for (int task = gw; task < L * 1024; task += NGW) {
        const int l = task >> 10, g = (task >> 8) & 3, nb = (task >> 4) & 15, c0 = (task & 15) * 8;
        const float* wb = w_br_c + (size_t)l * 512 * 1024 + (size_t)g * 128 * 1024 + nb * 64 + lane; const float* sc = pool_scale + l * 512 + g * 128;
        const float* wp = w_pool + ((size_t)l * 4 + g) * 128 * 128 + (size_t)c0 * 128;
        float acc[8];
#pragma unroll
        for (int q = 0; q < 8; ++q) acc[q] = 0.f;
#pragma unroll 16
        for (int d = 0; d < 128; ++d) { const float w = wb[(size_t)d * 1024] * sc[d];
#pragma unroll
            for (int q = 0; q < 8; ++q) acc[q] += wp[q * 128 + d] * w; }
        v4u o; o.x = pk2(acc[0], acc[1]); o.y = pk2(acc[2], acc[3]); o.z = pk2(acc[4], acc[5]); o.w = pk2(acc[6], acc[7]);
        *(GAS v4u*)(WbrT + (size_t)l * 1024 * 1536 + (size_t)(nb * 64 + lane) * 1536 + 1024 + g * 128 + c0) = o;
    }
    conv_service(ap, lds, tid, lane, wave, (unsigned)TA5, bx >= 192 ? (const unsigned*)(ws + WS_CTL) + CW_PD : nullptr, (unsigned)(G < 192 ? G : 192));
}

template <int MODE>
__device__ __forceinline__ void phase_rows(const float* xin, float* xout, const float* gain, const float* mod_sh, const float* mod_sc, const float* mod_g2, bf16* HN,
                                           const bf16* EO, const int* tokE, const int* tokS, const float* tokW, const LAS int* tp, int lane, int gw, int NGW) {
    asm volatile("" : "+v"(lane));
    for (int row = gw; row < NT; row += NGW) {
        const int b = row / S;
        const GAS f32x4* xr = (const GAS f32x4*)(xin + (size_t)row * D);
        f32x4 v[4];
#pragma unroll
        for (int j = 0; j < 4; ++j) v[j] = xr[lane + 64 * j];
        if (MODE != 0) {
            f32x4 acc[4];
#pragma unroll
            for (int j = 0; j < 4; ++j) acc[j] = (f32x4){0.f, 0.f, 0.f, 0.f};
#pragma unroll
            for (int k = 0; k < 4; ++k) { const int e = tokE[row * 4 + k]; const size_t r = (size_t)tp[e] * 256 + tokS[row * 4 + k]; const float w = tokW[row * 4 + k];
                const GAS v2u* er = (const GAS v2u*)(EO + r * 1024);
#pragma unroll
                for (int j = 0; j < 4; ++j) { const v2u ev = er[lane + 64 * j];
                    acc[j][0] += w * __uint_as_float(ev.x << 16); acc[j][1] += w * __uint_as_float(ev.x & 0xffff0000u); acc[j][2] += w * __uint_as_float(ev.y << 16); acc[j][3] += w * __uint_as_float(ev.y & 0xffff0000u); } }
#pragma unroll
            for (int j = 0; j < 4; ++j) { const f32x4 gg = *(const GAS f32x4*)(mod_g2 + b * 6144 + (lane + 64 * j) * 4); v[j] = v[j] + gg * acc[j]; *(GAS f32x4*)(xout + (size_t)row * D + (lane + 64 * j) * 4) = v[j]; }
        }
        if (MODE != 2) {
            float ss = 0.f;
#pragma unroll
            for (int j = 0; j < 4; ++j) ss += (v[j][0] * v[j][0] + v[j][1] * v[j][1]) + (v[j][2] * v[j][2] + v[j][3] * v[j][3]);
            const float rstd = rsqrtf(wave_sum(ss) * (1.f / D) + EPS);
#pragma unroll
            for (int j = 0; j < 4; ++j) { const int cc = (lane + 64 * j) * 4; const f32x4 gg = *(const GAS f32x4*)(gain + cc), sh = *(const GAS f32x4*)(mod_sh + b * 6144 + cc), sc = *(const GAS f32x4*)(mod_sc + b * 6144 + cc);
                const f32x4 h = v[j] * rstd * gg * (sc + 1.f) + sh; v2u o; o.x = pk2(h[0], h[1]); o.y = pk2(h[2], h[3]);
                *(GAS v2u*)(HN + (size_t)row * D + cc) = o; }
        }
    }
}
__device__ __forceinline__ void load_tp(const int* cnt, LAS int* tp, LAS int* cn, int tid) {
    if (tid < 32) cn[tid] = __hip_atomic_load(cnt + tid, __ATOMIC_RELAXED, __HIP_MEMORY_SCOPE_AGENT);
    __syncthreads();
    if (tid == 0) { int acc = 0; tp[0] = 0;
        for (int q = 0; q < 32; ++q) { acc += (cn[q] + 255) >> 8; tp[q + 1] = acc; } }
    __syncthreads();
}

__device__ __forceinline__ void phase_router(const float* x1, const float* gain, const float* mod_sh, const float* mod_sc, const float* wr, const float* br, bf16* hn2, int* cnt, int* list, int* tokE, int* tokS, float* tokW,
                                             LAS unsigned char* lds, int tid, int lane, int wave, int G, int bx) {
    asm volatile("" : "+v"(tid), "+v"(lane));
    LAS float* tile = (LAS float*)(lds + RING_OFF);
    LAS int* lw = (LAS int*)(lds + LDSCTL_OFF);
    LAS int* entE = lw + LW_ENTE; LAS float* entW = (LAS float*)(lw + LW_ENTW); LAS int* rank = lw + LW_RANK; LAS int* lcnt = lw + LW_LCNT; LAS int* base = lw + LW_BASE;
    const int l31 = lane & 31, h5 = lane >> 5;
    float breg[64];
#pragma unroll
    for (int j = 0; j < 64; ++j) breg[j] = wr[(size_t)(128 * wave + 2 * j + h5) * 32 + l31];
    if (tid < 32) lcnt[tid] = 0;
    __syncthreads();
    for (int bt = bx; bt < NT / 64; bt += G) {
#pragma unroll 1
      for (int hb = 0; hb < 2; ++hb) {
        const int row0 = bt * 64 + hb * 32 + wave * 4, b = row0 / S;
        int ln = lane; asm volatile("" : "+v"(ln));
#pragma unroll 1
        for (int rp = 0; rp < 2; ++rp) {
        f32x4 v[2][4];
#pragma unroll
        for (int rr = 0; rr < 2; ++rr)
#pragma unroll
            for (int j = 0; j < 4; ++j) v[rr][j] = ((const GAS f32x4*)(x1 + (size_t)(row0 + 2 * rp + rr) * D))[ln + 64 * j];
#pragma unroll
        for (int rr = 0; rr < 2; ++rr) {
            const int lr = wave * 4 + 2 * rp + rr, row = row0 + 2 * rp + rr;
            int l2 = ln; asm volatile("" : "+v"(l2));
            float ss = 0.f;
#pragma unroll
            for (int j = 0; j < 4; ++j) ss += (v[rr][j][0] * v[rr][j][0] + v[rr][j][1] * v[rr][j][1]) + (v[rr][j][2] * v[rr][j][2] + v[rr][j][3] * v[rr][j][3]);
            const float rstd = rsqrtf(wave_sum(ss) * (1.f / D) + EPS);
#pragma unroll
            for (int j = 0; j < 4; ++j) { const int cc = (l2 + 64 * j) * 4; const f32x4 gg = *(const GAS f32x4*)(gain + cc), sh = *(const GAS f32x4*)(mod_sh + b * 6144 + cc), sc = *(const GAS f32x4*)(mod_sc + b * 6144 + cc);
                const f32x4 hv = v[rr][j] * rstd * gg * (sc + 1.f) + sh; v2u o; o.x = pk2(hv[0], hv[1]); o.y = pk2(hv[2], hv[3]);
                *(GAS v2u*)(hn2 + (size_t)row * D + cc) = o;
#pragma unroll
                for (int q = 0; q < 4; ++q) tile[lr * 1024 + ((cc + q) ^ lr)] = hv[q]; }
        }
        }
        __syncthreads();
        f32x16 acc;
#pragma unroll
        for (int r = 0; r < 16; ++r) acc[r] = 0.f;
#pragma unroll
        for (int j = 0; j < 64; ++j) { const float a = tile[l31 * 1024 + ((128 * wave + 2 * j + h5) ^ l31)]; acc = __builtin_amdgcn_mfma_f32_32x32x2f32(a, breg[j], acc, 0, 0, 0);
            if ((j & 7) == 7) __builtin_amdgcn_sched_barrier(0); }
        __syncthreads();
#pragma unroll
        for (int r = 0; r < 16; ++r) tile[(wave * 32 + (r & 3) + 8 * (r >> 2) + 4 * h5) * 32 + l31] = acc[r];
        __syncthreads();
#pragma unroll 1
        for (int rr = 0; rr < 4; ++rr) {
            const int lr = wave * 4 + rr, er = hb * 32 + lr; float cur = br[l31];
#pragma unroll
            for (int w8 = 0; w8 < 8; ++w8) cur += tile[(w8 * 32 + lr) * 32 + l31];
            float tv[4]; int ti[4];
#pragma unroll
            for (int k = 0; k < 4; ++k) { float mv = cur; int mi = l31;
#pragma unroll
                for (int o = 1; o < 32; o <<= 1) { const float ov = __shfl_xor(mv, o); const int oi = __shfl_xor(mi, o); if (ov > mv || (ov == mv && oi < mi)) { mv = ov; mi = oi; } }
                tv[k] = mv; ti[k] = mi; if (l31 == mi) cur = -INFINITY; }
            const float e1 = __expf(tv[1] - tv[0]), e2 = __expf(tv[2] - tv[0]), e3 = __expf(tv[3] - tv[0]), inv = 1.f / (1.f + e1 + e2 + e3);
            if (lane == 0) { entE[er * 4 + 0] = ti[0]; entE[er * 4 + 1] = ti[1]; entE[er * 4 + 2] = ti[2]; entE[er * 4 + 3] = ti[3];
                entW[er * 4 + 0] = inv; entW[er * 4 + 1] = e1 * inv; entW[er * 4 + 2] = e2 * inv; entW[er * 4 + 3] = e3 * inv; }
        }
        __syncthreads();
      }
        if (tid < 256) rank[tid] = __hip_atomic_fetch_add(lcnt + entE[tid], 1, __ATOMIC_RELAXED, __HIP_MEMORY_SCOPE_WORKGROUP);
        __syncthreads();
        if (tid < 32) { const int n = lcnt[tid]; base[tid] = n ? __hip_atomic_fetch_add(cnt + tid, n, __ATOMIC_RELAXED, __HIP_MEMORY_SCOPE_AGENT) : 0; lcnt[tid] = 0; }
        __syncthreads();
        if (tid < 256) { const int e = entE[tid], slot = base[e] + rank[tid], row = bt * 64 + (tid >> 2);
            list[(size_t)e * CAP + slot] = row; tokE[row * 4 + (tid & 3)] = e; tokS[row * 4 + (tid & 3)] = slot; tokW[row * 4 + (tid & 3)] = entW[tid]; }
        __syncthreads();
    }
}

__device__ __forceinline__ int moe_workers(int total, int G) { const int gx = G >> 3, nmax = (total + 7) >> 3, rounds = (nmax + gx - 1) / gx; int jw = rounds > 0 ? (nmax + rounds - 1) / rounds : gx; return jw < 1 ? 1 : (jw > gx ? gx : jw); }
__global__ void __launch_bounds__(NTHR, 2) mk_fwd(MkArgs a) {
    extern __shared__ __attribute__((aligned(16))) unsigned char lds_raw[];
    LAS unsigned char* lds = (LAS unsigned char*)lds_raw;
    const int G = gridDim.x, bx = blockIdx.x, wave_s = __builtin_amdgcn_readfirstlane((int)threadIdx.x >> 6);
#define PH_LOCALS int tid = wave_s * 64 + (int)mk_lane_id(); asm volatile("" : "+v"(tid)); const int lane = tid & 63, wave = __builtin_amdgcn_readfirstlane(tid >> 6), gw = bx * NWAVES + wave, NGW = G * NWAVES; (void)lane; (void)gw; (void)NGW
    { PH_LOCALS; for (int u = tid; u < (LDS_BYTES - LDSCTL_OFF) / 4; u += NTHR) ((LAS unsigned*)(lds + LDSCTL_OFF))[u] = 0u; }
    __syncthreads();
    int lo, hi; XcdBarrier bar;
    { PH_LOCALS; KA_PTR(ka); lo = ka->ph_lo; hi = ka->ph_hi; bar = xcd_barrier_post((unsigned*)(ka->ws + WS_CTL) + CW_BAR + ka->li * XCD_BAR_WORDS, (volatile LAS unsigned*)(lds + LDSCTL_OFF) + LW_BAR, wave_s); }
    LAS int* lw = (LAS int*)(lds + LDSCTL_OFF); LAS int* tp = lw + LW_TP; LAS int* cn = lw + LW_CNT;
#ifndef MK_PHMASK
#define MK_PHMASK 0xFFFFFFFFu
#endif
#ifndef MK_DUP
#define MK_DUP 0u
#endif
#define NREP(p) (((MK_DUP >> (p)) & 1u) ? 2 : 1)
#ifndef MK_DUPSUB
#define MK_DUPSUB 0xFFu
#endif
#define SUBEN(bit) (rep_ == 0 || ((MK_DUPSUB >> (bit)) & 1u))
#define PHEN(p) ((MK_PHMASK >> (p)) & 1u)
#define IN(k) (lo <= (k) && (k) < hi)
#ifndef MK_HOOKPROBE
#define MK_HOOKPROBE 0
#endif
#ifndef MK_DUPBAR
#define MK_DUPBAR 0
#endif
#define SEAM(k) do { if (IN(k) && IN((k) + 1)) { xcd_barrier(bar); if (MK_DUPBAR) xcd_barrier(bar); } } while (0)
#define WSP(T, off) ((T*)(ws + (off)))
    if (PHEN(31) && IN(0)) for (int rep_ = 0; rep_ < NREP(31); ++rep_) { PH_LOCALS; KA_PTR(ka); phase_prologue(ka, lds, tid, lane, wave, G, bx); VM_WAIT(); __syncthreads(); }
    SEAM(0);
    for (int l = 0; l < L; ++l) {
        const int pb = 1 + l * NPH_L;
        if (PHEN(0) && IN(pb + 0)) for (int rep_ = 0; rep_ < NREP(0); ++rep_) { PH_LOCALS; KA_PTR(ka); unsigned char* ws = ka->ws; const float* modl = WSP(float, WS_MOD) + (size_t)l * 8 * 6144; const float* norm1_g = (const float*)ka->in[5] + l * D;
            if (l == 0) phase_rows<0>((const float*)ka->in[0], nullptr, norm1_g, modl + 0, modl + 1024, nullptr, WSP(bf16, WS_HN), nullptr, nullptr, nullptr, nullptr, tp, lane, gw, NGW);
            else { load_tp(WSP(int, WS_CTL) + CW_CNT + (l - 1) * 64, tp, cn, tid); int* tokE = WSP(int, WS_TOK);
                phase_rows<1>(WSP(float, WS_XA), WSP(float, WS_XB), norm1_g, modl + 0, modl + 1024, modl - 8 * 6144 + 5120, WSP(bf16, WS_HN), WSP(bf16, WS_EO), tokE, tokE + NT * 4, (const float*)(tokE + NT * 8), tp, lane, gw, NGW); }
        }
        SEAM(pb + 0);
        if (PHEN(1) && IN(pb + 1)) for (int rep_ = 0; rep_ < NREP(1); ++rep_) { PH_LOCALS; KA_PTR(ka); unsigned char* ws = ka->ws;
            const int GW = (G >= 232 && (G & 7) == 0) ? 232 : G; unsigned* pd = WSP(unsigned, WS_CTL) + CW_PD + 64 * (1 + 3 * l);
            if (bx < GW) {
                pg8::Gemm g{WSP(bf16, WS_HN), WSP(bf16, WS_WINT) + (size_t)l * INP * 1024, nullptr, 1024, 1024, 1024, 0}; pg8::StaticOrder So; So.init(NT, INP, GW, bx);
                EpiP E{WSP(bf16, WS_P), INP, WSP(bf16, WS_GT)};
                pg8::gemm_phase<EpiP, pg8::StaticOrder, true, true, false>(lds + RING_OFF, g, So, E, wave);
                if (tid == 0) __hip_atomic_fetch_add(pd, 1u, __ATOMIC_RELAXED, __HIP_MEMORY_SCOPE_AGENT);
            } else conv_service(ka, lds, tid, lane, wave, 0u, pd, (unsigned)GW);
        }
        SEAM(pb + 1);
        if (PHEN(2) && IN(pb + 2)) for (int rep_ = 0; rep_ < NREP(2); ++rep_) { PH_LOCALS; KA_PTR(ka); unsigned char* ws = ka->ws;
#if MK_HGRN_IN
            if (SUBEN(2)) hgrn_a_all(WSP(bf16, WS_P), WSP(float, WS_LB) + l * 512, WSP(float, WS_SLOC), WSP(float, WS_DEC), lds + RING_OFF, bx, G, tid, lane, wave);
#endif
#if MK_MLA_IN
            if (SUBEN(3)) for (int u = bx; u < NT / 64; u += G)
                mla_unit(WSP(bf16, WS_P), (const float*)ka->in[10] + l * 384, (const float*)ka->in[11] + l * 256, WSP(bf16, WS_WUQT) + (size_t)l * 768 * 384, WSP(bf16, WS_WUKVT) + (size_t)l * 1024 * 256,
                         (const float*)ka->in[14] + l * 96, (const float*)ka->in[15] + l * 96, WSP(float, WS_ROPE), WSP(bf16, WS_Q), WSP(bf16, WS_K), WSP(bf16, WS_V), lds + RING_OFF, u, lane, wave);
#endif
#if MK_POOL_IN
            if (SUBEN(4)) for (int u = bx; u < NT / 64; u += G) pool_unit(WSP(bf16, WS_P), WSP(bf16, WS_BR), u, tid);
#endif
        }
        SEAM(pb + 2);
        if (PHEN(3) && IN(pb + 3)) for (int rep_ = 0; rep_ < NREP(3); ++rep_) { PH_LOCALS; KA_PTR(ka); unsigned char* ws = ka->ws;
#if MK_HGRN_IN
            for (int u = bx; u < 256; u += G) hgrn_scan_unit(WSP(float, WS_SLOC), WSP(float, WS_DEC), WSP(bf16, WS_ST), u, tid);
#endif
        }
        SEAM(pb + 3);
        if (PHEN(4) && IN(pb + 4)) for (int rep_ = 0; rep_ < NREP(4); ++rep_) { PH_LOCALS; KA_PTR(ka); unsigned char* ws = ka->ws;
#if MK_ATTN_IN
            if (SUBEN(0)) for (int p = bx; p < 256; p += G) {
                attn_unit(WSP(bf16, WS_Q), WSP(bf16, WS_K), WSP(bf16, WS_V), WSP(bf16, WS_BR), lds + RING_OFF, p & 63, 7 - (p >> 6), tid, lane, wave);
                attn_unit(WSP(bf16, WS_Q), WSP(bf16, WS_K), WSP(bf16, WS_V), WSP(bf16, WS_BR), lds + RING_OFF, p & 63, p >> 6, tid, lane, wave);
            }
#endif
#if MK_HGRN_IN
            if (SUBEN(1)) for (int u = bx; u < 1024; u += G) hgrn_c_unit(WSP(bf16, WS_P), WSP(float, WS_LB) + l * 512, WSP(bf16, WS_ST), (const float*)ka->in[9] + l * 128, WSP(bf16, WS_BR), lds + RING_OFF, u, tid, lane, wave);
#endif
        }
        SEAM(pb + 4);
        if (PHEN(5) && IN(pb + 5)) for (int rep_ = 0; rep_ < NREP(5); ++rep_) { PH_LOCALS; KA_PTR(ka); unsigned char* ws = ka->ws;
            pg8::Gemm g{WSP(bf16, WS_BR), WSP(bf16, WS_WBRT) + (size_t)l * 1024 * 1536, nullptr, 1536, 1536, 1536, 0}; pg8::StaticOrder So; So.init(NT, 1024, G, bx);
#if MK_P5PROBE
            if (rep_ == 1) { EpiP E2{WSP(bf16, WS_MERGF), 1024, nullptr}; pg8::gemm_phase<EpiP, pg8::StaticOrder, false, true, false, 0>(lds + RING_OFF, g, So, E2, wave); } else
#endif
            { EpiBranch E{WSP(bf16, WS_GT), WSP(bf16, WS_MERGB)};
            pg8::gemm_phase<EpiBranch, pg8::StaticOrder, false, true, false, 8>(lds + RING_OFF, g, So, E, wave); }
        }
        SEAM(pb + 5);
        if (PHEN(6) && IN(pb + 6)) for (int rep_ = 0; rep_ < NREP(6); ++rep_) { PH_LOCALS; KA_PTR(ka); unsigned char* ws = ka->ws; const float* xin = (l == 0) ? (const float*)ka->in[0] : WSP(float, WS_XB);
            pg8::Gemm g{WSP(bf16, WS_MERGB), WSP(bf16, WS_WOUTT) + (size_t)l * 1024 * 1024, nullptr, 1024, 1024, 1024, 0}; pg8::StaticOrder So; So.init(NT, 1024, G, bx);
            EpiOut E{xin, WSP(float, WS_MOD) + (size_t)l * 8 * 6144 + 2048, WSP(float, WS_XA)};
            pg8::gemm_phase<EpiOut, pg8::StaticOrder, false, true, false>(lds + RING_OFF, g, So, E, wave);
        }
        SEAM(pb + 6);
        if (PHEN(7) && IN(pb + 7)) for (int rep_ = 0; rep_ < NREP(7); ++rep_) { PH_LOCALS; KA_PTR(ka); unsigned char* ws = ka->ws; const float* modl = WSP(float, WS_MOD) + (size_t)l * 8 * 6144; int* tokE = WSP(int, WS_TOK);
            if (rep_ == 1) tokE = WSP(int, WS_KVRAW);
            phase_router(WSP(float, WS_XA), (const float*)ka->in[6] + l * D, modl + 3072, modl + 4096, (const float*)ka->in[22] + (size_t)l * 1024 * 32, (const float*)ka->in[23] + l * 32, WSP(bf16, WS_HN2),
                         WSP(int, WS_CTL) + (rep_ == 1 ? 2048 : CW_CNT) + l * 64, rep_ == 1 ? WSP(int, WS_QRAW) : WSP(int, WS_LIST), tokE, tokE + NT * 4, (float*)(tokE + NT * 8), lds, tid, lane, wave, G, bx);
            conv_service(ka, lds, tid, lane, wave, (unsigned)(l * TA7 + TA6), nullptr, 0u); }
        SEAM(pb + 7);
        if (PHEN(8) && IN(pb + 8)) for (int rep_ = 0; rep_ < NREP(8); ++rep_) { PH_LOCALS; KA_PTR(ka); unsigned char* ws = ka->ws;
            load_tp(WSP(int, WS_CTL) + CW_CNT + l * 64, tp, cn, tid);
            const int jw = moe_workers(tp[32] * 8, G); unsigned* pd = WSP(unsigned, WS_CTL) + CW_PD + 64 * (2 + 3 * l); const bool worker = (bx >> 3) < jw || (G & 7) != 0;
            if (worker) {
                pg8::Gemm g{WSP(bf16, WS_HN2), WSP(bf16, WS_W1T) + (size_t)l * NE * 2048 * 1024, WSP(int, WS_LIST), 1024, 1024, 1024, 0}; MoeOrder So{tp, cn, 8, (G & 7) ? G : 8 * jw, bx, 0};
                EpiMoe1 E{(const float*)ka->in[25] + (size_t)l * NE * 2048, WSP(bf16, WS_ACT), (LAS float*)(lw + LW_BIAS)};
                pg8::gemm_phase<EpiMoe1, MoeOrder, true, true, true>(lds + RING_OFF, g, So, E, wave);
                if (tid == 0) __hip_atomic_fetch_add(pd, 1u, __ATOMIC_RELAXED, __HIP_MEMORY_SCOPE_AGENT);
            }
            conv_service(ka, lds, tid, lane, wave, (unsigned)((l + 1) * TA7), worker ? nullptr : pd, (unsigned)(8 * jw));
        }
        SEAM(pb + 8);
        if (PHEN(9) && IN(pb + 9)) for (int rep_ = 0; rep_ < NREP(9); ++rep_) { PH_LOCALS; KA_PTR(ka); unsigned char* ws = ka->ws;
            load_tp(WSP(int, WS_CTL) + CW_CNT + l * 64, tp, cn, tid);
            const int jw = moe_workers(tp[32] * 4, G); unsigned* pd = WSP(unsigned, WS_CTL) + CW_PD + 64 * (3 + 3 * l); const bool worker = (bx >> 3) < jw || (G & 7) != 0;
            if (worker) {
                pg8::Gemm g{WSP(bf16, WS_ACT), WSP(bf16, WS_W2T) + (size_t)l * NE * 1024 * 1024, nullptr, 1024, 1024, 1024, 0}; MoeOrder So{tp, cn, 4, (G & 7) ? G : 8 * jw, bx, 1};
                EpiMoe2 E{(const float*)ka->in[27] + (size_t)l * NE * 1024, WSP(bf16, WS_EO), (LAS float*)(lw + LW_BIAS)};
                pg8::gemm_phase<EpiMoe2, MoeOrder, true, true, false>(lds + RING_OFF, g, So, E, wave);
                if (tid == 0) __hip_atomic_fetch_add(pd, 1u, __ATOMIC_RELAXED, __HIP_MEMORY_SCOPE_AGENT);
            }
            conv_service(ka, lds, tid, lane, wave, (unsigned)(l + 1 < L ? (l + 1) * TA7 + TA5 : 0), worker ? nullptr : pd, (unsigned)(8 * jw));
        }
        SEAM(pb + 9);
    }
    if (PHEN(30) && IN(PH_FINAL)) for (int rep_ = 0; rep_ < NREP(30); ++rep_) { PH_LOCALS; KA_PTR(ka); unsigned char* ws = ka->ws; load_tp(WSP(int, WS_CTL) + CW_CNT + (L - 1) * 64, tp, cn, tid); int* tokE = WSP(int, WS_TOK);
        phase_rows<2>(WSP(float, WS_XA), ka->out, nullptr, nullptr, nullptr, WSP(float, WS_MOD) + (size_t)(L - 1) * 8 * 6144 + 5120, nullptr, WSP(bf16, WS_EO), tokE, tokE + NT * 4, (const float*)(tokE + NT * 8), tp, lane, gw, NGW); }
#undef IN
#undef SEAM
}
static void launch_mk(const MkArgs& base, int lo, int hi, int li, int grid, hipStream_t stream) {
    MkArgs a = base; a.ph_lo = lo; a.ph_hi = hi; a.li = li; a.pad = 0;
    hipLaunchKernelGGL(mk_fwd, dim3(grid), dim3(NTHR), LDS_BYTES, stream, a);
}
extern "C" void kernel_launch(void* const* d_in, const int* in_sizes, int n_in, void* d_out, int out_size, void* d_ws, size_t ws_size, hipStream_t stream) {
    static int grid = 0;
    if (grid == 0) {
        if (ws_size < WS_END || n_in != 28) { fprintf(stderr, "kernel_launch: bad ws/inputs: %zu < %zu, n_in %d\n", ws_size, (size_t)WS_END, n_in); grid = -1; return; }
        int dev = 0, cus = 0, per_cu = 0;
        if (hipGetDevice(&dev) != hipSuccess || hipDeviceGetAttribute(&cus, hipDeviceAttributeMultiprocessorCount, dev) != hipSuccess) { grid = -1; return; }
        if (hipFuncSetAttribute((const void*)mk_fwd, hipFuncAttributeMaxDynamicSharedMemorySize, LDS_BYTES) != hipSuccess) { fprintf(stderr, "kernel_launch: hipFuncSetAttribute failed\n"); grid = -1; return; }
        if (hipOccupancyMaxActiveBlocksPerMultiprocessor(&per_cu, (const void*)mk_fwd, NTHR, LDS_BYTES) != hipSuccess || per_cu < 1) { fprintf(stderr, "kernel_launch: occupancy query says %d\n", per_cu); (void)hipGetLastError(); grid = -1; return; }
        grid = cus;
    }
    if (grid < 0) return;
    unsigned char* ws = (unsigned char*)d_ws;
    (void)hipMemsetAsync(ws + WS_CTL, 0, 1 * MiB, stream);
    MkArgs a{};
    for (int i = 0; i < 28; ++i) a.in[i] = d_in[i];
    a.out = (float*)d_out; a.ws = ws;
    for (int j = 0; j < 16; ++j) a.invf[j] = (float)(1.0 / pow(10000.0, (double)j / 16.0));
#if MK_HYBRID
    const float* onorm_g = (const float*)d_in[9]; const float* qlat_g = (const float*)d_in[10]; const float* kvlat_g = (const float*)d_in[11]; const float* qn_g = (const float*)d_in[14]; const float* kn_g = (const float*)d_in[15];
    float* lb = (float*)(ws + WS_LB); float* rope = (float*)(ws + WS_ROPE);
    bf16 *WuqT = (bf16*)(ws + WS_WUQT), *WukvT = (bf16*)(ws + WS_WUKVT), *P = (bf16*)(ws + WS_P), *Qb = (bf16*)(ws + WS_Q), *Kb = (bf16*)(ws + WS_K), *Vb = (bf16*)(ws + WS_V), *BR = (bf16*)(ws + WS_BR), *QLN = (bf16*)(ws + WS_QLN), *KVN = (bf16*)(ws + WS_KVN);
    float *ORAW = (float*)(ws + WS_ORAW), *QRAW = (float*)(ws + WS_QRAW), *KVRAW = (float*)(ws + WS_KVRAW);
    int li = 0;
    for (int l = 0; l < L; ++l) {
        const int pb = 1 + l * NPH_L;
        launch_mk(a, l == 0 ? 0 : pb - 5, pb + 2, li++, grid, stream);
#if !MK_HGRN_IN
        k_hgrn_naive<<<NB * HH, 128, 0, stream>>>(P, lb + l * 512, ORAW);
        k_hgrn_out<<<NT * 4 / 4, 256, 0, stream>>>(ORAW, P, onorm_g + l * 128, BR);
#endif
#if !MK_MLA_IN
        k_mla_prep<<<NT / 4, 256, 0, stream>>>(P, qlat_g + l * 384, kvlat_g + l * 256, QLN, KVN);
        { GemmArgs g{}; g.A = QLN; g.Bt = WuqT + (size_t)l * 768 * 384; g.lda = 384; g.ldb = 384; g.K = 384; g.outf = QRAW; g.ldc = 768;
          k_gemm<1, 0><<<dim3(768 / 64, NT / 64), 256, 0, stream>>>(g); }
        { GemmArgs g{}; g.A = KVN; g.Bt = WukvT + (size_t)l * 1024 * 256; g.lda = 256; g.ldb = 256; g.K = 256; g.outf = KVRAW; g.ldc = 1024;
          k_gemm<1, 0><<<dim3(1024 / 64, NT / 64), 256, 0, stream>>>(g); }
        k_mla_post<<<NT * 8 / 4, 256, 0, stream>>>(QRAW, KVRAW, P, qn_g + l * 96, kn_g + l * 96, rope, Qb, Kb, Vb);
#endif
#if !MK_POOL_IN
        k_pool<<<NT * 512 / 256, 256, 0, stream>>>(P, BR);
#endif
#if MK_MLA_IN || MK_POOL_IN || MK_HGRN_IN
        launch_mk(a, pb + 2, pb + 3, li++, grid, stream);
#endif
#if MK_HGRN_IN
        launch_mk(a, pb + 3, pb + 4, li++, grid, stream);
#endif
#if MK_ATTN_IN || MK_HGRN_IN
        launch_mk(a, pb + 4, pb + 5, li++, grid, stream);
#else
        k_attn_naive<<<dim3(S / 64, NB * MH), 64, 0, stream>>>(Qb, Kb, Vb, BR);
#endif
    }
    launch_mk(a, 1 + (L - 1) * NPH_L + 5, NPH, li++, grid, stream);
#else
    launch_mk(a, 0, NPH, 0, grid, stream);
#endif
}
```

```cpp
#include <hip/hip_runtime.h>
#include <stdint.h>
#include <cstdio>
#include <cmath>

typedef unsigned short bf16;
__device__ __forceinline__ float bf2f(bf16 v) { return __uint_as_float(((unsigned)v) << 16); }
__device__ __forceinline__ bf16 f2bf(float f) { unsigned u = __float_as_uint(f); return (bf16)((u + 0x7fffu + ((u >> 16) & 1u)) >> 16); }
__device__ __forceinline__ float sigmoidf_(float x) { return 1.f / (1.f + __expf(-x)); }

constexpr int D = 1024, NB = 8, S = 2048, NT = NB * S, L = 2;
constexpr int HH = 4, HDK = 128, HW = 512, HCH = 64;
constexpr int MH = 8, MNOPE = 64, MROPE = 32, MQK = 96, MV = 64, MQR = 384, MKVR = 256, MW = 512;
constexpr int PW = 512;
constexpr int NE = 32, TOPK = 4, FF = 1024;
constexpr int INW = 6304, INP = 6400;
constexpr int C_HQ = 0, C_HF = 512, C_HI = 1024, C_HG = 1536, C_QLAT = 2048, C_KVLAT = 2432, C_KROPE = 2688, C_POOL = 2720, C_GA = 3232, C_GB = 4256, C_GC = 5280;
constexpr float EPS = 1e-6f;
constexpr int CAP = NT;
constexpr int MAXROWS = NT * TOPK + NE * 256;

constexpr size_t MiB = 1u << 20;
constexpr size_t WS_CTL = 0;
constexpr size_t WS_MOD = 1 * MiB;
constexpr size_t WS_LB = 2 * MiB;
constexpr size_t WS_ROPE = 3 * MiB;
constexpr size_t WS_WINT = 6 * MiB;
constexpr size_t WS_WUQT = 32 * MiB;
constexpr size_t WS_WUKVT = 34 * MiB;
constexpr size_t WS_WBRT = 36 * MiB;
constexpr size_t WS_WOUTT = 42 * MiB;
constexpr size_t WS_W1T = 48 * MiB;
constexpr size_t WS_W2T = 304 * MiB;
constexpr size_t WS_HN = 432 * MiB;
constexpr size_t WS_P = 464 * MiB;
constexpr size_t WS_Q = 664 * MiB;
constexpr size_t WS_K = 688 * MiB;
constexpr size_t WS_V = 712 * MiB;
constexpr size_t WS_BR = 728 * MiB;
constexpr size_t WS_MERGF = 776 * MiB;
constexpr size_t WS_MERGB = 840 * MiB;
constexpr size_t WS_XA = 872 * MiB;
constexpr size_t WS_XB = 936 * MiB;
constexpr size_t WS_HN2 = 1000 * MiB;
constexpr size_t WS_LIST = 1032 * MiB;
constexpr size_t WS_TOK = 1034 * MiB;
constexpr size_t WS_ACT = 1036 * MiB;
constexpr size_t WS_EO = 1180 * MiB;
constexpr size_t WS_ORAW = 1324 * MiB;
constexpr size_t WS_QLN = 1356 * MiB;
constexpr size_t WS_KVN = 1368 * MiB;
constexpr size_t WS_QRAW = 1376 * MiB;
constexpr size_t WS_KVRAW = 1424 * MiB;
constexpr size_t WS_SLOC = 1488 * MiB;
constexpr size_t WS_ST = 1552 * MiB;
constexpr size_t WS_DEC = 1584 * MiB;
constexpr size_t WS_GT = 1585 * MiB;
constexpr size_t WS_END = 1681 * MiB;
constexpr int CW_CNT = 64;
constexpr int CW_OFF = 256;

template <int MODE>
__global__ void k_transpose(const float* __restrict__ in, bf16* __restrict__ out, int K, int N, int NP, int rowoff, size_t ibs, size_t obs) {
    __shared__ float t[32][33];
    const int n0 = blockIdx.x * 32, k0 = blockIdx.y * 32, tx = threadIdx.x & 31, ty = threadIdx.x >> 5;
    const float* ip = in + (size_t)blockIdx.z * ibs; bf16* op = out + (size_t)blockIdx.z * obs;
#pragma unroll
    for (int j = 0; j < 4; ++j) t[ty + 8 * j][tx] = ip[(size_t)(k0 + ty + 8 * j) * N + n0 + tx];
    __syncthreads();
#pragma unroll
    for (int j = 0; j < 4; ++j) {
        int n = n0 + ty + 8 * j; int r = n;
        if (MODE == 1) { const int half = n >> 10, c = n & 1023; r = (c >> 7) * 256 + half * 128 + (c & 127); }
        op[(size_t)(rowoff + r) * K + k0 + tx] = f2bf(t[tx][ty + 8 * j]);
    }
}
__global__ void k_zero_bf16(bf16* p, size_t n) { size_t i = (size_t)blockIdx.x * blockDim.x + threadIdx.x; if (i < n) p[i] = 0; }

__global__ void k_fold_pool(const float* __restrict__ w_pool, const float* __restrict__ scale, const float* __restrict__ w_br_c, bf16* __restrict__ wbrt) {
    const int l = blockIdx.z, k = blockIdx.y, n = blockIdx.x * 256 + threadIdx.x, g = k >> 7, c = k & 127;
    const float* wp = w_pool + ((size_t)l * 4 + g) * 128 * 128 + (size_t)c * 128; const float* sc = scale + l * 512 + g * 128; const float* wb = w_br_c + (size_t)l * 512 * 1024 + (size_t)g * 128 * 1024;
    float a = 0.f;
    for (int d = 0; d < 128; ++d) a += wp[d] * sc[d] * wb[(size_t)d * 1024 + n];
    wbrt[(size_t)l * 3072 * 512 + (size_t)(2048 + n) * 512 + k] = f2bf(a);
}
__global__ void k_adaln(const float* __restrict__ c, const float* __restrict__ ada_w, const float* __restrict__ ada_b, float* __restrict__ mod) {
    __shared__ float cs[8][1024];
    for (int i = threadIdx.x; i < 8192; i += 256) { float v = c[i]; cs[i >> 10][i & 1023] = v / (1.f + __expf(-v)); }
    __syncthreads();
    const int l = blockIdx.y, j = blockIdx.x * 256 + threadIdx.x;
    const float* w = ada_w + (size_t)l * 1024 * 6144 + j;
    float a0 = 0, a1 = 0, a2 = 0, a3 = 0, a4 = 0, a5 = 0, a6 = 0, a7 = 0;
    for (int k = 0; k < 1024; ++k) { const float wv = w[(size_t)k * 6144];
        a0 += cs[0][k] * wv; a1 += cs[1][k] * wv; a2 += cs[2][k] * wv; a3 += cs[3][k] * wv; a4 += cs[4][k] * wv; a5 += cs[5][k] * wv; a6 += cs[6][k] * wv; a7 += cs[7][k] * wv; }
    const float bb = ada_b[l * 6144 + j]; float* m = mod + (size_t)l * 8 * 6144 + j;
    m[0 * 6144] = a0 + bb; m[1 * 6144] = a1 + bb; m[2 * 6144] = a2 + bb; m[3 * 6144] = a3 + bb; m[4 * 6144] = a4 + bb; m[5 * 6144] = a5 + bb; m[6 * 6144] = a6 + bb; m[7 * 6144] = a7 + bb;
}
struct InvF { float f[16]; };
__global__ void k_misc(const float* __restrict__ hgrn_lb, const int* __restrict__ pos, float* __restrict__ lb, float* __restrict__ rope, InvF invf) {
    const int i = blockIdx.x * 256 + threadIdx.x;
    if (i < 512) { const float a = hgrn_lb[i], b = hgrn_lb[512 + i]; const float m = fmaxf(a, b); const float ea = __expf(a - m), eb = __expf(b - m); lb[i] = 0.f; lb[512 + i] = eb / (ea + eb); }
    if (i < NT * 16) { const int t = i >> 4, j = i & 15; float fv = invf.f[0];
#pragma unroll
        for (int q = 1; q < 16; ++q) if (j == q) fv = invf.f[q];
        const double ang = (double)pos[t] * (double)fv;
        double r = ang * 0.15915494309189535; r -= floor(r + 0.5); const float a = (float)(r * 6.283185307179586);
        rope[i] = __cosf(a); rope[NT * 16 + i] = __sinf(a); }
}

__global__ void k_norm_mod(const float* __restrict__ x, const float* __restrict__ g, const float* __restrict__ mod_sh, const float* __restrict__ mod_sc, bf16* __restrict__ out) {
    const int row = blockIdx.x * 4 + (threadIdx.x >> 6), lane = threadIdx.x & 63, b = row / S;
    const float4* xr = (const float4*)(x + (size_t)row * D);
    float4 v[4]; float ss = 0.f;
#pragma unroll
    for (int j = 0; j < 4; ++j) { v[j] = xr[lane + 64 * j]; ss += v[j].x * v[j].x + v[j].y * v[j].y + v[j].z * v[j].z + v[j].w * v[j].w; }
#pragma unroll
    for (int o = 1; o < 64; o <<= 1) ss += __shfl_xor(ss, o);
    const float rstd = rsqrtf(ss * (1.f / D) + EPS);
#pragma unroll
    for (int j = 0; j < 4; ++j) { const int c = (lane + 64 * j) * 4; const float4 gg = *(const float4*)(g + c), sh = *(const float4*)(mod_sh + b * 6144 + c), sc = *(const float4*)(mod_sc + b * 6144 + c);
        ushort4 o; o.x = f2bf(v[j].x * rstd * gg.x * (1.f + sc.x) + sh.x); o.y = f2bf(v[j].y * rstd * gg.y * (1.f + sc.y) + sh.y); o.z = f2bf(v[j].z * rstd * gg.z * (1.f + sc.z) + sh.z); o.w = f2bf(v[j].w * rstd * gg.w * (1.f + sc.w) + sh.w);
        *(ushort4*)(out + (size_t)row * D + c) = o; }
}

struct GemmArgs { const bf16* A; const bf16* Bt; const int* rowlist; const int* cnt; const int* off; float* outf; bf16* outb; const bf16* gate; const float* xin; const float* gvec; const float* bias;
    int lda, ldb, K, ldc, pad0, pad1; };
template <int MODE, int BRI>
__global__ void __launch_bounds__(256) k_gemm(GemmArgs g) {
    __shared__ float As[16][65], Bs[16][65], Bs2[16][65];
    const int tid = threadIdx.x, tx = tid & 15, ty = tid >> 4;
    int m0 = blockIdx.y * 64, n0 = blockIdx.x * 64; int e = 0, cnt = 1 << 30, orow0 = m0;
    const bf16* Bt = g.Bt;
    if (MODE == 4 || MODE == 5) { e = blockIdx.z; cnt = g.cnt[e]; if (m0 >= cnt) return; orow0 = g.off[e] + m0; Bt += (size_t)e * (MODE == 4 ? 2048 : 1024) * g.ldb; }
    const int lr = tid >> 2, lk = (tid & 3) * 4;
    size_t arow;
    if (MODE == 4) { const int slot = m0 + lr; arow = (slot < cnt) ? (size_t)g.rowlist[(size_t)e * CAP + slot] : 0; }
    else if (MODE == 5) arow = (size_t)(orow0 + lr);
    else arow = (size_t)(m0 + lr);
    const bf16* ap = g.A + arow * g.lda + lk;
    int bn = n0 + lr;
    if (MODE == 4) { const int t = n0 >> 6;     const int col = n0 + lr; bn = (col >> 7) * 256 + (col & 127); (void)t; }
    const bf16* bp = Bt + (size_t)bn * g.ldb + lk;
    const bf16* bp2 = bp + (size_t)128 * g.ldb;
    float acc[4][4], acc2[4][4];
#pragma unroll
    for (int i = 0; i < 4; ++i)
#pragma unroll
        for (int j = 0; j < 4; ++j) { acc[i][j] = 0.f; acc2[i][j] = 0.f; }
    for (int k0 = 0; k0 < g.K; k0 += 16) {
        const ushort4 av = *(const ushort4*)(ap + k0), bv = *(const ushort4*)(bp + k0);
        As[lk + 0][lr] = bf2f(av.x); As[lk + 1][lr] = bf2f(av.y); As[lk + 2][lr] = bf2f(av.z); As[lk + 3][lr] = bf2f(av.w);
        Bs[lk + 0][lr] = bf2f(bv.x); Bs[lk + 1][lr] = bf2f(bv.y); Bs[lk + 2][lr] = bf2f(bv.z); Bs[lk + 3][lr] = bf2f(bv.w);
        if (MODE == 4) { const ushort4 cv = *(const ushort4*)(bp2 + k0); Bs2[lk + 0][lr] = bf2f(cv.x); Bs2[lk + 1][lr] = bf2f(cv.y); Bs2[lk + 2][lr] = bf2f(cv.z); Bs2[lk + 3][lr] = bf2f(cv.w); }
        __syncthreads();
#pragma unroll
        for (int kk = 0; kk < 16; ++kk) {
            float a[4], b[4], b2[4];
#pragma unroll
            for (int i = 0; i < 4; ++i) { a[i] = As[kk][ty * 4 + i]; b[i] = Bs[kk][tx * 4 + i]; if (MODE == 4) b2[i] = Bs2[kk][tx * 4 + i]; }
#pragma unroll
            for (int i = 0; i < 4; ++i)
#pragma unroll
                for (int j = 0; j < 4; ++j) { acc[i][j] += a[i] * b[j]; if (MODE == 4) acc2[i][j] += a[i] * b2[j]; }
        }
        __syncthreads();
    }
#pragma unroll
    for (int i = 0; i < 4; ++i) {
        const int rl = ty * 4 + i;
        if ((MODE == 4 || MODE == 5) && m0 + rl >= cnt) continue;
        const size_t row = (MODE == 4 || MODE == 5) ? (size_t)(orow0 + rl) : (size_t)(m0 + rl);
#pragma unroll
        for (int j = 0; j < 4; ++j) {
            const int col = n0 + tx * 4 + j; const float v = acc[i][j];
            if (MODE == 0) g.outb[row * g.ldc + col] = f2bf(v);
            else if (MODE == 1) g.outf[row * g.ldc + col] = v;
            else if (MODE == 2) { const float gt = sigmoidf_(bf2f(g.gate[row * INP + col])) * v; float* o = g.outf + row * g.ldc + col;
                if (BRI == 0) *o = gt; else if (BRI == 1) *o += gt; else { const float s = *o + gt; *o = s; g.outb[row * g.ldc + col] = f2bf(s); } }
            else if (MODE == 3) { const int b = (int)(row / S); g.outf[row * g.ldc + col] = g.xin[row * g.ldc + col] + g.gvec[b * 6144 + col] * v; }
            else if (MODE == 4) { float glu = v + g.bias[e * 2048 + col], lin = acc2[i][j] + g.bias[e * 2048 + 1024 + col];
                glu = fminf(glu, 7.f); lin = fminf(fmaxf(lin, -7.f), 7.f);
                g.outb[row * g.ldc + col] = f2bf(glu * sigmoidf_(1.702f * glu) * (lin + 1.f)); }
            else if (MODE == 5) g.outb[row * g.ldc + col] = f2bf(v + g.bias[e * 1024 + col]);
        }
    }
}

__global__ void __launch_bounds__(128) k_hgrn_naive(const bf16* __restrict__ P, const float* __restrict__ lb, float* __restrict__ oraw) {
    __shared__ float qs[16][128], ks[16][128], fs[16][128];
    const int b = blockIdx.x >> 2, h = blockIdx.x & 3, v = threadIdx.x;
    const float lbv = lb[h * 128 + v];
    float st[128];
#pragma unroll
    for (int d = 0; d < 128; ++d) st[d] = 0.f;
    for (int t0 = 0; t0 < S; t0 += 16) {
        __syncthreads();
        for (int tt = 0; tt < 16; ++tt) { const bf16* pr = P + (size_t)(b * S + t0 + tt) * INP;
            const float z = bf2f(pr[C_HF + h * 128 + v]); const float sg = sigmoidf_(z);
            qs[tt][v] = bf2f(pr[C_HQ + h * 128 + v]); fs[tt][v] = lbv + (1.f - lbv) * sg; ks[tt][v] = (1.f - lbv) * (1.f - sg); }
        __syncthreads();
        for (int tt = 0; tt < 16; ++tt) {
            const float vv = bf2f(P[(size_t)(b * S + t0 + tt) * INP + C_HI + h * 128 + v]);
            float o = 0.f;
#pragma unroll
            for (int d = 0; d < 128; ++d) { st[d] = fs[tt][d] * st[d] + ks[tt][d] * vv; o += qs[tt][d] * st[d]; }
            oraw[(size_t)(b * S + t0 + tt) * 512 + h * 128 + v] = o;
        }
    }
}
__global__ void k_hgrn_out(const float* __restrict__ oraw, const bf16* __restrict__ P, const float* __restrict__ og, bf16* __restrict__ BR) {
    const int idx = blockIdx.x * 4 + (threadIdx.x >> 6), lane = threadIdx.x & 63, t = idx >> 2, h = idx & 3;
    const float o0 = oraw[(size_t)t * 512 + h * 128 + lane], o1 = oraw[(size_t)t * 512 + h * 128 + 64 + lane];
    float ss = o0 * o0 + o1 * o1;
#pragma unroll
    for (int o = 1; o < 64; o <<= 1) ss += __shfl_xor(ss, o);
    const float rstd = rsqrtf(ss * (1.f / 128.f) + EPS);
    const float g0 = bf2f(P[(size_t)t * INP + C_HG + h * 128 + lane]), g1 = bf2f(P[(size_t)t * INP + C_HG + h * 128 + 64 + lane]);
    BR[(size_t)t * 1536 + h * 128 + lane] = f2bf(o0 * rstd * og[lane] * g0 * sigmoidf_(g0));
    BR[(size_t)t * 1536 + h * 128 + 64 + lane] = f2bf(o1 * rstd * og[64 + lane] * g1 * sigmoidf_(g1));
}
__global__ void k_mla_prep(const bf16* __restrict__ P, const float* __restrict__ qg, const float* __restrict__ kvg, bf16* __restrict__ qln, bf16* __restrict__ kvn) {
    const int t = blockIdx.x * 4 + (threadIdx.x >> 6), lane = threadIdx.x & 63; const bf16* pr = P + (size_t)t * INP;
    float q[6], kv[4], s1 = 0.f, s2 = 0.f;
#pragma unroll
    for (int j = 0; j < 6; ++j) { q[j] = bf2f(pr[C_QLAT + lane + 64 * j]); s1 += q[j] * q[j]; }
#pragma unroll
    for (int j = 0; j < 4; ++j) { kv[j] = bf2f(pr[C_KVLAT + lane + 64 * j]); s2 += kv[j] * kv[j]; }
#pragma unroll
    for (int o = 1; o < 64; o <<= 1) { s1 += __shfl_xor(s1, o); s2 += __shfl_xor(s2, o); }
    const float r1 = rsqrtf(s1 * (1.f / 384.f) + EPS), r2 = rsqrtf(s2 * (1.f / 256.f) + EPS);
#pragma unroll
    for (int j = 0; j < 6; ++j) qln[(size_t)t * 384 + lane + 64 * j] = f2bf(q[j] * r1 * qg[lane + 64 * j]);
#pragma unroll
    for (int j = 0; j < 4; ++j) kvn[(size_t)t * 256 + lane + 64 * j] = f2bf(kv[j] * r2 * kvg[lane + 64 * j]);
}
__global__ void k_mla_post(const float* __restrict__ qraw, const float* __restrict__ kvraw, const bf16* __restrict__ P, const float* __restrict__ qng, const float* __restrict__ kng,
                           const float* __restrict__ rope, bf16* __restrict__ Q, bf16* __restrict__ K, bf16* __restrict__ V) {
    const int idx = blockIdx.x * 4 + (threadIdx.x >> 6), lane = threadIdx.x & 63, t = idx >> 3, h = idx & 7, b = t / S, s = t % S;
    const float qa = qraw[(size_t)t * 768 + h * 96 + lane], qb = qraw[(size_t)t * 768 + h * 96 + 64 + (lane & 31)];
    const float ka = kvraw[(size_t)t * 1024 + h * 128 + lane], kb = bf2f(P[(size_t)t * INP + C_KROPE + (lane & 31)]);
    const float va = kvraw[(size_t)t * 1024 + h * 128 + 64 + lane];
    float sq = qa * qa + (lane < 32 ? qb * qb : 0.f), sk = ka * ka + (lane < 32 ? kb * kb : 0.f);
#pragma unroll
    for (int o = 1; o < 64; o <<= 1) { sq += __shfl_xor(sq, o); sk += __shfl_xor(sk, o); }
    const float rq = rsqrtf(sq * (1.f / 96.f) + EPS), rk = rsqrtf(sk * (1.f / 96.f) + EPS);
    const size_t ob = ((size_t)(b * MH + h) * S + s);
    Q[ob * 96 + lane] = f2bf(qa * rq * qng[lane]); K[ob * 96 + lane] = f2bf(ka * rk * kng[lane]); V[((size_t)(b * MH + h) * 64 + lane) * S + s] = f2bf(va);
    const float qn = qb * rq * qng[64 + (lane & 31)], kn = kb * rk * kng[64 + (lane & 31)];
    const float qo = __shfl_xor(qn, 16), ko = __shfl_xor(kn, 16);
    const int i = lane & 15; const float cs = rope[(size_t)t * 16 + i], sn = rope[(size_t)NT * 16 + (size_t)t * 16 + i];
    if (lane < 32) { float qr, kr; if (lane < 16) { qr = qn * cs - qo * sn; kr = kn * cs - ko * sn; } else { qr = qn * cs + qo * sn; kr = kn * cs + ko * sn; }
        Q[ob * 96 + 64 + lane] = f2bf(qr); K[ob * 96 + 64 + lane] = f2bf(kr); }
}
__global__ void __launch_bounds__(64) k_attn_naive(const bf16* __restrict__ Q, const bf16* __restrict__ K, const bf16* __restrict__ V, bf16* __restrict__ BR) {
    __shared__ float ks[16][96], vs[16][64];
    const int bh = blockIdx.y, q0 = blockIdx.x * 64, qi = q0 + threadIdx.x, b = bh >> 3, h = bh & 7;
    float q[96], o[64]; float m = -INFINITY, l = 0.f;
    const bf16* qp = Q + ((size_t)bh * S + qi) * 96;
#pragma unroll
    for (int d = 0; d < 96; ++d) q[d] = bf2f(qp[d]) * 0.10206207261596575f;
#pragma unroll
    for (int d = 0; d < 64; ++d) o[d] = 0.f;
    for (int k0 = 0; k0 < q0 + 64; k0 += 16) {
        __syncthreads();
        for (int i = threadIdx.x; i < 16 * 96; i += 64) ks[i / 96][i % 96] = bf2f(K[((size_t)bh * S + k0) * 96 + i]);
        for (int i = threadIdx.x; i < 16 * 64; i += 64) vs[i & 15][i >> 4] = bf2f(V[((size_t)bh * 64 + (i >> 4)) * S + k0 + (i & 15)]);
        __syncthreads();
        for (int j = 0; j < 16; ++j) {
            if (k0 + j > qi) break;
            float sc = 0.f;
#pragma unroll
            for (int d = 0; d < 96; ++d) sc += q[d] * ks[j][d];
            const float mn = fmaxf(m, sc), corr = __expf(m - mn), p = __expf(sc - mn);
            l = l * corr + p; m = mn;
#pragma unroll
            for (int d = 0; d < 64; ++d) o[d] = o[d] * corr + p * vs[j][d];
        }
    }
    const float inv = 1.f / l; bf16* op = BR + (size_t)(b * S + qi) * 1536 + 512 + h * 64;
#pragma unroll
    for (int d = 0; d < 64; ++d) op[d] = f2bf(o[d] * inv);
}
__global__ void k_pool(const bf16* __restrict__ P, bf16* __restrict__ BR) {
    const int i = blockIdx.x * 256 + threadIdx.x, t = i >> 9, c = i & 511, g = c >> 7, s = t % S, w = 2 << g;
    const int n = (s + 1 < w) ? s + 1 : w; float sum = 0.f;
    for (int j = 0; j < n; ++j) sum += bf2f(P[(size_t)(t - j) * INP + C_POOL + c]);
    const float u = bf2f(P[(size_t)t * INP + C_POOL + c]);
    BR[(size_t)t * 1536 + 1024 + c] = f2bf(sum / (float)n - u);
}
__global__ void k_router(const float* __restrict__ x, const float* __restrict__ g, const float* __restrict__ mod_sh, const float* __restrict__ mod_sc, const float* __restrict__ wr, const float* __restrict__ br,
                         bf16* __restrict__ hn2, int* __restrict__ cnt, int* __restrict__ list, int* __restrict__ tokE, int* __restrict__ tokS, float* __restrict__ tokW) {
    __shared__ float hs[4][1024];
    const int w = threadIdx.x >> 6, row = blockIdx.x * 4 + w, lane = threadIdx.x & 63, b = row / S;
    const float4* xr = (const float4*)(x + (size_t)row * D);
    float4 v[4]; float ss = 0.f;
#pragma unroll
    for (int j = 0; j < 4; ++j) { v[j] = xr[lane + 64 * j]; ss += v[j].x * v[j].x + v[j].y * v[j].y + v[j].z * v[j].z + v[j].w * v[j].w; }
#pragma unroll
    for (int o = 1; o < 64; o <<= 1) ss += __shfl_xor(ss, o);
    const float rstd = rsqrtf(ss * (1.f / D) + EPS);
#pragma unroll
    for (int j = 0; j < 4; ++j) { const int c = (lane + 64 * j) * 4; const float4 gg = *(const float4*)(g + c), sh = *(const float4*)(mod_sh + b * 6144 + c), sc = *(const float4*)(mod_sc + b * 6144 + c);
        float4 hv; hv.x = v[j].x * rstd * gg.x * (1.f + sc.x) + sh.x; hv.y = v[j].y * rstd * gg.y * (1.f + sc.y) + sh.y; hv.z = v[j].z * rstd * gg.z * (1.f + sc.z) + sh.z; hv.w = v[j].w * rstd * gg.w * (1.f + sc.w) + sh.w;
        ushort4 o; o.x = f2bf(hv.x); o.y = f2bf(hv.y); o.z = f2bf(hv.z); o.w = f2bf(hv.w);
        *(ushort4*)(hn2 + (size_t)row * D + c) = o; *(float4*)&hs[w][c] = hv; }
    __syncthreads();
    const int e = lane & 31, half = lane >> 5; float a = 0.f;
    for (int k = half * 512; k < half * 512 + 512; ++k) a += hs[w][k] * wr[k * 32 + e];
    a += __shfl_xor(a, 32); a += br[e];
    float cur = a; float tv[4]; int ti[4];
#pragma unroll
    for (int k = 0; k < 4; ++k) { float mv = cur; int mi = e;
#pragma unroll
        for (int o = 1; o < 32; o <<= 1) { const float ov = __shfl_xor(mv, o); const int oi = __shfl_xor(mi, o); if (ov > mv || (ov == mv && oi < mi)) { mv = ov; mi = oi; } }
        tv[k] = mv; ti[k] = mi; if (e == mi) cur = -INFINITY; }
    const float e1 = __expf(tv[1] - tv[0]), e2 = __expf(tv[2] - tv[0]), e3 = __expf(tv[3] - tv[0]), inv = 1.f / (1.f + e1 + e2 + e3);
    if (lane == 0) {
        const float ww[4] = {inv, e1 * inv, e2 * inv, e3 * inv};
#pragma unroll
        for (int k = 0; k < 4; ++k) { const int slot = atomicAdd(&cnt[ti[k]], 1); list[(size_t)ti[k] * CAP + slot] = row; tokE[row * 4 + k] = ti[k]; tokS[row * 4 + k] = slot; tokW[row * 4 + k] = ww[k]; }
    }
}
__global__ void k_offsets(const int* __restrict__ cnt, int* __restrict__ off) { if (threadIdx.x == 0) { int a = 0; for (int e = 0; e < 32; ++e) { off[e] = a; a += (cnt[e] + 255) & ~255; } off[32] = a; } }
__global__ void k_combine(const float* __restrict__ x1, const float* __restrict__ mod_g2, const bf16* __restrict__ EO, const int* __restrict__ off, const int* __restrict__ tokE, const int* __restrict__ tokS, const float* __restrict__ tokW, float* __restrict__ out) {
    const int row = blockIdx.x, b = row / S, c = threadIdx.x * 4;
    float4 acc = {0.f, 0.f, 0.f, 0.f};
#pragma unroll
    for (int k = 0; k < 4; ++k) { const int e = tokE[row * 4 + k]; const size_t r = (size_t)off[e] + tokS[row * 4 + k]; const float w = tokW[row * 4 + k];
        const ushort4 ev = *(const ushort4*)(EO + r * 1024 + c); acc.x += w * bf2f(ev.x); acc.y += w * bf2f(ev.y); acc.z += w * bf2f(ev.z); acc.w += w * bf2f(ev.w); }
    const float4 xv = *(const float4*)(x1 + (size_t)row * D + c), gg = *(const float4*)(mod_g2 + b * 6144 + c);
    float4 o; o.x = xv.x + gg.x * acc.x; o.y = xv.y + gg.y * acc.y; o.z = xv.z + gg.z * acc.z; o.w = xv.w + gg.w * acc.w;
    *(float4*)(out + (size_t)row * D + c) = o;
}

#define MK_HYBRID 0
#define MK_POOL_IN 1
#define MK_MLA_IN 1
#define MK_ATTN_IN 1
#define MK_HGRN_IN 1
__device__ __forceinline__ unsigned mk_lane_id() { unsigned l; asm volatile("v_mbcnt_lo_u32_b32 %0, -1, 0\n\tv_mbcnt_hi_u32_b32 %0, -1, %0" : "=v"(l)); return l; }
#define GAS __attribute__((address_space(1)))
#define LAS __attribute__((address_space(3)))
#define XB_TMO      128
#define XB_XCNT(j)  (256  + 64 * (j))
#define XB_XSUB(j)  (1280 + 64 * (j))
#define XB_XGEN(j)  (2304 + 64 * (j))
#define XB_TOP      3328
#define XB_TOPGEN   3392
#define XCD_BAR_WORDS 3456
#define XB_SPIN_CAP (1u << 18)

__device__ __forceinline__ unsigned xb_ld(unsigned* p)              { return __hip_atomic_load(p, __ATOMIC_RELAXED, __HIP_MEMORY_SCOPE_AGENT); }
__device__ __forceinline__ unsigned xb_add(unsigned* p, unsigned v) { return __hip_atomic_fetch_add(p, v, __ATOMIC_RELAXED, __HIP_MEMORY_SCOPE_AGENT); }
__device__ __forceinline__ unsigned xb_xcc_id() { return (unsigned)__builtin_amdgcn_s_getreg((3 << 11) | 20) & 0xFu; }
#define XB_SPIN(cond, bar) do { unsigned _sp = 0; while (cond) { __builtin_amdgcn_s_sleep(1); \
    if ((++_sp & 255u) == 0u) { if (xb_ld(&(bar)[XB_TMO])) break; if (_sp > XB_SPIN_CAP) { atomicAdd(&(bar)[XB_TMO], 1u); break; } } } } while (0)

struct XcdBarrier {
    unsigned* bar; unsigned x; int wv;
    volatile LAS unsigned* st;
};

__device__ __forceinline__ bool xb_thread0(int wv) { return wv == 0 && mk_lane_id() == 0u; }
__device__ __forceinline__ XcdBarrier xcd_barrier_post(unsigned* bar, volatile LAS unsigned* st, int wv) {
    XcdBarrier b; b.bar = bar; b.x = xb_xcc_id(); b.st = st; b.wv = wv;
    if (xb_thread0(wv)) (void)xb_add(&bar[XB_XCNT(b.x)], 1u);
    return b;
}
__device__ __forceinline__ void xcd_barrier_complete(unsigned* bar, unsigned x, unsigned& nloc, unsigned& nx) {
    const unsigned G = gridDim.x * gridDim.y * gridDim.z;
    unsigned sum, cnt, mine, sp = 0u;
    for (;;) {
        sum = 0u; cnt = 0u; mine = 0u;
#pragma unroll
        for (unsigned j = 0; j < 16; ++j) { const unsigned c = xb_ld(&bar[XB_XCNT(j)]); sum += c; cnt += (c > 0u) ? 1u : 0u; mine = (j == x) ? c : mine; }
        if (sum == G) break;
        __builtin_amdgcn_s_sleep(1);
        if ((++sp & 255u) == 0u) { if (xb_ld(&bar[XB_TMO])) break; if (sp > XB_SPIN_CAP) { atomicAdd(&bar[XB_TMO], 1u); break; } }
    }
    nloc = mine > 0u ? mine : 1u; nx = cnt > 0u ? cnt : 1u;
}

__device__ __forceinline__ void xcd_barrier(const XcdBarrier& b) {
    asm volatile("s_waitcnt vmcnt(0)" ::: "memory");
    __syncthreads();
    if (xb_thread0(b.wv)) {
        unsigned* bar = b.bar;
        __builtin_amdgcn_s_waitcnt(0);
        unsigned nloc = b.st[0], nx = b.st[1];
        if (nloc == 0u) { xcd_barrier_complete(bar, b.x, nloc, nx); b.st[0] = nloc; b.st[1] = nx; }
        const unsigned old = xb_add(&bar[XB_XSUB(b.x)], 1u);
        const unsigned gen = old / nloc;
        if (old + 1u == (gen + 1u) * nloc) {
            __builtin_amdgcn_fence(__ATOMIC_RELEASE, "agent");
            asm volatile("s_waitcnt vmcnt(0)" ::: "memory");
            const unsigned og = xb_add(&bar[XB_TOP], 1u);
            const unsigned tg = og / nx;
            if (og + 1u == (tg + 1u) * nx) xb_add(&bar[XB_TOPGEN], 1u);
            else XB_SPIN(xb_ld(&bar[XB_TOPGEN]) == tg, bar);
            __builtin_amdgcn_fence(__ATOMIC_ACQUIRE, "agent");
            xb_add(&bar[XB_XGEN(b.x)], 1u);
            asm volatile("s_waitcnt vmcnt(0)" ::: "memory");
        } else {
            XB_SPIN(xb_ld(&bar[XB_XGEN(b.x)]) == gen, bar);
            __builtin_amdgcn_fence(__ATOMIC_ACQUIRE, "agent");
            asm volatile("s_waitcnt vmcnt(0)" ::: "memory");
        }
    }
    __syncthreads();
}
namespace pg8 {
#define PG8_LAS __attribute__((address_space(3)))
typedef unsigned short bf16_t;
typedef short bf16x8 __attribute__((ext_vector_type(8)));
typedef float f32x4 __attribute__((ext_vector_type(4)));
typedef unsigned u32x4 __attribute__((ext_vector_type(4)));
constexpr int BM = 256, BK = 64, HALF = 128, HTB = HALF * BK * 2  , STAGE_BYTES = 8 * HTB, NXCD = 8, WGM = 8;

__host__ __device__ __forceinline__ int lds_byte(int r, int c) { const int st = (r >> 4) * 2 + (c >> 5), rr = r & 15, cc = c & 31, ob = rr * 64 + cc * 2; return st * 1024 + (ob ^ (((ob >> 9) & 1) << 5)); }
__host__ __device__ __forceinline__ void stage_rc(int b, int& R, int& C) { const int st = b / 1024, sb = b % 1024, swz = sb ^ (((sb >> 9) & 1) << 5); R = (st >> 1) * 16 + swz / 64; C = (st & 1) * 32 + (swz % 64) / 2; }
__host__ __device__ __forceinline__ int perm32(int rho) { const int n = rho >> 4, i = rho & 15; return 8 * (i >> 2) + 4 * n + (i & 3); }

struct Unit { int pm, pn, ka, aux, e, gbase, gcnt, pad; };
struct Gemm { const bf16_t* A; const bf16_t* Bt; const int* rowlist; int lda, ldb, K, pad; };

struct StaticOrder {
    int nM, nN, nwg, G, c;
    __host__ __device__ void init(int M, int N, int G_, int c_) { nM = M / BM; nN = N / BM; nwg = nM * nN; G = G_; c = c_; }
    __host__ __device__ bool next(int i, Unit& u) const {
        const long L = (long)i * G + c; if (L >= nwg) return false;
        int wgid = (int)L; { const int q = nwg / NXCD, r = nwg % NXCD, xcd = wgid % NXCD, off = wgid / NXCD; wgid = (xcd < r ? xcd * (q + 1) : r * (q + 1) + (xcd - r) * q) + off; }
        const int nig = WGM * nN, gid = wgid / nig, fm = gid * WGM, gsz = (nM - fm) < WGM ? (nM - fm) : WGM;
        u.pm = fm + ((wgid % nig) % gsz); u.pn = (wgid % nig) / gsz; u.ka = 0; u.aux = 0; u.e = 0; u.gbase = 0; u.gcnt = 0; u.pad = 0; return true;
    }
};

typedef float cvt_f32x2 __attribute__((ext_vector_type(2)));
typedef __bf16 cvt_bf16x2 __attribute__((ext_vector_type(2)));
__device__ __forceinline__ unsigned cvt_pk_bf16(float lo, float hi) { const cvt_f32x2 v = {lo, hi}; return __builtin_bit_cast(unsigned, __builtin_convertvector(v, cvt_bf16x2)); }

template <class Epi, class Sched, bool ALIGN_EPI, bool SP2, bool GATHER, int HOOK = 0>
__device__ __forceinline__ void gemm_phase(PG8_LAS unsigned char* lds, const Gemm g, const Sched& S, const Epi& E, int wave_in) {
    int tid_ = wave_in * 64 + (int)mk_lane_id(); asm volatile("" : "+v"(tid_));
    const int tid = tid_, wid = __builtin_amdgcn_readfirstlane(tid >> 6), lane = tid & 63, wr = wid >> 2, wc = wid & 3, fr = lane & 15, fq = lane >> 4;
    const int K = g.K, nt = K / BK;
    const unsigned ldaB = (unsigned)g.lda * 2u, ldbB = (unsigned)g.ldb * 2u;
    unsigned voffA[2], voffB[2]; int rowA[2];
#pragma unroll
    for (int i = 0; i < 2; ++i) { int R, C; stage_rc(tid * 16 + i * 8192, R, C); const int Rb = Epi::PERM ? ((R & ~31) + perm32(R & 31)) : R;
        rowA[i] = R; voffA[i] = GATHER ? (unsigned)C * 2u : (unsigned)R * ldaB + (unsigned)C * 2u; voffB[i] = (unsigned)Rb * ldbB + (unsigned)C * 2u; }
    const size_t kstep = (size_t)(BK * 2);
    const size_t hstepA = GATHER ? 0 : (size_t)HALF * ldaB, hstepB = (size_t)HALF * ldbB;
    const size_t tstepA = 2 * (size_t)HALF * ldaB, tstepB = 2 * hstepB;
    const unsigned ldsw = (unsigned)wid * 1024u;
    const int aoff = lds_byte(wr * 64 + fr, fq * 8), boff = lds_byte(wc * 32 + fr, fq * 8);
    unsigned gvc[2][2], gvn[2][2];
#define PG8_SA(b, h) (((b) * 2 + (h)) * HTB)
#define PG8_SB(b, h) ((4 + (b) * 2 + (h)) * HTB)
#define PG8_STAGE(bufoff, gbase, voff) do { _Pragma("unroll") for (int _i = 0; _i < 2; ++_i) \
        __builtin_amdgcn_global_load_lds((const unsigned*)((const char*)(gbase) + (voff)[_i]), (PG8_LAS unsigned*)(lds + (bufoff) + ldsw + _i * 8192), 16, 0, 0); } while (0)
#define PG8_STAGEA(bufoff, gbase, h, nx) do { if constexpr (GATHER) { unsigned _vo[2]; _vo[0] = ((nx) ? gvn[h][0] : gvc[h][0]) + voffA[0]; _vo[1] = ((nx) ? gvn[h][1] : gvc[h][1]) + voffA[1]; PG8_STAGE(bufoff, gbase, _vo); } \
        else { PG8_STAGE(bufoff, (const char*)(gbase) + (h) * hstepA, voffA); } } while (0)
#define PG8_GLOAD(dst, u) do { _Pragma("unroll") for (int _h = 0; _h < 2; ++_h) _Pragma("unroll") for (int _i = 0; _i < 2; ++_i) { const int _r = _h * HALF + rowA[_i]; \
        const int _row = (_r < (u).gcnt) ? g.rowlist[(u).gbase + _r] : 0; dst[_h][_i] = (unsigned)_row * ldaB; } } while (0)
#define PG8_LDA(dst, b, h) do { _Pragma("unroll") for (int m = 0; m < 4; ++m) _Pragma("unroll") for (int k = 0; k < 2; ++k) dst[m][k] = *(const PG8_LAS bf16x8*)(lds + PG8_SA(b, h) + aoff + m * 2048 + k * 1024); } while (0)
#define PG8_LDB(dst, b, h) do { _Pragma("unroll") for (int n = 0; n < 2; ++n) _Pragma("unroll") for (int k = 0; k < 2; ++k) dst[n][k] = *(const PG8_LAS bf16x8*)(lds + PG8_SB(b, h) + boff + n * 2048 + k * 1024); } while (0)
#define PG8_MMA(ai, bj, At, Bt) do { __builtin_amdgcn_s_setprio(1); _Pragma("unroll") for (int m = 0; m < 4; ++m) _Pragma("unroll") for (int n = 0; n < 2; ++n) _Pragma("unroll") for (int k = 0; k < 2; ++k) \
        acc[ai][bj][m][n] = __builtin_amdgcn_mfma_f32_16x16x32_bf16(Bt[n][k], At[m][k], acc[ai][bj][m][n], 0, 0, 0); __builtin_amdgcn_s_setprio(0); } while (0)
#define PG8_WAIT_V(n) asm volatile("s_waitcnt vmcnt(" #n ")" ::: "memory")
#define PG8_WAIT_L(n) asm volatile("s_waitcnt lgkmcnt(" #n ")" ::: "memory")
#define PG8_BAR __builtin_amdgcn_s_barrier()
#define PG8_SCHED __builtin_amdgcn_sched_barrier(0)
    Unit cur, nxt; int ui = 0;
    if (!S.next(0, cur)) return;
    f32x4 acc[2][2][4][2];
#pragma unroll
    for (int a = 0; a < 2; ++a)
#pragma unroll
        for (int b = 0; b < 2; ++b)
#pragma unroll
            for (int m = 0; m < 4; ++m)
#pragma unroll
                for (int n = 0; n < 2; ++n) acc[a][b][m][n] = (f32x4){0.f, 0.f, 0.f, 0.f};
    bf16x8 At[4][2], B0[2][2], B1[2][2];
    const char* cA = (const char*)g.A + (GATHER ? (size_t)0 : (size_t)cur.pm * tstepA) + (size_t)cur.ka * 2; const char* cB = (const char*)g.Bt + (size_t)cur.pn * tstepB;
    if constexpr (GATHER) { PG8_GLOAD(gvc, cur); }
#pragma unroll
    for (int h = 0; h < 2; ++h)
#pragma unroll
        for (int i = 0; i < 2; ++i) gvn[h][i] = GATHER ? gvc[h][i] : 0u;
    {
        PG8_STAGE(PG8_SB(0, 0), cB, voffB); PG8_STAGE(PG8_SB(0, 1), cB + hstepB, voffB); PG8_STAGEA(PG8_SA(0, 0), cA, 0, false); PG8_STAGEA(PG8_SA(0, 1), cA, 1, false);
        if (wr == 1) PG8_BAR;
        PG8_WAIT_V(2); PG8_BAR;
        PG8_STAGE(PG8_SB(1, 0), cB + kstep, voffB); PG8_STAGEA(PG8_SA(1, 0), cA + kstep, 0, false); PG8_STAGE(PG8_SB(1, 1), cB + hstepB + kstep, voffB);
        PG8_WAIT_V(6); PG8_BAR;
    }
    for (;;) {
        const bool has_next = S.next(ui + 1, nxt);
        const char* nA = has_next ? (const char*)g.A + (GATHER ? (size_t)0 : (size_t)nxt.pm * tstepA) + (size_t)nxt.ka * 2 : cA; const char* nB = has_next ? (const char*)g.Bt + (size_t)nxt.pn * tstepB : cB;
        if constexpr (GATHER) { if (has_next) { PG8_GLOAD(gvn, nxt); } }
        E.prefetch(cur, wid, lane);
        for (int t = 0; t < nt; t += 2) {
            const bool last = (t == nt - 2);
            if constexpr (HOOK > 0) { if (t > 0 && (t % HOOK) == 0) E.mid(acc, cur, wr, wc, fr, fq, t); }
            const char* a1 = cA + (size_t)(t + 1) * kstep;
            const char* a2 = last ? nA : cA + (size_t)(t + 2) * kstep; const char* b2 = last ? nB : cB + (size_t)(t + 2) * kstep;
            const char* a3 = a2 + kstep; const char* b3 = b2 + kstep;
            PG8_LDB(B0, 0, 0); PG8_LDB(B1, 0, 1); PG8_SCHED; PG8_LDA(At, 0, 0); PG8_STAGEA(PG8_SA(1, 1), a1, 1, false);
            PG8_WAIT_V(8); PG8_WAIT_L(0); PG8_BAR; PG8_MMA(0, 0, At, B0); PG8_MMA(0, 1, At, B1); PG8_BAR; PG8_SCHED;
            PG8_LDA(At, 0, 1); PG8_STAGE(PG8_SB(0, 0), b2, voffB); PG8_STAGE(PG8_SB(0, 1), b2 + hstepB, voffB); PG8_STAGEA(PG8_SA(0, 0), a2, 0, last);
            PG8_WAIT_V(8); PG8_WAIT_L(0); PG8_BAR; PG8_MMA(1, 0, At, B0); PG8_MMA(1, 1, At, B1); PG8_BAR; PG8_SCHED;
            PG8_LDB(B0, 1, 0); PG8_LDB(B1, 1, 1); PG8_SCHED; PG8_LDA(At, 1, 0); PG8_STAGEA(PG8_SA(0, 1), a2, 1, last);
            PG8_WAIT_V(8); PG8_WAIT_L(0); PG8_BAR; PG8_MMA(0, 0, At, B0); PG8_MMA(0, 1, At, B1); PG8_BAR; PG8_SCHED;
            PG8_LDA(At, 1, 1); PG8_STAGE(PG8_SB(1, 0), b3, voffB); PG8_STAGE(PG8_SB(1, 1), b3 + hstepB, voffB); PG8_STAGEA(PG8_SA(1, 0), a3, 0, last);
            PG8_WAIT_V(8); PG8_WAIT_L(0); PG8_BAR; PG8_MMA(1, 0, At, B0); PG8_MMA(1, 1, At, B1); PG8_BAR; PG8_SCHED;
        }
        if constexpr (ALIGN_EPI) { if (wr == 0) PG8_BAR; }
        E(acc, cur, wr, wc, fr, fq);
        if (!has_next) break;
#pragma unroll
        for (int a = 0; a < 2; ++a)
#pragma unroll
            for (int b = 0; b < 2; ++b)
#pragma unroll
                for (int m = 0; m < 4; ++m)
#pragma unroll
                    for (int n = 0; n < 2; ++n) acc[a][b][m][n] = (f32x4){0.f, 0.f, 0.f, 0.f};
        cur = nxt; cA = nA; cB = nB; ++ui;
#pragma unroll
        for (int h = 0; h < 2; ++h)
#pragma unroll
            for (int i = 0; i < 2; ++i) gvc[h][i] = gvn[h][i];
        if constexpr (ALIGN_EPI) { if (wr == 1) PG8_BAR; }
    }
    PG8_WAIT_V(0);
    if constexpr (!ALIGN_EPI) { if (wr == 0) PG8_BAR; }
    PG8_BAR;
#undef PG8_SA
#undef PG8_SB
#undef PG8_STAGE
#undef PG8_STAGEA
#undef PG8_GLOAD
#undef PG8_LDA
#undef PG8_LDB
#undef PG8_MMA
#undef PG8_WAIT_V
#undef PG8_WAIT_L
#undef PG8_BAR
#undef PG8_SCHED
}
}
#ifndef MK_P5PROBE
#define MK_P5PROBE 0
#endif
#ifndef MK_HOOKPROBE
#define MK_HOOKPROBE 0
#endif
typedef unsigned v4u __attribute__((ext_vector_type(4)));
typedef unsigned v2u __attribute__((ext_vector_type(2)));
typedef float f32x4 __attribute__((ext_vector_type(4)));
typedef float f32x16 __attribute__((ext_vector_type(16)));
typedef short bf16x8 __attribute__((ext_vector_type(8)));
#define LDS_WAIT() asm volatile("s_waitcnt lgkmcnt(0)" ::: "memory")
#define VM_WAIT() asm volatile("s_waitcnt vmcnt(0)" ::: "memory")
__device__ __forceinline__ unsigned pk2(float lo, float hi) { return pg8::cvt_pk_bf16(lo, hi); }
__device__ __forceinline__ bf16 f2bf_hw(float x) { return (bf16)(pk2(x, 0.f) & 0xffffu); }
__device__ __forceinline__ float wave_sum(float v) {
#pragma unroll
    for (int o = 1; o < 64; o <<= 1) v += __shfl_xor(v, o);
    return v;
}

__device__ __forceinline__ float bflo(unsigned w) { return __uint_as_float(w << 16); }
__device__ __forceinline__ float bfhi(unsigned w) { return __uint_as_float(w & 0xffff0000u); }
#define MFMA32(a, b, c) __builtin_amdgcn_mfma_f32_32x32x16_bf16((a), (b), (c), 0, 0, 0)
typedef float f32x2 __attribute__((ext_vector_type(2)));
__device__ __forceinline__ f32x2 sq16(const f32x16& a, f32x2 s) {
#pragma unroll
    for (int r = 0; r < 16; r += 2) { const f32x2 p = {a[r], a[r + 1]}; s += p * p; }
    return s;
}

__device__ __forceinline__ void pool_unit(const bf16* __restrict__ P, bf16* __restrict__ BR, int unit, int tid) {
    asm volatile("" : "+v"(tid));
    const int tr = tid >> 6, tc = tid & 63, g = tc >> 4, w = 2 << g;
#pragma unroll 1
    for (int rr = 0; rr < 8; ++rr) {
        const int row = unit * 64 + rr * 8 + tr, s = row & (S - 1), n = (s + 1 < w) ? s + 1 : w;
        const bf16* p = P + (size_t)row * INP + C_POOL + 8 * tc;
        float a[8];
#pragma unroll
        for (int q = 0; q < 8; ++q) a[q] = 0.f;
        v4u wv[16];
#pragma unroll
        for (int j = 0; j < 16; ++j) wv[j] = (j < n) ? *(const GAS v4u*)(p - (size_t)j * INP) : (v4u){0u, 0u, 0u, 0u};
        const v4u u0 = wv[0];
#pragma unroll
        for (int j = 0; j < 16; ++j) { const v4u v = wv[j];
            a[0] += bflo(v.x); a[1] += bfhi(v.x); a[2] += bflo(v.y); a[3] += bfhi(v.y); a[4] += bflo(v.z); a[5] += bfhi(v.z); a[6] += bflo(v.w); a[7] += bfhi(v.w); }
        const float inv = __builtin_amdgcn_rcpf((float)n);
        v4u o; o.x = pk2(a[0] * inv - bflo(u0.x), a[1] * inv - bfhi(u0.x)); o.y = pk2(a[2] * inv - bflo(u0.y), a[3] * inv - bfhi(u0.y));
        o.z = pk2(a[4] * inv - bflo(u0.z), a[5] * inv - bfhi(u0.z)); o.w = pk2(a[6] * inv - bflo(u0.w), a[7] * inv - bfhi(u0.w));
        *(GAS v4u*)(BR + (size_t)row * 1536 + 1024 + 8 * tc) = o;
    }
}

constexpr int MLA_QS = 784, MLA_KS = 528;
__device__ __forceinline__ void mla_unit(const bf16* __restrict__ P, const float* __restrict__ qlat_g, const float* __restrict__ kvlat_g, const bf16* __restrict__ WuqT, const bf16* __restrict__ WukvT,
                                         const float* __restrict__ qn_g, const float* __restrict__ kn_g, const float* __restrict__ rope, bf16* __restrict__ Q, bf16* __restrict__ K, bf16* __restrict__ VT,
                                         LAS unsigned char* lds, int unit, int lane, int wave) {
    asm volatile("" : "+v"(lane));
    LAS unsigned char* qn = lds; LAS unsigned char* kvn = lds + 64 * MLA_QS;
    const int t0 = unit * 64;
#pragma unroll 1
    for (int rb = 0; rb < 2; ++rb) {
        unsigned qv[4][3], kv[4][2];
#pragma unroll
        for (int rr = 0; rr < 4; ++rr) { const bf16* pr = P + (size_t)(t0 + wave * 8 + rb * 4 + rr) * INP;
#pragma unroll
            for (int j = 0; j < 3; ++j) qv[rr][j] = *(const GAS unsigned*)(pr + C_QLAT + 2 * lane + 128 * j);
#pragma unroll
            for (int j = 0; j < 2; ++j) kv[rr][j] = *(const GAS unsigned*)(pr + C_KVLAT + 2 * lane + 128 * j); }
#pragma unroll
        for (int rr = 0; rr < 4; ++rr) {
            const int lr = wave * 8 + rb * 4 + rr; float s1 = 0.f, s2 = 0.f;
#pragma unroll
            for (int j = 0; j < 3; ++j) s1 += bflo(qv[rr][j]) * bflo(qv[rr][j]) + bfhi(qv[rr][j]) * bfhi(qv[rr][j]);
#pragma unroll
            for (int j = 0; j < 2; ++j) s2 += bflo(kv[rr][j]) * bflo(kv[rr][j]) + bfhi(kv[rr][j]) * bfhi(kv[rr][j]);
            s1 = wave_sum(s1); s2 = wave_sum(s2);
            const float r1 = rsqrtf(s1 * (1.f / 384.f) + EPS), r2 = rsqrtf(s2 * (1.f / 256.f) + EPS);
#pragma unroll
            for (int j = 0; j < 3; ++j) { const int c = 2 * lane + 128 * j; *(LAS unsigned*)(qn + lr * MLA_QS + c * 2) = pk2(bflo(qv[rr][j]) * r1 * qlat_g[c], bfhi(qv[rr][j]) * r1 * qlat_g[c + 1]); }
#pragma unroll
            for (int j = 0; j < 2; ++j) { const int c = 2 * lane + 128 * j; *(LAS unsigned*)(kvn + lr * MLA_KS + c * 2) = pk2(bflo(kv[rr][j]) * r2 * kvlat_g[c], bfhi(kv[rr][j]) * r2 * kvlat_g[c + 1]); }
        }
    }
    __syncthreads();
    const int l31 = lane & 31, h5 = lane >> 5;
    {
        f32x16 acc[3][2];
#pragma unroll
        for (int mt = 0; mt < 3; ++mt)
#pragma unroll
            for (int nt = 0; nt < 2; ++nt)
#pragma unroll
                for (int r = 0; r < 16; ++r) acc[mt][nt][r] = 0.f;
        const bf16* wp = WuqT + (size_t)(wave * 96 + l31) * 384 + 8 * h5;
        bf16x8 ar[4][3];
#pragma unroll
        for (int p = 0; p < 3; ++p)
#pragma unroll
            for (int mt = 0; mt < 3; ++mt) ar[p][mt] = *(const GAS bf16x8*)(wp + (size_t)mt * 32 * 384 + 16 * p);
#pragma unroll
        for (int ks = 0; ks < 24; ++ks) {
            if (ks + 3 < 24) {
#pragma unroll
                for (int mt = 0; mt < 3; ++mt) ar[(ks + 3) & 3][mt] = *(const GAS bf16x8*)(wp + (size_t)mt * 32 * 384 + 16 * (ks + 3)); }
            bf16x8 b[2];
#pragma unroll
            for (int nt = 0; nt < 2; ++nt) b[nt] = *(const LAS bf16x8*)(qn + (32 * nt + l31) * MLA_QS + (16 * ks + 8 * h5) * 2);
#pragma unroll
            for (int mt = 0; mt < 3; ++mt)
#pragma unroll
                for (int nt = 0; nt < 2; ++nt) acc[mt][nt] = MFMA32(ar[ks & 3][mt], b[nt], acc[mt][nt]);
        }
#pragma unroll
        for (int nt = 0; nt < 2; ++nt) {
            const int tok = t0 + 32 * nt + l31, b = tok / S, s = tok & (S - 1);
            f32x2 s2 = {0.f, 0.f};
#pragma unroll
            for (int mt = 0; mt < 3; ++mt) s2 = sq16(acc[mt][nt], s2);
            float ss = s2.x + s2.y;
            ss += __shfl_xor(ss, 32);
            const float rstd = rsqrtf(ss * (1.f / 96.f) + EPS);
            bf16* qo = Q + ((size_t)(b * MH + wave) * S + s) * 96;
#pragma unroll
            for (int mt = 0; mt < 2; ++mt)
#pragma unroll
                for (int g = 0; g < 4; ++g) { const int d0 = 32 * mt + 8 * g + 4 * h5; const f32x4 gn = *(const GAS f32x4*)(qn_g + d0);
                    v2u o; o.x = pk2(acc[mt][nt][4 * g] * rstd * gn[0], acc[mt][nt][4 * g + 1] * rstd * gn[1]); o.y = pk2(acc[mt][nt][4 * g + 2] * rstd * gn[2], acc[mt][nt][4 * g + 3] * rstd * gn[3]);
                    *(GAS v2u*)(qo + d0) = o; }
#pragma unroll
            for (int g = 0; g < 2; ++g) { const int i0 = 8 * g + 4 * h5;
                const f32x4 cs = *(const GAS f32x4*)(rope + (size_t)tok * 16 + i0), sn = *(const GAS f32x4*)(rope + (size_t)NT * 16 + (size_t)tok * 16 + i0);
                const f32x4 g1 = *(const GAS f32x4*)(qn_g + 64 + i0), g2 = *(const GAS f32x4*)(qn_g + 80 + i0);
                float o1[4], o2[4];
#pragma unroll
                for (int j = 0; j < 4; ++j) { const float x1 = acc[2][nt][4 * g + j] * rstd * g1[j], x2 = acc[2][nt][8 + 4 * g + j] * rstd * g2[j]; o1[j] = x1 * cs[j] - x2 * sn[j]; o2[j] = x2 * cs[j] + x1 * sn[j]; }
                v2u w1, w2; w1.x = pk2(o1[0], o1[1]); w1.y = pk2(o1[2], o1[3]); w2.x = pk2(o2[0], o2[1]); w2.y = pk2(o2[2], o2[3]);
                *(GAS v2u*)(qo + 64 + i0) = w1; *(GAS v2u*)(qo + 80 + i0) = w2; }
        }
    }
#pragma unroll 1
    for (int pass = 0; pass < 2; ++pass) {
        f32x16 acc[2][2];
#pragma unroll
        for (int mt = 0; mt < 2; ++mt)
#pragma unroll
            for (int nt = 0; nt < 2; ++nt)
#pragma unroll
                for (int r = 0; r < 16; ++r) acc[mt][nt][r] = 0.f;
        const bf16* wp = WukvT + (size_t)(wave * 128 + pass * 64 + l31) * 256 + 8 * h5;
        bf16x8 ar[4][2];
#pragma unroll
        for (int p = 0; p < 3; ++p)
#pragma unroll
            for (int mt = 0; mt < 2; ++mt) ar[p][mt] = *(const GAS bf16x8*)(wp + (size_t)mt * 32 * 256 + 16 * p);
#pragma unroll
        for (int ks = 0; ks < 16; ++ks) {
            if (ks + 3 < 16) {
#pragma unroll
                for (int mt = 0; mt < 2; ++mt) ar[(ks + 3) & 3][mt] = *(const GAS bf16x8*)(wp + (size_t)mt * 32 * 256 + 16 * (ks + 3)); }
            bf16x8 b[2];
#pragma unroll
            for (int nt = 0; nt < 2; ++nt) b[nt] = *(const LAS bf16x8*)(kvn + (32 * nt + l31) * MLA_KS + (16 * ks + 8 * h5) * 2);
#pragma unroll
            for (int mt = 0; mt < 2; ++mt)
#pragma unroll
                for (int nt = 0; nt < 2; ++nt) acc[mt][nt] = MFMA32(ar[ks & 3][mt], b[nt], acc[mt][nt]);
        }
        if (pass == 0) {
#pragma unroll
          for (int nt = 0; nt < 2; ++nt) {
            const int tok = t0 + 32 * nt + l31, b = tok / S, s = tok & (S - 1);
            float kr[16];
#pragma unroll
            for (int g = 0; g < 4; ++g) { const v2u kv = *(const GAS v2u*)(P + (size_t)tok * INP + C_KROPE + 8 * g + 4 * h5); kr[4 * g] = bflo(kv.x); kr[4 * g + 1] = bfhi(kv.x); kr[4 * g + 2] = bflo(kv.y); kr[4 * g + 3] = bfhi(kv.y); }
            f32x2 s2 = {0.f, 0.f};
#pragma unroll
            for (int mt = 0; mt < 2; ++mt) s2 = sq16(acc[mt][nt], s2);
            float ss = s2.x + s2.y;
#pragma unroll
            for (int r = 0; r < 16; ++r) ss += kr[r] * kr[r];
            ss += __shfl_xor(ss, 32);
            const float rstd = rsqrtf(ss * (1.f / 96.f) + EPS);
            bf16* ko = K + ((size_t)(b * MH + wave) * S + s) * 96;
#pragma unroll
            for (int mt = 0; mt < 2; ++mt)
#pragma unroll
                for (int g = 0; g < 4; ++g) { const int d0 = 32 * mt + 8 * g + 4 * h5; const f32x4 gn = *(const GAS f32x4*)(kn_g + d0);
                    v2u o; o.x = pk2(acc[mt][nt][4 * g] * rstd * gn[0], acc[mt][nt][4 * g + 1] * rstd * gn[1]); o.y = pk2(acc[mt][nt][4 * g + 2] * rstd * gn[2], acc[mt][nt][4 * g + 3] * rstd * gn[3]);
                    *(GAS v2u*)(ko + d0) = o; }
#pragma unroll
            for (int g = 0; g < 4; ++g) { const f32x4 gn = *(const GAS f32x4*)(kn_g + 64 + 8 * g + 4 * h5);
#pragma unroll
                for (int j = 0; j < 4; ++j) kr[4 * g + j] *= rstd * gn[j]; }
#pragma unroll
            for (int g = 0; g < 2; ++g) { const f32x4 cs = *(const GAS f32x4*)(rope + (size_t)tok * 16 + 8 * g + 4 * h5), sn = *(const GAS f32x4*)(rope + (size_t)NT * 16 + (size_t)tok * 16 + 8 * g + 4 * h5);
                float o1[4], o2[4];
#pragma unroll
                for (int j = 0; j < 4; ++j) { const float x1 = kr[4 * g + j], x2 = kr[8 + 4 * g + j]; o1[j] = x1 * cs[j] - x2 * sn[j]; o2[j] = x2 * cs[j] + x1 * sn[j]; }
                v2u w1, w2; w1.x = pk2(o1[0], o1[1]); w1.y = pk2(o1[2], o1[3]); w2.x = pk2(o2[0], o2[1]); w2.y = pk2(o2[2], o2[3]);
                *(GAS v2u*)(ko + 64 + 8 * g + 4 * h5) = w1; *(GAS v2u*)(ko + 80 + 8 * g + 4 * h5) = w2; }
          }
        } else {
#pragma unroll
          for (int nt = 0; nt < 2; ++nt) {
            int hq = h5; asm volatile("" : "+v"(hq));
            const int tok = t0 + 32 * nt + l31, b = tok / S, s = tok & (S - 1);
            bf16* vo = VT + ((size_t)(b * MH + wave) * 64 + 4 * hq) * S + s;
#pragma unroll
            for (int mt = 0; mt < 2; ++mt)
#pragma unroll
                for (int r = 0; r < 16; ++r) { const int dv = 32 * mt + (r & 3) + 8 * (r >> 2); vo[(size_t)dv * S] = f2bf_hw(acc[mt][nt][r]); }
          }
        }
    }
    __syncthreads();
}

constexpr int AT_KS = 208, AT_VS = 136;
constexpr int AT_KB = 64 * AT_KS, AT_VB = 64 * AT_VS;
constexpr float AT_C = 0.10206207261596575f * 1.4426950408889634f;
__device__ __forceinline__ void attn_unit(const bf16* __restrict__ Q, const bf16* __restrict__ K, const bf16* __restrict__ VT, bf16* __restrict__ BR, LAS unsigned char* lds, int bh, int qb, int tid, int lane, int wave) {
    asm volatile("" : "+v"(lane), "+v"(tid));
    const int l31 = lane & 31, h5 = lane >> 5;
    const int qw0 = 256 * qb + 32 * wave, ntile = 4 * qb + 4, mytiles = 4 * qb + (wave >> 1) + 1;
    const bf16* Kg = K + (size_t)bh * S * 96; const bf16* Vg = VT + (size_t)bh * 64 * S;
    LAS unsigned char* kbuf = lds; LAS unsigned char* vbuf = lds + 2 * AT_KB;
    bf16x8 qf[6];
    { const bf16* qp = Q + ((size_t)bh * S + qw0 + l31) * 96 + 8 * h5;
#pragma unroll
      for (int ks = 0; ks < 6; ++ks) qf[ks] = *(const GAS bf16x8*)(qp + 16 * ks); }
    f32x16 o[2];
#pragma unroll
    for (int r = 0; r < 16; ++r) { o[0][r] = 0.f; o[1][r] = 0.f; }
    float mrow = -INFINITY, lrow = 0.f;
    const int kc0 = tid, kc1 = tid + 512; const bool k1 = kc1 < 768;
    const unsigned kl0 = (unsigned)((kc0 / 12) * AT_KS + (kc0 % 12) * 16), kl1 = (unsigned)((kc1 / 12) * AT_KS + (kc1 % 12) * 16), vl = (unsigned)((tid >> 3) * AT_VS + (tid & 7) * 16);
    v4u sk0, sk1 = (v4u){0u, 0u, 0u, 0u}, sv;
#define AT_GLOADK(j) do { const bf16* kp = Kg + (size_t)(j) * 64 * 96; sk0 = *(const GAS v4u*)(kp + (size_t)kc0 * 8); if (k1) sk1 = *(const GAS v4u*)(kp + (size_t)kc1 * 8); } while (0)
#define AT_GLOADV(j) do { sv = *(const GAS v4u*)(Vg + (size_t)(tid >> 3) * S + (size_t)(j) * 64 + (tid & 7) * 8); } while (0)
#define AT_LSTOREK(buf) do { LAS unsigned char* kb = kbuf + (buf) * AT_KB; *(LAS v4u*)(kb + kl0) = sk0; if (k1) *(LAS v4u*)(kb + kl1) = sk1; } while (0)
#define AT_LSTOREV(buf) do { LAS unsigned char* vb = vbuf + (buf) * AT_VB + vl; *(LAS v2u*)(vb) = (v2u){sv.x, sv.y}; *(LAS v2u*)(vb + 8) = (v2u){sv.z, sv.w}; } while (0)
#define AT_QK(dst, buf) do { const LAS unsigned char* kb = kbuf + (buf) * AT_KB; _Pragma("unroll") for (int kt = 0; kt < 2; ++kt) { _Pragma("unroll") for (int r = 0; r < 16; ++r) dst[kt][r] = 0.f; \
        _Pragma("unroll") for (int ks = 0; ks < 6; ++ks) { const bf16x8 kf = *(const LAS bf16x8*)(kb + (32 * kt + l31) * AT_KS + (16 * ks + 8 * h5) * 2); dst[kt] = MFMA32(kf, qf[ks], dst[kt]); } } } while (0)
    AT_GLOADK(0); AT_GLOADV(0); AT_LSTOREK(0); AT_LSTOREV(0);
    AT_GLOADK(1); AT_LSTOREK(1);
    __syncthreads();
    f32x16 sa[2], sb[2];
    AT_QK(sa, 0);
    __syncthreads();
#define AT_BODY(SC, SN, J) do { const int j = (J); \
        if (j + 2 < ntile) AT_GLOADK(j + 2); \
        if (j + 1 < ntile) AT_GLOADV(j + 1); \
        if (j + 1 < mytiles) AT_QK(SN, (j + 1) & 1); \
        if (j < mytiles) { \
            const LAS unsigned char* vb = vbuf + (j & 1) * AT_VB; \
            if (j == mytiles - 1) { const int qq = qw0 + l31 - 64 * j; asm volatile("; diagonal tile" ::: "memory");     \
                _Pragma("unroll") for (int kt = 0; kt < 2; ++kt) _Pragma("unroll") for (int r = 0; r < 16; ++r) { const int kk = 32 * kt + (r & 3) + 8 * (r >> 2) + 4 * h5; if (kk > qq) SC[kt][r] = -INFINITY; } } \
            float mx = SC[0][0]; \
            _Pragma("unroll") for (int kt = 0; kt < 2; ++kt) _Pragma("unroll") for (int r = 0; r < 16; ++r) mx = fmaxf(mx, SC[kt][r]); \
            mx = fmaxf(mx, __shfl_xor(mx, 32)); \
            const float mnew = fmaxf(mrow, mx * AT_C), alpha = __builtin_amdgcn_exp2f(mrow - mnew); \
            mrow = mnew; \
            f32x2 ls2 = {0.f, 0.f}; const f32x2 c2 = {AT_C, AT_C}, m2 = {mnew, mnew}; \
            _Pragma("unroll") for (int kt = 0; kt < 2; ++kt) _Pragma("unroll") for (int r = 0; r < 16; r += 2) { f32x2 x = {SC[kt][r], SC[kt][r + 1]}; x = x * c2 - m2; \
                f32x2 pp; pp.x = __builtin_amdgcn_exp2f(x.x); pp.y = __builtin_amdgcn_exp2f(x.y); SC[kt][r] = pp.x; SC[kt][r + 1] = pp.y; ls2 += pp; } \
            lrow = lrow * alpha + (ls2.x + ls2.y); \
            _Pragma("unroll") for (int r = 0; r < 16; ++r) { o[0][r] *= alpha; o[1][r] *= alpha; } \
            _Pragma("unroll") for (int kt = 0; kt < 2; ++kt) _Pragma("unroll") for (int s2 = 0; s2 < 2; ++s2) { \
                union { bf16x8 v; unsigned u[4]; } pf; \
                _Pragma("unroll") for (int q = 0; q < 4; ++q) pf.u[q] = pk2(SC[kt][8 * s2 + 2 * q], SC[kt][8 * s2 + 2 * q + 1]); \
                _Pragma("unroll") for (int dvt = 0; dvt < 2; ++dvt) { union { bf16x8 v; v2u h[2]; } vf; \
                    const LAS unsigned char* vp = vb + (32 * dvt + l31) * AT_VS + (32 * kt + 16 * s2 + 4 * h5) * 2; \
                    vf.h[0] = *(const LAS v2u*)(vp); vf.h[1] = *(const LAS v2u*)(vp + 16); \
                    o[dvt] = MFMA32(vf.v, pf.v, o[dvt]); } } \
        } \
        if (j + 2 < ntile) AT_LSTOREK(j & 1); \
        if (j + 1 < ntile) AT_LSTOREV((j + 1) & 1); \
        __syncthreads(); } while (0)
#pragma unroll 1
    for (int jj = 0; jj < ntile; jj += 2) { AT_BODY(sa, sb, jj); AT_BODY(sb, sa, jj + 1); }
#undef AT_BODY
#undef AT_GLOADK
#undef AT_GLOADV
#undef AT_LSTOREK
#undef AT_LSTOREV
#undef AT_QK
    lrow += __shfl_xor(lrow, 32);
    const float inv = __builtin_amdgcn_rcpf(lrow);
    const int b = bh >> 3, h = bh & 7;
    bf16* op = BR + (size_t)(b * S + qw0 + l31) * 1536 + 512 + h * 64;
#pragma unroll
    for (int dvt = 0; dvt < 2; ++dvt)
#pragma unroll
        for (int g = 0; g < 4; ++g) { v2u w; w.x = pk2(o[dvt][4 * g] * inv, o[dvt][4 * g + 1] * inv); w.y = pk2(o[dvt][4 * g + 2] * inv, o[dvt][4 * g + 3] * inv);
            *(GAS v2u*)(op + 32 * dvt + 8 * g + 4 * h5) = w; }
}
#define MFMA16(a, b, c) __builtin_amdgcn_mfma_f32_16x16x32_bf16((a), (b), (c), 0, 0, 0)
constexpr int HG_VS = 144;
constexpr int HG_QS = 272;
__device__ __forceinline__ void hgrn_gate(float z, float lbv, float l1, float l2, float& lf, float& kv) {
    const float e = __expf(-fabsf(z)), ls = fminf(z, 0.f) - __logf(1.f + e);
    const float rc = __builtin_amdgcn_rcpf(1.f + e), sg = (z >= 0.f) ? rc : e * rc;
    kv = (1.f - lbv) * (1.f - sg);
    const float a = l1 + ls;
    if (lbv > 0.f) { const float mx = fmaxf(a, l2), dd = -fabsf(a - l2); lf = mx + __logf(1.f + __expf(dd)); } else lf = a;
}
struct HgA { unsigned zz[8]; unsigned vp[8]; };
__device__ __forceinline__ void hgrn_a_load(const bf16* __restrict__ P, int unit, int tid, HgA& r) {
    asm volatile("" : "+v"(tid));
    const int bh = unit >> 5, c = unit & 31, b = bh >> 2, h = bh & 3, tok0 = b * S + c * 64, d = tid & 127, seg = tid >> 7;
    const bf16* pz = P + (size_t)(tok0 + seg * 16) * INP + C_HF + h * 128 + d;
    const bf16* pv = P + (size_t)(tok0 + seg * 16) * INP + C_HI + h * 128 + d;
#pragma unroll
    for (int t = 0; t < 8; ++t) { r.zz[t] = (unsigned)pz[(size_t)(2 * t) * INP] | ((unsigned)pz[(size_t)(2 * t + 1) * INP] << 16); r.vp[t] = (unsigned)pv[(size_t)(2 * t) * INP] | ((unsigned)pv[(size_t)(2 * t + 1) * INP] << 16); }
}
__device__ __forceinline__ void hgrn_a_compute(const HgA& r, const float* __restrict__ lb, float* __restrict__ SLOC, float* __restrict__ DEC, LAS unsigned char* lds, int unit, int tid, int lane, int wave) {
    asm volatile("" : "+v"(tid), "+v"(lane));
    const int bh = unit >> 5, h = bh & 3;
    LAS float* tot = (LAS float*)lds;
    LAS unsigned char* vT = lds + 2048;
    LAS unsigned char* kT = vT + 128 * HG_VS;
    const int d = tid & 127, seg = tid >> 7;
    const float lbv = lb[h * 128 + d], l1 = __logf(1.f - lbv), l2 = (lbv > 0.f) ? __logf(lbv) : -INFINITY;
    float cs[16], kv[16]; float run = 0.f;
#pragma unroll
    for (int t = 0; t < 16; ++t) { float lf; hgrn_gate((t & 1) ? bfhi(r.zz[t >> 1]) : bflo(r.zz[t >> 1]), lbv, l1, l2, lf, kv[t]); run += lf; cs[t] = run; }
    tot[seg * 128 + d] = run;
#pragma unroll
    for (int t = 0; t < 8; ++t) *(LAS unsigned*)(vT + d * HG_VS + (seg * 16 + 2 * t) * 2) = r.vp[t];
    __syncthreads();
    float off = 0.f, bl = 0.f;
#pragma unroll
    for (int s = 0; s < 4; ++s) { const float tv = tot[s * 128 + d]; bl += tv; if (s < seg) off += tv; }
#pragma unroll
    for (int t = 0; t < 8; ++t) { const float k0 = kv[2 * t] * __expf(bl - (cs[2 * t] + off)), k1 = kv[2 * t + 1] * __expf(bl - (cs[2 * t + 1] + off));
        *(LAS unsigned*)(kT + d * HG_VS + (seg * 16 + 2 * t) * 2) = pk2(k0, k1); }
    if (seg == 0) DEC[(size_t)unit * 128 + d] = __expf(bl);
    __syncthreads();
    const int l31 = lane & 31, h5 = lane >> 5, mt = wave >> 1;
    f32x16 acc[2];
#pragma unroll
    for (int r2 = 0; r2 < 16; ++r2) { acc[0][r2] = 0.f; acc[1][r2] = 0.f; }
#pragma unroll
    for (int ks = 0; ks < 4; ++ks) {
        const bf16x8 a = *(const LAS bf16x8*)(vT + (32 * mt + l31) * HG_VS + (16 * ks + 8 * h5) * 2);
#pragma unroll
        for (int q = 0; q < 2; ++q) { const int nt = 2 * (wave & 1) + q; const bf16x8 bb = *(const LAS bf16x8*)(kT + (32 * nt + l31) * HG_VS + (16 * ks + 8 * h5) * 2); acc[q] = MFMA32(a, bb, acc[q]); }
    }
    float* so = SLOC + (size_t)unit * 16384;
#pragma unroll
    for (int q = 0; q < 2; ++q) { const int nt = 2 * (wave & 1) + q;
#pragma unroll
        for (int r2 = 0; r2 < 16; ++r2) { const int v = 32 * mt + (r2 & 3) + 8 * (r2 >> 2) + 4 * h5; so[(size_t)v * 128 + 32 * nt + l31] = acc[q][r2]; } }
    __syncthreads();
}
__device__ __forceinline__ void hgrn_a_all(const bf16* __restrict__ P, const float* __restrict__ lb, float* __restrict__ SLOC, float* __restrict__ DEC, LAS unsigned char* lds, int bx, int G, int tid, int lane, int wave) {
    HgA ra, rb; int u = bx;
    if (u < 1024) hgrn_a_load(P, u, tid, ra);
    while (u < 1024) {
        const int u2 = u + G, u3 = u2 + G;
        if (u2 < 1024) hgrn_a_load(P, u2, tid, rb);
        hgrn_a_compute(ra, lb, SLOC, DEC, lds, u, tid, lane, wave);
        if (u2 >= 1024) break;
        if (u3 < 1024) hgrn_a_load(P, u3, tid, ra);
        hgrn_a_compute(rb, lb, SLOC, DEC, lds, u2, tid, lane, wave);
        u = u3;
    }
}
__device__ __forceinline__ void hgrn_scan_unit(const float* __restrict__ SLOC, const float* __restrict__ DEC, bf16* __restrict__ ST, int unit, int tid) {
    asm volatile("" : "+v"(tid));
    const int bh = unit >> 3, idx = (unit & 7) * 2048 + tid * 4, d = idx & 127;
    f32x4 st = {0.f, 0.f, 0.f, 0.f};
    const float* sp = SLOC + (size_t)bh * 32 * 16384 + idx; const float* dp = DEC + (size_t)bh * 32 * 128 + d; bf16* op = ST + (size_t)bh * 32 * 16384 + idx;
#pragma unroll 1
    for (int cb = 0; cb < 32; cb += 16) {
        f32x4 sl[16], dc[16];
#pragma unroll
        for (int c = 0; c < 16; ++c) { sl[c] = *(const GAS f32x4*)(sp + (size_t)(cb + c) * 16384); dc[c] = *(const GAS f32x4*)(dp + (cb + c) * 128); }
#pragma unroll
        for (int c = 0; c < 16; ++c) {
            v2u o; o.x = pk2(st[0], st[1]); o.y = pk2(st[2], st[3]);
            *(GAS v2u*)(op + (size_t)(cb + c) * 16384) = o;
            st = dc[c] * st + sl[c];
        }
    }
}
__device__ __forceinline__ void hgrn_c_unit(const bf16* __restrict__ P, const float* __restrict__ lb, const bf16* __restrict__ ST, const float* __restrict__ og, bf16* __restrict__ BR, LAS unsigned char* lds, int unit, int tid, int lane, int wave) {
    asm volatile("" : "+v"(tid), "+v"(lane));
    const int bh = unit >> 5, c = unit & 31, b = bh >> 2, h = bh & 3, tok0 = b * S + c * 64;
    LAS float* bcum = (LAS float*)lds;
    LAS unsigned char* q0 = lds + 32768;
    LAS unsigned char* qi = q0 + 64 * HG_QS;
    LAS unsigned char* kr = qi + 64 * HG_QS;
    LAS unsigned char* vT = kr + 64 * HG_QS;
    LAS unsigned char* at = vT + 128 * HG_VS;
    LAS float* tot = (LAS float*)(at + 64 * HG_VS);
    LAS float* ob = (LAS float*)lds;
    const int d = tid & 127, seg = tid >> 7;
    const int l31 = lane & 31, h5 = lane >> 5, mtw = wave >> 2, ntw = wave & 3;
    unsigned zq[16], vp[8]; v4u gq0, gq1; bf16x8 stf[8];
    {
        const bf16* pz = P + (size_t)(tok0 + seg * 16) * INP + C_HF + h * 128 + d;
        const bf16* pq = P + (size_t)(tok0 + seg * 16) * INP + C_HQ + h * 128 + d;
        const bf16* pv = P + (size_t)(tok0 + seg * 16) * INP + C_HI + h * 128 + d;
#pragma unroll
        for (int t = 0; t < 16; ++t) zq[t] = (unsigned)pz[(size_t)t * INP] | ((unsigned)pq[(size_t)t * INP] << 16);
#pragma unroll
        for (int t = 0; t < 8; ++t) vp[t] = (unsigned)pv[(size_t)(2 * t) * INP] | ((unsigned)pv[(size_t)(2 * t + 1) * INP] << 16);
        const bf16* pg = P + (size_t)(tok0 + (tid >> 3)) * INP + C_HG + h * 128 + (tid & 7) * 16;
        gq0 = *(const GAS v4u*)pg; gq1 = *(const GAS v4u*)(pg + 8);
        if (c > 0) { const bf16* sp = ST + (size_t)unit * 16384 + (size_t)(32 * ntw + l31) * 128 + 8 * h5;
#pragma unroll
            for (int ks = 0; ks < 8; ++ks) stf[ks] = *(const GAS bf16x8*)(sp + 16 * ks); }
        else {
#pragma unroll
            for (int ks = 0; ks < 8; ++ks) stf[ks] = (bf16x8){0, 0, 0, 0, 0, 0, 0, 0}; }
    }
    {
        const float lbv = lb[h * 128 + d], l1 = __logf(1.f - lbv), l2 = (lbv > 0.f) ? __logf(lbv) : -INFINITY;
        float cs[16], kv[16]; float run = 0.f;
#pragma unroll
        for (int t = 0; t < 16; ++t) { float lf; hgrn_gate(bflo(zq[t]), lbv, l1, l2, lf, kv[t]); run += lf; cs[t] = run; }
        tot[seg * 128 + d] = run;
#pragma unroll
        for (int t = 0; t < 8; ++t) *(LAS unsigned*)(vT + d * HG_VS + (seg * 16 + 2 * t) * 2) = vp[t];
        for (int i = tid; i < 64 * HG_VS / 4; i += 512) ((LAS unsigned*)at)[i] = 0u;
        __syncthreads();
        float off = 0.f;
#pragma unroll
        for (int s = 0; s < 4; ++s) { const float tv = tot[s * 128 + d]; if (s < seg) off += tv; }
#pragma unroll
        for (int t = 0; t < 16; ++t) { const int tt = seg * 16 + t; const float qv = bfhi(zq[t]);
            bcum[tt * 128 + d] = cs[t] + off;
            *(LAS bf16*)(q0 + tt * HG_QS + d * 2) = f2bf_hw(qv * __expf(cs[t] + off));
            *(LAS bf16*)(qi + tt * HG_QS + d * 2) = f2bf_hw(qv * __expf(cs[t]));
            *(LAS bf16*)(kr + tt * HG_QS + d * 2) = f2bf_hw(kv[t]); }
    }
    __syncthreads();
    {
        const int l15 = lane & 15, g4 = lane >> 4;
#pragma unroll 1
        for (int blk = wave; blk < 10; blk += 8) {
            const int i = (blk >= 6) ? 3 : (blk >= 3) ? 2 : (blk >= 1) ? 1 : 0, j = blk - ((i * (i + 1)) >> 1);
            f32x4 acc = {0.f, 0.f, 0.f, 0.f};
#pragma unroll
            for (int ks = 0; ks < 4; ++ks) {
                const int dd = 32 * ks + 8 * g4;
                const bf16x8 a = *(const LAS bf16x8*)(qi + (16 * i + l15) * HG_QS + dd * 2);
                const v4u kw = *(const LAS v4u*)(kr + (16 * j + l15) * HG_QS + dd * 2);
                const f32x4 b0 = *(const LAS f32x4*)(bcum + (16 * j + l15) * 128 + dd), b1 = *(const LAS f32x4*)(bcum + (16 * j + l15) * 128 + dd + 4);
                f32x4 r0 = {0.f, 0.f, 0.f, 0.f}, r1 = {0.f, 0.f, 0.f, 0.f};
                if (i > 0) { r0 = *(const LAS f32x4*)(bcum + (16 * i - 1) * 128 + dd); r1 = *(const LAS f32x4*)(bcum + (16 * i - 1) * 128 + dd + 4); }
                union { bf16x8 v; unsigned u[4]; } kf;
                kf.u[0] = pk2(bflo(kw.x) * __expf(r0[0] - b0[0]), bfhi(kw.x) * __expf(r0[1] - b0[1])); kf.u[1] = pk2(bflo(kw.y) * __expf(r0[2] - b0[2]), bfhi(kw.y) * __expf(r0[3] - b0[3]));
                kf.u[2] = pk2(bflo(kw.z) * __expf(r1[0] - b1[0]), bfhi(kw.z) * __expf(r1[1] - b1[1])); kf.u[3] = pk2(bflo(kw.w) * __expf(r1[2] - b1[2]), bfhi(kw.w) * __expf(r1[3] - b1[3]));
                acc = MFMA16(a, kf.v, acc);
            }
#pragma unroll
            for (int r = 0; r < 4; ++r) { const int tl = 4 * g4 + r; float v = acc[r]; if (i == j && l15 > tl) v = 0.f; *(LAS bf16*)(at + (16 * i + tl) * HG_VS + (16 * j + l15) * 2) = f2bf_hw(v); }
        }
    }
    __syncthreads();
    {
        const int mt = mtw, nt = ntw;
        f32x16 acc;
#pragma unroll
        for (int r = 0; r < 16; ++r) acc[r] = 0.f;
#pragma unroll
        for (int ks = 0; ks < 4; ++ks) { const bf16x8 a = *(const LAS bf16x8*)(at + (32 * mt + l31) * HG_VS + (16 * ks + 8 * h5) * 2), bb = *(const LAS bf16x8*)(vT + (32 * nt + l31) * HG_VS + (16 * ks + 8 * h5) * 2); acc = MFMA32(a, bb, acc); }
        if (c > 0) {
#pragma unroll
            for (int ks = 0; ks < 8; ++ks) { const bf16x8 a = *(const LAS bf16x8*)(q0 + (32 * mt + l31) * HG_QS + (16 * ks + 8 * h5) * 2); acc = MFMA32(a, stf[ks], acc); } }
        __syncthreads();
#pragma unroll
        for (int r = 0; r < 16; ++r) { const int t = 32 * mt + (r & 3) + 8 * (r >> 2) + 4 * h5; ob[t * 132 + 32 * nt + l31] = acc[r]; }
    }
    __syncthreads();
    {
        const int t = tid >> 3, v0 = (tid & 7) * 16;
        f32x4 o4[4]; float ss = 0.f;
#pragma unroll
        for (int q = 0; q < 4; ++q) { o4[q] = *(const LAS f32x4*)(ob + t * 132 + v0 + 4 * q); ss += (o4[q][0] * o4[q][0] + o4[q][1] * o4[q][1]) + (o4[q][2] * o4[q][2] + o4[q][3] * o4[q][3]); }
        ss += __shfl_xor(ss, 1); ss += __shfl_xor(ss, 2); ss += __shfl_xor(ss, 4);
        const float rstd = rsqrtf(ss * (1.f / 128.f) + EPS);
        const v4u g0 = gq0, g1 = gq1;
        float gv[16]; gv[0] = bflo(g0.x); gv[1] = bfhi(g0.x); gv[2] = bflo(g0.y); gv[3] = bfhi(g0.y); gv[4] = bflo(g0.z); gv[5] = bfhi(g0.z); gv[6] = bflo(g0.w); gv[7] = bfhi(g0.w);
        gv[8] = bflo(g1.x); gv[9] = bfhi(g1.x); gv[10] = bflo(g1.y); gv[11] = bfhi(g1.y); gv[12] = bflo(g1.z); gv[13] = bfhi(g1.z); gv[14] = bflo(g1.w); gv[15] = bfhi(g1.w);
        float ov[16];
#pragma unroll
        for (int q = 0; q < 4; ++q) { const f32x4 gn = *(const GAS f32x4*)(og + v0 + 4 * q);
#pragma unroll
            for (int jj = 0; jj < 4; ++jj) { const float gg = gv[4 * q + jj]; ov[4 * q + jj] = o4[q][jj] * rstd * gn[jj] * gg * __builtin_amdgcn_rcpf(1.f + __expf(-gg)); } }
        v4u w0, w1; w0.x = pk2(ov[0], ov[1]); w0.y = pk2(ov[2], ov[3]); w0.z = pk2(ov[4], ov[5]); w0.w = pk2(ov[6], ov[7]); w1.x = pk2(ov[8], ov[9]); w1.y = pk2(ov[10], ov[11]); w1.z = pk2(ov[12], ov[13]); w1.w = pk2(ov[14], ov[15]);
        bf16* po = BR + (size_t)(tok0 + t) * 1536 + h * 128 + v0;
        *(GAS v4u*)po = w0; *(GAS v4u*)(po + 8) = w1;
    }
    __syncthreads();
}
constexpr int NWAVES = 8, NTHR = 512;
constexpr int RING_OFF = 0, RING_BYTES = 131072, LDSCTL_OFF = RING_BYTES, LDS_BYTES = 147456;
constexpr int LW_BAR = 0, LW_TP = 16, LW_CNT = 64, LW_LCNT = 96, LW_BASE = 128, LW_ENTE = 256, LW_ENTW = 512, LW_RANK = 768, LW_BIAS = 1024;
constexpr int CW_Q = 1024, CW_PD = 1088;
constexpr int LW_CONV = 8;
constexpr int CW_BAR = 4096;
constexpr int NPH_L = 10, PH_FINAL = 1 + L * NPH_L, NPH = PH_FINAL + 1;

struct MkArgs { const void* in[28]; float* out; unsigned char* ws; float invf[16]; int ph_lo, ph_hi, li, pad; };
typedef const MkArgs __attribute__((address_space(4))) CMkArgs;
#define KA_PTR(name) CMkArgs* name = (CMkArgs*)__builtin_amdgcn_kernarg_segment_ptr(); asm volatile("" : "+s"(name))

using pg8::Unit; using pg8::u32x4; using pg8::cvt_pk_bf16;
constexpr int GATE_TILE0 = 13;
__device__ __forceinline__ size_t gt_off(int g, int pm, int pn4, int chunk, int tid) { return ((((size_t)(g * 64 + pm) * 4 + pn4) * 16 + chunk) * 512 + tid) * 8; }
struct EpiP {
    static constexpr bool PERM = true; bf16* O; int ldc; bf16* GT;
    __device__ __forceinline__ void prefetch(const Unit&, int, int) const {}
    __device__ __forceinline__ void operator()(const f32x4 (&acc)[2][2][4][2], const Unit& u, int wr, int wc, int fr, int fq) const {
        const int row0 = u.pm * 256 + wr * 64 + fr, col0 = u.pn * 256 + wc * 32 + 8 * fq;
        const bool gate = (GT != nullptr) && u.pn >= GATE_TILE0; const int gi = (u.pn - GATE_TILE0) >> 2, pn4 = (u.pn - GATE_TILE0) & 3, tid = (wr * 4 + wc) * 64 + fq * 16 + fr;
#pragma unroll
        for (int ai = 0; ai < 2; ++ai)
#pragma unroll
            for (int m = 0; m < 4; ++m) { bf16* rowp = O + (size_t)(row0 + ai * 128 + m * 16) * ldc + col0;
#pragma unroll
                for (int bj = 0; bj < 2; ++bj) { f32x4 v0 = acc[ai][bj][m][0], v1 = acc[ai][bj][m][1];
                    u32x4 w; w.x = cvt_pk_bf16(v0[0], v0[1]); w.y = cvt_pk_bf16(v0[2], v0[3]); w.z = cvt_pk_bf16(v1[0], v1[1]); w.w = cvt_pk_bf16(v1[2], v1[3]);
                    if (gate) *(u32x4*)(GT + gt_off(gi, u.pm, pn4, (ai * 4 + m) * 2 + bj, tid)) = w; else *(u32x4*)(rowp + bj * 128) = w; } }
    }
};
struct EpiBranch {
    static constexpr bool PERM = true; const bf16* GT; bf16* MB;
    __device__ __forceinline__ void prefetch(const Unit&, int, int) const {}
    __device__ __forceinline__ static void unpack8(const u32x4 w, float (&g)[8]) { g[0] = __uint_as_float(w.x << 16); g[1] = __uint_as_float(w.x & 0xffff0000u); g[2] = __uint_as_float(w.y << 16); g[3] = __uint_as_float(w.y & 0xffff0000u);
        g[4] = __uint_as_float(w.z << 16); g[5] = __uint_as_float(w.z & 0xffff0000u); g[6] = __uint_as_float(w.w << 16); g[7] = __uint_as_float(w.w & 0xffff0000u); }
    __device__ __forceinline__ static float em(float x) { return __expf(-fminf(fmaxf(x, -30.f), 30.f)); }
    __device__ __forceinline__ void mid(f32x4 (&acc)[2][2][4][2], const Unit& u, int wr, int wc, int fr, int fq, int t) const {
        asm volatile("" : "+v"(fr), "+v"(fq));
        const int gnum = (t == 8) ? 0 : 1, tid = (wr * 4 + wc) * 64 + fq * 16 + fr;
        const bf16* gn0 = GT + gt_off(gnum, u.pm, u.pn, 0, tid); const bf16* gd0 = GT + gt_off(gnum + 1, u.pm, u.pn, 0, tid);
#pragma unroll
        for (int ai = 0; ai < 2; ++ai)
#pragma unroll
            for (int m = 0; m < 4; ++m)
#pragma unroll
                for (int bj = 0; bj < 2; ++bj) { const int ch = (ai * 4 + m) * 2 + bj; float gn[8], gd[8]; unpack8(*(const u32x4*)(gn0 + (size_t)ch * 4096), gn); unpack8(*(const u32x4*)(gd0 + (size_t)ch * 4096), gd);
#pragma unroll
                    for (int j = 0; j < 4; ++j) { acc[ai][bj][m][0][j] *= (1.f + em(gd[j])) * __builtin_amdgcn_rcpf(1.f + em(gn[j])); acc[ai][bj][m][1][j] *= (1.f + em(gd[4 + j])) * __builtin_amdgcn_rcpf(1.f + em(gn[4 + j])); } }
    }
    __device__ __forceinline__ void operator()(const f32x4 (&acc)[2][2][4][2], const Unit& u, int wr, int wc, int fr, int fq) const {
        const int row0 = u.pm * 256 + wr * 64 + fr, col0 = u.pn * 256 + wc * 32 + 8 * fq, tid = (wr * 4 + wc) * 64 + fq * 16 + fr;
        const bf16* gc0 = GT + gt_off(2, u.pm, u.pn, 0, tid);
#pragma unroll
        for (int ai = 0; ai < 2; ++ai)
#pragma unroll
            for (int m = 0; m < 4; ++m) { const size_t row = (size_t)(row0 + ai * 128 + m * 16);
#pragma unroll
                for (int bj = 0; bj < 2; ++bj) { const int col = col0 + bj * 128; float gc[8]; unpack8(*(const u32x4*)(gc0 + (size_t)((ai * 4 + m) * 2 + bj) * 4096), gc);
                    f32x4 v0 = acc[ai][bj][m][0], v1 = acc[ai][bj][m][1];
#pragma unroll
                    for (int j = 0; j < 4; ++j) { v0[j] *= __builtin_amdgcn_rcpf(1.f + em(gc[j])); v1[j] *= __builtin_amdgcn_rcpf(1.f + em(gc[4 + j])); }
                    u32x4 w; w.x = cvt_pk_bf16(v0[0], v0[1]); w.y = cvt_pk_bf16(v0[2], v0[3]); w.z = cvt_pk_bf16(v1[0], v1[1]); w.w = cvt_pk_bf16(v1[2], v1[3]); *(u32x4*)(MB + row * 1024 + col) = w; } }
    }
};
struct EpiOut {
    static constexpr bool PERM = false; const float* xin; const float* gvec; float* out;
    __device__ __forceinline__ void prefetch(const Unit&, int, int) const {}
    __device__ __forceinline__ void operator()(const f32x4 (&acc)[2][2][4][2], const Unit& u, int wr, int wc, int fr, int fq) const {
        const int row0 = u.pm * 256 + wr * 64 + fr, col0 = u.pn * 256 + wc * 32 + 4 * fq;
#pragma unroll
        for (int ai = 0; ai < 2; ++ai)
#pragma unroll
            for (int m = 0; m < 4; ++m) { const size_t row = (size_t)(row0 + ai * 128 + m * 16); const int b = (int)(row / S);
#pragma unroll
                for (int bj = 0; bj < 2; ++bj)
#pragma unroll
                    for (int n = 0; n < 2; ++n) { const int col = col0 + bj * 128 + 16 * n;
                        const f32x4 xv = *(const f32x4*)(xin + row * 1024 + col), gv = *(const f32x4*)(gvec + b * 6144 + col);
                        *(f32x4*)(out + row * 1024 + col) = xv + gv * acc[ai][bj][m][n]; } }
    }
};
struct EpiMoe1 {
    static constexpr bool PERM = true; const float* b1; bf16* ACT; LAS float* bl;
    typedef float f2 __attribute__((ext_vector_type(2)));
    __device__ __forceinline__ void prefetch(const Unit& u, int wid, int lane) const {
        if (wid < 4) { const float* src = b1 + u.e * 2048 + (wid >> 1) * 1024 + u.aux * 128 + (wid & 1) * 64 + lane;
            __builtin_amdgcn_global_load_lds((const unsigned*)src, (LAS unsigned*)(bl + wid * 64), 4, 0, 0); } }
    __device__ __forceinline__ static f2 act2(f2 g, f2 l) {
        const f2 c7 = {7.f, 7.f}, cm7 = {-7.f, -7.f}, one = {1.f, 1.f}, ck = {-1.702f * 1.4426950408889634f, -1.702f * 1.4426950408889634f};
        g = __builtin_elementwise_min(g, c7); l = __builtin_elementwise_min(__builtin_elementwise_max(l, cm7), c7);
        const f2 x = g * ck; f2 ex; ex.x = __builtin_amdgcn_exp2f(x.x); ex.y = __builtin_amdgcn_exp2f(x.y);
        const f2 d = ex + one; f2 r; r.x = __builtin_amdgcn_rcpf(d.x); r.y = __builtin_amdgcn_rcpf(d.y);
        return (g * r) * (l + one);
    }
    __device__ __forceinline__ void operator()(const f32x4 (&acc)[2][2][4][2], const Unit& u, int wr, int wc, int fr, int fq) const {
        const int row0 = u.pm * 256 + wr * 64 + fr, lc = wc * 32 + 8 * fq, ccol = u.aux * 128 + lc;
        const f32x4 bg0 = *(const LAS f32x4*)(bl + lc), bg1 = *(const LAS f32x4*)(bl + lc + 4), bl0 = *(const LAS f32x4*)(bl + 128 + lc), bl1 = *(const LAS f32x4*)(bl + 128 + lc + 4);
#pragma unroll
        for (int ai = 0; ai < 2; ++ai)
#pragma unroll
            for (int m = 0; m < 4; ++m) { const size_t row = (size_t)(row0 + ai * 128 + m * 16);
                const f32x4 g0 = acc[ai][0][m][0] + bg0, g1 = acc[ai][0][m][1] + bg1, l0 = acc[ai][1][m][0] + bl0, l1 = acc[ai][1][m][1] + bl1;
                const f2 o0 = act2((f2){g0[0], g0[1]}, (f2){l0[0], l0[1]}), o1 = act2((f2){g0[2], g0[3]}, (f2){l0[2], l0[3]}), o2 = act2((f2){g1[0], g1[1]}, (f2){l1[0], l1[1]}), o3 = act2((f2){g1[2], g1[3]}, (f2){l1[2], l1[3]});
                u32x4 w; w.x = cvt_pk_bf16(o0.x, o0.y); w.y = cvt_pk_bf16(o1.x, o1.y); w.z = cvt_pk_bf16(o2.x, o2.y); w.w = cvt_pk_bf16(o3.x, o3.y);
                *(u32x4*)(ACT + row * 1024 + ccol) = w; }
    }
};
struct EpiMoe2 {
    static constexpr bool PERM = true; const float* b2; bf16* EO; LAS float* bl;
    __device__ __forceinline__ void prefetch(const Unit& u, int wid, int lane) const {
        if (wid < 4) __builtin_amdgcn_global_load_lds((const unsigned*)(b2 + u.e * 1024 + u.aux * 256 + wid * 64 + lane), (LAS unsigned*)(bl + wid * 64), 4, 0, 0); }
    __device__ __forceinline__ void operator()(const f32x4 (&acc)[2][2][4][2], const Unit& u, int wr, int wc, int fr, int fq) const {
        const int row0 = u.pm * 256 + wr * 64 + fr, lc = wc * 32 + 8 * fq, col0 = u.aux * 256 + lc;
        f32x4 bv[2][2];
#pragma unroll
        for (int bj = 0; bj < 2; ++bj) { bv[bj][0] = *(const LAS f32x4*)(bl + lc + bj * 128); bv[bj][1] = *(const LAS f32x4*)(bl + lc + bj * 128 + 4); }
#pragma unroll
        for (int ai = 0; ai < 2; ++ai)
#pragma unroll
            for (int m = 0; m < 4; ++m) { bf16* rowp = EO + (size_t)(row0 + ai * 128 + m * 16) * 1024 + col0;
#pragma unroll
                for (int bj = 0; bj < 2; ++bj) { const f32x4 v0 = acc[ai][bj][m][0] + bv[bj][0], v1 = acc[ai][bj][m][1] + bv[bj][1];
                    u32x4 w; w.x = cvt_pk_bf16(v0[0], v0[1]); w.y = cvt_pk_bf16(v0[2], v0[3]); w.z = cvt_pk_bf16(v1[0], v1[1]); w.w = cvt_pk_bf16(v1[2], v1[3]);
                    *(u32x4*)(rowp + bj * 128) = w; } }
    }
};
struct MoeOrder {
    const LAS int* tp; const LAS int* cn; int NTn, G, c, rev;
    __device__ __forceinline__ bool next(int i, Unit& u) const {
        const int total = tp[32] * NTn; int Lx;
        if ((G & 7) == 0) { const int x = c & 7, j = c >> 3, lo = (int)(((long)total * x) >> 3), hi = (int)(((long)total * (x + 1)) >> 3); Lx = lo + i * (G >> 3) + j; if (Lx >= hi) return false;
            if (rev) Lx = hi - 1 - (Lx - lo); }
        else { Lx = i * G + c; if (Lx >= total) return false; }
        int e = 0;
        for (int q = 1; q < 32; ++q) if (Lx >= tp[q] * NTn) e = q;
        const int t0 = tp[e], r = Lx - t0 * NTn, mt = r / NTn, nt = r - mt * NTn;
        u.pm = __builtin_amdgcn_readfirstlane(t0 + mt); u.pn = __builtin_amdgcn_readfirstlane(e * NTn + nt); u.ka = 0; u.aux = __builtin_amdgcn_readfirstlane(nt); u.e = __builtin_amdgcn_readfirstlane(e);
        u.gbase = __builtin_amdgcn_readfirstlane(e * CAP + mt * 256); u.gcnt = __builtin_amdgcn_readfirstlane(cn[e] - mt * 256); u.pad = 0;
        return true;
    }
};
struct TrItem { const float* W; bf16* WT; int K, N, mode, row_off, ldk, koff, k0, n0; };
__device__ __forceinline__ void tr_load(const TrItem& t, float (&wv)[32], int lane) {
#pragma unroll
    for (int i = 0; i < 32; ++i) wv[i] = __builtin_nontemporal_load(t.W + (size_t)(t.k0 + 2 * i + (lane >> 5)) * t.N + t.n0 + (lane & 31));
}
__device__ __forceinline__ void tr_store(const TrItem& t, const float (&wv)[32], LAS float* scr, int lane) {
#pragma unroll
    for (int i = 0; i < 32; ++i) scr[(2 * i + (lane >> 5)) * 33 + (lane & 31)] = wv[i];
    LDS_WAIT(); asm volatile("" ::: "memory");
    const int c = lane & 7;
#pragma unroll
    for (int j = 0; j < 4; ++j) { const int n = (lane >> 3) + 8 * j; const LAS float* s = scr + (8 * c) * 33 + n;
        v4u o; o.x = pk2(s[0 * 33], s[1 * 33]); o.y = pk2(s[2 * 33], s[3 * 33]); o.z = pk2(s[4 * 33], s[5 * 33]); o.w = pk2(s[6 * 33], s[7 * 33]);
        const int nn = t.n0 + n; int r = nn; if (t.mode == 1) { const int half = nn >> 10, cc = nn & 1023; r = (cc >> 7) * 256 + half * 128 + (cc & 127); }
        if (t.mode == 2) r = (nn < 3232) ? nn : nn + 96;
        __builtin_nontemporal_store(o, (GAS v4u*)(t.WT + (size_t)(t.row_off + r) * t.ldk + t.koff + t.k0 + 8 * c)); }
    LDS_WAIT(); asm volatile("" ::: "memory");
}
constexpr int TI_IN = 16 * 197, TI_UQ = 6 * 24, TI_UKV = 4 * 32, TI_BR = 8 * 32, TI_OUT = 16 * 32, TI_E1 = 16 * 64, TI_E2 = 16 * 32;
constexpr int TA0 = TI_IN, TA1 = TA0 + TI_UQ, TA2 = TA1 + TI_UKV, TA3 = TA2 + TI_BR, TA4 = TA3 + TI_BR, TA5 = TA4 + TI_OUT, TA6 = TA5 + NE * TI_E1, TA7 = TA6 + NE * TI_E2, TR_NTOT = L * TA7, CONV_B = 16;
static_assert(L == 2 && TR_NTOT % CONV_B == 0 && TA5 % CONV_B == 0 && TA6 % CONV_B == 0 && TA7 % CONV_B == 0, "conversion queue layout");
__device__ __forceinline__ void tr_setup(CMkArgs* ap, int it, TrItem& t) {
    unsigned char* ws = ap->ws;
    const int l = it >= TA7 ? 1 : 0; int r = it - l * TA7, q;
    if (r < TA0) { q = r; t = TrItem{(const float*)ap->in[7] + (size_t)l * 1024 * INW, (bf16*)(ws + WS_WINT) + (size_t)l * INP * 1024, 1024, INW, 2, 0, 1024, 0, 0, 0}; }
    else if (r < TA1) { q = r - TA0; t = TrItem{(const float*)ap->in[12] + (size_t)l * 384 * 768, (bf16*)(ws + WS_WUQT) + (size_t)l * 768 * 384, 384, 768, 0, 0, 384, 0, 0, 0}; }
    else if (r < TA2) { q = r - TA1; t = TrItem{(const float*)ap->in[13] + (size_t)l * 256 * 1024, (bf16*)(ws + WS_WUKVT) + (size_t)l * 1024 * 256, 256, 1024, 0, 0, 256, 0, 0, 0}; }
    else if (r < TA3) { q = r - TA2; t = TrItem{(const float*)ap->in[18] + (size_t)l * 512 * 1024, (bf16*)(ws + WS_WBRT) + (size_t)l * 1024 * 1536, 512, 1024, 0, 0, 1536, 0, 0, 0}; }
    else if (r < TA4) { q = r - TA3; t = TrItem{(const float*)ap->in[19] + (size_t)l * 512 * 1024, (bf16*)(ws + WS_WBRT) + (size_t)l * 1024 * 1536, 512, 1024, 0, 0, 1536, 512, 0, 0}; }
    else if (r < TA5) { q = r - TA4; t = TrItem{(const float*)ap->in[21] + (size_t)l * 1024 * 1024, (bf16*)(ws + WS_WOUTT) + (size_t)l * 1024 * 1024, 1024, 1024, 0, 0, 1024, 0, 0, 0}; }
    else if (r < TA6) { r -= TA5; const int e = r / TI_E1; q = r - e * TI_E1; const int b = l * NE + e; t = TrItem{(const float*)ap->in[24] + (size_t)b * 1024 * 2048, (bf16*)(ws + WS_W1T) + (size_t)b * 2048 * 1024, 1024, 2048, 1, 0, 1024, 0, 0, 0}; }
    else { r -= TA6; const int e = r / TI_E2; q = r - e * TI_E2; const int b = l * NE + e; t = TrItem{(const float*)ap->in[26] + (size_t)b * 1024 * 1024, (bf16*)(ws + WS_W2T) + (size_t)b * 1024 * 1024, 1024, 1024, 0, 0, 1024, 0, 0, 0}; }
    const int nblk = t.N / 32, kb = q / nblk; t.k0 = 64 * kb; t.n0 = 32 * (q - kb * nblk);
}
__device__ __forceinline__ void conv_service(CMkArgs* ap, LAS unsigned char* lds, int tid, int lane, int wave, unsigned need, const unsigned* stop, unsigned stop_val) {
    asm volatile("" : "+v"(tid), "+v"(lane));
    unsigned* qh = (unsigned*)(ap->ws + WS_CTL) + CW_Q;
    LAS unsigned* slot = (LAS unsigned*)(lds + LDSCTL_OFF) + LW_CONV;
    LAS float* scr = (LAS float*)(lds + wave * 8448);
    const bool pre = (stop == nullptr);
    unsigned nxt = 0xFFFFFFFFu;
#define CONV_CLAIM() do { nxt = 0xFFFFFFFFu; \
        const bool go_ = stop != nullptr && __hip_atomic_load(stop, __ATOMIC_RELAXED, __HIP_MEMORY_SCOPE_AGENT) < stop_val; \
        if (go_ || __hip_atomic_load(qh, __ATOMIC_RELAXED, __HIP_MEMORY_SCOPE_AGENT) < need) { const unsigned i_ = __hip_atomic_fetch_add(qh, (unsigned)CONV_B, __ATOMIC_RELAXED, __HIP_MEMORY_SCOPE_AGENT); if (i_ < (unsigned)TR_NTOT) nxt = i_; } } while (0)
    if (tid == 0) CONV_CLAIM();
    for (int n = 0;; ++n) {
        if (tid == 0) slot[n & 1] = nxt;
        __syncthreads();
        const unsigned idx = __builtin_amdgcn_readfirstlane(slot[n & 1]);
        if (idx == 0xFFFFFFFFu) break;
        if (pre && tid == 0) CONV_CLAIM();
        { TrItem ta, tb; float va[32], vb[32];
          tr_setup(ap, (int)idx + wave, ta); tr_load(ta, va, lane);
          tr_setup(ap, (int)idx + 8 + wave, tb); tr_load(tb, vb, lane);
          tr_store(ta, va, scr, lane); tr_store(tb, vb, scr, lane); }
        if (!pre && tid == 0) CONV_CLAIM();
    }
#undef CONV_CLAIM
}
__device__ __forceinline__ void phase_prologue(CMkArgs* ap, LAS unsigned char* lds, int tid, int lane, int wave, int G, int bx) {
    asm volatile("" : "+v"(tid), "+v"(lane));
    unsigned char* ws = ap->ws;
    const float* c = (const float*)ap->in[1]; const int* pos = (const int*)ap->in[2]; const float* ada_w = (const float*)ap->in[3]; const float* ada_b = (const float*)ap->in[4];
    const float* w_in = (const float*)ap->in[7]; const float* hgrn_lb = (const float*)ap->in[8]; const float* w_uq = (const float*)ap->in[12]; const float* w_ukv = (const float*)ap->in[13];
    const float* w_pool = (const float*)ap->in[16]; const float* pool_scale = (const float*)ap->in[17]; const float* w_br_a = (const float*)ap->in[18]; const float* w_br_b = (const float*)ap->in[19]; const float* w_br_c = (const float*)ap->in[20];
    const float* w_out = (const float*)ap->in[21]; const float* w_exp1 = (const float*)ap->in[24]; const float* w_exp2 = (const float*)ap->in[26];
    float* mod = (float*)(ws + WS_MOD); float* lb = (float*)(ws + WS_LB); float* rope = (float*)(ws + WS_ROPE);
    bf16 *WinT = (bf16*)(ws + WS_WINT), *WuqT = (bf16*)(ws + WS_WUQT), *WukvT = (bf16*)(ws + WS_WUKVT), *WbrT = (bf16*)(ws + WS_WBRT), *WoutT = (bf16*)(ws + WS_WOUTT), *W1T = (bf16*)(ws + WS_W1T), *W2T = (bf16*)(ws + WS_W2T);
    if (bx < 192) {
        LAS float* cs = (LAS float*)(lds + 67584);
        LAS float* part = (LAS float*)(lds + 100352);
        for (int i = tid; i < 8192; i += NTHR) { const float v = c[i]; cs[i] = v / (1.f + __expf(-v)); }
        __syncthreads();
        for (int u = bx; u < 192; u += G) {
            const int l = u / 96, j = (u - l * 96) * 64 + lane;
            const float* w = ada_w + (size_t)l * 1024 * 6144 + (size_t)(wave * 128) * 6144 + j;
            float acc[8];
#pragma unroll
            for (int b = 0; b < 8; ++b) acc[b] = 0.f;
#pragma unroll 16
            for (int k = 0; k < 128; ++k) { const float wv = w[(size_t)k * 6144];
#pragma unroll
                for (int b = 0; b < 8; ++b) acc[b] += cs[b * 1024 + wave * 128 + k] * wv; }
#pragma unroll
            for (int b = 0; b < 8; ++b) part[(wave * 8 + b) * 64 + lane] = acc[b];
            __syncthreads();
            { const int b = tid >> 6; float s = 0.f;
#pragma unroll
              for (int w8 = 0; w8 < 8; ++w8) s += part[(w8 * 8 + b) * 64 + lane];
              mod[(size_t)l * 8 * 6144 + b * 6144 + j] = s + ada_b[l * 6144 + j]; }
            __syncthreads();
        }
        if (tid == 0) __hip_atomic_fetch_add((unsigned*)(ws + WS_CTL) + CW_PD, 1u, __ATOMIC_RELAXED, __HIP_MEMORY_SCOPE_AGENT);
    }
    const int gw = bx * NWAVES + wave, NGW = G * NWAVES, gt = bx * NTHR + tid, NGT = G * NTHR;
    for (int i = gt; i < 512; i += NGT) { const float p = hgrn_lb[i], q = hgrn_lb[512 + i]; const float m = fmaxf(p, q); const float ea = __expf(p - m), eb = __expf(q - m); lb[i] = 0.f; lb[512 + i] = eb / (ea + eb); }
    for (int i = gt; i < NT * 16; i += NGT) { const int t = i >> 4, j = i & 15; float fv = ap->invf[0];
#pragma unroll
        for (int q = 1; q < 16; ++q) if (j == q) fv = ap->invf[q];
        const double ang = (double)pos[t] * (double)fv; double r = ang * 0.15915494309189535; r -= floor(r + 0.5); const float an = (float)(r * 6.283185307179586);
        rope[i] = __cosf(an); rope[NT * 16 + i] = __sinf(an); }
    for (int i = gt; i < L * 96 * 128; i += NGT) { const int l = i / (96 * 128), r = i - l * 96 * 128; *(GAS v4u*)(WinT + (size_t)l * INP * 1024 + (size_t)3232 * 1024 + (size_t)r * 8) = (v4u){0u, 0u, 0u, 0u}; }
    for (int task = gw; task < L * 1024; task += NGW) {
        const int l = task >> 10, g = (task >> 8) & 3, nb = (task >> 4) & 15, c0 = (task & 15) * 8;
        const float* wb = w_br_c + (size_t)l * 512 * 1024 + (size_t)g * 128 * 1024 + nb * 64 + lane; const float* sc = pool_scale + l * 512 + g * 128;
        const float* wp = w_pool + ((size_t)l * 4 + g) * 128 * 128 + (size_t)c0 * 128;
        float acc[8];
#pragma unroll
        for (int q = 0; q < 8; ++q) acc[q] = 0.f;
#pragma unroll 16
        for (int d = 0; d < 128; ++d) { const float w = wb[(size_t)d * 1024] * sc[d];
#pragma unroll
            for (int q = 0; q < 8; ++q) acc[q] += wp[q * 128 + d] * w; }
        v4u o; o.x = pk2(acc[0], acc[1]); o.y = pk2(acc[2], acc[3]); o.z = pk2(acc[4], acc[5]); o.w = pk2(acc[6], acc[7]);
        *(GAS v4u*)(WbrT + (size_t)l * 1024 * 1536 + (size_t)(nb * 64 + lane) * 1536 + 1024 + g * 128 + c0) = o;
    }
    conv_service(ap, lds, tid, lane, wave, (unsigned)TA5, bx >= 192 ? (const unsigned*)(ws + WS_CTL) + CW_PD : nullptr, (unsigned)(G < 192 ? G : 192));
}

template <int MODE>
__device__ __forceinline__ void phase_rows(const float* xin, float* xout, const float* gain, const float* mod_sh, const float* mod_sc, const float* mod_g2, bf16* HN,
                                           const bf16* EO, const int* tokE, const int* tokS, const float* tokW, const LAS int* tp, int lane, int gw, int NGW) {
    asm volatile("" : "+v"(lane));
    for (int row = gw; row < NT; row += NGW) {
        const int b = row / S;
        const GAS f32x4* xr = (const GAS f32x4*)(xin + (size_t)row * D);
        f32x4 v[4];
#pragma unroll
        for (int j = 0; j < 4; ++j) v[j] = xr[lane + 64 * j];
        if (MODE != 0) {
            f32x4 acc[4];
#pragma unroll
            for (int j = 0; j < 4; ++j) acc[j] = (f32x4){0.f, 0.f, 0.f, 0.f};
#pragma unroll
            for (int k = 0; k < 4; ++k) { const int e = tokE[row * 4 + k]; const size_t r = (size_t)tp[e] * 256 + tokS[row * 4 + k]; const float w = tokW[row * 4 + k];
                const GAS v2u* er = (const GAS v2u*)(EO + r * 1024);
#pragma unroll
                for (int j = 0; j < 4; ++j) { const v2u ev = er[lane + 64 * j];
                    acc[j][0] += w * __uint_as_float(ev.x << 16); acc[j][1] += w * __uint_as_float(ev.x & 0xffff0000u); acc[j][2] += w * __uint_as_float(ev.y << 16); acc[j][3] += w * __uint_as_float(ev.y & 0xffff0000u); } }
#pragma unroll
            for (int j = 0; j < 4; ++j) { const f32x4 gg = *(const GAS f32x4*)(mod_g2 + b * 6144 + (lane + 64 * j) * 4); v[j] = v[j] + gg * acc[j]; *(GAS f32x4*)(xout + (size_t)row * D + (lane + 64 * j) * 4) = v[j]; }
        }
        if (MODE != 2) {
            float ss = 0.f;
#pragma unroll
            for (int j = 0; j < 4; ++j) ss += (v[j][0] * v[j][0] + v[j][1] * v[j][1]) + (v[j][2] * v[j][2] + v[j][3] * v[j][3]);
            const float rstd = rsqrtf(wave_sum(ss) * (1.f / D) + EPS);
#pragma unroll
            for (int j = 0; j < 4; ++j) { const int cc = (lane + 64 * j) * 4; const f32x4 gg = *(const GAS f32x4*)(gain + cc), sh = *(const GAS f32x4*)(mod_sh + b * 6144 + cc), sc = *(const GAS f32x4*)(mod_sc + b * 6144 + cc);
                const f32x4 h = v[j] * rstd * gg * (sc + 1.f) + sh; v2u o; o.x = pk2(h[0], h[1]); o.y = pk2(h[2], h[3]);
                *(GAS v2u*)(HN + (size_t)row * D + cc) = o; }
        }
    }
}
__device__ __forceinline__ void load_tp(const int* cnt, LAS int* tp, LAS int* cn, int tid) {
    if (tid < 32) cn[tid] = __hip_atomic_load(cnt + tid, __ATOMIC_RELAXED, __HIP_MEMORY_SCOPE_AGENT);
    __syncthreads();
    if (tid == 0) { int acc = 0; tp[0] = 0;
        for (int q = 0; q < 32; ++q) { acc += (cn[q] + 255) >> 8; tp[q + 1] = acc; } }
    __syncthreads();
}

__device__ __forceinline__ void phase_router(const float* x1, const float* gain, const float* mod_sh, const float* mod_sc, const float* wr, const float* br, bf16* hn2, int* cnt, int* list, int* tokE, int* tokS, float* tokW,
                                             LAS unsigned char* lds, int tid, int lane, int wave, int G, int bx) {
    asm volatile("" : "+v"(tid), "+v"(lane));
    LAS float* tile = (LAS float*)(lds + RING_OFF);
    LAS int* lw = (LAS int*)(lds + LDSCTL_OFF);
    LAS int* entE = lw + LW_ENTE; LAS float* entW = (LAS float*)(lw + LW_ENTW); LAS int* rank = lw + LW_RANK; LAS int* lcnt = lw + LW_LCNT; LAS int* base = lw + LW_BASE;
    const int l31 = lane & 31, h5 = lane >> 5;
    float breg[64];
#pragma unroll
    for (int j = 0; j < 64; ++j) breg[j] = wr[(size_t)(128 * wave + 2 * j + h5) * 32 + l31];
    if (tid < 32) lcnt[tid] = 0;
    __syncthreads();
    for (int bt = bx; bt < NT / 64; bt += G) {
#pragma unroll 1
      for (int hb = 0; hb < 2; ++hb) {
        const int row0 = bt * 64 + hb * 32 + wave * 4, b = row0 / S;
        int ln = lane; asm volatile("" : "+v"(ln));
#pragma unroll 1
        for (int rp = 0; rp < 2; ++rp) {
        f32x4 v[2][4];
#pragma unroll
        for (int rr = 0; rr < 2; ++rr)
#pragma unroll
            for (int j = 0; j < 4; ++j) v[rr][j] = ((const GAS f32x4*)(x1 + (size_t)(row0 + 2 * rp + rr) * D))[ln + 64 * j];
#pragma unroll
        for (int rr = 0; rr < 2; ++rr) {
            const int lr = wave * 4 + 2 * rp + rr, row = row0 + 2 * rp + rr;
            int l2 = ln; asm volatile("" : "+v"(l2));
            float ss = 0.f;
#pragma unroll
            for (int j = 0; j < 4; ++j) ss += (v[rr][j][0] * v[rr][j][0] + v[rr][j][1] * v[rr][j][1]) + (v[rr][j][2] * v[rr][j][2] + v[rr][j][3] * v[rr][j][3]);
            const float rstd = rsqrtf(wave_sum(ss) * (1.f / D) + EPS);
#pragma unroll
            for (int j = 0; j < 4; ++j) { const int cc = (l2 + 64 * j) * 4; const f32x4 gg = *(const GAS f32x4*)(gain + cc), sh = *(const GAS f32x4*)(mod_sh + b * 6144 + cc), sc = *(const GAS f32x4*)(mod_sc + b * 6144 + cc);
                const f32x4 hv = v[rr][j] * rstd * gg * (sc + 1.f) + sh; v2u o; o.x = pk2(hv[0], hv[1]); o.y = pk2(hv[2], hv[3]);
                *(GAS v2u*)(hn2 + (size_t)row * D + cc) = o;
#pragma unroll
                for (int q = 0; q < 4; ++q) tile[lr * 1024 + ((cc + q) ^ lr)] = hv[q]; }
        }
        }
        __syncthreads();
        f32x16 acc;
#pragma unroll
        for (int r = 0; r < 16; ++r) acc[r] = 0.f;
#pragma unroll
        for (int j = 0; j < 64; ++j) { const float a = tile[l31 * 1024 + ((128 * wave + 2 * j + h5) ^ l31)]; acc = __builtin_amdgcn_mfma_f32_32x32x2f32(a, breg[j], acc, 0, 0, 0);
            if ((j & 7) == 7) __builtin_amdgcn_sched_barrier(0); }
        __syncthreads();
#pragma unroll
        for (int r = 0; r < 16; ++r) tile[(wave * 32 + (r & 3) + 8 * (r >> 2) + 4 * h5) * 32 + l31] = acc[r];
        __syncthreads();
#pragma unroll 1
        for (int rr = 0; rr < 4; ++rr) {
            const int lr = wave * 4 + rr, er = hb * 32 + lr; float cur = br[l31];
#pragma unroll
            for (int w8 = 0; w8 < 8; ++w8) cur += tile[(w8 * 32 + lr) * 32 + l31];
            float tv[4]; int ti[4];
#pragma unroll
            for (int k = 0; k < 4; ++k) { float mv = cur; int mi = l31;
#pragma unroll
                for (int o = 1; o < 32; o <<= 1) { const float ov = __shfl_xor(mv, o); const int oi = __shfl_xor(mi, o); if (ov > mv || (ov == mv && oi < mi)) { mv = ov; mi = oi; } }
                tv[k] = mv; ti[k] = mi; if (l31 == mi) cur = -INFINITY; }
            const float e1 = __expf(tv[1] - tv[0]), e2 = __expf(tv[2] - tv[0]), e3 = __expf(tv[3] - tv[0]), inv = 1.f / (1.f + e1 + e2 + e3);
            if (lane == 0) { entE[er * 4 + 0] = ti[0]; entE[er * 4 + 1] = ti[1]; entE[er * 4 + 2] = ti[2]; entE[er * 4 + 3] = ti[3];
                entW[er * 4 + 0] = inv; entW[er * 4 + 1] = e1 * inv; entW[er * 4 + 2] = e2 * inv; entW[er * 4 + 3] = e3 * inv; }
        }
        __syncthreads();
      }
        if (tid < 256) rank[tid] = __hip_atomic_fetch_add(lcnt + entE[tid], 1, __ATOMIC_RELAXED, __HIP_MEMORY_SCOPE_WORKGROUP);
        __syncthreads();
        if (tid < 32) { const int n = lcnt[tid]; base[tid] = n ? __hip_atomic_fetch_add(cnt + tid, n, __ATOMIC_RELAXED, __HIP_MEMORY_SCOPE_AGENT) : 0; lcnt[tid] = 0; }
        __syncthreads();
        if (tid < 256) { const int e = entE[tid], slot = base[e] + rank[tid], row = bt * 64 + (tid >> 2);
            list[(size_t)e * CAP + slot] = row; tokE[row * 4 + (tid & 3)] = e; tokS[row * 4 + (tid & 3)] = slot; tokW[row * 4 + (tid & 3)] = entW[tid]; }
        __syncthreads();
    }
}

__device__ __forceinline__ int moe_workers(int total, int G) { const int gx = G >> 3, nmax = (total + 7) >> 3, rounds = (nmax + gx - 1) / gx; int jw = rounds > 0 ? (nmax + rounds - 1) / rounds : gx; return jw < 1 ? 1 : (jw > gx ? gx : jw); }
__global__ void __launch_bounds__(NTHR, 2) mk_fwd(MkArgs a) {
    extern __shared__ __attribute__((aligned(16))) unsigned char lds_raw[];
    LAS unsigned char* lds = (LAS unsigned char*)lds_raw;
    const int G = gridDim.x, bx = blockIdx.x, wave_s = __builtin_amdgcn_readfirstlane((int)threadIdx.x >> 6);
#define PH_LOCALS int tid = wave_s * 64 + (int)mk_lane_id(); asm volatile("" : "+v"(tid)); const int lane = tid & 63, wave = __builtin_amdgcn_readfirstlane(tid >> 6), gw = bx * NWAVES + wave, NGW = G * NWAVES; (void)lane; (void)gw; (void)NGW
    { PH_LOCALS; for (int u = tid; u < (LDS_BYTES - LDSCTL_OFF) / 4; u += NTHR) ((LAS unsigned*)(lds + LDSCTL_OFF))[u] = 0u; }
    __syncthreads();
    int lo, hi; XcdBarrier bar;
    { PH_LOCALS; KA_PTR(ka); lo = ka->ph_lo; hi = ka->ph_hi; bar = xcd_barrier_post((unsigned*)(ka->ws + WS_CTL) + CW_BAR + ka->li * XCD_BAR_WORDS, (volatile LAS unsigned*)(lds + LDSCTL_OFF) + LW_BAR, wave_s); }
    LAS int* lw = (LAS int*)(lds + LDSCTL_OFF); LAS int* tp = lw + LW_TP; LAS int* cn = lw + LW_CNT;
#ifndef MK_PHMASK
#define MK_PHMASK 0xFFFFFFFFu
#endif
#ifndef MK_DUP
#define MK_DUP 0u
#endif
#define NREP(p) (((MK_DUP >> (p)) & 1u) ? 2 : 1)
#ifndef MK_DUPSUB
#define MK_DUPSUB 0xFFu
#endif
#define SUBEN(bit) (rep_ == 0 || ((MK_DUPSUB >> (bit)) & 1u))
#define PHEN(p) ((MK_PHMASK >> (p)) & 1u)
#define IN(k) (lo <= (k) && (k) < hi)
#ifndef MK_HOOKPROBE
#define MK_HOOKPROBE 0
#endif
#ifndef MK_DUPBAR
#define MK_DUPBAR 0
#endif
#define SEAM(k) do { if (IN(k) && IN((k) + 1)) { xcd_barrier(bar); if (MK_DUPBAR) xcd_barrier(bar); } } while (0)
#define WSP(T, off) ((T*)(ws + (off)))
    if (PHEN(31) && IN(0)) for (int rep_ = 0; rep_ < NREP(31); ++rep_) { PH_LOCALS; KA_PTR(ka); phase_prologue(ka, lds, tid, lane, wave, G, bx); VM_WAIT(); __syncthreads(); }
    SEAM(0);
    for (int l = 0; l < L; ++l) {
        const int pb = 1 + l * NPH_L;
        if (PHEN(0) && IN(pb + 0)) for (int rep_ = 0; rep_ < NREP(0); ++rep_) { PH_LOCALS; KA_PTR(ka); unsigned char* ws = ka->ws; const float* modl = WSP(float, WS_MOD) + (size_t)l * 8 * 6144; const float* norm1_g = (const float*)ka->in[5] + l * D;
            if (l == 0) phase_rows<0>((const float*)ka->in[0], nullptr, norm1_g, modl + 0, modl + 1024, nullptr, WSP(bf16, WS_HN), nullptr, nullptr, nullptr, nullptr, tp, lane, gw, NGW);
            else { load_tp(WSP(int, WS_CTL) + CW_CNT + (l - 1) * 64, tp, cn, tid); int* tokE = WSP(int, WS_TOK);
                phase_rows<1>(WSP(float, WS_XA), WSP(float, WS_XB), norm1_g, modl + 0, modl + 1024, modl - 8 * 6144 + 5120, WSP(bf16, WS_HN), WSP(bf16, WS_EO), tokE, tokE + NT * 4, (const float*)(tokE + NT * 8), tp, lane, gw, NGW); }
        }
        SEAM(pb + 0);
        if (PHEN(1) && IN(pb + 1)) for (int rep_ = 0; rep_ < NREP(1); ++rep_) { PH_LOCALS; KA_PTR(ka); unsigned char* ws = ka->ws;
            const int GW = (G >= 232 && (G & 7) == 0) ? 232 : G; unsigned* pd = WSP(unsigned, WS_CTL) + CW_PD + 64 * (1 + 3 * l);
            if (bx < GW) {
                pg8::Gemm g{WSP(bf16, WS_HN), WSP(bf16, WS_WINT) + (size_t)l * INP * 1024, nullptr, 1024, 1024, 1024, 0}; pg8::StaticOrder So; So.init(NT, INP, GW, bx);
                EpiP E{WSP(bf16, WS_P), INP, WSP(bf16, WS_GT)};
                pg8::gemm_phase<EpiP, pg8::StaticOrder, true, true, false>(lds + RING_OFF, g, So, E, wave);
                if (tid == 0) __hip_atomic_fetch_add(pd, 1u, __ATOMIC_RELAXED, __HIP_MEMORY_SCOPE_AGENT);
            } else conv_service(ka, lds, tid, lane, wave, 0u, pd, (unsigned)GW);
        }
        SEAM(pb + 1);
        if (PHEN(2) && IN(pb + 2)) for (int rep_ = 0; rep_ < NREP(2); ++rep_) { PH_LOCALS; KA_PTR(ka); unsigned char* ws = ka->ws;
#if MK_HGRN_IN
            if (SUBEN(2)) hgrn_a_all(WSP(bf16, WS_P), WSP(float, WS_LB) + l * 512, WSP(float, WS_SLOC), WSP(float, WS_DEC), lds + RING_OFF, bx, G, tid, lane, wave);
#endif
#if MK_MLA_IN
            if (SUBEN(3)) for (int u = bx; u < NT / 64; u += G)
                mla_unit(WSP(bf16, WS_P), (const float*)ka->in[10] + l * 384, (const float*)ka->in[11] + l * 256, WSP(bf16, WS_WUQT) + (size_t)l * 768 * 384, WSP(bf16, WS_WUKVT) + (size_t)l * 1024 * 256,
                         (const float*)ka->in[14] + l * 96, (const float*)ka->in[15] + l * 96, WSP(float, WS_ROPE), WSP(bf16, WS_Q), WSP(bf16, WS_K), WSP(bf16, WS_V), lds + RING_OFF, u, lane, wave);
#endif
#if MK_POOL_IN
            if (SUBEN(4)) for (int u = bx; u < NT / 64; u += G) pool_unit(WSP(bf16, WS_P), WSP(bf16, WS_BR), u, tid);
#endif
        }
        SEAM(pb + 2);
        if (PHEN(3) && IN(pb + 3)) for (int rep_ = 0; rep_ < NREP(3); ++rep_) { PH_LOCALS; KA_PTR(ka); unsigned char* ws = ka->ws;
#if MK_HGRN_IN
            for (int u = bx; u < 256; u += G) hgrn_scan_unit(WSP(float, WS_SLOC), WSP(float, WS_DEC), WSP(bf16, WS_ST), u, tid);
#endif
        }
        SEAM(pb + 3);
        if (PHEN(4) && IN(pb + 4)) for (int rep_ = 0; rep_ < NREP(4); ++rep_) { PH_LOCALS; KA_PTR(ka); unsigned char* ws = ka->ws;
#if MK_ATTN_IN
            if (SUBEN(0)) for (int p = bx; p < 256; p += G) {
                attn_unit(WSP(bf16, WS_Q), WSP(bf16, WS_K), WSP(bf16, WS_V), WSP(bf16, WS_BR), lds + RING_OFF, p & 63, 7 - (p >> 6), tid, lane, wave);
                attn_unit(WSP(bf16, WS_Q), WSP(bf16, WS_K), WSP(bf16, WS_V), WSP(bf16, WS_BR), lds + RING_OFF, p & 63, p >> 6, tid, lane, wave);
            }
#endif
#if MK_HGRN_IN
            if (SUBEN(1)) for (int u = bx; u < 1024; u += G) hgrn_c_unit(WSP(bf16, WS_P), WSP(float, WS_LB) + l * 512, WSP(bf16, WS_ST), (const float*)ka->in[9] + l * 128, WSP(bf16, WS_BR), lds + RING_OFF, u, tid, lane, wave);
#endif
        }
        SEAM(pb + 4);
        if (PHEN(5) && IN(pb + 5)) for (int rep_ = 0; rep_ < NREP(5); ++rep_) { PH_LOCALS; KA_PTR(ka); unsigned char* ws = ka->ws;
            pg8::Gemm g{WSP(bf16, WS_BR), WSP(bf16, WS_WBRT) + (size_t)l * 1024 * 1536, nullptr, 1536, 1536, 1536, 0}; pg8::StaticOrder So; So.init(NT, 1024, G, bx);
#if MK_P5PROBE
            if (rep_ == 1) { EpiP E2{WSP(bf16, WS_MERGF), 1024, nullptr}; pg8::gemm_phase<EpiP, pg8::StaticOrder, false, true, false, 0>(lds + RING_OFF, g, So, E2, wave); } else
#endif
            { EpiBranch E{WSP(bf16, WS_GT), WSP(bf16, WS_MERGB)};
            pg8::gemm_phase<EpiBranch, pg8::StaticOrder, false, true, false, 8>(lds + RING_OFF, g, So, E, wave); }
        }
        SEAM(pb + 5);
        if (PHEN(6) && IN(pb + 6)) for (int rep_ = 0; rep_ < NREP(6); ++rep_) { PH_LOCALS; KA_PTR(ka); unsigned char* ws = ka->ws; const float* xin = (l == 0) ? (const float*)ka->in[0] : WSP(float, WS_XB);
            pg8::Gemm g{WSP(bf16, WS_MERGB), WSP(bf16, WS_WOUTT) + (size_t)l * 1024 * 1024, nullptr, 1024, 1024, 1024, 0}; pg8::StaticOrder So; So.init(NT, 1024, G, bx);
            EpiOut E{xin, WSP(float, WS_MOD) + (size_t)l * 8 * 6144 + 2048, WSP(float, WS_XA)};
            pg8::gemm_phase<EpiOut, pg8::StaticOrder, false, true, false>(lds + RING_OFF, g, So, E, wave);
        }
        SEAM(pb + 6);
        if (PHEN(7) && IN(pb + 7)) for (int rep_ = 0; rep_ < NREP(7); ++rep_) { PH_LOCALS; KA_PTR(ka); unsigned char* ws = ka->ws; const float* modl = WSP(float, WS_MOD) + (size_t)l * 8 * 6144; int* tokE = WSP(int, WS_TOK);
            if (rep_ == 1) tokE = WSP(int, WS_KVRAW);
            phase_router(WSP(float, WS_XA), (const float*)ka->in[6] + l * D, modl + 3072, modl + 4096, (const float*)ka->in[22] + (size_t)l * 1024 * 32, (const float*)ka->in[23] + l * 32, WSP(bf16, WS_HN2),
                         WSP(int, WS_CTL) + (rep_ == 1 ? 2048 : CW_CNT) + l * 64, rep_ == 1 ? WSP(int, WS_QRAW) : WSP(int, WS_LIST), tokE, tokE + NT * 4, (float*)(tokE + NT * 8), lds, tid, lane, wave, G, bx);
            conv_service(ka, lds, tid, lane, wave, (unsigned)(l * TA7 + TA6), nullptr, 0u); }
        SEAM(pb + 7);
        if (PHEN(8) && IN(pb + 8)) for (int rep_ = 0; rep_ < NREP(8); ++rep_) { PH_LOCALS; KA_PTR(ka); unsigned char* ws = ka->ws;
            load_tp(WSP(int, WS_CTL) + CW_CNT + l * 64, tp, cn, tid);
            const int jw = moe_workers(tp[32] * 8, G); unsigned* pd = WSP(unsigned, WS_CTL) + CW_PD + 64 * (2 + 3 * l); const bool worker = (bx >> 3) < jw || (G & 7) != 0;
            if (worker) {
                pg8::Gemm g{WSP(bf16, WS_HN2), WSP(bf16, WS_W1T) + (size_t)l * NE * 2048 * 1024, WSP(int, WS_LIST), 1024, 1024, 1024, 0}; MoeOrder So{tp, cn, 8, (G & 7) ? G : 8 * jw, bx, 0};
                EpiMoe1 E{(const float*)ka->in[25] + (size_t)l * NE * 2048, WSP(bf16, WS_ACT), (LAS float*)(lw + LW_BIAS)};
                pg8::gemm_phase<EpiMoe1, MoeOrder, true, true, true>(lds + RING_OFF, g, So, E, wave);
                if (tid == 0) __hip_atomic_fetch_add(pd, 1u, __ATOMIC_RELAXED, __HIP_MEMORY_SCOPE_AGENT);
            }
            conv_service(ka, lds, tid, lane, wave, (unsigned)((l + 1) * TA7), worker ? nullptr : pd, (unsigned)(8 * jw));
        }
        SEAM(pb + 8);
        if (PHEN(9) && IN(pb + 9)) for (int rep_ = 0; rep_ < NREP(9); ++rep_) { PH_LOCALS; KA_PTR(ka); unsigned char* ws = ka->ws;
            load_tp(WSP(int, WS_CTL) + CW_CNT + l * 64, tp, cn, tid);
            const int jw = moe_workers(tp[32] * 4, G); unsigned* pd = WSP(unsigned, WS_CTL) + CW_PD + 64 * (3 + 3 * l); const bool worker = (bx >> 3) < jw || (G & 7) != 0;
            if (worker) {
                pg8::Gemm g{WSP(bf16, WS_ACT), WSP(bf16, WS_W2T) + (size_t)l * NE * 1024 * 1024, nullptr, 1024, 1024, 1024, 0}; MoeOrder So{tp, cn, 4, (G & 7) ? G : 8 * jw, bx, 1};
                EpiMoe2 E{(const float*)ka->in[27] + (size_t)l * NE * 1024, WSP(bf16, WS_EO), (LAS float*)(lw + LW_BIAS)};
                pg8::gemm_phase<EpiMoe2, MoeOrder, true, true, false>(lds + RING_OFF, g, So, E, wave);
                if (tid == 0) __hip_atomic_fetch_add(pd, 1u, __ATOMIC_RELAXED, __HIP_MEMORY_SCOPE_AGENT);
            }
            conv_service(ka, lds, tid, lane, wave, (unsigned)(l + 1 < L ? (l + 1) * TA7 + TA5 : 0), worker ? nullptr : pd, (unsigned)(8 * jw));
        }
        SEAM(pb + 9);
    }
    if (PHEN(30) && IN(PH_FINAL)) for (int rep_ = 0; rep_ < NREP(30); ++rep_) { PH_LOCALS; KA_PTR(ka); unsigned char* ws = ka->ws; load_tp(WSP(int, WS_CTL) + CW_CNT + (L - 1) * 64, tp, cn, tid); int* tokE = WSP(int, WS_TOK);
        phase_rows<2>(WSP(float, WS_XA), ka->out, nullptr, nullptr, nullptr, WSP(float, WS_MOD) + (size_t)(L - 1) * 8 * 6144 + 5120, nullptr, WSP(bf16, WS_EO), tokE, tokE + NT * 4, (const float*)(tokE + NT * 8), tp, lane, gw, NGW); }
#undef IN
#undef SEAM
}
static void launch_mk(const MkArgs& base, int lo, int hi, int li, int grid, hipStream_t stream) {
    MkArgs a = base; a.ph_lo = lo; a.ph_hi = hi; a.li = li; a.pad = 0;
    hipLaunchKernelGGL(mk_fwd, dim3(grid), dim3(NTHR), LDS_BYTES, stream, a);
}
extern "C" void kernel_launch(void* const* d_in, const int* in_sizes, int n_in, void* d_out, int out_size, void* d_ws, size_t ws_size, hipStream_t stream) {
    static int grid = 0;
    if (grid == 0) {
        if (ws_size < WS_END || n_in != 28) { fprintf(stderr, "kernel_launch: bad ws/inputs: %zu < %zu, n_in %d\n", ws_size, (size_t)WS_END, n_in); grid = -1; return; }
        int dev = 0, cus = 0, per_cu = 0;
        if (hipGetDevice(&dev) != hipSuccess || hipDeviceGetAttribute(&cus, hipDeviceAttributeMultiprocessorCount, dev) != hipSuccess) { grid = -1; return; }
        if (hipFuncSetAttribute((const void*)mk_fwd, hipFuncAttributeMaxDynamicSharedMemorySize, LDS_BYTES) != hipSuccess) { fprintf(stderr, "kernel_launch: hipFuncSetAttribute failed\n"); grid = -1; return; }
        if (hipOccupancyMaxActiveBlocksPerMultiprocessor(&per_cu, (const void*)mk_fwd, NTHR, LDS_BYTES) != hipSuccess || per_cu < 1) { fprintf(stderr, "kernel_launch: occupancy query says %d\n", per_cu); (void)hipGetLastError(); grid = -1; return; }
        grid = cus;
    }
    if (grid < 0) return;
    unsigned char* ws = (unsigned char*)d_ws;
    (void)hipMemsetAsync(ws + WS_CTL, 0, 1 * MiB, stream);
    MkArgs a{};
    for (int i = 0; i < 28; ++i) a.in[i] = d_in[i];
    a.out = (float*)d_out; a.ws = ws;
    for (int j = 0; j < 16; ++j) a.invf[j] = (float)(1.0 / pow(10000.0, (double)j / 16.0));
#if MK_HYBRID
    const float* onorm_g = (const float*)d_in[9]; const float* qlat_g = (const float*)d_in[10]; const float* kvlat_g = (const float*)d_in[11]; const float* qn_g = (const float*)d_in[14]; const float* kn_g = (const float*)d_in[15];
    float* lb = (float*)(ws + WS_LB); float* rope = (float*)(ws + WS_ROPE);
    bf16 *WuqT = (bf16*)(ws + WS_WUQT), *WukvT = (bf16*)(ws + WS_WUKVT), *P = (bf16*)(ws + WS_P), *Qb = (bf16*)(ws + WS_Q), *Kb = (bf16*)(ws + WS_K), *Vb = (bf16*)(ws + WS_V), *BR = (bf16*)(ws + WS_BR), *QLN = (bf16*)(ws + WS_QLN), *KVN = (bf16*)(ws + WS_KVN);
    float *ORAW = (float*)(ws + WS_ORAW), *QRAW = (float*)(ws + WS_QRAW), *KVRAW = (float*)(ws + WS_KVRAW);
    int li = 0;
    for (int l = 0; l < L; ++l) {
        const int pb = 1 + l * NPH_L;
        launch_mk(a, l == 0 ? 0 : pb - 5, pb + 2, li++, grid, stream);
#if !MK_HGRN_IN
        k_hgrn_naive<<<NB * HH, 128, 0, stream>>>(P, lb + l * 512, ORAW);
        k_hgrn_out<<<NT * 4 / 4, 256, 0, stream>>>(ORAW, P, onorm_g + l * 128, BR);
#endif
#if !MK_MLA_IN
        k_mla_prep<<<NT / 4, 256, 0, stream>>>(P, qlat_g + l * 384, kvlat_g + l * 256, QLN, KVN);
        { GemmArgs g{}; g.A = QLN; g.Bt = WuqT + (size_t)l * 768 * 384; g.lda = 384; g.ldb = 384; g.K = 384; g.outf = QRAW; g.ldc = 768;
          k_gemm<1, 0><<<dim3(768 / 64, NT / 64), 256, 0, stream>>>(g); }
        { GemmArgs g{}; g.A = KVN; g.Bt = WukvT + (size_t)l * 1024 * 256; g.lda = 256; g.ldb = 256; g.K = 256; g.outf = KVRAW; g.ldc = 1024;
          k_gemm<1, 0><<<dim3(1024 / 64, NT / 64), 256, 0, stream>>>(g); }
        k_mla_post<<<NT * 8 / 4, 256, 0, stream>>>(QRAW, KVRAW, P, qn_g + l * 96, kn_g + l * 96, rope, Qb, Kb, Vb);
#endif
#if !MK_POOL_IN
        k_pool<<<NT * 512 / 256, 256, 0, stream>>>(P, BR);
#endif
#if MK_MLA_IN || MK_POOL_IN || MK_HGRN_IN
        launch_mk(a, pb + 2, pb + 3, li++, grid, stream);
#endif
#if MK_HGRN_IN
        launch_mk(a, pb + 3, pb + 4, li++, grid, stream);
#endif
#if MK_ATTN_IN || MK_HGRN_IN
        launch_mk(a, pb + 4, pb + 5, li++, grid, stream);
#else
        k_attn_naive<<<dim3(S / 64, NB * MH), 64, 0, stream>>>(Qb, Kb, Vb, BR);
#endif
    }
    launch_mk(a, 1 + (L - 1) * NPH_L + 5, NPH, li++, grid, stream);
#else
    launch_mk(a, 0, NPH, 0, grid, stream);
#endif
}
```

```cpp
#include <hip/hip_runtime.h>
#include <stdint.h>
#include <cstdio>
#include <cmath>

typedef unsigned short bf16;
__device__ __forceinline__ float bf2f(bf16 v) { return __uint_as_float(((unsigned)v) << 16); }
__device__ __forceinline__ bf16 f2bf(float f) { unsigned u = __float_as_uint(f); return (bf16)((u + 0x7fffu + ((u >> 16) & 1u)) >> 16); }
__device__ __forceinline__ float sigmoidf_(float x) { return 1.f / (1.f + __expf(-x)); }

constexpr int D = 1024, NB = 8, S = 2048, NT = NB * S, L = 2;
constexpr int HH = 4, HDK = 128, HW = 512, HCH = 64;
constexpr int MH = 8, MNOPE = 64, MROPE = 32, MQK = 96, MV = 64, MQR = 384, MKVR = 256, MW = 512;
constexpr int PW = 512;
constexpr int NE = 32, TOPK = 4, FF = 1024;
constexpr int INW = 6304, INP = 6400;
constexpr int C_HQ = 0, C_HF = 512, C_HI = 1024, C_HG = 1536, C_QLAT = 2048, C_KVLAT = 2432, C_KROPE = 2688, C_POOL = 2720, C_GA = 3232, C_GB = 4256, C_GC = 5280;
constexpr float EPS = 1e-6f;
constexpr int CAP = NT;
constexpr int MAXROWS = NT * TOPK + NE * 256;

constexpr size_t MiB = 1u << 20;
constexpr size_t WS_CTL = 0;
constexpr size_t WS_MOD = 1 * MiB;
constexpr size_t WS_LB = 2 * MiB;
constexpr size_t WS_ROPE = 3 * MiB;
constexpr size_t WS_WINT = 6 * MiB;
constexpr size_t WS_WUQT = 32 * MiB;
constexpr size_t WS_WUKVT = 34 * MiB;
constexpr size_t WS_WBRT = 36 * MiB;
constexpr size_t WS_WOUTT = 42 * MiB;
constexpr size_t WS_W1T = 48 * MiB;
constexpr size_t WS_W2T = 304 * MiB;
constexpr size_t WS_HN = 432 * MiB;
constexpr size_t WS_P = 464 * MiB;
constexpr size_t WS_Q = 664 * MiB;
constexpr size_t WS_K = 688 * MiB;
constexpr size_t WS_V = 712 * MiB;
constexpr size_t WS_BR = 728 * MiB;
constexpr size_t WS_MERGF = 776 * MiB;
constexpr size_t WS_MERGB = 840 * MiB;
constexpr size_t WS_XA = 872 * MiB;
constexpr size_t WS_XB = 936 * MiB;
constexpr size_t WS_HN2 = 1000 * MiB;
constexpr size_t WS_LIST = 1032 * MiB;
constexpr size_t WS_TOK = 1034 * MiB;
constexpr size_t WS_ACT = 1036 * MiB;
constexpr size_t WS_EO = 1180 * MiB;
constexpr size_t WS_ORAW = 1324 * MiB;
constexpr size_t WS_QLN = 1356 * MiB;
constexpr size_t WS_KVN = 1368 * MiB;
constexpr size_t WS_QRAW = 1376 * MiB;
constexpr size_t WS_KVRAW = 1424 * MiB;
constexpr size_t WS_SLOC = 1488 * MiB;
constexpr size_t WS_ST = 1552 * MiB;
constexpr size_t WS_DEC = 1584 * MiB;
constexpr size_t WS_GT = 1585 * MiB;
constexpr size_t WS_END = 1681 * MiB;
constexpr int CW_CNT = 64;
constexpr int CW_OFF = 256;

template <int MODE>
__global__ void k_transpose(const float* __restrict__ in, bf16* __restrict__ out, int K, int N, int NP, int rowoff, size_t ibs, size_t obs) {
    __shared__ float t[32][33];
    const int n0 = blockIdx.x * 32, k0 = blockIdx.y * 32, tx = threadIdx.x & 31, ty = threadIdx.x >> 5;
    const float* ip = in + (size_t)blockIdx.z * ibs; bf16* op = out + (size_t)blockIdx.z * obs;
#pragma unroll
    for (int j = 0; j < 4; ++j) t[ty + 8 * j][tx] = ip[(size_t)(k0 + ty + 8 * j) * N + n0 + tx];
    __syncthreads();
#pragma unroll
    for (int j = 0; j < 4; ++j) {
        int n = n0 + ty + 8 * j; int r = n;
        if (MODE == 1) { const int half = n >> 10, c = n & 1023; r = (c >> 7) * 256 + half * 128 + (c & 127); }
        op[(size_t)(rowoff + r) * K + k0 + tx] = f2bf(t[tx][ty + 8 * j]);
    }
}
__global__ void k_zero_bf16(bf16* p, size_t n) { size_t i = (size_t)blockIdx.x * blockDim.x + threadIdx.x; if (i < n) p[i] = 0; }

__global__ void k_fold_pool(const float* __restrict__ w_pool, const float* __restrict__ scale, const float* __restrict__ w_br_c, bf16* __restrict__ wbrt) {
    const int l = blockIdx.z, k = blockIdx.y, n = blockIdx.x * 256 + threadIdx.x, g = k >> 7, c = k & 127;
    const float* wp = w_pool + ((size_t)l * 4 + g) * 128 * 128 + (size_t)c * 128; const float* sc = scale + l * 512 + g * 128; const float* wb = w_br_c + (size_t)l * 512 * 1024 + (size_t)g * 128 * 1024;
    float a = 0.f;
    for (int d = 0; d < 128; ++d) a += wp[d] * sc[d] * wb[(size_t)d * 1024 + n];
    wbrt[(size_t)l * 3072 * 512 + (size_t)(2048 + n) * 512 + k] = f2bf(a);
}
__global__ void k_adaln(const float* __restrict__ c, const float* __restrict__ ada_w, const float* __restrict__ ada_b, float* __restrict__ mod) {
    __shared__ float cs[8][1024];
    for (int i = threadIdx.x; i < 8192; i += 256) { float v = c[i]; cs[i >> 10][i & 1023] = v / (1.f + __expf(-v)); }
    __syncthreads();
    const int l = blockIdx.y, j = blockIdx.x * 256 + threadIdx.x;
    const float* w = ada_w + (size_t)l * 1024 * 6144 + j;
    float a0 = 0, a1 = 0, a2 = 0, a3 = 0, a4 = 0, a5 = 0, a6 = 0, a7 = 0;
    for (int k = 0; k < 1024; ++k) { const float wv = w[(size_t)k * 6144];
        a0 += cs[0][k] * wv; a1 += cs[1][k] * wv; a2 += cs[2][k] * wv; a3 += cs[3][k] * wv; a4 += cs[4][k] * wv; a5 += cs[5][k] * wv; a6 += cs[6][k] * wv; a7 += cs[7][k] * wv; }
    const float bb = ada_b[l * 6144 + j]; float* m = mod + (size_t)l * 8 * 6144 + j;
    m[0 * 6144] = a0 + bb; m[1 * 6144] = a1 + bb; m[2 * 6144] = a2 + bb; m[3 * 6144] = a3 + bb; m[4 * 6144] = a4 + bb; m[5 * 6144] = a5 + bb; m[6 * 6144] = a6 + bb; m[7 * 6144] = a7 + bb;
}
struct InvF { float f[16]; };
__global__ void k_misc(const float* __restrict__ hgrn_lb, const int* __restrict__ pos, float* __restrict__ lb, float* __restrict__ rope, InvF invf) {
    const int i = blockIdx.x * 256 + threadIdx.x;
    if (i < 512) { const float a = hgrn_lb[i], b = hgrn_lb[512 + i]; const float m = fmaxf(a, b); const float ea = __expf(a - m), eb = __expf(b - m); lb[i] = 0.f; lb[512 + i] = eb / (ea + eb); }
    if (i < NT * 16) { const int t = i >> 4, j = i & 15; float fv = invf.f[0];
#pragma unroll
        for (int q = 1; q < 16; ++q) if (j == q) fv = invf.f[q];
        const double ang = (double)pos[t] * (double)fv;
        double r = ang * 0.15915494309189535; r -= floor(r + 0.5); const float a = (float)(r * 6.283185307179586);
        rope[i] = __cosf(a); rope[NT * 16 + i] = __sinf(a); }
}

__global__ void k_norm_mod(const float* __restrict__ x, const float* __restrict__ g, const float* __restrict__ mod_sh, const float* __restrict__ mod_sc, bf16* __restrict__ out) {
    const int row = blockIdx.x * 4 + (threadIdx.x >> 6), lane = threadIdx.x & 63, b = row / S;
    const float4* xr = (const float4*)(x + (size_t)row * D);
    float4 v[4]; float ss = 0.f;
#pragma unroll
    for (int j = 0; j < 4; ++j) { v[j] = xr[lane + 64 * j]; ss += v[j].x * v[j].x + v[j].y * v[j].y + v[j].z * v[j].z + v[j].w * v[j].w; }
#pragma unroll
    for (int o = 1; o < 64; o <<= 1) ss += __shfl_xor(ss, o);
    const float rstd = rsqrtf(ss * (1.f / D) + EPS);
#pragma unroll
    for (int j = 0; j < 4; ++j) { const int c = (lane + 64 * j) * 4; const float4 gg = *(const float4*)(g + c), sh = *(const float4*)(mod_sh + b * 6144 + c), sc = *(const float4*)(mod_sc + b * 6144 + c);
        ushort4 o; o.x = f2bf(v[j].x * rstd * gg.x * (1.f + sc.x) + sh.x); o.y = f2bf(v[j].y * rstd * gg.y * (1.f + sc.y) + sh.y); o.z = f2bf(v[j].z * rstd * gg.z * (1.f + sc.z) + sh.z); o.w = f2bf(v[j].w * rstd * gg.w * (1.f + sc.w) + sh.w);
        *(ushort4*)(out + (size_t)row * D + c) = o; }
}

struct GemmArgs { const bf16* A; const bf16* Bt; const int* rowlist; const int* cnt; const int* off; float* outf; bf16* outb; const bf16* gate; const float* xin; const float* gvec; const float* bias;
    int lda, ldb, K, ldc, pad0, pad1; };
template <int MODE, int BRI>
__global__ void __launch_bounds__(256) k_gemm(GemmArgs g) {
    __shared__ float As[16][65], Bs[16][65], Bs2[16][65];
    const int tid = threadIdx.x, tx = tid & 15, ty = tid >> 4;
    int m0 = blockIdx.y * 64, n0 = blockIdx.x * 64; int e = 0, cnt = 1 << 30, orow0 = m0;
    const bf16* Bt = g.Bt;
    if (MODE == 4 || MODE == 5) { e = blockIdx.z; cnt = g.cnt[e]; if (m0 >= cnt) return; orow0 = g.off[e] + m0; Bt += (size_t)e * (MODE == 4 ? 2048 : 1024) * g.ldb; }
    const int lr = tid >> 2, lk = (tid & 3) * 4;
    size_t arow;
    if (MODE == 4) { const int slot = m0 + lr; arow = (slot < cnt) ? (size_t)g.rowlist[(size_t)e * CAP + slot] : 0; }
    else if (MODE == 5) arow = (size_t)(orow0 + lr);
    else arow = (size_t)(m0 + lr);
    const bf16* ap = g.A + arow * g.lda + lk;
    int bn = n0 + lr;
    if (MODE == 4) { const int t = n0 >> 6;     const int col = n0 + lr; bn = (col >> 7) * 256 + (col & 127); (void)t; }
    const bf16* bp = Bt + (size_t)bn * g.ldb + lk;
    const bf16* bp2 = bp + (size_t)128 * g.ldb;
    float acc[4][4], acc2[4][4];
#pragma unroll
    for (int i = 0; i < 4; ++i)
#pragma unroll
        for (int j = 0; j < 4; ++j) { acc[i][j] = 0.f; acc2[i][j] = 0.f; }
    for (int k0 = 0; k0 < g.K; k0 += 16) {
        const ushort4 av = *(const ushort4*)(ap + k0), bv = *(const ushort4*)(bp + k0);
        As[lk + 0][lr] = bf2f(av.x); As[lk + 1][lr] = bf2f(av.y); As[lk + 2][lr] = bf2f(av.z); As[lk + 3][lr] = bf2f(av.w);
        Bs[lk + 0][lr] = bf2f(bv.x); Bs[lk + 1][lr] = bf2f(bv.y); Bs[lk + 2][lr] = bf2f(bv.z); Bs[lk + 3][lr] = bf2f(bv.w);
        if (MODE == 4) { const ushort4 cv = *(const ushort4*)(bp2 + k0); Bs2[lk + 0][lr] = bf2f(cv.x); Bs2[lk + 1][lr] = bf2f(cv.y); Bs2[lk + 2][lr] = bf2f(cv.z); Bs2[lk + 3][lr] = bf2f(cv.w); }
        __syncthreads();
#pragma unroll
        for (int kk = 0; kk < 16; ++kk) {
            float a[4], b[4], b2[4];
#pragma unroll
            for (int i = 0; i < 4; ++i) { a[i] = As[kk][ty * 4 + i]; b[i] = Bs[kk][tx * 4 + i]; if (MODE == 4) b2[i] = Bs2[kk][tx * 4 + i]; }
#pragma unroll
            for (int i = 0; i < 4; ++i)
#pragma unroll
                for (int j = 0; j < 4; ++j) { acc[i][j] += a[i] * b[j]; if (MODE == 4) acc2[i][j] += a[i] * b2[j]; }
        }
        __syncthreads();
    }
#pragma unroll
    for (int i = 0; i < 4; ++i) {
        const int rl = ty * 4 + i;
        if ((MODE == 4 || MODE == 5) && m0 + rl >= cnt) continue;
        const size_t row = (MODE == 4 || MODE == 5) ? (size_t)(orow0 + rl) : (size_t)(m0 + rl);
#pragma unroll
        for (int j = 0; j < 4; ++j) {
            const int col = n0 + tx * 4 + j; const float v = acc[i][j];
            if (MODE == 0) g.outb[row * g.ldc + col] = f2bf(v);
            else if (MODE == 1) g.outf[row * g.ldc + col] = v;
            else if (MODE == 2) { const float gt = sigmoidf_(bf2f(g.gate[row * INP + col])) * v; float* o = g.outf + row * g.ldc + col;
                if (BRI == 0) *o = gt; else if (BRI == 1) *o += gt; else { const float s = *o + gt; *o = s; g.outb[row * g.ldc + col] = f2bf(s); } }
            else if (MODE == 3) { const int b = (int)(row / S); g.outf[row * g.ldc + col] = g.xin[row * g.ldc + col] + g.gvec[b * 6144 + col] * v; }
            else if (MODE == 4) { float glu = v + g.bias[e * 2048 + col], lin = acc2[i][j] + g.bias[e * 2048 + 1024 + col];
                glu = fminf(glu, 7.f); lin = fminf(fmaxf(lin, -7.f), 7.f);
                g.outb[row * g.ldc + col] = f2bf(glu * sigmoidf_(1.702f * glu) * (lin + 1.f)); }
            else if (MODE == 5) g.outb[row * g.ldc + col] = f2bf(v + g.bias[e * 1024 + col]);
        }
    }
}

__global__ void __launch_bounds__(128) k_hgrn_naive(const bf16* __restrict__ P, const float* __restrict__ lb, float* __restrict__ oraw) {
    __shared__ float qs[16][128], ks[16][128], fs[16][128];
    const int b = blockIdx.x >> 2, h = blockIdx.x & 3, v = threadIdx.x;
    const float lbv = lb[h * 128 + v];
    float st[128];
#pragma unroll
    for (int d = 0; d < 128; ++d) st[d] = 0.f;
    for (int t0 = 0; t0 < S; t0 += 16) {
        __syncthreads();
        for (int tt = 0; tt < 16; ++tt) { const bf16* pr = P + (size_t)(b * S + t0 + tt) * INP;
            const float z = bf2f(pr[C_HF + h * 128 + v]); const float sg = sigmoidf_(z);
            qs[tt][v] = bf2f(pr[C_HQ + h * 128 + v]); fs[tt][v] = lbv + (1.f - lbv) * sg; ks[tt][v] = (1.f - lbv) * (1.f - sg); }
        __syncthreads();
        for (int tt = 0; tt < 16; ++tt) {
            const float vv = bf2f(P[(size_t)(b * S + t0 + tt) * INP + C_HI + h * 128 + v]);
            float o = 0.f;
#pragma unroll
            for (int d = 0; d < 128; ++d) { st[d] = fs[tt][d] * st[d] + ks[tt][d] * vv; o += qs[tt][d] * st[d]; }
            oraw[(size_t)(b * S + t0 + tt) * 512 + h * 128 + v] = o;
        }
    }
}
__global__ void k_hgrn_out(const float* __restrict__ oraw, const bf16* __restrict__ P, const float* __restrict__ og, bf16* __restrict__ BR) {
    const int idx = blockIdx.x * 4 + (threadIdx.x >> 6), lane = threadIdx.x & 63, t = idx >> 2, h = idx & 3;
    const float o0 = oraw[(size_t)t * 512 + h * 128 + lane], o1 = oraw[(size_t)t * 512 + h * 128 + 64 + lane];
    float ss = o0 * o0 + o1 * o1;
#pragma unroll
    for (int o = 1; o < 64; o <<= 1) ss += __shfl_xor(ss, o);
    const float rstd = rsqrtf(ss * (1.f / 128.f) + EPS);
    const float g0 = bf2f(P[(size_t)t * INP + C_HG + h * 128 + lane]), g1 = bf2f(P[(size_t)t * INP + C_HG + h * 128 + 64 + lane]);
    BR[(size_t)t * 1536 + h * 128 + lane] = f2bf(o0 * rstd * og[lane] * g0 * sigmoidf_(g0));
    BR[(size_t)t * 1536 + h * 128 + 64 + lane] = f2bf(o1 * rstd * og[64 + lane] * g1 * sigmoidf_(g1));
}
__global__ void k_mla_prep(const bf16* __restrict__ P, const float* __restrict__ qg, const float* __restrict__ kvg, bf16* __restrict__ qln, bf16* __restrict__ kvn) {
    const int t = blockIdx.x * 4 + (threadIdx.x >> 6), lane = threadIdx.x & 63; const bf16* pr = P + (size_t)t * INP;
    float q[6], kv[4], s1 = 0.f, s2 = 0.f;
#pragma unroll
    for (int j = 0; j < 6; ++j) { q[j] = bf2f(pr[C_QLAT + lane + 64 * j]); s1 += q[j] * q[j]; }
#pragma unroll
    for (int j = 0; j < 4; ++j) { kv[j] = bf2f(pr[C_KVLAT + lane + 64 * j]); s2 += kv[j] * kv[j]; }
#pragma unroll
    for (int o = 1; o < 64; o <<= 1) { s1 += __shfl_xor(s1, o); s2 += __shfl_xor(s2, o); }
    const float r1 = rsqrtf(s1 * (1.f / 384.f) + EPS), r2 = rsqrtf(s2 * (1.f / 256.f) + EPS);
#pragma unroll
    for (int j = 0; j < 6; ++j) qln[(size_t)t * 384 + lane + 64 * j] = f2bf(q[j] * r1 * qg[lane + 64 * j]);
#pragma unroll
    for (int j = 0; j < 4; ++j) kvn[(size_t)t * 256 + lane + 64 * j] = f2bf(kv[j] * r2 * kvg[lane + 64 * j]);
}
__global__ void k_mla_post(const float* __restrict__ qraw, const float* __restrict__ kvraw, const bf16* __restrict__ P, const float* __restrict__ qng, const float* __restrict__ kng,
                           const float* __restrict__ rope, bf16* __restrict__ Q, bf16* __restrict__ K, bf16* __restrict__ V) {
    const int idx = blockIdx.x * 4 + (threadIdx.x >> 6), lane = threadIdx.x & 63, t = idx >> 3, h = idx & 7, b = t / S, s = t % S;
    const float qa = qraw[(size_t)t * 768 + h * 96 + lane], qb = qraw[(size_t)t * 768 + h * 96 + 64 + (lane & 31)];
    const float ka = kvraw[(size_t)t * 1024 + h * 128 + lane], kb = bf2f(P[(size_t)t * INP + C_KROPE + (lane & 31)]);
    const float va = kvraw[(size_t)t * 1024 + h * 128 + 64 + lane];
    float sq = qa * qa + (lane < 32 ? qb * qb : 0.f), sk = ka * ka + (lane < 32 ? kb * kb : 0.f);
#pragma unroll
    for (int o = 1; o < 64; o <<= 1) { sq += __shfl_xor(sq, o); sk += __shfl_xor(sk, o); }
    const float rq = rsqrtf(sq * (1.f / 96.f) + EPS), rk = rsqrtf(sk * (1.f / 96.f) + EPS);
    const size_t ob = ((size_t)(b * MH + h) * S + s);
    Q[ob * 96 + lane] = f2bf(qa * rq * qng[lane]); K[ob * 96 + lane] = f2bf(ka * rk * kng[lane]); V[((size_t)(b * MH + h) * 64 + lane) * S + s] = f2bf(va);
    const float qn = qb * rq * qng[64 + (lane & 31)], kn = kb * rk * kng[64 + (lane & 31)];
    const float qo = __shfl_xor(qn, 16), ko = __shfl_xor(kn, 16);
    const int i = lane & 15; const float cs = rope[(size_t)t * 16 + i], sn = rope[(size_t)NT * 16 + (size_t)t * 16 + i];
    if (lane < 32) { float qr, kr; if (lane < 16) { qr = qn * cs - qo * sn; kr = kn * cs - ko * sn; } else { qr = qn * cs + qo * sn; kr = kn * cs + ko * sn; }
        Q[ob * 96 + 64 + lane] = f2bf(qr); K[ob * 96 + 64 + lane] = f2bf(kr); }
}
__global__ void __launch_bounds__(64) k_attn_naive(const bf16* __restrict__ Q, const bf16* __restrict__ K, const bf16* __restrict__ V, bf16* __restrict__ BR) {
    __shared__ float ks[16][96], vs[16][64];
    const int bh = blockIdx.y, q0 = blockIdx.x * 64, qi = q0 + threadIdx.x, b = bh >> 3, h = bh & 7;
    float q[96], o[64]; float m = -INFINITY, l = 0.f;
    const bf16* qp = Q + ((size_t)bh * S + qi) * 96;
#pragma unroll
    for (int d = 0; d < 96; ++d) q[d] = bf2f(qp[d]) * 0.10206207261596575f;
#pragma unroll
    for (int d = 0; d < 64; ++d) o[d] = 0.f;
    for (int k0 = 0; k0 < q0 + 64; k0 += 16) {
        __syncthreads();
        for (int i = threadIdx.x; i < 16 * 96; i += 64) ks[i / 96][i % 96] = bf2f(K[((size_t)bh * S + k0) * 96 + i]);
        for (int i = threadIdx.x; i < 16 * 64; i += 64) vs[i & 15][i >> 4] = bf2f(V[((size_t)bh * 64 + (i >> 4)) * S + k0 + (i & 15)]);
        __syncthreads();
        for (int j = 0; j < 16; ++j) {
            if (k0 + j > qi) break;
            float sc = 0.f;
#pragma unroll
            for (int d = 0; d < 96; ++d) sc += q[d] * ks[j][d];
            const float mn = fmaxf(m, sc), corr = __expf(m - mn), p = __expf(sc - mn);
            l = l * corr + p; m = mn;
#pragma unroll
            for (int d = 0; d < 64; ++d) o[d] = o[d] * corr + p * vs[j][d];
        }
    }
    const float inv = 1.f / l; bf16* op = BR + (size_t)(b * S + qi) * 1536 + 512 + h * 64;
#pragma unroll
    for (int d = 0; d < 64; ++d) op[d] = f2bf(o[d] * inv);
}
__global__ void k_pool(const bf16* __restrict__ P, bf16* __restrict__ BR) {
    const int i = blockIdx.x * 256 + threadIdx.x, t = i >> 9, c = i & 511, g = c >> 7, s = t % S, w = 2 << g;
    const int n = (s + 1 < w) ? s + 1 : w; float sum = 0.f;
    for (int j = 0; j < n; ++j) sum += bf2f(P[(size_t)(t - j) * INP + C_POOL + c]);
    const float u = bf2f(P[(size_t)t * INP + C_POOL + c]);
    BR[(size_t)t * 1536 + 1024 + c] = f2bf(sum / (float)n - u);
}
__global__ void k_router(const float* __restrict__ x, const float* __restrict__ g, const float* __restrict__ mod_sh, const float* __restrict__ mod_sc, const float* __restrict__ wr, const float* __restrict__ br,
                         bf16* __restrict__ hn2, int* __restrict__ cnt, int* __restrict__ list, int* __restrict__ tokE, int* __restrict__ tokS, float* __restrict__ tokW) {
    __shared__ float hs[4][1024];
    const int w = threadIdx.x >> 6, row = blockIdx.x * 4 + w, lane = threadIdx.x & 63, b = row / S;
    const float4* xr = (const float4*)(x + (size_t)row * D);
    float4 v[4]; float ss = 0.f;
#pragma unroll
    for (int j = 0; j < 4; ++j) { v[j] = xr[lane + 64 * j]; ss += v[j].x * v[j].x + v[j].y * v[j].y + v[j].z * v[j].z + v[j].w * v[j].w; }
#pragma unroll
    for (int o = 1; o < 64; o <<= 1) ss += __shfl_xor(ss, o);
    const float rstd = rsqrtf(ss * (1.f / D) + EPS);
#pragma unroll
    for (int j = 0; j < 4; ++j) { const int c = (lane + 64 * j) * 4; const float4 gg = *(const float4*)(g + c), sh = *(const float4*)(mod_sh + b * 6144 + c), sc = *(const float4*)(mod_sc + b * 6144 + c);
        float4 hv; hv.x = v[j].x * rstd * gg.x * (1.f + sc.x) + sh.x; hv.y = v[j].y * rstd * gg.y * (1.f + sc.y) + sh.y; hv.z = v[j].z * rstd * gg.z * (1.f + sc.z) + sh.z; hv.w = v[j].w * rstd * gg.w * (1.f + sc.w) + sh.w;
        ushort4 o; o.x = f2bf(hv.x); o.y = f2bf(hv.y); o.z = f2bf(hv.z); o.w = f2bf(hv.w);
        *(ushort4*)(hn2 + (size_t)row * D + c) = o; *(float4*)&hs[w][c] = hv; }
    __syncthreads();
    const int e = lane & 31, half = lane >> 5; float a = 0.f;
    for (int k = half * 512; k < half * 512 + 512; ++k) a += hs[w][k] * wr[k * 32 + e];
    a += __shfl_xor(a, 32); a += br[e];
    float cur = a; float tv[4]; int ti[4];
#pragma unroll
    for (int k = 0; k < 4; ++k) { float mv = cur; int mi = e;
#pragma unroll
        for (int o = 1; o < 32; o <<= 1) { const float ov = __shfl_xor(mv, o); const int oi = __shfl_xor(mi, o); if (ov > mv || (ov == mv && oi < mi)) { mv = ov; mi = oi; } }
        tv[k] = mv; ti[k] = mi; if (e == mi) cur = -INFINITY; }
    const float e1 = __expf(tv[1] - tv[0]), e2 = __expf(tv[2] - tv[0]), e3 = __expf(tv[3] - tv[0]), inv = 1.f / (1.f + e1 + e2 + e3);
    if (lane == 0) {
        const float ww[4] = {inv, e1 * inv, e2 * inv, e3 * inv};
#pragma unroll
        for (int k = 0; k < 4; ++k) { const int slot = atomicAdd(&cnt[ti[k]], 1); list[(size_t)ti[k] * CAP + slot] = row; tokE[row * 4 + k] = ti[k]; tokS[row * 4 + k] = slot; tokW[row * 4 + k] = ww[k]; }
    }
}
__global__ void k_offsets(const int* __restrict__ cnt, int* __restrict__ off) { if (threadIdx.x == 0) { int a = 0; for (int e = 0; e < 32; ++e) { off[e] = a; a += (cnt[e] + 255) & ~255; } off[32] = a; } }
__global__ void k_combine(const float* __restrict__ x1, const float* __restrict__ mod_g2, const bf16* __restrict__ EO, const int* __restrict__ off, const int* __restrict__ tokE, const int* __restrict__ tokS, const float* __restrict__ tokW, float* __restrict__ out) {
    const int row = blockIdx.x, b = row / S, c = threadIdx.x * 4;
    float4 acc = {0.f, 0.f, 0.f, 0.f};
#pragma unroll
    for (int k = 0; k < 4; ++k) { const int e = tokE[row * 4 + k]; const size_t r = (size_t)off[e] + tokS[row * 4 + k]; const float w = tokW[row * 4 + k];
        const ushort4 ev = *(const ushort4*)(EO + r * 1024 + c); acc.x += w * bf2f(ev.x); acc.y += w * bf2f(ev.y); acc.z += w * bf2f(ev.z); acc.w += w * bf2f(ev.w); }
    const float4 xv = *(const float4*)(x1 + (size_t)row * D + c), gg = *(const float4*)(mod_g2 + b * 6144 + c);
    float4 o; o.x = xv.x + gg.x * acc.x; o.y = xv.y + gg.y * acc.y; o.z = xv.z + gg.z * acc.z; o.w = xv.w + gg.w * acc.w;
    *(float4*)(out + (size_t)row * D + c) = o;
}

#define MK_HYBRID 0
#define MK_POOL_IN 1
#define MK_MLA_IN 1
#define MK_ATTN_IN 1
#define MK_HGRN_IN 1
__device__ __forceinline__ unsigned mk_lane_id() { unsigned l; asm volatile("v_mbcnt_lo_u32_b32 %0, -1, 0\n\tv_mbcnt_hi_u32_b32 %0, -1, %0" : "=v"(l)); return l; }
#define GAS __attribute__((address_space(1)))
#define LAS __attribute__((address_space(3)))
#define XB_TMO      128
#define XB_XCNT(j)  (256  + 64 * (j))
#define XB_XSUB(j)  (1280 + 64 * (j))
#define XB_XGEN(j)  (2304 + 64 * (j))
#define XB_TOP      3328
#define XB_TOPGEN   3392
#define XCD_BAR_WORDS 3456
#define XB_SPIN_CAP (1u << 18)

__device__ __forceinline__ unsigned xb_ld(unsigned* p)              { return __hip_atomic_load(p, __ATOMIC_RELAXED, __HIP_MEMORY_SCOPE_AGENT); }
__device__ __forceinline__ unsigned xb_add(unsigned* p, unsigned v) { return __hip_atomic_fetch_add(p, v, __ATOMIC_RELAXED, __HIP_MEMORY_SCOPE_AGENT); }
__device__ __forceinline__ unsigned xb_xcc_id() { return (unsigned)__builtin_amdgcn_s_getreg((3 << 11) | 20) & 0xFu; }
#define XB_SPIN(cond, bar) do { unsigned _sp = 0; while (cond) { __builtin_amdgcn_s_sleep(1); \
    if ((++_sp & 255u) == 0u) { if (xb_ld(&(bar)[XB_TMO])) break; if (_sp > XB_SPIN_CAP) { atomicAdd(&(bar)[XB_TMO], 1u); break; } } } } while (0)

struct XcdBarrier {
    unsigned* bar; unsigned x; int wv;
    volatile LAS unsigned* st;
};

__device__ __forceinline__ bool xb_thread0(int wv) { return wv == 0 && mk_lane_id() == 0u; }
__device__ __forceinline__ XcdBarrier xcd_barrier_post(unsigned* bar, volatile LAS unsigned* st, int wv) {
    XcdBarrier b; b.bar = bar; b.x = xb_xcc_id(); b.st = st; b.wv = wv;
    if (xb_thread0(wv)) (void)xb_add(&bar[XB_XCNT(b.x)], 1u);
    return b;
}
__device__ __forceinline__ void xcd_barrier_complete(unsigned* bar, unsigned x, unsigned& nloc, unsigned& nx) {
    const unsigned G = gridDim.x * gridDim.y * gridDim.z;
    unsigned sum, cnt, mine, sp = 0u;
    for (;;) {
        sum = 0u; cnt = 0u; mine = 0u;
#pragma unroll
        for (unsigned j = 0; j < 16; ++j) { const unsigned c = xb_ld(&bar[XB_XCNT(j)]); sum += c; cnt += (c > 0u) ? 1u : 0u; mine = (j == x) ? c : mine; }
        if (sum == G) break;
        __builtin_amdgcn_s_sleep(1);
        if ((++sp & 255u) == 0u) { if (xb_ld(&bar[XB_TMO])) break; if (sp > XB_SPIN_CAP) { atomicAdd(&bar[XB_TMO], 1u); break; } }
    }
    nloc = mine > 0u ? mine : 1u; nx = cnt > 0u ? cnt : 1u;
}

__device__ __forceinline__ void xcd_barrier(const XcdBarrier& b) {
    asm volatile("s_waitcnt vmcnt(0)" ::: "memory");
    __syncthreads();
    if (xb_thread0(b.wv)) {
        unsigned* bar = b.bar;
        __builtin_amdgcn_s_waitcnt(0);
        unsigned nloc = b.st[0], nx = b.st[1];
        if (nloc == 0u) { xcd_barrier_complete(bar, b.x, nloc, nx); b.st[0] = nloc; b.st[1] = nx; }
        const unsigned old = xb_add(&bar[XB_XSUB(b.x)], 1u);
        const unsigned gen = old / nloc;
        if (old + 1u == (gen + 1u) * nloc) {
            __builtin_amdgcn_fence(__ATOMIC_RELEASE, "agent");
            asm volatile("s_waitcnt vmcnt(0)" ::: "memory");
            const unsigned og = xb_add(&bar[XB_TOP], 1u);
            const unsigned tg = og / nx;
            if (og + 1u == (tg + 1u) * nx) xb_add(&bar[XB_TOPGEN], 1u);
            else XB_SPIN(xb_ld(&bar[XB_TOPGEN]) == tg, bar);
            __builtin_amdgcn_fence(__ATOMIC_ACQUIRE, "agent");
            xb_add(&bar[XB_XGEN(b.x)], 1u);
            asm volatile("s_waitcnt vmcnt(0)" ::: "memory");
        } else {
            XB_SPIN(xb_ld(&bar[XB_XGEN(b.x)]) == gen, bar);
            __builtin_amdgcn_fence(__ATOMIC_ACQUIRE, "agent");
            asm volatile("s_waitcnt vmcnt(0)" ::: "memory");
        }
    }
    __syncthreads();
}
namespace pg8 {
#define PG8_LAS __attribute__((address_space(3)))
typedef unsigned short bf16_t;
typedef short bf16x8 __attribute__((ext_vector_type(8)));
typedef float f32x4 __attribute__((ext_vector_type(4)));
typedef unsigned u32x4 __attribute__((ext_vector_type(4)));
constexpr int BM = 256, BK = 64, HALF = 128, HTB = HALF * BK * 2  , STAGE_BYTES = 8 * HTB, NXCD = 8, WGM = 8;

__host__ __device__ __forceinline__ int lds_byte(int r, int c) { const int st = (r >> 4) * 2 + (c >> 5), rr = r & 15, cc = c & 31, ob = rr * 64 + cc * 2; return st * 1024 + (ob ^ (((ob >> 9) & 1) << 5)); }
__host__ __device__ __forceinline__ void stage_rc(int b, int& R, int& C) { const int st = b / 1024, sb = b % 1024, swz = sb ^ (((sb >> 9) & 1) << 5); R = (st >> 1) * 16 + swz / 64; C = (st & 1) * 32 + (swz % 64) / 2; }
__host__ __device__ __forceinline__ int perm32(int rho) { const int n = rho >> 4, i = rho & 15; return 8 * (i >> 2) + 4 * n + (i & 3); }

struct Unit { int pm, pn, ka, aux, e, gbase, gcnt, pad; };
struct Gemm { const bf16_t* A; const bf16_t* Bt; const int* rowlist; int lda, ldb, K, pad; };

struct StaticOrder {
    int nM, nN, nwg, G, c;
    __host__ __device__ void init(int M, int N, int G_, int c_) { nM = M / BM; nN = N / BM; nwg = nM * nN; G = G_; c = c_; }
    __host__ __device__ bool next(int i, Unit& u) const {
        const long L = (long)i * G + c; if (L >= nwg) return false;
        int wgid = (int)L; { const int q = nwg / NXCD, r = nwg % NXCD, xcd = wgid % NXCD, off = wgid / NXCD; wgid = (xcd < r ? xcd * (q + 1) : r * (q + 1) + (xcd - r) * q) + off; }
        const int nig = WGM * nN, gid = wgid / nig, fm = gid * WGM, gsz = (nM - fm) < WGM ? (nM - fm) : WGM;
        u.pm = fm + ((wgid % nig) % gsz); u.pn = (wgid % nig) / gsz; u.ka = 0; u.aux = 0; u.e = 0; u.gbase = 0; u.gcnt = 0; u.pad = 0; return true;
    }
};

typedef float cvt_f32x2 __attribute__((ext_vector_type(2)));
typedef __bf16 cvt_bf16x2 __attribute__((ext_vector_type(2)));
__device__ __forceinline__ unsigned cvt_pk_bf16(float lo, float hi) { const cvt_f32x2 v = {lo, hi}; return __builtin_bit_cast(unsigned, __builtin_convertvector(v, cvt_bf16x2)); }

template <class Epi, class Sched, bool ALIGN_EPI, bool SP2, bool GATHER, int HOOK = 0>
__device__ __forceinline__ void gemm_phase(PG8_LAS unsigned char* lds, const Gemm g, const Sched& S, const Epi& E, int wave_in) {
    int tid_ = wave_in * 64 + (int)mk_lane_id(); asm volatile("" : "+v"(tid_));
    const int tid = tid_, wid = __builtin_amdgcn_readfirstlane(tid >> 6), lane = tid & 63, wr = wid >> 2, wc = wid & 3, fr = lane & 15, fq = lane >> 4;
    const int K = g.K, nt = K / BK;
    const unsigned ldaB = (unsigned)g.lda * 2u, ldbB = (unsigned)g.ldb * 2u;
    unsigned voffA[2], voffB[2]; int rowA[2];
#pragma unroll
    for (int i = 0; i < 2; ++i) { int R, C; stage_rc(tid * 16 + i * 8192, R, C); const int Rb = Epi::PERM ? ((R & ~31) + perm32(R & 31)) : R;
        rowA[i] = R; voffA[i] = GATHER ? (unsigned)C * 2u : (unsigned)R * ldaB + (unsigned)C * 2u; voffB[i] = (unsigned)Rb * ldbB + (unsigned)C * 2u; }
    const size_t kstep = (size_t)(BK * 2);
    const size_t hstepA = GATHER ? 0 : (size_t)HALF * ldaB, hstepB = (size_t)HALF * ldbB;
    const size_t tstepA = 2 * (size_t)HALF * ldaB, tstepB = 2 * hstepB;
    const unsigned ldsw = (unsigned)wid * 1024u;
    const int aoff = lds_byte(wr * 64 + fr, fq * 8), boff = lds_byte(wc * 32 + fr, fq * 8);
    unsigned gvc[2][2], gvn[2][2];
#define PG8_SA(b, h) (((b) * 2 + (h)) * HTB)
#define PG8_SB(b, h) ((4 + (b) * 2 + (h)) * HTB)
#define PG8_STAGE(bufoff, gbase, voff) do { _Pragma("unroll") for (int _i = 0; _i < 2; ++_i) \
        __builtin_amdgcn_global_load_lds((const unsigned*)((const char*)(gbase) + (voff)[_i]), (PG8_LAS unsigned*)(lds + (bufoff) + ldsw + _i * 8192), 16, 0, 0); } while (0)
#define PG8_STAGEA(bufoff, gbase, h, nx) do { if constexpr (GATHER) { unsigned _vo[2]; _vo[0] = ((nx) ? gvn[h][0] : gvc[h][0]) + voffA[0]; _vo[1] = ((nx) ? gvn[h][1] : gvc[h][1]) + voffA[1]; PG8_STAGE(bufoff, gbase, _vo); } \
        else { PG8_STAGE(bufoff, (const char*)(gbase) + (h) * hstepA, voffA); } } while (0)
#define PG8_GLOAD(dst, u) do { _Pragma("unroll") for (int _h = 0; _h < 2; ++_h) _Pragma("unroll") for (int _i = 0; _i < 2; ++_i) { const int _r = _h * HALF + rowA[_i]; \
        const int _row = (_r < (u).gcnt) ? g.rowlist[(u).gbase + _r] : 0; dst[_h][_i] = (unsigned)_row * ldaB; } } while (0)
#define PG8_LDA(dst, b, h) do { _Pragma("unroll") for (int m = 0; m < 4; ++m) _Pragma("unroll") for (int k = 0; k < 2; ++k) dst[m][k] = *(const PG8_LAS bf16x8*)(lds + PG8_SA(b, h) + aoff + m * 2048 + k * 1024); } while (0)
#define PG8_LDB(dst, b, h) do { _Pragma("unroll") for (int n = 0; n < 2; ++n) _Pragma("unroll") for (int k = 0; k < 2; ++k) dst[n][k] = *(const PG8_LAS bf16x8*)(lds + PG8_SB(b, h) + boff + n * 2048 + k * 1024); } while (0)
#define PG8_MMA(ai, bj, At, Bt) do { __builtin_amdgcn_s_setprio(1); _Pragma("unroll") for (int m = 0; m < 4; ++m) _Pragma("unroll") for (int n = 0; n < 2; ++n) _Pragma("unroll") for (int k = 0; k < 2; ++k) \
        acc[ai][bj][m][n] = __builtin_amdgcn_mfma_f32_16x16x32_bf16(Bt[n][k], At[m][k], acc[ai][bj][m][n], 0, 0, 0); __builtin_amdgcn_s_setprio(0); } while (0)
#define PG8_WAIT_V(n) asm volatile("s_waitcnt vmcnt(" #n ")" ::: "memory")
#define PG8_WAIT_L(n) asm volatile("s_waitcnt lgkmcnt(" #n ")" ::: "memory")
#define PG8_BAR __builtin_amdgcn_s_barrier()
#define PG8_SCHED __builtin_amdgcn_sched_barrier(0)
    Unit cur, nxt; int ui = 0;
    if (!S.next(0, cur)) return;
    f32x4 acc[2][2][4][2];
#pragma unroll
    for (int a = 0; a < 2; ++a)
#pragma unroll
        for (int b = 0; b < 2; ++b)
#pragma unroll
            for (int m = 0; m < 4; ++m)
#pragma unroll
                for (int n = 0; n < 2; ++n) acc[a][b][m][n] = (f32x4){0.f, 0.f, 0.f, 0.f};
    bf16x8 At[4][2], B0[2][2], B1[2][2];
    const char* cA = (const char*)g.A + (GATHER ? (size_t)0 : (size_t)cur.pm * tstepA) + (size_t)cur.ka * 2; const char* cB = (const char*)g.Bt + (size_t)cur.pn * tstepB;
    if constexpr (GATHER) { PG8_GLOAD(gvc, cur); }
#pragma unroll
    for (int h = 0; h < 2; ++h)
#pragma unroll
        for (int i = 0; i < 2; ++i) gvn[h][i] = GATHER ? gvc[h][i] : 0u;
    {
        PG8_STAGE(PG8_SB(0, 0), cB, voffB); PG8_STAGE(PG8_SB(0, 1), cB + hstepB, voffB); PG8_STAGEA(PG8_SA(0, 0), cA, 0, false); PG8_STAGEA(PG8_SA(0, 1), cA, 1, false);
        if (wr == 1) PG8_BAR;
        PG8_WAIT_V(2); PG8_BAR;
        PG8_STAGE(PG8_SB(1, 0), cB + kstep, voffB); PG8_STAGEA(PG8_SA(1, 0), cA + kstep, 0, false); PG8_STAGE(PG8_SB(1, 1), cB + hstepB + kstep, voffB);
        PG8_WAIT_V(6); PG8_BAR;
    }
    for (;;) {
        const bool has_next = S.next(ui + 1, nxt);
        const char* nA = has_next ? (const char*)g.A + (GATHER ? (size_t)0 : (size_t)nxt.pm * tstepA) + (size_t)nxt.ka * 2 : cA; const char* nB = has_next ? (const char*)g.Bt + (size_t)nxt.pn * tstepB : cB;
        if constexpr (GATHER) { if (has_next) { PG8_GLOAD(gvn, nxt); } }
        E.prefetch(cur, wid, lane);
        for (int t = 0; t < nt; t += 2) {
            const bool last = (t == nt - 2);
            if constexpr (HOOK > 0) { if (t > 0 && (t % HOOK) == 0) E.mid(acc, cur, wr, wc, fr, fq, t); }
            const char* a1 = cA + (size_t)(t + 1) * kstep;
            const char* a2 = last ? nA : cA + (size_t)(t + 2) * kstep; const char* b2 = last ? nB : cB + (size_t)(t + 2) * kstep;
            const char* a3 = a2 + kstep; const char* b3 = b2 + kstep;
            PG8_LDB(B0, 0, 0); PG8_LDB(B1, 0, 1); PG8_SCHED; PG8_LDA(At, 0, 0); PG8_STAGEA(PG8_SA(1, 1), a1, 1, false);
            PG8_WAIT_V(8); PG8_WAIT_L(0); PG8_BAR; PG8_MMA(0, 0, At, B0); PG8_MMA(0, 1, At, B1); PG8_BAR; PG8_SCHED;
            PG8_LDA(At, 0, 1); PG8_STAGE(PG8_SB(0, 0), b2, voffB); PG8_STAGE(PG8_SB(0, 1), b2 + hstepB, voffB); PG8_STAGEA(PG8_SA(0, 0), a2, 0, last);
            PG8_WAIT_V(8); PG8_WAIT_L(0); PG8_BAR; PG8_MMA(1, 0, At, B0); PG8_MMA(1, 1, At, B1); PG8_BAR; PG8_SCHED;
            PG8_LDB(B0, 1, 0); PG8_LDB(B1, 1, 1); PG8_SCHED; PG8_LDA(At, 1, 0); PG8_STAGEA(PG8_SA(0, 1), a2, 1, last);
            PG8_WAIT_V(8); PG8_WAIT_L(0); PG8_BAR; PG8_MMA(0, 0, At, B0); PG8_MMA(0, 1, At, B1); PG8_BAR; PG8_SCHED;
            PG8_LDA(At, 1, 1); PG8_STAGE(PG8_SB(1, 0), b3, voffB); PG8_STAGE(PG8_SB(1, 1), b3 + hstepB, voffB); PG8_STAGEA(PG8_SA(1, 0), a3, 0, last);
            PG8_WAIT_V(8); PG8_WAIT_L(0); PG8_BAR; PG8_MMA(1, 0, At, B0); PG8_MMA(1, 1, At, B1); PG8_BAR; PG8_SCHED;
        }
        if constexpr (ALIGN_EPI) { if (wr == 0) PG8_BAR; }
        E(acc, cur, wr, wc, fr, fq);
        if (!has_next) break;
#pragma unroll
        for (int a = 0; a < 2; ++a)
#pragma unroll
            for (int b = 0; b < 2; ++b)
#pragma unroll
                for (int m = 0; m < 4; ++m)
#pragma unroll
                    for (int n = 0; n < 2; ++n) acc[a][b][m][n] = (f32x4){0.f, 0.f, 0.f, 0.f};
        cur = nxt; cA = nA; cB = nB; ++ui;
#pragma unroll
        for (int h = 0; h < 2; ++h)
#pragma unroll
            for (int i = 0; i < 2; ++i) gvc[h][i] = gvn[h][i];
        if constexpr (ALIGN_EPI) { if (wr == 1) PG8_BAR; }
    }
    PG8_WAIT_V(0);
    if constexpr (!ALIGN_EPI) { if (wr == 0) PG8_BAR; }
    PG8_BAR;
#undef PG8_SA
#undef PG8_SB
#undef PG8_STAGE
#undef PG8_STAGEA
#undef PG8_GLOAD
#undef PG8_LDA
#undef PG8_LDB
#undef PG8_MMA
#undef PG8_WAIT_V
#undef PG8_WAIT_L
#undef PG8_BAR
#undef PG8_SCHED
}
}
#ifndef MK_P5PROBE
#define MK_P5PROBE 0
#endif
#ifndef MK_HOOKPROBE
#define MK_HOOKPROBE 0
#endif
typedef unsigned v4u __attribute__((ext_vector_type(4)));
typedef unsigned v2u __attribute__((ext_vector_type(2)));
typedef float f32x4 __attribute__((ext_vector_type(4)));
typedef float f32x16 __attribute__((ext_vector_type(16)));
typedef short bf16x8 __attribute__((ext_vector_type(8)));
#define LDS_WAIT() asm volatile("s_waitcnt lgkmcnt(0)" ::: "memory")
#define VM_WAIT() asm volatile("s_waitcnt vmcnt(0)" ::: "memory")
__device__ __forceinline__ unsigned pk2(float lo, float hi) { return pg8::cvt_pk_bf16(lo, hi); }
__device__ __forceinline__ bf16 f2bf_hw(float x) { return (bf16)(pk2(x, 0.f) & 0xffffu); }
__device__ __forceinline__ float wave_sum(float v) {
#pragma unroll
    for (int o = 1; o < 64; o <<= 1) v += __shfl_xor(v, o);
    return v;
}

__device__ __forceinline__ float bflo(unsigned w) { return __uint_as_float(w << 16); }
__device__ __forceinline__ float bfhi(unsigned w) { return __uint_as_float(w & 0xffff0000u); }
#define MFMA32(a, b, c) __builtin_amdgcn_mfma_f32_32x32x16_bf16((a), (b), (c), 0, 0, 0)
typedef float f32x2 __attribute__((ext_vector_type(2)));
__device__ __forceinline__ f32x2 sq16(const f32x16& a, f32x2 s) {
#pragma unroll
    for (int r = 0; r < 16; r += 2) { const f32x2 p = {a[r], a[r + 1]}; s += p * p; }
    return s;
}

__device__ __forceinline__ void pool_unit(const bf16* __restrict__ P, bf16* __restrict__ BR, int unit, int tid) {
    asm volatile("" : "+v"(tid));
    const int tr = tid >> 6, tc = tid & 63, g = tc >> 4, w = 2 << g;
#pragma unroll 1
    for (int rr = 0; rr < 8; ++rr) {
        const int row = unit * 64 + rr * 8 + tr, s = row & (S - 1), n = (s + 1 < w) ? s + 1 : w;
        const bf16* p = P + (size_t)row * INP + C_POOL + 8 * tc;
        float a[8];
#pragma unroll
        for (int q = 0; q < 8; ++q) a[q] = 0.f;
        v4u wv[16];
#pragma unroll
        for (int j = 0; j < 16; ++j) wv[j] = (j < n) ? *(const GAS v4u*)(p - (size_t)j * INP) : (v4u){0u, 0u, 0u, 0u};
        const v4u u0 = wv[0];
#pragma unroll
        for (int j = 0; j < 16; ++j) { const v4u v = wv[j];
            a[0] += bflo(v.x); a[1] += bfhi(v.x); a[2] += bflo(v.y); a[3] += bfhi(v.y); a[4] += bflo(v.z); a[5] += bfhi(v.z); a[6] += bflo(v.w); a[7] += bfhi(v.w); }
        const float inv = __builtin_amdgcn_rcpf((float)n);
        v4u o; o.x = pk2(a[0] * inv - bflo(u0.x), a[1] * inv - bfhi(u0.x)); o.y = pk2(a[2] * inv - bflo(u0.y), a[3] * inv - bfhi(u0.y));
        o.z = pk2(a[4] * inv - bflo(u0.z), a[5] * inv - bfhi(u0.z)); o.w = pk2(a[6] * inv - bflo(u0.w), a[7] * inv - bfhi(u0.w));
        *(GAS v4u*)(BR + (size_t)row * 1536 + 1024 + 8 * tc) = o;
    }
}

constexpr int MLA_QS = 784, MLA_KS = 528;
__device__ __forceinline__ void mla_unit(const bf16* __restrict__ P, const float* __restrict__ qlat_g, const float* __restrict__ kvlat_g, const bf16* __restrict__ WuqT, const bf16* __restrict__ WukvT,
                                         const float* __restrict__ qn_g, const float* __restrict__ kn_g, const float* __restrict__ rope, bf16* __restrict__ Q, bf16* __restrict__ K, bf16* __restrict__ VT,
                                         LAS unsigned char* lds, int unit, int lane, int wave) {
    asm volatile("" : "+v"(lane));
    LAS unsigned char* qn = lds; LAS unsigned char* kvn = lds + 64 * MLA_QS;
    const int t0 = unit * 64;
#pragma unroll 1
    for (int rb = 0; rb < 2; ++rb) {
        unsigned qv[4][3], kv[4][2];
#pragma unroll
        for (int rr = 0; rr < 4; ++rr) { const bf16* pr = P + (size_t)(t0 + wave * 8 + rb * 4 + rr) * INP;
#pragma unroll
            for (int j = 0; j < 3; ++j) qv[rr][j] = *(const GAS unsigned*)(pr + C_QLAT + 2 * lane + 128 * j);
#pragma unroll
            for (int j = 0; j < 2; ++j) kv[rr][j] = *(const GAS unsigned*)(pr + C_KVLAT + 2 * lane + 128 * j); }
#pragma unroll
        for (int rr = 0; rr < 4; ++rr) {
            const int lr = wave * 8 + rb * 4 + rr; float s1 = 0.f, s2 = 0.f;
#pragma unroll
            for (int j = 0; j < 3; ++j) s1 += bflo(qv[rr][j]) * bflo(qv[rr][j]) + bfhi(qv[rr][j]) * bfhi(qv[rr][j]);
#pragma unroll
            for (int j = 0; j < 2; ++j) s2 += bflo(kv[rr][j]) * bflo(kv[rr][j]) + bfhi(kv[rr][j]) * bfhi(kv[rr][j]);
            s1 = wave_sum(s1); s2 = wave_sum(s2);
            const float r1 = rsqrtf(s1 * (1.f / 384.f) + EPS), r2 = rsqrtf(s2 * (1.f / 256.f) + EPS);
#pragma unroll
            for (int j = 0; j < 3; ++j) { const int c = 2 * lane + 128 * j; *(LAS unsigned*)(qn + lr * MLA_QS + c * 2) = pk2(bflo(qv[rr][j]) * r1 * qlat_g[c], bfhi(qv[rr][j]) * r1 * qlat_g[c + 1]); }
#pragma unroll
            for (int j = 0; j < 2; ++j) { const int c = 2 * lane + 128 * j; *(LAS unsigned*)(kvn + lr * MLA_KS + c * 2) = pk2(bflo(kv[rr][j]) * r2 * kvlat_g[c], bfhi(kv[rr][j]) * r2 * kvlat_g[c + 1]); }
        }
    }
    __syncthreads();
    const int l31 = lane & 31, h5 = lane >> 5;
    {
        f32x16 acc[3][2];
#pragma unroll
        for (int mt = 0; mt < 3; ++mt)
#pragma unroll
            for (int nt = 0; nt < 2; ++nt)
#pragma unroll
                for (int r = 0; r < 16; ++r) acc[mt][nt][r] = 0.f;
        const bf16* wp = WuqT + (size_t)(wave * 96 + l31) * 384 + 8 * h5;
        bf16x8 ar[4][3];
#pragma unroll
        for (int p = 0; p < 3; ++p)
#pragma unroll
            for (int mt = 0; mt < 3; ++mt) ar[p][mt] = *(const GAS bf16x8*)(wp + (size_t)mt * 32 * 384 + 16 * p);
#pragma unroll
        for (int ks = 0; ks < 24; ++ks) {
            if (ks + 3 < 24) {
#pragma unroll
                for (int mt = 0; mt < 3; ++mt) ar[(ks + 3) & 3][mt] = *(const GAS bf16x8*)(wp + (size_t)mt * 32 * 384 + 16 * (ks + 3)); }
            bf16x8 b[2];
#pragma unroll
            for (int nt = 0; nt < 2; ++nt) b[nt] = *(const LAS bf16x8*)(qn + (32 * nt + l31) * MLA_QS + (16 * ks + 8 * h5) * 2);
#pragma unroll
            for (int mt = 0; mt < 3; ++mt)
#pragma unroll
                for (int nt = 0; nt < 2; ++nt) acc[mt][nt] = MFMA32(ar[ks & 3][mt], b[nt], acc[mt][nt]);
        }
#pragma unroll
        for (int nt = 0; nt < 2; ++nt) {
            const int tok = t0 + 32 * nt + l31, b = tok / S, s = tok & (S - 1);
            f32x2 s2 = {0.f, 0.f};
#pragma unroll
            for (int mt = 0; mt < 3; ++mt) s2 = sq16(acc[mt][nt], s2);
            float ss = s2.x + s2.y;
            ss += __shfl_xor(ss, 32);
            const float rstd = rsqrtf(ss * (1.f / 96.f) + EPS);
            bf16* qo = Q + ((size_t)(b * MH + wave) * S + s) * 96;
#pragma unroll
            for (int mt = 0; mt < 2; ++mt)
#pragma unroll
                for (int g = 0; g < 4; ++g) { const int d0 = 32 * mt + 8 * g + 4 * h5; const f32x4 gn = *(const GAS f32x4*)(qn_g + d0);
                    v2u o; o.x = pk2(acc[mt][nt][4 * g] * rstd * gn[0], acc[mt][nt][4 * g + 1] * rstd * gn[1]); o.y = pk2(acc[mt][nt][4 * g + 2] * rstd * gn[2], acc[mt][nt][4 * g + 3] * rstd * gn[3]);
                    *(GAS v2u*)(qo + d0) = o; }
#pragma unroll
            for (int g = 0; g < 2; ++g) { const int i0 = 8 * g + 4 * h5;
                const f32x4 cs = *(const GAS f32x4*)(rope + (size_t)tok * 16 + i0), sn = *(const GAS f32x4*)(rope + (size_t)NT * 16 + (size_t)tok * 16 + i0);
                const f32x4 g1 = *(const GAS f32x4*)(qn_g + 64 + i0), g2 = *(const GAS f32x4*)(qn_g + 80 + i0);
                float o1[4], o2[4];
#pragma unroll
                for (int j = 0; j < 4; ++j) { const float x1 = acc[2][nt][4 * g + j] * rstd * g1[j], x2 = acc[2][nt][8 + 4 * g + j] * rstd * g2[j]; o1[j] = x1 * cs[j] - x2 * sn[j]; o2[j] = x2 * cs[j] + x1 * sn[j]; }
                v2u w1, w2; w1.x = pk2(o1[0], o1[1]); w1.y = pk2(o1[2], o1[3]); w2.x = pk2(o2[0], o2[1]); w2.y = pk2(o2[2], o2[3]);
                *(GAS v2u*)(qo + 64 + i0) = w1; *(GAS v2u*)(qo + 80 + i0) = w2; }
        }
    }
#pragma unroll 1
    for (int pass = 0; pass < 2; ++pass) {
        f32x16 acc[2][2];
#pragma unroll
        for (int mt = 0; mt < 2; ++mt)
#pragma unroll
            for (int nt = 0; nt < 2; ++nt)
#pragma unroll
                for (int r = 0; r < 16; ++r) acc[mt][nt][r] = 0.f;
        const bf16* wp = WukvT + (size_t)(wave * 128 + pass * 64 + l31) * 256 + 8 * h5;
        bf16x8 ar[4][2];
#pragma unroll
        for (int p = 0; p < 3; ++p)
#pragma unroll
            for (int mt = 0; mt < 2; ++mt) ar[p][mt] = *(const GAS bf16x8*)(wp + (size_t)mt * 32 * 256 + 16 * p);
#pragma unroll
        for (int ks = 0; ks < 16; ++ks) {
            if (ks + 3 < 16) {
#pragma unroll
                for (int mt = 0; mt < 2; ++mt) ar[(ks + 3) & 3][mt] = *(const GAS bf16x8*)(wp + (size_t)mt * 32 * 256 + 16 * (ks + 3)); }
            bf16x8 b[2];
#pragma unroll
            for (int nt = 0; nt < 2; ++nt) b[nt] = *(const LAS bf16x8*)(kvn + (32 * nt + l31) * MLA_KS + (16 * ks + 8 * h5) * 2);
#pragma unroll
            for (int mt = 0; mt < 2; ++mt)
#pragma unroll
                for (int nt = 0; nt < 2; ++nt) acc[mt][nt] = MFMA32(ar[ks & 3][mt], b[nt], acc[mt][nt]);
        }
        if (pass == 0) {
#pragma unroll
          for (int nt = 0; nt < 2; ++nt) {
            const int tok = t0 + 32 * nt + l31, b = tok / S, s = tok & (S - 1);
            float kr[16];
#pragma unroll
            for (int g = 0; g < 4; ++g) { const v2u kv = *(const GAS v2u*)(P + (size_t)tok * INP + C_KROPE + 8 * g + 4 * h5); kr[4 * g] = bflo(kv.x); kr[4 * g + 1] = bfhi(kv.x); kr[4 * g + 2] = bflo(kv.y); kr[4 * g + 3] = bfhi(kv.y); }
            f32x2 s2 = {0.f, 0.f};
#pragma unroll
            for (int mt = 0; mt < 2; ++mt) s2 = sq16(acc[mt][nt], s2);
            float ss = s2.x + s2.y;
#pragma unroll
            for (int r = 0; r < 16; ++r) ss += kr[r] * kr[r];
            ss += __shfl_xor(ss, 32);
            const float rstd = rsqrtf(ss * (1.f / 96.f) + EPS);
            bf16* ko = K + ((size_t)(b * MH + wave) * S + s) * 96;
#pragma unroll
            for (int mt = 0; mt < 2; ++mt)
#pragma unroll
                for (int g = 0; g < 4; ++g) { const int d0 = 32 * mt + 8 * g + 4 * h5; const f32x4 gn = *(const GAS f32x4*)(kn_g + d0);
                    v2u o; o.x = pk2(acc[mt][nt][4 * g] * rstd * gn[0], acc[mt][nt][4 * g + 1] * rstd * gn[1]); o.y = pk2(acc[mt][nt][4 * g + 2] * rstd * gn[2], acc[mt][nt][4 * g + 3] * rstd * gn[3]);
                    *(GAS v2u*)(ko + d0) = o; }
#pragma unroll
            for (int g = 0; g < 4; ++g) { const f32x4 gn = *(const GAS f32x4*)(kn_g + 64 + 8 * g + 4 * h5);
#pragma unroll
                for (int j = 0; j < 4; ++j) kr[4 * g + j] *= rstd * gn[j]; }
#pragma unroll
            for (int g = 0; g < 2; ++g) { const f32x4 cs = *(const GAS f32x4*)(rope + (size_t)tok * 16 + 8 * g + 4 * h5), sn = *(const GAS f32x4*)(rope + (size_t)NT * 16 + (size_t)tok * 16 + 8 * g + 4 * h5);
                float o1[4], o2[4];
#pragma unroll
                for (int j = 0; j < 4; ++j) { const float x1 = kr[4 * g + j], x2 = kr[8 + 4 * g + j]; o1[j] = x1 * cs[j] - x2 * sn[j]; o2[j] = x2 * cs[j] + x1 * sn[j]; }
                v2u w1, w2; w1.x = pk2(o1[0], o1[1]); w1.y = pk2(o1[2], o1[3]); w2.x = pk2(o2[0], o2[1]); w2.y = pk2(o2[2], o2[3]);
                *(GAS v2u*)(ko + 64 + 8 * g + 4 * h5) = w1; *(GAS v2u*)(ko + 80 + 8 * g + 4 * h5) = w2; }
          }
        } else {
#pragma unroll
          for (int nt = 0; nt < 2; ++nt) {
            int hq = h5; asm volatile("" : "+v"(hq));
            const int tok = t0 + 32 * nt + l31, b = tok / S, s = tok & (S - 1);
            bf16* vo = VT + ((size_t)(b * MH + wave) * 64 + 4 * hq) * S + s;
#pragma unroll
            for (int mt = 0; mt < 2; ++mt)
#pragma unroll
                for (int r = 0; r < 16; ++r) { const int dv = 32 * mt + (r & 3) + 8 * (r >> 2); vo[(size_t)dv * S] = f2bf_hw(acc[mt][nt][r]); }
          }
        }
    }
    __syncthreads();
}

constexpr int AT_KS = 208, AT_VS = 136;
constexpr int AT_KB = 64 * AT_KS, AT_VB = 64 * AT_VS;
constexpr float AT_C = 0.10206207261596575f * 1.4426950408889634f;
__device__ __forceinline__ void attn_unit(const bf16* __restrict__ Q, const bf16* __restrict__ K, const bf16* __restrict__ VT, bf16* __restrict__ BR, LAS unsigned char* lds, int bh, int qb, int tid, int lane, int wave) {
    asm volatile("" : "+v"(lane), "+v"(tid));
    const int l31 = lane & 31, h5 = lane >> 5;
    const int qw0 = 256 * qb + 32 * wave, ntile = 4 * qb + 4, mytiles = 4 * qb + (wave >> 1) + 1;
    const bf16* Kg = K + (size_t)bh * S * 96; const bf16* Vg = VT + (size_t)bh * 64 * S;
    LAS unsigned char* kbuf = lds; LAS unsigned char* vbuf = lds + 2 * AT_KB;
    bf16x8 qf[6];
    { const bf16* qp = Q + ((size_t)bh * S + qw0 + l31) * 96 + 8 * h5;
#pragma unroll
      for (int ks = 0; ks < 6; ++ks) qf[ks] = *(const GAS bf16x8*)(qp + 16 * ks); }
    f32x16 o[2];
#pragma unroll
    for (int r = 0; r < 16; ++r) { o[0][r] = 0.f; o[1][r] = 0.f; }
    float mrow = -INFINITY, lrow = 0.f;
    const int kc0 = tid, kc1 = tid + 512; const bool k1 = kc1 < 768;
    const unsigned kl0 = (unsigned)((kc0 / 12) * AT_KS + (kc0 % 12) * 16), kl1 = (unsigned)((kc1 / 12) * AT_KS + (kc1 % 12) * 16), vl = (unsigned)((tid >> 3) * AT_VS + (tid & 7) * 16);
    v4u sk0, sk1 = (v4u){0u, 0u, 0u, 0u}, sv;
#define AT_GLOADK(j) do { const bf16* kp = Kg + (size_t)(j) * 64 * 96; sk0 = *(const GAS v4u*)(kp + (size_t)kc0 * 8); if (k1) sk1 = *(const GAS v4u*)(kp + (size_t)kc1 * 8); } while (0)
#define AT_GLOADV(j) do { sv = *(const GAS v4u*)(Vg + (size_t)(tid >> 3) * S + (size_t)(j) * 64 + (tid & 7) * 8); } while (0)
#define AT_LSTOREK(buf) do { LAS unsigned char* kb = kbuf + (buf) * AT_KB; *(LAS v4u*)(kb + kl0) = sk0; if (k1) *(LAS v4u*)(kb + kl1) = sk1; } while (0)
#define AT_LSTOREV(buf) do { LAS unsigned char* vb = vbuf + (buf) * AT_VB + vl; *(LAS v2u*)(vb) = (v2u){sv.x, sv.y}; *(LAS v2u*)(vb + 8) = (v2u){sv.z, sv.w}; } while (0)
#define AT_QK(dst, buf) do { const LAS unsigned char* kb = kbuf + (buf) * AT_KB; _Pragma("unroll") for (int kt = 0; kt < 2; ++kt) { _Pragma("unroll") for (int r = 0; r < 16; ++r) dst[kt][r] = 0.f; \
        _Pragma("unroll") for (int ks = 0; ks < 6; ++ks) { const bf16x8 kf = *(const LAS bf16x8*)(kb + (32 * kt + l31) * AT_KS + (16 * ks + 8 * h5) * 2); dst[kt] = MFMA32(kf, qf[ks], dst[kt]); } } } while (0)
    AT_GLOADK(0); AT_GLOADV(0); AT_LSTOREK(0); AT_LSTOREV(0);
    AT_GLOADK(1); AT_LSTOREK(1);
    __syncthreads();
    f32x16 sa[2], sb[2];
    AT_QK(sa, 0);
    __syncthreads();
#define AT_BODY(SC, SN, J) do { const int j = (J); \
        if (j + 2 < ntile) AT_GLOADK(j + 2); \
        if (j + 1 < ntile) AT_GLOADV(j + 1); \
        if (j + 1 < mytiles) AT_QK(SN, (j + 1) & 1); \
        if (j < mytiles) { \
            const LAS unsigned char* vb = vbuf + (j & 1) * AT_VB; \
            if (j == mytiles - 1) { const int qq = qw0 + l31 - 64 * j; asm volatile("; diagonal tile" ::: "memory");     \
                _Pragma("unroll") for (int kt = 0; kt < 2; ++kt) _Pragma("unroll") for (int r = 0; r < 16; ++r) { const int kk = 32 * kt + (r & 3) + 8 * (r >> 2) + 4 * h5; if (kk > qq) SC[kt][r] = -INFINITY; } } \
            float mx = SC[0][0]; \
            _Pragma("unroll") for (int kt = 0; kt < 2; ++kt) _Pragma("unroll") for (int r = 0; r < 16; ++r) mx = fmaxf(mx, SC[kt][r]); \
            mx = fmaxf(mx, __shfl_xor(mx, 32)); \
            const float mnew = fmaxf(mrow, mx * AT_C), alpha = __builtin_amdgcn_exp2f(mrow - mnew); \
            mrow = mnew; \
            f32x2 ls2 = {0.f, 0.f}; const f32x2 c2 = {AT_C, AT_C}, m2 = {mnew, mnew}; \
            _Pragma("unroll") for (int kt = 0; kt < 2; ++kt) _Pragma("unroll") for (int r = 0; r < 16; r += 2) { f32x2 x = {SC[kt][r], SC[kt][r + 1]}; x = x * c2 - m2; \
                f32x2 pp; pp.x = __builtin_amdgcn_exp2f(x.x); pp.y = __builtin_amdgcn_exp2f(x.y); SC[kt][r] = pp.x; SC[kt][r + 1] = pp.y; ls2 += pp; } \
            lrow = lrow * alpha + (ls2.x + ls2.y); \
            _Pragma("unroll") for (int r = 0; r < 16; ++r) { o[0][r] *= alpha; o[1][r] *= alpha; } \
            _Pragma("unroll") for (int kt = 0; kt < 2; ++kt) _Pragma("unroll") for (int s2 = 0; s2 < 2; ++s2) { \
                union { bf16x8 v; unsigned u[4]; } pf; \
                _Pragma("unroll") for (int q = 0; q < 4; ++q) pf.u[q] = pk2(SC[kt][8 * s2 + 2 * q], SC[kt][8 * s2 + 2 * q + 1]); \
                _Pragma("unroll") for (int dvt = 0; dvt < 2; ++dvt) { union { bf16x8 v; v2u h[2]; } vf; \
                    const LAS unsigned char* vp = vb + (32 * dvt + l31) * AT_VS + (32 * kt + 16 * s2 + 4 * h5) * 2; \
                    vf.h[0] = *(const LAS v2u*)(vp); vf.h[1] = *(const LAS v2u*)(vp + 16); \
                    o[dvt] = MFMA32(vf.v, pf.v, o[dvt]); } } \
        } \
        if (j + 2 < ntile) AT_LSTOREK(j & 1); \
        if (j + 1 < ntile) AT_LSTOREV((j + 1) & 1); \
        __syncthreads(); } while (0)
#pragma unroll 1
    for (int jj = 0; jj < ntile; jj += 2) { AT_BODY(sa, sb, jj); AT_BODY(sb, sa, jj + 1); }
#undef AT_BODY
#undef AT_GLOADK
#undef AT_GLOADV
#undef AT_LSTOREK
#undef AT_LSTOREV
#undef AT_QK
    lrow += __shfl_xor(lrow, 32);
    const float inv = __builtin_amdgcn_rcpf(lrow);
    const int b = bh >> 3, h = bh & 7;
    bf16* op = BR + (size_t)(b * S + qw0 + l31) * 1536 + 512 + h * 64;
#pragma unroll
    for (int dvt = 0; dvt < 2; ++dvt)
#pragma unroll
        for (int g = 0; g < 4; ++g) { v2u w; w.x = pk2(o[dvt][4 * g] * inv, o[dvt][4 * g + 1] * inv); w.y = pk2(o[dvt][4 * g + 2] * inv, o[dvt][4 * g + 3] * inv);
            *(GAS v2u*)(op + 32 * dvt + 8 * g + 4 * h5) = w; }
}
#define MFMA16(a, b, c) __builtin_amdgcn_mfma_f32_16x16x32_bf16((a), (b), (c), 0, 0, 0)
constexpr int HG_VS = 144;
constexpr int HG_QS = 272;
__device__ __forceinline__ void hgrn_gate(float z, float lbv, float l1, float l2, float& lf, float& kv) {
    const float e = __expf(-fabsf(z)), ls = fminf(z, 0.f) - __logf(1.f + e);
    const float rc = __builtin_amdgcn_rcpf(1.f + e), sg = (z >= 0.f) ? rc : e * rc;
    kv = (1.f - lbv) * (1.f - sg);
    const float a = l1 + ls;
    if (lbv > 0.f) { const float mx = fmaxf(a, l2), dd = -fabsf(a - l2); lf = mx + __logf(1.f + __expf(dd)); } else lf = a;
}
struct HgA { unsigned zz[8]; unsigned vp[8]; };
__device__ __forceinline__ void hgrn_a_load(const bf16* __restrict__ P, int unit, int tid, HgA& r) {
    asm volatile("" : "+v"(tid));
    const int bh = unit >> 5, c = unit & 31, b = bh >> 2, h = bh & 3, tok0 = b * S + c * 64, d = tid & 127, seg = tid >> 7;
    const bf16* pz = P + (size_t)(tok0 + seg * 16) * INP + C_HF + h * 128 + d;
    const bf16* pv = P + (size_t)(tok0 + seg * 16) * INP + C_HI + h * 128 + d;
#pragma unroll
    for (int t = 0; t < 8; ++t) { r.zz[t] = (unsigned)pz[(size_t)(2 * t) * INP] | ((unsigned)pz[(size_t)(2 * t + 1) * INP] << 16); r.vp[t] = (unsigned)pv[(size_t)(2 * t) * INP] | ((unsigned)pv[(size_t)(2 * t + 1) * INP] << 16); }
}
__device__ __forceinline__ void hgrn_a_compute(const HgA& r, const float* __restrict__ lb, float* __restrict__ SLOC, float* __restrict__ DEC, LAS unsigned char* lds, int unit, int tid, int lane, int wave) {
    asm volatile("" : "+v"(tid), "+v"(lane));
    const int bh = unit >> 5, h = bh & 3;
    LAS float* tot = (LAS float*)lds;
    LAS unsigned char* vT = lds + 2048;
    LAS unsigned char* kT = vT + 128 * HG_VS;
    const int d = tid & 127, seg = tid >> 7;
    const float lbv = lb[h * 128 + d], l1 = __logf(1.f - lbv), l2 = (lbv > 0.f) ? __logf(lbv) : -INFINITY;
    float cs[16], kv[16]; float run = 0.f;
#pragma unroll
    for (int t = 0; t < 16; ++t) { float lf; hgrn_gate((t & 1) ? bfhi(r.zz[t >> 1]) : bflo(r.zz[t >> 1]), lbv, l1, l2, lf, kv[t]); run += lf; cs[t] = run; }
    tot[seg * 128 + d] = run;
#pragma unroll
    for (int t = 0; t < 8; ++t) *(LAS unsigned*)(vT + d * HG_VS + (seg * 16 + 2 * t) * 2) = r.vp[t];
    __syncthreads();
    float off = 0.f, bl = 0.f;
#pragma unroll
    for (int s = 0; s < 4; ++s) { const float tv = tot[s * 128 + d]; bl += tv; if (s < seg) off += tv; }
#pragma unroll
    for (int t = 0; t < 8; ++t) { const float k0 = kv[2 * t] * __expf(bl - (cs[2 * t] + off)), k1 = kv[2 * t + 1] * __expf(bl - (cs[2 * t + 1] + off));
        *(LAS unsigned*)(kT + d * HG_VS + (seg * 16 + 2 * t) * 2) = pk2(k0, k1); }
    if (seg == 0) DEC[(size_t)unit * 128 + d] = __expf(bl);
    __syncthreads();
    const int l31 = lane & 31, h5 = lane >> 5, mt = wave >> 1;
    f32x16 acc[2];
#pragma unroll
    for (int r2 = 0; r2 < 16; ++r2) { acc[0][r2] = 0.f; acc[1][r2] = 0.f; }
#pragma unroll
    for (int ks = 0; ks < 4; ++ks) {
        const bf16x8 a = *(const LAS bf16x8*)(vT + (32 * mt + l31) * HG_VS + (16 * ks + 8 * h5) * 2);
#pragma unroll
        for (int q = 0; q < 2; ++q) { const int nt = 2 * (wave & 1) + q; const bf16x8 bb = *(const LAS bf16x8*)(kT + (32 * nt + l31) * HG_VS + (16 * ks + 8 * h5) * 2); acc[q] = MFMA32(a, bb, acc[q]); }
    }
    float* so = SLOC + (size_t)unit * 16384;
#pragma unroll
    for (int q = 0; q < 2; ++q) { const int nt = 2 * (wave & 1) + q;
#pragma unroll
        for (int r2 = 0; r2 < 16; ++r2) { const int v = 32 * mt + (r2 & 3) + 8 * (r2 >> 2) + 4 * h5; so[(size_t)v * 128 + 32 * nt + l31] = acc[q][r2]; } }
    __syncthreads();
}
__device__ __forceinline__ void hgrn_a_all(const bf16* __restrict__ P, const float* __restrict__ lb, float* __restrict__ SLOC, float* __restrict__ DEC, LAS unsigned char* lds, int bx, int G, int tid, int lane, int wave) {
    HgA ra, rb; int u = bx;
    if (u < 1024) hgrn_a_load(P, u, tid, ra);
    while (u < 1024) {
        const int u2 = u + G, u3 = u2 + G;
        if (u2 < 1024) hgrn_a_load(P, u2, tid, rb);
        hgrn_a_compute(ra, lb, SLOC, DEC, lds, u, tid, lane, wave);
        if (u2 >= 1024) break;
        if (u3 < 1024) hgrn_a_load(P, u3, tid, ra);
        hgrn_a_compute(rb, lb, SLOC, DEC, lds, u2, tid, lane, wave);
        u = u3;
    }
}
__device__ __forceinline__ void hgrn_scan_unit(const float* __restrict__ SLOC, const float* __restrict__ DEC, bf16* __restrict__ ST, int unit, int tid) {
    asm volatile("" : "+v"(tid));
    const int bh = unit >> 3, idx = (unit & 7) * 2048 + tid * 4, d = idx & 127;
    f32x4 st = {0.f, 0.f, 0.f, 0.f};
    const float* sp = SLOC + (size_t)bh * 32 * 16384 + idx; const float* dp = DEC + (size_t)bh * 32 * 128 + d; bf16* op = ST + (size_t)bh * 32 * 16384 + idx;
#pragma unroll 1
    for (int cb = 0; cb < 32; cb += 16) {
        f32x4 sl[16], dc[16];
#pragma unroll
        for (int c = 0; c < 16; ++c) { sl[c] = *(const GAS f32x4*)(sp + (size_t)(cb + c) * 16384); dc[c] = *(const GAS f32x4*)(dp + (cb + c) * 128); }
#pragma unroll
        for (int c = 0; c < 16; ++c) {
            v2u o; o.x = pk2(st[0], st[1]); o.y = pk2(st[2], st[3]);
            *(GAS v2u*)(op + (size_t)(cb + c) * 16384) = o;
            st = dc[c] * st + sl[c];
        }
    }
}
__device__ __forceinline__ void hgrn_c_unit(const bf16* __restrict__ P, const float* __restrict__ lb, const bf16* __restrict__ ST, const float* __restrict__ og, bf16* __restrict__ BR, LAS unsigned char* lds, int unit, int tid, int lane, int wave) {
    asm volatile("" : "+v"(tid), "+v"(lane));
    const int bh = unit >> 5, c = unit & 31, b = bh >> 2, h = bh & 3, tok0 = b * S + c * 64;
    LAS float* bcum = (LAS float*)lds;
    LAS unsigned char* q0 = lds + 32768;
    LAS unsigned char* qi = q0 + 64 * HG_QS;
    LAS unsigned char* kr = qi + 64 * HG_QS;
    LAS unsigned char* vT = kr + 64 * HG_QS;
    LAS unsigned char* at = vT + 128 * HG_VS;
    LAS float* tot = (LAS float*)(at + 64 * HG_VS);
    LAS float* ob = (LAS float*)lds;
    const int d = tid & 127, seg = tid >> 7;
    const int l31 = lane & 31, h5 = lane >> 5, mtw = wave >> 2, ntw = wave & 3;
    unsigned zq[16], vp[8]; v4u gq0, gq1; bf16x8 stf[8];
    {
        const bf16* pz = P + (size_t)(tok0 + seg * 16) * INP + C_HF + h * 128 + d;
        const bf16* pq = P + (size_t)(tok0 + seg * 16) * INP + C_HQ + h * 128 + d;
        const bf16* pv = P + (size_t)(tok0 + seg * 16) * INP + C_HI + h * 128 + d;
#pragma unroll
        for (int t = 0; t < 16; ++t) zq[t] = (unsigned)pz[(size_t)t * INP] | ((unsigned)pq[(size_t)t * INP] << 16);
#pragma unroll
        for (int t = 0; t < 8; ++t) vp[t] = (unsigned)pv[(size_t)(2 * t) * INP] | ((unsigned)pv[(size_t)(2 * t + 1) * INP] << 16);
        const bf16* pg = P + (size_t)(tok0 + (tid >> 3)) * INP + C_HG + h * 128 + (tid & 7) * 16;
        gq0 = *(const GAS v4u*)pg; gq1 = *(const GAS v4u*)(pg + 8);
        if (c > 0) { const bf16* sp = ST + (size_t)unit * 16384 + (size_t)(32 * ntw + l31) * 128 + 8 * h5;
#pragma unroll
            for (int ks = 0; ks < 8; ++ks) stf[ks] = *(const GAS bf16x8*)(sp + 16 * ks); }
        else {
#pragma unroll
            for (int ks = 0; ks < 8; ++ks) stf[ks] = (bf16x8){0, 0, 0, 0, 0, 0, 0, 0}; }
    }
    {
        const float lbv = lb[h * 128 + d], l1 = __logf(1.f - lbv), l2 = (lbv > 0.f) ? __logf(lbv) : -INFINITY;
        float cs[16], kv[16]; float run = 0.f;
#pragma unroll
        for (int t = 0; t < 16; ++t) { float lf; hgrn_gate(bflo(zq[t]), lbv, l1, l2, lf, kv[t]); run += lf; cs[t] = run; }
        tot[seg * 128 + d] = run;
#pragma unroll
        for (int t = 0; t < 8; ++t) *(LAS unsigned*)(vT + d * HG_VS + (seg * 16 + 2 * t) * 2) = vp[t];
        for (int i = tid; i < 64 * HG_VS / 4; i += 512) ((LAS unsigned*)at)[i] = 0u;
        __syncthreads();
        float off = 0.f;
#pragma unroll
        for (int s = 0; s < 4; ++s) { const float tv = tot[s * 128 + d]; if (s < seg) off += tv; }
#pragma unroll
        for (int t = 0; t < 16; ++t) { const int tt = seg * 16 + t; const float qv = bfhi(zq[t]);
            bcum[tt * 128 + d] = cs[t] + off;
            *(LAS bf16*)(q0 + tt * HG_QS + d * 2) = f2bf_hw(qv * __expf(cs[t] + off));
            *(LAS bf16*)(qi + tt * HG_QS + d * 2) = f2bf_hw(qv * __expf(cs[t]));
            *(LAS bf16*)(kr + tt * HG_QS + d * 2) = f2bf_hw(kv[t]); }
    }
    __syncthreads();
    {
        const int l15 = lane & 15, g4 = lane >> 4;
#pragma unroll 1
        for (int blk = wave; blk < 10; blk += 8) {
            const int i = (blk >= 6) ? 3 : (blk >= 3) ? 2 : (blk >= 1) ? 1 : 0, j = blk - ((i * (i + 1)) >> 1);
            f32x4 acc = {0.f, 0.f, 0.f, 0.f};
#pragma unroll
            for (int ks = 0; ks < 4; ++ks) {
                const int dd = 32 * ks + 8 * g4;
                const bf16x8 a = *(const LAS bf16x8*)(qi + (16 * i + l15) * HG_QS + dd * 2);
                const v4u kw = *(const LAS v4u*)(kr + (16 * j + l15) * HG_QS + dd * 2);
                const f32x4 b0 = *(const LAS f32x4*)(bcum + (16 * j + l15) * 128 + dd), b1 = *(const LAS f32x4*)(bcum + (16 * j + l15) * 128 + dd + 4);
                f32x4 r0 = {0.f, 0.f, 0.f, 0.f}, r1 = {0.f, 0.f, 0.f, 0.f};
                if (i > 0) { r0 = *(const LAS f32x4*)(bcum + (16 * i - 1) * 128 + dd); r1 = *(const LAS f32x4*)(bcum + (16 * i - 1) * 128 + dd + 4); }
                union { bf16x8 v; unsigned u[4]; } kf;
                kf.u[0] = pk2(bflo(kw.x) * __expf(r0[0] - b0[0]), bfhi(kw.x) * __expf(r0[1] - b0[1])); kf.u[1] = pk2(bflo(kw.y) * __expf(r0[2] - b0[2]), bfhi(kw.y) * __expf(r0[3] - b0[3]));
                kf.u[2] = pk2(bflo(kw.z) * __expf(r1[0] - b1[0]), bfhi(kw.z) * __expf(r1[1] - b1[1])); kf.u[3] = pk2(bflo(kw.w) * __expf(r1[2] - b1[2]), bfhi(kw.w) * __expf(r1[3] - b1[3]));
                acc = MFMA16(a, kf.v, acc);
            }
#pragma unroll
            for (int r = 0; r < 4; ++r) { const int tl = 4 * g4 + r; float v = acc[r]; if (i == j && l15 > tl) v = 0.f; *(LAS bf16*)(at + (16 * i + tl) * HG_VS + (16 * j + l15) * 2) = f2bf_hw(v); }
        }
    }
    __syncthreads();
    {
        const int mt = mtw, nt = ntw;
        f32x16 acc;
#pragma unroll
        for (int r = 0; r < 16; ++r) acc[r] = 0.f;
#pragma unroll
        for (int ks = 0; ks < 4; ++ks) { const bf16x8 a = *(const LAS bf16x8*)(at + (32 * mt + l31) * HG_VS + (16 * ks + 8 * h5) * 2), bb = *(const LAS bf16x8*)(vT + (32 * nt + l31) * HG_VS + (16 * ks + 8 * h5) * 2); acc = MFMA32(a, bb, acc); }
        if (c > 0) {
#pragma unroll
            for (int ks = 0; ks < 8; ++ks) { const bf16x8 a = *(const LAS bf16x8*)(q0 + (32 * mt + l31) * HG_QS + (16 * ks + 8 * h5) * 2); acc = MFMA32(a, stf[ks], acc); } }
        __syncthreads();
#pragma unroll
        for (int r = 0; r < 16; ++r) { const int t = 32 * mt + (r & 3) + 8 * (r >> 2) + 4 * h5; ob[t * 132 + 32 * nt + l31] = acc[r]; }
    }
    __syncthreads();
    {
        const int t = tid >> 3, v0 = (tid & 7) * 16;
        f32x4 o4[4]; float ss = 0.f;
#pragma unroll
        for (int q = 0; q < 4; ++q) { o4[q] = *(const LAS f32x4*)(ob + t * 132 + v0 + 4 * q); ss += (o4[q][0] * o4[q][0] + o4[q][1] * o4[q][1]) + (o4[q][2] * o4[q][2] + o4[q][3] * o4[q][3]); }
        ss += __shfl_xor(ss, 1); ss += __shfl_xor(ss, 2); ss += __shfl_xor(ss, 4);
        const float rstd = rsqrtf(ss * (1.f / 128.f) + EPS);
        const v4u g0 = gq0, g1 = gq1;
        float gv[16]; gv[0] = bflo(g0.x); gv[1] = bfhi(g0.x); gv[2] = bflo(g0.y); gv[3] = bfhi(g0.y); gv[4] = bflo(g0.z); gv[5] = bfhi(g0.z); gv[6] = bflo(g0.w); gv[7] = bfhi(g0.w);
        gv[8] = bflo(g1.x); gv[9] = bfhi(g1.x); gv[10] = bflo(g1.y); gv[11] = bfhi(g1.y); gv[12] = bflo(g1.z); gv[13] = bfhi(g1.z); gv[14] = bflo(g1.w); gv[15] = bfhi(g1.w);
        float ov[16];
#pragma unroll
        for (int q = 0; q < 4; ++q) { const f32x4 gn = *(const GAS f32x4*)(og + v0 + 4 * q);
#pragma unroll
            for (int jj = 0; jj < 4; ++jj) { const float gg = gv[4 * q + jj]; ov[4 * q + jj] = o4[q][jj] * rstd * gn[jj] * gg * __builtin_amdgcn_rcpf(1.f + __expf(-gg)); } }
        v4u w0, w1; w0.x = pk2(ov[0], ov[1]); w0.y = pk2(ov[2], ov[3]); w0.z = pk2(ov[4], ov[5]); w0.w = pk2(ov[6], ov[7]); w1.x = pk2(ov[8], ov[9]); w1.y = pk2(ov[10], ov[11]); w1.z = pk2(ov[12], ov[13]); w1.w = pk2(ov[14], ov[15]);
        bf16* po = BR + (size_t)(tok0 + t) * 1536 + h * 128 + v0;
        *(GAS v4u*)po = w0; *(GAS v4u*)(po + 8) = w1;
    }
    __syncthreads();
}
constexpr int NWAVES = 8, NTHR = 512;
constexpr int RING_OFF = 0, RING_BYTES = 131072, LDSCTL_OFF = RING_BYTES, LDS_BYTES = 147456;
constexpr int LW_BAR = 0, LW_TP = 16, LW_CNT = 64, LW_LCNT = 96, LW_BASE = 128, LW_ENTE = 256, LW_ENTW = 512, LW_RANK = 768, LW_BIAS = 1024;
constexpr int CW_Q = 1024, CW_PD = 1088;
constexpr int LW_CONV = 8;
constexpr int CW_BAR = 4096;
constexpr int NPH_L = 10, PH_FINAL = 1 + L * NPH_L, NPH = PH_FINAL + 1;

struct MkArgs { const void* in[28]; float* out; unsigned char* ws; float invf[16]; int ph_lo, ph_hi, li, pad; };
typedef const MkArgs __attribute__((address_space(4))) CMkArgs;
#define KA_PTR(name) CMkArgs* name = (CMkArgs*)__builtin_amdgcn_kernarg_segment_ptr(); asm volatile("" : "+s"(name))

using pg8::Unit; using pg8::u32x4; using pg8::cvt_pk_bf16;
constexpr int GATE_TILE0 = 13;
__device__ __forceinline__ size_t gt_off(int g, int pm, int pn4, int chunk, int tid) { return ((((size_t)(g * 64 + pm) * 4 + pn4) * 16 + chunk) * 512 + tid) * 8; }
struct EpiP {
    static constexpr bool PERM = true; bf16* O; int ldc; bf16* GT;
    __device__ __forceinline__ void prefetch(const Unit&, int, int) const {}
    __device__ __forceinline__ void operator()(const f32x4 (&acc)[2][2][4][2], const Unit& u, int wr, int wc, int fr, int fq) const {
        const int row0 = u.pm * 256 + wr * 64 + fr, col0 = u.pn * 256 + wc * 32 + 8 * fq;
        const bool gate = (GT != nullptr) && u.pn >= GATE_TILE0; const int gi = (u.pn - GATE_TILE0) >> 2, pn4 = (u.pn - GATE_TILE0) & 3, tid = (wr * 4 + wc) * 64 + fq * 16 + fr;
#pragma unroll
        for (int ai = 0; ai < 2; ++ai)
#pragma unroll
            for (int m = 0; m < 4; ++m) { bf16* rowp = O + (size_t)(row0 + ai * 128 + m * 16) * ldc + col0;
#pragma unroll
                for (int bj = 0; bj < 2; ++bj) { f32x4 v0 = acc[ai][bj][m][0], v1 = acc[ai][bj][m][1];
                    u32x4 w; w.x = cvt_pk_bf16(v0[0], v0[1]); w.y = cvt_pk_bf16(v0[2], v0[3]); w.z = cvt_pk_bf16(v1[0], v1[1]); w.w = cvt_pk_bf16(v1[2], v1[3]);
                    if (gate) *(u32x4*)(GT + gt_off(gi, u.pm, pn4, (ai * 4 + m) * 2 + bj, tid)) = w; else *(u32x4*)(rowp + bj * 128) = w; } }
    }
};
struct EpiBranch {
    static constexpr bool PERM = true; const bf16* GT; bf16* MB;
    __device__ __forceinline__ void prefetch(const Unit&, int, int) const {}
    __device__ __forceinline__ static void unpack8(const u32x4 w, float (&g)[8]) { g[0] = __uint_as_float(w.x << 16); g[1] = __uint_as_float(w.x & 0xffff0000u); g[2] = __uint_as_float(w.y << 16); g[3] = __uint_as_float(w.y & 0xffff0000u);
        g[4] = __uint_as_float(w.z << 16); g[5] = __uint_as_float(w.z & 0xffff0000u); g[6] = __uint_as_float(w.w << 16); g[7] = __uint_as_float(w.w & 0xffff0000u); }
    __device__ __forceinline__ static float em(float x) { return __expf(-fminf(fmaxf(x, -30.f), 30.f)); }
    __device__ __forceinline__ void mid(f32x4 (&acc)[2][2][4][2], const Unit& u, int wr, int wc, int fr, int fq, int t) const {
        asm volatile("" : "+v"(fr), "+v"(fq));
        const int gnum = (t == 8) ? 0 : 1, tid = (wr * 4 + wc) * 64 + fq * 16 + fr;
        const bf16* gn0 = GT + gt_off(gnum, u.pm, u.pn, 0, tid); const bf16* gd0 = GT + gt_off(gnum + 1, u.pm, u.pn, 0, tid);
#pragma unroll
        for (int ai = 0; ai < 2; ++ai)
#pragma unroll
            for (int m = 0; m < 4; ++m)
#pragma unroll
                for (int bj = 0; bj < 2; ++bj) { const int ch = (ai * 4 + m) * 2 + bj; float gn[8], gd[8]; unpack8(*(const u32x4*)(gn0 + (size_t)ch * 4096), gn); unpack8(*(const u32x4*)(gd0 + (size_t)ch * 4096), gd);
#pragma unroll
                    for (int j = 0; j < 4; ++j) { acc[ai][bj][m][0][j] *= (1.f + em(gd[j])) * __builtin_amdgcn_rcpf(1.f + em(gn[j])); acc[ai][bj][m][1][j] *= (1.f + em(gd[4 + j])) * __builtin_amdgcn_rcpf(1.f + em(gn[4 + j])); } }
    }
    __device__ __forceinline__ void operator()(const f32x4 (&acc)[2][2][4][2], const Unit& u, int wr, int wc, int fr, int fq) const {
        const int row0 = u.pm * 256 + wr * 64 + fr, col0 = u.pn * 256 + wc * 32 + 8 * fq, tid = (wr * 4 + wc) * 64 + fq * 16 + fr;
        const bf16* gc0 = GT + gt_off(2, u.pm, u.pn, 0, tid);
#pragma unroll
        for (int ai = 0; ai < 2; ++ai)
#pragma unroll
            for (int m = 0; m < 4; ++m) { const size_t row = (size_t)(row0 + ai * 128 + m * 16);
#pragma unroll
                for (int bj = 0; bj < 2; ++bj) { const int col = col0 + bj * 128; float gc[8]; unpack8(*(const u32x4*)(gc0 + (size_t)((ai * 4 + m) * 2 + bj) * 4096), gc);
                    f32x4 v0 = acc[ai][bj][m][0], v1 = acc[ai][bj][m][1];
#pragma unroll
                    for (int j = 0; j < 4; ++j) { v0[j] *= __builtin_amdgcn_rcpf(1.f + em(gc[j])); v1[j] *= __builtin_amdgcn_rcpf(1.f + em(gc[4 + j])); }
                    u32x4 w; w.x = cvt_pk_bf16(v0[0], v0[1]); w.y = cvt_pk_bf16(v0[2], v0[3]); w.z = cvt_pk_bf16(v1[0], v1[1]); w.w = cvt_pk_bf16(v1[2], v1[3]); *(u32x4*)(MB + row * 1024 + col) = w; } }
    }
};
struct EpiOut {
    static constexpr bool PERM = false; const float* xin; const float* gvec; float* out;
    __device__ __forceinline__ void prefetch(const Unit&, int, int) const {}
    __device__ __forceinline__ void operator()(const f32x4 (&acc)[2][2][4][2], const Unit& u, int wr, int wc, int fr, int fq) const {
        const int row0 = u.pm * 256 + wr * 64 + fr, col0 = u.pn * 256 + wc * 32 + 4 * fq;
#pragma unroll
        for (int ai = 0; ai < 2; ++ai)
#pragma unroll
            for (int m = 0; m < 4; ++m) { const size_t row = (size_t)(row0 + ai * 128 + m * 16); const int b = (int)(row / S);
#pragma unroll
                for (int bj = 0; bj < 2; ++bj)
#pragma unroll
                    for (int n = 0; n < 2; ++n) { const int col = col0 + bj * 128 + 16 * n;
                        const f32x4 xv = *(const f32x4*)(xin + row * 1024 + col), gv = *(const f32x4*)(gvec + b * 6144 + col);
                        *(f32x4*)(out + row * 1024 + col) = xv + gv * acc[ai][bj][m][n]; } }
    }
};
struct EpiMoe1 {
    static constexpr bool PERM = true; const float* b1; bf16* ACT; LAS float* bl;
    typedef float f2 __attribute__((ext_vector_type(2)));
    __device__ __forceinline__ void prefetch(const Unit& u, int wid, int lane) const {
        if (wid < 4) { const float* src = b1 + u.e * 2048 + (wid >> 1) * 1024 + u.aux * 128 + (wid & 1) * 64 + lane;
            __builtin_amdgcn_global_load_lds((const unsigned*)src, (LAS unsigned*)(bl + wid * 64), 4, 0, 0); } }
    __device__ __forceinline__ static f2 act2(f2 g, f2 l) {
        const f2 c7 = {7.f, 7.f}, cm7 = {-7.f, -7.f}, one = {1.f, 1.f}, ck = {-1.702f * 1.4426950408889634f, -1.702f * 1.4426950408889634f};
        g = __builtin_elementwise_min(g, c7); l = __builtin_elementwise_min(__builtin_elementwise_max(l, cm7), c7);
        const f2 x = g * ck; f2 ex; ex.x = __builtin_amdgcn_exp2f(x.x); ex.y = __builtin_amdgcn_exp2f(x.y);
        const f2 d = ex + one; f2 r; r.x = __builtin_amdgcn_rcpf(d.x); r.y = __builtin_amdgcn_rcpf(d.y);
        return (g * r) * (l + one);
    }
    __device__ __forceinline__ void operator()(const f32x4 (&acc)[2][2][4][2], const Unit& u, int wr, int wc, int fr, int fq) const {
        const int row0 = u.pm * 256 + wr * 64 + fr, lc = wc * 32 + 8 * fq, ccol = u.aux * 128 + lc;
        const f32x4 bg0 = *(const LAS f32x4*)(bl + lc), bg1 = *(const LAS f32x4*)(bl + lc + 4), bl0 = *(const LAS f32x4*)(bl + 128 + lc), bl1 = *(const LAS f32x4*)(bl + 128 + lc + 4);
#pragma unroll
        for (int ai = 0; ai < 2; ++ai)
#pragma unroll
            for (int m = 0; m < 4; ++m) { const size_t row = (size_t)(row0 + ai * 128 + m * 16);
                const f32x4 g0 = acc[ai][0][m][0] + bg0, g1 = acc[ai][0][m][1] + bg1, l0 = acc[ai][1][m][0] + bl0, l1 = acc[ai][1][m][1] + bl1;
                const f2 o0 = act2((f2){g0[0], g0[1]}, (f2){l0[0], l0[1]}), o1 = act2((f2){g0[2], g0[3]}, (f2){l0[2], l0[3]}), o2 = act2((f2){g1[0], g1[1]}, (f2){l1[0], l1[1]}), o3 = act2((f2){g1[2], g1[3]}, (f2){l1[2], l1[3]});
                u32x4 w; w.x = cvt_pk_bf16(o0.x, o0.y); w.y = cvt_pk_bf16(o1.x, o1.y); w.z = cvt_pk_bf16(o2.x, o2.y); w.w = cvt_pk_bf16(o3.x, o3.y);
                *(u32x4*)(ACT + row * 1024 + ccol) = w; }
    }
};
struct EpiMoe2 {
    static constexpr bool PERM = true; const float* b2; bf16* EO; LAS float* bl;
    __device__ __forceinline__ void prefetch(const Unit& u, int wid, int lane) const {
        if (wid < 4) __builtin_amdgcn_global_load_lds((const unsigned*)(b2 + u.e * 1024 + u.aux * 256 + wid * 64 + lane), (LAS unsigned*)(bl + wid * 64), 4, 0, 0); }
    __device__ __forceinline__ void operator()(const f32x4 (&acc)[2][2][4][2], const Unit& u, int wr, int wc, int fr, int fq) const {
        const int row0 = u.pm * 256 + wr * 64 + fr, lc = wc * 32 + 8 * fq, col0 = u.aux * 256 + lc;
        f32x4 bv[2][2];
#pragma unroll
        for (int bj = 0; bj < 2; ++bj) { bv[bj][0] = *(const LAS f32x4*)(bl + lc + bj * 128); bv[bj][1] = *(const LAS f32x4*)(bl + lc + bj * 128 + 4); }
#pragma unroll
        for (int ai = 0; ai < 2; ++ai)
#pragma unroll
            for (int m = 0; m < 4; ++m) { bf16* rowp = EO + (size_t)(row0 + ai * 128 + m * 16) * 1024 + col0;
#pragma unroll
                for (int bj = 0; bj < 2; ++bj) { const f32x4 v0 = acc[ai][bj][m][0] + bv[bj][0], v1 = acc[ai][bj][m][1] + bv[bj][1];
                    u32x4 w; w.x = cvt_pk_bf16(v0[0], v0[1]); w.y = cvt_pk_bf16(v0[2], v0[3]); w.z = cvt_pk_bf16(v1[0], v1[1]); w.w = cvt_pk_bf16(v1[2], v1[3]);
                    *(u32x4*)(rowp + bj * 128) = w; } }
    }
};
struct MoeOrder {
    const LAS int* tp; const LAS int* cn; int NTn, G, c, rev;
    __device__ __forceinline__ bool next(int i, Unit& u) const {
        const int total = tp[32] * NTn; int Lx;
        if ((G & 7) == 0) { const int x = c & 7, j = c >> 3, lo = (int)(((long)total * x) >> 3), hi = (int)(((long)total * (x + 1)) >> 3); Lx = lo + i * (G >> 3) + j; if (Lx >= hi) return false;
            if (rev) Lx = hi - 1 - (Lx - lo); }
        else { Lx = i * G + c; if (Lx >= total) return false; }
        int e = 0;
        for (int q = 1; q < 32; ++q) if (Lx >= tp[q] * NTn) e = q;
        const int t0 = tp[e], r = Lx - t0 * NTn, mt = r / NTn, nt = r - mt * NTn;
        u.pm = __builtin_amdgcn_readfirstlane(t0 + mt); u.pn = __builtin_amdgcn_readfirstlane(e * NTn + nt); u.ka = 0; u.aux = __builtin_amdgcn_readfirstlane(nt); u.e = __builtin_amdgcn_readfirstlane(e);
        u.gbase = __builtin_amdgcn_readfirstlane(e * CAP + mt * 256); u.gcnt = __builtin_amdgcn_readfirstlane(cn[e] - mt * 256); u.pad = 0;
        return true;
    }
};
struct TrItem { const float* W; bf16* WT; int K, N, mode, row_off, ldk, koff, k0, n0; };
__device__ __forceinline__ void tr_load(const TrItem& t, float (&wv)[32], int lane) {
#pragma unroll
    for (int i = 0; i < 32; ++i) wv[i] = __builtin_nontemporal_load(t.W + (size_t)(t.k0 + 2 * i + (lane >> 5)) * t.N + t.n0 + (lane & 31));
}
__device__ __forceinline__ void tr_store(const TrItem& t, const float (&wv)[32], LAS float* scr, int lane) {
#pragma unroll
    for (int i = 0; i < 32; ++i) scr[(2 * i + (lane >> 5)) * 33 + (lane & 31)] = wv[i];
    LDS_WAIT(); asm volatile("" ::: "memory");
    const int c = lane & 7;
#pragma unroll
    for (int j = 0; j < 4; ++j) { const int n = (lane >> 3) + 8 * j; const LAS float* s = scr + (8 * c) * 33 + n;
        v4u o; o.x = pk2(s[0 * 33], s[1 * 33]); o.y = pk2(s[2 * 33], s[3 * 33]); o.z = pk2(s[4 * 33], s[5 * 33]); o.w = pk2(s[6 * 33], s[7 * 33]);
        const int nn = t.n0 + n; int r = nn; if (t.mode == 1) { const int half = nn >> 10, cc = nn & 1023; r = (cc >> 7) * 256 + half * 128 + (cc & 127); }
        if (t.mode == 2) r = (nn < 3232) ? nn : nn + 96;
        __builtin_nontemporal_store(o, (GAS v4u*)(t.WT + (size_t)(t.row_off + r) * t.ldk + t.koff + t.k0 + 8 * c)); }
    LDS_WAIT(); asm volatile("" ::: "memory");
}
constexpr int TI_IN = 16 * 197, TI_UQ = 6 * 24, TI_UKV = 4 * 32, TI_BR = 8 * 32, TI_OUT = 16 * 32, TI_E1 = 16 * 64, TI_E2 = 16 * 32;
constexpr int TA0 = TI_IN, TA1 = TA0 + TI_UQ, TA2 = TA1 + TI_UKV, TA3 = TA2 + TI_BR, TA4 = TA3 + TI_BR, TA5 = TA4 + TI_OUT, TA6 = TA5 + NE * TI_E1, TA7 = TA6 + NE * TI_E2, TR_NTOT = L * TA7, CONV_B = 16;
static_assert(L == 2 && TR_NTOT % CONV_B == 0 && TA5 % CONV_B == 0 && TA6 % CONV_B == 0 && TA7 % CONV_B == 0, "conversion queue layout");
__device__ __forceinline__ void tr_setup(CMkArgs* ap, int it, TrItem& t) {
    unsigned char* ws = ap->ws;
    const int l = it >= TA7 ? 1 : 0; int r = it - l * TA7, q;
    if (r < TA0) { q = r; t = TrItem{(const float*)ap->in[7] + (size_t)l * 1024 * INW, (bf16*)(ws + WS_WINT) + (size_t)l * INP * 1024, 1024, INW, 2, 0, 1024, 0, 0, 0}; }
    else if (r < TA1) { q = r - TA0; t = TrItem{(const float*)ap->in[12] + (size_t)l * 384 * 768, (bf16*)(ws + WS_WUQT) + (size_t)l * 768 * 384, 384, 768, 0, 0, 384, 0, 0, 0}; }
    else if (r < TA2) { q = r - TA1; t = TrItem{(const float*)ap->in[13] + (size_t)l * 256 * 1024, (bf16*)(ws + WS_WUKVT) + (size_t)l * 1024 * 256, 256, 1024, 0, 0, 256, 0, 0, 0}; }
    else if (r < TA3) { q = r - TA2; t = TrItem{(const float*)ap->in[18] + (size_t)l * 512 * 1024, (bf16*)(ws + WS_WBRT) + (size_t)l * 1024 * 1536, 512, 1024, 0, 0, 1536, 0, 0, 0}; }
    else if (r < TA4) { q = r - TA3; t = TrItem{(const float*)ap->in[19] + (size_t)l * 512 * 1024, (bf16*)(ws + WS_WBRT) + (size_t)l * 1024 * 1536, 512, 1024, 0, 0, 1536, 512, 0, 0}; }
    else if (r < TA5) { q = r - TA4; t = TrItem{(const float*)ap->in[21] + (size_t)l * 1024 * 1024, (bf16*)(ws + WS_WOUTT) + (size_t)l * 1024 * 1024, 1024, 1024, 0, 0, 1024, 0, 0, 0}; }
    else if (r < TA6) { r -= TA5; const int e = r / TI_E1; q = r - e * TI_E1; const int b = l * NE + e; t = TrItem{(const float*)ap->in[24] + (size_t)b * 1024 * 2048, (bf16*)(ws + WS_W1T) + (size_t)b * 2048 * 1024, 1024, 2048, 1, 0, 1024, 0, 0, 0}; }
    else { r -= TA6; const int e = r / TI_E2; q = r - e * TI_E2; const int b = l * NE + e; t = TrItem{(const float*)ap->in[26] + (size_t)b * 1024 * 1024, (bf16*)(ws + WS_W2T) + (size_t)b * 1024 * 1024, 1024, 1024, 0, 0, 1024, 0, 0, 0}; }
    const int nblk = t.N / 32, kb = q / nblk; t.k0 = 64 * kb; t.n0 = 32 * (q - kb * nblk);
}
__device__ __forceinline__ void conv_service(CMkArgs* ap, LAS unsigned char* lds, int tid, int lane, int wave, unsigned need, const unsigned* stop, unsigned stop_val) {
    asm volatile("" : "+v"(tid), "+v"(lane));
    unsigned* qh = (unsigned*)(ap->ws + WS_CTL) + CW_Q;
    LAS unsigned* slot = (LAS unsigned*)(lds + LDSCTL_OFF) + LW_CONV;
    LAS float* scr = (LAS float*)(lds + wave * 8448);
    const bool pre = (stop == nullptr);
    unsigned nxt = 0xFFFFFFFFu;
#define CONV_CLAIM() do { nxt = 0xFFFFFFFFu; \
        const bool go_ = stop != nullptr && __hip_atomic_load(stop, __ATOMIC_RELAXED, __HIP_MEMORY_SCOPE_AGENT) < stop_val; \
        if (go_ || __hip_atomic_load(qh, __ATOMIC_RELAXED, __HIP_MEMORY_SCOPE_AGENT) < need) { const unsigned i_ = __hip_atomic_fetch_add(qh, (unsigned)CONV_B, __ATOMIC_RELAXED, __HIP_MEMORY_SCOPE_AGENT); if (i_ < (unsigned)TR_NTOT) nxt = i_; } } while (0)
    if (tid == 0) CONV_CLAIM();
    for (int n = 0;; ++n) {
        if (tid == 0) slot[n & 1] = nxt;
        __syncthreads();
        const unsigned idx = __builtin_amdgcn_readfirstlane(slot[n & 1]);
        if (idx == 0xFFFFFFFFu) break;
        if (pre && tid == 0) CONV_CLAIM();
        { TrItem ta, tb; float va[32], vb[32];
          tr_setup(ap, (int)idx + wave, ta); tr_load(ta, va, lane);
          tr_setup(ap, (int)idx + 8 + wave, tb); tr_load(tb, vb, lane);
          tr_store(ta, va, scr, lane); tr_store(tb, vb, scr, lane); }
        if (!pre && tid == 0) CONV_CLAIM();
    }
#undef CONV_CLAIM
}
__device__ __forceinline__ void phase_prologue(CMkArgs* ap, LAS unsigned char* lds, int tid, int lane, int wave, int G, int bx) {
    asm volatile("" : "+v"(tid), "+v"(lane));
    unsigned char* ws = ap->ws;
    const float* c = (const float*)ap->in[1]; const int* pos = (const int*)ap->in[2]; const float* ada_w = (const float*)ap->in[3]; const float* ada_b = (const float*)ap->in[4];
    const float* w_in = (const float*)ap->in[7]; const float* hgrn_lb = (const float*)ap->in[8]; const float* w_uq = (const float*)ap->in[12]; const float* w_ukv = (const float*)ap->in[13];
    const float* w_pool = (const float*)ap->in[16]; const float* pool_scale = (const float*)ap->in[17]; const float* w_br_a = (const float*)ap->in[18]; const float* w_br_b = (const float*)ap->in[19]; const float* w_br_c = (const float*)ap->in[20];
    const float* w_out = (const float*)ap->in[21]; const float* w_exp1 = (const float*)ap->in[24]; const float* w_exp2 = (const float*)ap->in[26];
    float* mod = (float*)(ws + WS_MOD); float* lb = (float*)(ws + WS_LB); float* rope = (float*)(ws + WS_ROPE);
    bf16 *WinT = (bf16*)(ws + WS_WINT), *WuqT = (bf16*)(ws + WS_WUQT), *WukvT = (bf16*)(ws + WS_WUKVT), *WbrT = (bf16*)(ws + WS_WBRT), *WoutT = (bf16*)(ws + WS_WOUTT), *W1T = (bf16*)(ws + WS_W1T), *W2T = (bf16*)(ws + WS_W2T);
    if (bx < 192) {
        LAS float* cs = (LAS float*)(lds + 67584);
        LAS float* part = (LAS float*)(lds + 100352);
        for (int i = tid; i < 8192; i += NTHR) { const float v = c[i]; cs[i] = v / (1.f + __expf(-v)); }
        __syncthreads();
        for (int u = bx; u < 192; u += G) {
            const int l = u / 96, j = (u - l * 96) * 64 + lane;
            const float* w = ada_w + (size_t)l * 1024 * 6144 + (size_t)(wave * 128) * 6144 + j;
            float acc[8];
#pragma unroll
            for (int b = 0; b < 8; ++b) acc[b] = 0.f;
#pragma unroll 16
            for (int k = 0; k < 128; ++k) { const float wv = w[(size_t)k * 6144];
#pragma unroll
                for (int b = 0; b < 8; ++b) acc[b] += cs[b * 1024 + wave * 128 + k] * wv; }
#pragma unroll
            for (int b = 0; b < 8; ++b) part[(wave * 8 + b) * 64 + lane] = acc[b];
            __syncthreads();
            { const int b = tid >> 6; float s = 0.f;
#pragma unroll
              for (int w8 = 0; w8 < 8; ++w8) s += part[(w8 * 8 + b) * 64 + lane];
              mod[(size_t)l * 8 * 6144 + b * 6144 + j] = s + ada_b[l * 6144 + j]; }
            __syncthreads();
        }
        if (tid == 0) __hip_atomic_fetch_add((unsigned*)(ws + WS_CTL) + CW_PD, 1u, __ATOMIC_RELAXED, __HIP_MEMORY_SCOPE_AGENT);
    }
    const int gw = bx * NWAVES + wave, NGW = G * NWAVES, gt = bx * NTHR + tid, NGT = G * NTHR;
    for (int i = gt; i < 512; i += NGT) { const float p = hgrn_lb[i], q = hgrn_lb[512 + i]; const float m = fmaxf(p, q); const float ea = __expf(p - m), eb = __expf(q - m); lb[i] = 0.f; lb[512 + i] = eb / (ea + eb); }
    for (int i = gt; i < NT * 16; i += NGT) { const int t = i >> 4, j = i & 15; float fv = ap->invf[0];
#pragma unroll
        for (int q = 1; q < 16; ++q) if (j == q) fv = ap->invf[q];
        const double ang = (double)pos[t] * (double)fv; double r = ang * 0.15915494309189535; r -= floor(r + 0.5); const float an = (float)(r * 6.283185307179586);
        rope[i] = __cosf(an); rope[NT * 16 + i] = __sinf(an); }
    for (int i = gt; i < L * 96 * 128; i += NGT) { const int l = i / (96 * 128), r = i - l * 96 * 128; *(GAS v4u*)(WinT + (size_t)l * INP * 1024 + (size_t)3232 * 1024 + (size_t)r * 8) = (v4u){0u, 0u, 0u, 0u}; }
    for (int task = gw; task < L * 1024; task += NGW) {
        const int l = task >> 10, g = (task >> 8) & 3, nb = (task >> 4) & 15, c0 = (task & 15) * 8;
        const float* wb = w_br_c + (size_t)l * 512 * 1024 + (size_t)g * 128 * 1024 + nb * 64 + lane; const float* sc = pool_scale + l * 512 + g * 128;
        const float* wp = w_pool + ((size_t)l * 4 + g) * 128 * 128 + (size_t)c0 * 128;
        float acc[8];
#pragma unroll
        for (int q = 0; q < 8; ++q) acc[q] = 0.f;
#pragma unroll 16
        for (int d = 0; d < 128; ++d) { const float w = wb[(size_t)d * 1024] * sc[d];
#pragma unroll
            for (int q = 0; q < 8; ++q) acc[q] += wp[q * 128 + d] * w; }
        v4u o; o.x = pk2(acc[0], acc[1]); o.y = pk2(acc[2], acc[3]); o.z = pk2(acc[4], acc[5]); o.w = pk2(acc[6], acc[7]);
        *(GAS v4u*)(WbrT + (size_t)l * 1024 * 1536 + (size_t)(nb * 64 + lane) * 1536 + 1024 + g * 128 + c0) = o;
    }
    conv_service(ap, lds, tid, lane, wave, (unsigned)TA5, bx >= 192 ? (const unsigned*)(ws + WS_CTL) + CW_PD : nullptr, (unsigned)(G < 192 ? G : 192));
}

template <int MODE>
__device__ __forceinline__ void phase_rows(const float* xin, float* xout, const float* gain, const float* mod_sh, const float* mod_sc, const float* mod_g2, bf16* HN,
                                           const bf16* EO, const int* tokE, const int* tokS, const float* tokW, const LAS int* tp, int lane, int gw, int NGW) {
    asm volatile("" : "+v"(lane));
    for (int row = gw; row < NT; row += NGW) {
        const int b = row / S;
        const GAS f32x4* xr = (const GAS f32x4*)(xin + (size_t)row * D);
        f32x4 v[4];
#pragma unroll
        for (int j = 0; j < 4; ++j) v[j] = xr[lane + 64 * j];
        if (MODE != 0) {
            f32x4 acc[4];
#pragma unroll
            for (int j = 0; j < 4; ++j) acc[j] = (f32x4){0.f, 0.f, 0.f, 0.f};
#pragma unroll
            for (int k = 0; k < 4; ++k) { const int e = tokE[row * 4 + k]; const size_t r = (size_t)tp[e] * 256 + tokS[row * 4 + k]; const float w = tokW[row * 4 + k];
                const GAS v2u* er = (const GAS v2u*)(EO + r * 1024);
#pragma unroll
                for (int j = 0; j < 4; ++j) { const v2u ev = er[lane + 64 * j];
                    acc[j][0] += w * __uint_as_float(ev.x << 16); acc[j][1] += w * __uint_as_float(ev.x & 0xffff0000u); acc[j][2] += w * __uint_as_float(ev.y << 16); acc[j][3] += w * __uint_as_float(ev.y & 0xffff0000u); } }
#pragma unroll
            for (int j = 0; j < 4; ++j) { const f32x4 gg = *(const GAS f32x4*)(mod_g2 + b * 6144 + (lane + 64 * j) * 4); v[j] = v[j] + gg * acc[j]; *(GAS f32x4*)(xout + (size_t)row * D + (lane + 64 * j) * 4) = v[j]; }
        }
        if (MODE != 2) {
            float ss = 0.f;
#pragma unroll
            for (int j = 0; j < 4; ++j) ss += (v[j][0] * v[j][0] + v[j][1] * v[j][1]) + (v[j][2] * v[j][2] + v[j][3] * v[j][3]);
            const float rstd = rsqrtf(wave_sum(ss) * (1.f / D) + EPS);
#pragma unroll
            for (int j = 0; j < 4; ++j) { const int cc = (lane + 64 * j) * 4; const f32x4 gg = *(const GAS f32x4*)(gain + cc), sh = *(const GAS f32x4*)(mod_sh + b * 6144 + cc), sc = *(const GAS f32x4*)(mod_sc + b * 6144 + cc);
                const f32x4 h = v[j] * rstd * gg * (sc + 1.f) + sh; v2u o; o.x = pk2(h[0], h[1]); o.y = pk2(h[2], h[3]);
                *(GAS v2u*)(HN + (size_t)row * D + cc) = o; }
        }
    }
}
__device__ __forceinline__ void load_tp(const int* cnt, LAS int* tp, LAS int* cn, int tid) {
    if (tid < 32) cn[tid] = __hip_atomic_load(cnt + tid, __ATOMIC_RELAXED, __HIP_MEMORY_SCOPE_AGENT);
    __syncthreads();
    if (tid == 0) { int acc = 0; tp[0] = 0;
        for (int q = 0; q < 32; ++q) { acc += (cn[q] + 255) >> 8; tp[q + 1] = acc; } }
    __syncthreads();
}

__device__ __forceinline__ void phase_router(const float* x1, const float* gain, const float* mod_sh, const float* mod_sc, const float* wr, const float* br, bf16* hn2, int* cnt, int* list, int* tokE, int* tokS, float* tokW,
                                             LAS unsigned char* lds, int tid, int lane, int wave, int G, int bx) {
    asm volatile("" : "+v"(tid), "+v"(lane));
    LAS float* tile = (LAS float*)(lds + RING_OFF);
    LAS int* lw = (LAS int*)(lds + LDSCTL_OFF);
    LAS int* entE = lw + LW_ENTE; LAS float* entW = (LAS float*)(lw + LW_ENTW); LAS int* rank = lw + LW_RANK; LAS int* lcnt = lw + LW_LCNT; LAS int* base = lw + LW_BASE;
    const int l31 = lane & 31, h5 = lane >> 5;
    float breg[64];
#pragma unroll
    for (int j = 0; j < 64; ++j) breg[j] = wr[(size_t)(128 * wave + 2 * j + h5) * 32 + l31];
    if (tid < 32) lcnt[tid] = 0;
    __syncthreads();
    for (int bt = bx; bt < NT / 64; bt += G) {
#pragma unroll 1
      for (int hb = 0; hb < 2; ++hb) {
        const int row0 = bt * 64 + hb * 32 + wave * 4, b = row0 / S;
        int ln = lane; asm volatile("" : "+v"(ln));
#pragma unroll 1
        for (int rp = 0; rp < 2; ++rp) {
        f32x4 v[2][4];
#pragma unroll
        for (int rr = 0; rr < 2; ++rr)
#pragma unroll
            for (int j = 0; j < 4; ++j) v[rr][j] = ((const GAS f32x4*)(x1 + (size_t)(row0 + 2 * rp + rr) * D))[ln + 64 * j];
#pragma unroll
        for (int rr = 0; rr < 2; ++rr) {
            const int lr = wave * 4 + 2 * rp + rr, row = row0 + 2 * rp + rr;
            int l2 = ln; asm volatile("" : "+v"(l2));
            float ss = 0.f;
#pragma unroll
            for (int j = 0; j < 4; ++j) ss += (v[rr][j][0] * v[rr][j][0] + v[rr][j][1] * v[rr][j][1]) + (v[rr][j][2] * v[rr][j][2] + v[rr][j][3] * v[rr][j][3]);
            const float rstd = rsqrtf(wave_sum(ss) * (1.f / D) + EPS);
#pragma unroll
            for (int j = 0; j < 4; ++j) { const int cc = (l2 + 64 * j) * 4; const f32x4 gg = *(const GAS f32x4*)(gain + cc), sh = *(const GAS f32x4*)(mod_sh + b * 6144 + cc), sc = *(const GAS f32x4*)(mod_sc + b * 6144 + cc);
                const f32x4 hv = v[rr][j] * rstd * gg * (sc + 1.f) + sh; v2u o; o.x = pk2(hv[0], hv[1]); o.y = pk2(hv[2], hv[3]);
                *(GAS v2u*)(hn2 + (size_t)row * D + cc) = o;
#pragma unroll
                for (int q = 0; q < 4; ++q) tile[lr * 1024 + ((cc + q) ^ lr)] = hv[q]; }
        }
        }
        __syncthreads();
        f32x16 acc;
#pragma unroll
        for (int r = 0; r < 16; ++r) acc[r] = 0.f;
#pragma unroll
        for (int j = 0; j < 64; ++j) { const float a = tile[l31 * 1024 + ((128 * wave + 2 * j + h5) ^ l31)]; acc = __builtin_amdgcn_mfma_f32_32x32x2f32(a, breg[j], acc, 0, 0, 0);
            if ((j & 7) == 7) __builtin_amdgcn_sched_barrier(0); }
        __syncthreads();
#pragma unroll
        for (int r = 0; r < 16; ++r) tile[(wave * 32 + (r & 3) + 8 * (r >> 2) + 4 * h5) * 32 + l31] = acc[r];
        __syncthreads();
#pragma unroll 1
        for (int rr = 0; rr < 4; ++rr) {
            const int lr = wave * 4 + rr, er = hb * 32 + lr; float cur = br[l31];
#pragma unroll
            for (int w8 = 0; w8 < 8; ++w8) cur += tile[(w8 * 32 + lr) * 32 + l31];
            float tv[4]; int ti[4];
#pragma unroll
            for (int k = 0; k < 4; ++k) { float mv = cur; int mi = l31;
#pragma unroll
                for (int o = 1; o < 32; o <<= 1) { const float ov = __shfl_xor(mv, o); const int oi = __shfl_xor(mi, o); if (ov > mv || (ov == mv && oi < mi)) { mv = ov; mi = oi; } }
                tv[k] = mv; ti[k] = mi; if (l31 == mi) cur = -INFINITY; }
            const float e1 = __expf(tv[1] - tv[0]), e2 = __expf(tv[2] - tv[0]), e3 = __expf(tv[3] - tv[0]), inv = 1.f / (1.f + e1 + e2 + e3);
            if (lane == 0) { entE[er * 4 + 0] = ti[0]; entE[er * 4 + 1] = ti[1]; entE[er * 4 + 2] = ti[2]; entE[er * 4 + 3] = ti[3];
                entW[er * 4 + 0] = inv; entW[er * 4 + 1] = e1 * inv; entW[er * 4 + 2] = e2 * inv; entW[er * 4 + 3] = e3 * inv; }
        }
        __syncthreads();
      }
        if (tid < 256) rank[tid] = __hip_atomic_fetch_add(lcnt + entE[tid], 1, __ATOMIC_RELAXED, __HIP_MEMORY_SCOPE_WORKGROUP);
        __syncthreads();
        if (tid < 32) { const int n = lcnt[tid]; base[tid] = n ? __hip_atomic_fetch_add(cnt + tid, n, __ATOMIC_RELAXED, __HIP_MEMORY_SCOPE_AGENT) : 0; lcnt[tid] = 0; }
        __syncthreads();
        if (tid < 256) { const int e = entE[tid], slot = base[e] + rank[tid], row = bt * 64 + (tid >> 2);
            list[(size_t)e * CAP + slot] = row; tokE[row * 4 + (tid & 3)] = e; tokS[row * 4 + (tid & 3)] = slot; tokW[row * 4 + (tid & 3)] = entW[tid]; }
        __syncthreads();
    }
}

__device__ __forceinline__ int moe_workers(int total, int G) { const int gx = G >> 3, nmax = (total + 7) >> 3, rounds = (nmax + gx - 1) / gx; int jw = rounds > 0 ? (nmax + rounds - 1) / rounds : gx; return jw < 1 ? 1 : (jw > gx ? gx : jw); }
__device__ __forceinline__ bool moe_early(int total, int jw, int bx) { const int x = bx & 7, j = bx >> 3, lo = (int)(((long)total * x) >> 3), hi = (int)(((long)total * (x + 1)) >> 3), nmax = (total + 7) >> 3;
    const int mine = (hi - lo - j + jw - 1) / jw, maxr = (nmax + jw - 1) / jw; return mine < maxr; }
__global__ void __launch_bounds__(NTHR, 2) mk_fwd(MkArgs a) {
    extern __shared__ __attribute__((aligned(16))) unsigned char lds_raw[];
    LAS unsigned char* lds = (LAS unsigned char*)lds_raw;
    const int G = gridDim.x, bx = blockIdx.x, wave_s = __builtin_amdgcn_readfirstlane((int)threadIdx.x >> 6);
#define PH_LOCALS int tid = wave_s * 64 + (int)mk_lane_id(); asm volatile("" : "+v"(tid)); const int lane = tid & 63, wave = __builtin_amdgcn_readfirstlane(tid >> 6), gw = bx * NWAVES + wave, NGW = G * NWAVES; (void)lane; (void)gw; (void)NGW
    { PH_LOCALS; for (int u = tid; u < (LDS_BYTES - LDSCTL_OFF) / 4; u += NTHR) ((LAS unsigned*)(lds + LDSCTL_OFF))[u] = 0u; }
    __syncthreads();
    int lo, hi; XcdBarrier bar;
    { PH_LOCALS; KA_PTR(ka); lo = ka->ph_lo; hi = ka->ph_hi; bar = xcd_barrier_post((unsigned*)(ka->ws + WS_CTL) + CW_BAR + ka->li * XCD_BAR_WORDS, (volatile LAS unsigned*)(lds + LDSCTL_OFF) + LW_BAR, wave_s); }
    LAS int* lw = (LAS int*)(lds + LDSCTL_OFF); LAS int* tp = lw + LW_TP; LAS int* cn = lw + LW_CNT;
#ifndef MK_PHMASK
#define MK_PHMASK 0xFFFFFFFFu
#endif
#ifndef MK_DUP
#define MK_DUP 0u
#endif
#define NREP(p) (((MK_DUP >> (p)) & 1u) ? 2 : 1)
#ifndef MK_DUPSUB
#define MK_DUPSUB 0xFFu
#endif
#define SUBEN(bit) (rep_ == 0 || ((MK_DUPSUB >> (bit)) & 1u))
#define PHEN(p) ((MK_PHMASK >> (p)) & 1u)
#define IN(k) (lo <= (k) && (k) < hi)
#ifndef MK_HOOKPROBE
#define MK_HOOKPROBE 0
#endif
#ifndef MK_DUPBAR
#define MK_DUPBAR 0
#endif
#define SEAM(k) do { if (IN(k) && IN((k) + 1)) { xcd_barrier(bar); if (MK_DUPBAR) xcd_barrier(bar); } } while (0)
#define WSP(T, off) ((T*)(ws + (off)))
    if (PHEN(31) && IN(0)) for (int rep_ = 0; rep_ < NREP(31); ++rep_) { PH_LOCALS; KA_PTR(ka); phase_prologue(ka, lds, tid, lane, wave, G, bx); VM_WAIT(); __syncthreads(); }
    SEAM(0);
    for (int l = 0; l < L; ++l) {
        const int pb = 1 + l * NPH_L;
        if (PHEN(0) && IN(pb + 0)) for (int rep_ = 0; rep_ < NREP(0); ++rep_) { PH_LOCALS; KA_PTR(ka); unsigned char* ws = ka->ws; const float* modl = WSP(float, WS_MOD) + (size_t)l * 8 * 6144; const float* norm1_g = (const float*)ka->in[5] + l * D;
            if (l == 0) phase_rows<0>((const float*)ka->in[0], nullptr, norm1_g, modl + 0, modl + 1024, nullptr, WSP(bf16, WS_HN), nullptr, nullptr, nullptr, nullptr, tp, lane, gw, NGW);
            else { load_tp(WSP(int, WS_CTL) + CW_CNT + (l - 1) * 64, tp, cn, tid); int* tokE = WSP(int, WS_TOK);
                phase_rows<1>(WSP(float, WS_XA), WSP(float, WS_XB), norm1_g, modl + 0, modl + 1024, modl - 8 * 6144 + 5120, WSP(bf16, WS_HN), WSP(bf16, WS_EO), tokE, tokE + NT * 4, (const float*)(tokE + NT * 8), tp, lane, gw, NGW); }
        }
        SEAM(pb + 0);
        if (PHEN(1) && IN(pb + 1)) for (int rep_ = 0; rep_ < NREP(1); ++rep_) { PH_LOCALS; KA_PTR(ka); unsigned char* ws = ka->ws;
#if defined(MK_DBG) && MK_DBG
            if (bx == 0 && tid == 0 && l == MK_DBG_L) WSP(unsigned, WS_CTL)[1030] = (MK_DBG == 1) ? __hip_atomic_load(WSP(unsigned, WS_CTL) + CW_Q, __ATOMIC_RELAXED, __HIP_MEMORY_SCOPE_AGENT) : (unsigned)__builtin_amdgcn_s_memrealtime();
#endif
            const int GW = (G >= 232 && (G & 7) == 0) ? 232 : G; unsigned* pd = WSP(unsigned, WS_CTL) + CW_PD + 64 * (1 + 3 * l);
            if (bx < GW) {
                pg8::Gemm g{WSP(bf16, WS_HN), WSP(bf16, WS_WINT) + (size_t)l * INP * 1024, nullptr, 1024, 1024, 1024, 0}; pg8::StaticOrder So; So.init(NT, INP, GW, bx);
                EpiP E{WSP(bf16, WS_P), INP, WSP(bf16, WS_GT)};
                pg8::gemm_phase<EpiP, pg8::StaticOrder, true, true, false>(lds + RING_OFF, g, So, E, wave);
                if (tid == 0) __hip_atomic_fetch_add(pd, 1u, __ATOMIC_RELAXED, __HIP_MEMORY_SCOPE_AGENT);
                if (((NT / 256) * (INP / 256) - bx + GW - 1) / GW < ((NT / 256) * (INP / 256) + GW - 1) / GW) conv_service(ka, lds, tid, lane, wave, 0u, pd, (unsigned)GW);
            } else conv_service(ka, lds, tid, lane, wave, 0u, pd, (unsigned)GW);
        }
        SEAM(pb + 1);
#if defined(MK_DBG) && MK_DBG
        { PH_LOCALS; KA_PTR(ka); unsigned char* ws = ka->ws; if (bx == 0 && tid == 0 && l == MK_DBG_L) WSP(unsigned, WS_CTL)[1031] = (MK_DBG == 1) ? __hip_atomic_load(WSP(unsigned, WS_CTL) + CW_Q, __ATOMIC_RELAXED, __HIP_MEMORY_SCOPE_AGENT) : (unsigned)__builtin_amdgcn_s_memrealtime(); }
#endif
        if (PHEN(2) && IN(pb + 2)) for (int rep_ = 0; rep_ < NREP(2); ++rep_) { PH_LOCALS; KA_PTR(ka); unsigned char* ws = ka->ws;
#if MK_HGRN_IN
            if (SUBEN(2)) hgrn_a_all(WSP(bf16, WS_P), WSP(float, WS_LB) + l * 512, WSP(float, WS_SLOC), WSP(float, WS_DEC), lds + RING_OFF, bx, G, tid, lane, wave);
#endif
#if MK_MLA_IN
            if (SUBEN(3)) for (int u = bx; u < NT / 64; u += G)
                mla_unit(WSP(bf16, WS_P), (const float*)ka->in[10] + l * 384, (const float*)ka->in[11] + l * 256, WSP(bf16, WS_WUQT) + (size_t)l * 768 * 384, WSP(bf16, WS_WUKVT) + (size_t)l * 1024 * 256,
                         (const float*)ka->in[14] + l * 96, (const float*)ka->in[15] + l * 96, WSP(float, WS_ROPE), WSP(bf16, WS_Q), WSP(bf16, WS_K), WSP(bf16, WS_V), lds + RING_OFF, u, lane, wave);
#endif
#if MK_POOL_IN
            if (SUBEN(4)) for (int u = bx; u < NT / 64; u += G) pool_unit(WSP(bf16, WS_P), WSP(bf16, WS_BR), u, tid);
#endif
        }
        SEAM(pb + 2);
        if (PHEN(3) && IN(pb + 3)) for (int rep_ = 0; rep_ < NREP(3); ++rep_) { PH_LOCALS; KA_PTR(ka); unsigned char* ws = ka->ws;
#if MK_HGRN_IN
            for (int u = bx; u < 256; u += G) hgrn_scan_unit(WSP(float, WS_SLOC), WSP(float, WS_DEC), WSP(bf16, WS_ST), u, tid);
#endif
        }
        SEAM(pb + 3);
        if (PHEN(4) && IN(pb + 4)) for (int rep_ = 0; rep_ < NREP(4); ++rep_) { PH_LOCALS; KA_PTR(ka); unsigned char* ws = ka->ws;
#if MK_ATTN_IN
            if (SUBEN(0)) for (int p = bx; p < 256; p += G) {
                attn_unit(WSP(bf16, WS_Q), WSP(bf16, WS_K), WSP(bf16, WS_V), WSP(bf16, WS_BR), lds + RING_OFF, p & 63, 7 - (p >> 6), tid, lane, wave);
                attn_unit(WSP(bf16, WS_Q), WSP(bf16, WS_K), WSP(bf16, WS_V), WSP(bf16, WS_BR), lds + RING_OFF, p & 63, p >> 6, tid, lane, wave);
            }
#endif
#if MK_HGRN_IN
            if (SUBEN(1)) for (int u = bx; u < 1024; u += G) hgrn_c_unit(WSP(bf16, WS_P), WSP(float, WS_LB) + l * 512, WSP(bf16, WS_ST), (const float*)ka->in[9] + l * 128, WSP(bf16, WS_BR), lds + RING_OFF, u, tid, lane, wave);
#endif
        }
        SEAM(pb + 4);
        if (PHEN(5) && IN(pb + 5)) for (int rep_ = 0; rep_ < NREP(5); ++rep_) { PH_LOCALS; KA_PTR(ka); unsigned char* ws = ka->ws;
            pg8::Gemm g{WSP(bf16, WS_BR), WSP(bf16, WS_WBRT) + (size_t)l * 1024 * 1536, nullptr, 1536, 1536, 1536, 0}; pg8::StaticOrder So; So.init(NT, 1024, G, bx);
#if MK_P5PROBE
            if (rep_ == 1) { EpiP E2{WSP(bf16, WS_MERGF), 1024, nullptr}; pg8::gemm_phase<EpiP, pg8::StaticOrder, false, true, false, 0>(lds + RING_OFF, g, So, E2, wave); } else
#endif
            { EpiBranch E{WSP(bf16, WS_GT), WSP(bf16, WS_MERGB)};
            pg8::gemm_phase<EpiBranch, pg8::StaticOrder, false, true, false, 8>(lds + RING_OFF, g, So, E, wave); }
        }
        SEAM(pb + 5);
        if (PHEN(6) && IN(pb + 6)) for (int rep_ = 0; rep_ < NREP(6); ++rep_) { PH_LOCALS; KA_PTR(ka); unsigned char* ws = ka->ws; const float* xin = (l == 0) ? (const float*)ka->in[0] : WSP(float, WS_XB);
            pg8::Gemm g{WSP(bf16, WS_MERGB), WSP(bf16, WS_WOUTT) + (size_t)l * 1024 * 1024, nullptr, 1024, 1024, 1024, 0}; pg8::StaticOrder So; So.init(NT, 1024, G, bx);
            EpiOut E{xin, WSP(float, WS_MOD) + (size_t)l * 8 * 6144 + 2048, WSP(float, WS_XA)};
            pg8::gemm_phase<EpiOut, pg8::StaticOrder, false, true, false>(lds + RING_OFF, g, So, E, wave);
        }
        SEAM(pb + 6);
        if (PHEN(7) && IN(pb + 7)) for (int rep_ = 0; rep_ < NREP(7); ++rep_) { PH_LOCALS; KA_PTR(ka); unsigned char* ws = ka->ws; const float* modl = WSP(float, WS_MOD) + (size_t)l * 8 * 6144; int* tokE = WSP(int, WS_TOK);
            if (rep_ == 1) tokE = WSP(int, WS_KVRAW);
            phase_router(WSP(float, WS_XA), (const float*)ka->in[6] + l * D, modl + 3072, modl + 4096, (const float*)ka->in[22] + (size_t)l * 1024 * 32, (const float*)ka->in[23] + l * 32, WSP(bf16, WS_HN2),
                         WSP(int, WS_CTL) + (rep_ == 1 ? 2048 : CW_CNT) + l * 64, rep_ == 1 ? WSP(int, WS_QRAW) : WSP(int, WS_LIST), tokE, tokE + NT * 4, (float*)(tokE + NT * 8), lds, tid, lane, wave, G, bx);
            conv_service(ka, lds, tid, lane, wave, (unsigned)(l * TA7 + TA6), nullptr, 0u); }
        SEAM(pb + 7);
        if (PHEN(8) && IN(pb + 8)) for (int rep_ = 0; rep_ < NREP(8); ++rep_) { PH_LOCALS; KA_PTR(ka); unsigned char* ws = ka->ws;
            load_tp(WSP(int, WS_CTL) + CW_CNT + l * 64, tp, cn, tid);
            const int jw = moe_workers(tp[32] * 8, G); unsigned* pd = WSP(unsigned, WS_CTL) + CW_PD + 64 * (2 + 3 * l); const bool worker = (bx >> 3) < jw || (G & 7) != 0;
            if (worker) {
                pg8::Gemm g{WSP(bf16, WS_HN2), WSP(bf16, WS_W1T) + (size_t)l * NE * 2048 * 1024, WSP(int, WS_LIST), 1024, 1024, 1024, 0}; MoeOrder So{tp, cn, 8, (G & 7) ? G : 8 * jw, bx, 0};
                EpiMoe1 E{(const float*)ka->in[25] + (size_t)l * NE * 2048, WSP(bf16, WS_ACT), (LAS float*)(lw + LW_BIAS)};
                pg8::gemm_phase<EpiMoe1, MoeOrder, true, true, true>(lds + RING_OFF, g, So, E, wave);
                if (tid == 0) __hip_atomic_fetch_add(pd, 1u, __ATOMIC_RELAXED, __HIP_MEMORY_SCOPE_AGENT);
            }
            conv_service(ka, lds, tid, lane, wave, (unsigned)((l + 1) * TA7), (worker && !moe_early(tp[32] * 8, jw, bx)) ? nullptr : pd, (unsigned)(8 * jw));
        }
        SEAM(pb + 8);
        if (PHEN(9) && IN(pb + 9)) for (int rep_ = 0; rep_ < NREP(9); ++rep_) { PH_LOCALS; KA_PTR(ka); unsigned char* ws = ka->ws;
            load_tp(WSP(int, WS_CTL) + CW_CNT + l * 64, tp, cn, tid);
            const int jw = moe_workers(tp[32] * 4, G); unsigned* pd = WSP(unsigned, WS_CTL) + CW_PD + 64 * (3 + 3 * l); const bool worker = (bx >> 3) < jw || (G & 7) != 0;
            if (worker) {
                pg8::Gemm g{WSP(bf16, WS_ACT), WSP(bf16, WS_W2T) + (size_t)l * NE * 1024 * 1024, nullptr, 1024, 1024, 1024, 0}; MoeOrder So{tp, cn, 4, (G & 7) ? G : 8 * jw, bx, 1};
                EpiMoe2 E{(const float*)ka->in[27] + (size_t)l * NE * 1024, WSP(bf16, WS_EO), (LAS float*)(lw + LW_BIAS)};
                pg8::gemm_phase<EpiMoe2, MoeOrder, true, true, false>(lds + RING_OFF, g, So, E, wave);
                if (tid == 0) __hip_atomic_fetch_add(pd, 1u, __ATOMIC_RELAXED, __HIP_MEMORY_SCOPE_AGENT);
            }
            conv_service(ka, lds, tid, lane, wave, (unsigned)(l + 1 < L ? (l + 1) * TA7 + TA5 : 0), (worker && !moe_early(tp[32] * 4, jw, bx)) ? nullptr : pd, (unsigned)(8 * jw));
        }
        SEAM(pb + 9);
    }
    if (PHEN(30) && IN(PH_FINAL)) for (int rep_ = 0; rep_ < NREP(30); ++rep_) { PH_LOCALS; KA_PTR(ka); unsigned char* ws = ka->ws; load_tp(WSP(int, WS_CTL) + CW_CNT + (L - 1) * 64, tp, cn, tid); int* tokE = WSP(int, WS_TOK);
        phase_rows<2>(WSP(float, WS_XA), ka->out, nullptr, nullptr, nullptr, WSP(float, WS_MOD) + (size_t)(L - 1) * 8 * 6144 + 5120, nullptr, WSP(bf16, WS_EO), tokE, tokE + NT * 4, (const float*)(tokE + NT * 8), tp, lane, gw, NGW); }
#if defined(MK_DBG) && MK_DBG
    xcd_barrier(bar);
    { PH_LOCALS; KA_PTR(ka); unsigned char* ws = ka->ws; const unsigned d = __hip_atomic_load(WSP(unsigned, WS_CTL) + 1031, __ATOMIC_RELAXED, __HIP_MEMORY_SCOPE_AGENT) - __hip_atomic_load(WSP(unsigned, WS_CTL) + 1030, __ATOMIC_RELAXED, __HIP_MEMORY_SCOPE_AGENT);
      const unsigned K = d * (unsigned)MK_DBG_SCALE; for (unsigned i = bx * NTHR + tid; i < K && i < (unsigned)NT * 1024u; i += G * NTHR) ka->out[i] = 0.f; }
#endif
#undef IN
#undef SEAM
}
static void launch_mk(const MkArgs& base, int lo, int hi, int li, int grid, hipStream_t stream) {
    MkArgs a = base; a.ph_lo = lo; a.ph_hi = hi; a.li = li; a.pad = 0;
    hipLaunchKernelGGL(mk_fwd, dim3(grid), dim3(NTHR), LDS_BYTES, stream, a);
}
extern "C" void kernel_launch(void* const* d_in, const int* in_sizes, int n_in, void* d_out, int out_size, void* d_ws, size_t ws_size, hipStream_t stream) {
    static int grid = 0;
    if (grid == 0) {
        if (ws_size < WS_END || n_in != 28) { fprintf(stderr, "kernel_launch: bad ws/inputs: %zu < %zu, n_in %d\n", ws_size, (size_t)WS_END, n_in); grid = -1; return; }
        int dev = 0, cus = 0, per_cu = 0;
        if (hipGetDevice(&dev) != hipSuccess || hipDeviceGetAttribute(&cus, hipDeviceAttributeMultiprocessorCount, dev) != hipSuccess) { grid = -1; return; }
        if (hipFuncSetAttribute((const void*)mk_fwd, hipFuncAttributeMaxDynamicSharedMemorySize, LDS_BYTES) != hipSuccess) { fprintf(stderr, "kernel_launch: hipFuncSetAttribute failed\n"); grid = -1; return; }
        if (hipOccupancyMaxActiveBlocksPerMultiprocessor(&per_cu, (const void*)mk_fwd, NTHR, LDS_BYTES) != hipSuccess || per_cu < 1) { fprintf(stderr, "kernel_launch: occupancy query says %d\n", per_cu); (void)hipGetLastError(); grid = -1; return; }
        grid = cus;
    }
    if (grid < 0) return;
    unsigned char* ws = (unsigned char*)d_ws;
    (void)hipMemsetAsync(ws + WS_CTL, 0, 1 * MiB, stream);
    MkArgs a{};
    for (int i = 0; i < 28; ++i) a.in[i] = d_in[i];
    a.out = (float*)d_out; a.ws = ws;
    for (int j = 0; j < 16; ++j) a.invf[j] = (float)(1.0 / pow(10000.0, (double)j / 16.0));
#if MK_HYBRID
    const float* onorm_g = (const float*)d_in[9]; const float* qlat_g = (const float*)d_in[10]; const float* kvlat_g = (const float*)d_in[11]; const float* qn_g = (const float*)d_in[14]; const float* kn_g = (const float*)d_in[15];
    float* lb = (float*)(ws + WS_LB); float* rope = (float*)(ws + WS_ROPE);
    bf16 *WuqT = (bf16*)(ws + WS_WUQT), *WukvT = (bf16*)(ws + WS_WUKVT), *P = (bf16*)(ws + WS_P), *Qb = (bf16*)(ws + WS_Q), *Kb = (bf16*)(ws + WS_K), *Vb = (bf16*)(ws + WS_V), *BR = (bf16*)(ws + WS_BR), *QLN = (bf16*)(ws + WS_QLN), *KVN = (bf16*)(ws + WS_KVN);
    float *ORAW = (float*)(ws + WS_ORAW), *QRAW = (float*)(ws + WS_QRAW), *KVRAW = (float*)(ws + WS_KVRAW);
    int li = 0;
    for (int l = 0; l < L; ++l) {
        const int pb = 1 + l * NPH_L;
        launch_mk(a, l == 0 ? 0 : pb - 5, pb + 2, li++, grid, stream);
#if !MK_HGRN_IN
        k_hgrn_naive<<<NB * HH, 128, 0, stream>>>(P, lb + l * 512, ORAW);
        k_hgrn_out<<<NT * 4 / 4, 256, 0, stream>>>(ORAW, P, onorm_g + l * 128, BR);
#endif
#if !MK_MLA_IN
        k_mla_prep<<<NT / 4, 256, 0, stream>>>(P, qlat_g + l * 384, kvlat_g + l * 256, QLN, KVN);
        { GemmArgs g{}; g.A = QLN; g.Bt = WuqT + (size_t)l * 768 * 384; g.lda = 384; g.ldb = 384; g.K = 384; g.outf = QRAW; g.ldc = 768;
          k_gemm<1, 0><<<dim3(768 / 64, NT / 64), 256, 0, stream>>>(g); }
        { GemmArgs g{}; g.A = KVN; g.Bt = WukvT + (size_t)l * 1024 * 256; g.lda = 256; g.ldb = 256; g.K = 256; g.outf = KVRAW; g.ldc = 1024;
          k_gemm<1, 0><<<dim3(1024 / 64, NT / 64), 256, 0, stream>>>(g); }
        k_mla_post<<<NT * 8 / 4, 256, 0, stream>>>(QRAW, KVRAW, P, qn_g + l * 96, kn_g + l * 96, rope, Qb, Kb, Vb);
#endif
#if !MK_POOL_IN
        k_pool<<<NT * 512 / 256, 256, 0, stream>>>(P, BR);
#endif
#if MK_MLA_IN || MK_POOL_IN || MK_HGRN_IN
        launch_mk(a, pb + 2, pb + 3, li++, grid, stream);
#endif
#if MK_HGRN_IN
        launch_mk(a, pb + 3, pb + 4, li++, grid, stream);
#endif
#if MK_ATTN_IN || MK_HGRN_IN
        launch_mk(a, pb + 4, pb + 5, li++, grid, stream);
#else
        k_attn_naive<<<dim3(S / 64, NB * MH), 64, 0, stream>>>(Qb, Kb, Vb, BR);
#endif
    }
    launch_mk(a, 1 + (L - 1) * NPH_L + 5, NPH, li++, grid, stream);
#else
    launch_mk(a, 0, NPH, 0, grid, stream);
#endif
}
```

```cpp
#include <hip/hip_runtime.h>
#include <stdint.h>
#include <cstdio>
#include <cmath>

typedef unsigned short bf16;
__device__ __forceinline__ float bf2f(bf16 v) { return __uint_as_float(((unsigned)v) << 16); }
__device__ __forceinline__ bf16 f2bf(float f) { unsigned u = __float_as_uint(f); return (bf16)((u + 0x7fffu + ((u >> 16) & 1u)) >> 16); }
__device__ __forceinline__ float sigmoidf_(float x) { return 1.f / (1.f + __expf(-x)); }

constexpr int D = 1024, NB = 8, S = 2048, NT = NB * S, L = 2;
constexpr int HH = 4, HDK = 128, HW = 512, HCH = 64;
constexpr int MH = 8, MNOPE = 64, MROPE = 32, MQK = 96, MV = 64, MQR = 384, MKVR = 256, MW = 512;
constexpr int PW = 512;
constexpr int NE = 32, TOPK = 4, FF = 1024;
constexpr int INW = 6304, INP = 6400;
constexpr int C_HQ = 0, C_HF = 512, C_HI = 1024, C_HG = 1536, C_QLAT = 2048, C_KVLAT = 2432, C_KROPE = 2688, C_POOL = 2720, C_GA = 3232, C_GB = 4256, C_GC = 5280;
constexpr float EPS = 1e-6f;
constexpr int CAP = NT;
constexpr int MAXROWS = NT * TOPK + NE * 256;

constexpr size_t MiB = 1u << 20;
constexpr size_t WS_CTL = 0;
constexpr size_t WS_MOD = 1 * MiB;
constexpr size_t WS_LB = 2 * MiB;
constexpr size_t WS_ROPE = 3 * MiB;
constexpr size_t WS_WINT = 6 * MiB;
constexpr size_t WS_WUQT = 32 * MiB;
constexpr size_t WS_WUKVT = 34 * MiB;
constexpr size_t WS_WBRT = 36 * MiB;
constexpr size_t WS_WOUTT = 42 * MiB;
constexpr size_t WS_W1T = 48 * MiB;
constexpr size_t WS_W2T = 304 * MiB;
constexpr size_t WS_HN = 432 * MiB;
constexpr size_t WS_P = 464 * MiB;
constexpr size_t WS_Q = 664 * MiB;
constexpr size_t WS_K = 688 * MiB;
constexpr size_t WS_V = 712 * MiB;
constexpr size_t WS_BR = 728 * MiB;
constexpr size_t WS_MERGF = 776 * MiB;
constexpr size_t WS_MERGB = 840 * MiB;
constexpr size_t WS_XA = 872 * MiB;
constexpr size_t WS_XB = 936 * MiB;
constexpr size_t WS_HN2 = 1000 * MiB;
constexpr size_t WS_LIST = 1032 * MiB;
constexpr size_t WS_TOK = 1034 * MiB;
constexpr size_t WS_ACT = 1036 * MiB;
constexpr size_t WS_EO = 1180 * MiB;
constexpr size_t WS_ORAW = 1324 * MiB;
constexpr size_t WS_QLN = 1356 * MiB;
constexpr size_t WS_KVN = 1368 * MiB;
constexpr size_t WS_QRAW = 1376 * MiB;
constexpr size_t WS_KVRAW = 1424 * MiB;
constexpr size_t WS_SLOC = 1488 * MiB;
constexpr size_t WS_ST = 1552 * MiB;
constexpr size_t WS_DEC = 1584 * MiB;
constexpr size_t WS_GT = 1585 * MiB;
constexpr size_t WS_END = 1681 * MiB;
constexpr int CW_CNT = 64;
constexpr int CW_OFF = 256;

template <int MODE>
__global__ void k_transpose(const float* __restrict__ in, bf16* __restrict__ out, int K, int N, int NP, int rowoff, size_t ibs, size_t obs) {
    __shared__ float t[32][33];
    const int n0 = blockIdx.x * 32, k0 = blockIdx.y * 32, tx = threadIdx.x & 31, ty = threadIdx.x >> 5;
    const float* ip = in + (size_t)blockIdx.z * ibs; bf16* op = out + (size_t)blockIdx.z * obs;
#pragma unroll
    for (int j = 0; j < 4; ++j) t[ty + 8 * j][tx] = ip[(size_t)(k0 + ty + 8 * j) * N + n0 + tx];
    __syncthreads();
#pragma unroll
    for (int j = 0; j < 4; ++j) {
        int n = n0 + ty + 8 * j; int r = n;
        if (MODE == 1) { const int half = n >> 10, c = n & 1023; r = (c >> 7) * 256 + half * 128 + (c & 127); }
        op[(size_t)(rowoff + r) * K + k0 + tx] = f2bf(t[tx][ty + 8 * j]);
    }
}
__global__ void k_zero_bf16(bf16* p, size_t n) { size_t i = (size_t)blockIdx.x * blockDim.x + threadIdx.x; if (i < n) p[i] = 0; }

__global__ void k_fold_pool(const float* __restrict__ w_pool, const float* __restrict__ scale, const float* __restrict__ w_br_c, bf16* __restrict__ wbrt) {
    const int l = blockIdx.z, k = blockIdx.y, n = blockIdx.x * 256 + threadIdx.x, g = k >> 7, c = k & 127;
    const float* wp = w_pool + ((size_t)l * 4 + g) * 128 * 128 + (size_t)c * 128; const float* sc = scale + l * 512 + g * 128; const float* wb = w_br_c + (size_t)l * 512 * 1024 + (size_t)g * 128 * 1024;
    float a = 0.f;
    for (int d = 0; d < 128; ++d) a += wp[d] * sc[d] * wb[(size_t)d * 1024 + n];
    wbrt[(size_t)l * 3072 * 512 + (size_t)(2048 + n) * 512 + k] = f2bf(a);
}
__global__ void k_adaln(const float* __restrict__ c, const float* __restrict__ ada_w, const float* __restrict__ ada_b, float* __restrict__ mod) {
    __shared__ float cs[8][1024];
    for (int i = threadIdx.x; i < 8192; i += 256) { float v = c[i]; cs[i >> 10][i & 1023] = v / (1.f + __expf(-v)); }
    __syncthreads();
    const int l = blockIdx.y, j = blockIdx.x * 256 + threadIdx.x;
    const float* w = ada_w + (size_t)l * 1024 * 6144 + j;
    float a0 = 0, a1 = 0, a2 = 0, a3 = 0, a4 = 0, a5 = 0, a6 = 0, a7 = 0;
    for (int k = 0; k < 1024; ++k) { const float wv = w[(size_t)k * 6144];
        a0 += cs[0][k] * wv; a1 += cs[1][k] * wv; a2 += cs[2][k] * wv; a3 += cs[3][k] * wv; a4 += cs[4][k] * wv; a5 += cs[5][k] * wv; a6 += cs[6][k] * wv; a7 += cs[7][k] * wv; }
    const float bb = ada_b[l * 6144 + j]; float* m = mod + (size_t)l * 8 * 6144 + j;
    m[0 * 6144] = a0 + bb; m[1 * 6144] = a1 + bb; m[2 * 6144] = a2 + bb; m[3 * 6144] = a3 + bb; m[4 * 6144] = a4 + bb; m[5 * 6144] = a5 + bb; m[6 * 6144] = a6 + bb; m[7 * 6144] = a7 + bb;
}
struct InvF { float f[16]; };
__global__ void k_misc(const float* __restrict__ hgrn_lb, const int* __restrict__ pos, float* __restrict__ lb, float* __restrict__ rope, InvF invf) {
    const int i = blockIdx.x * 256 + threadIdx.x;
    if (i < 512) { const float a = hgrn_lb[i], b = hgrn_lb[512 + i]; const float m = fmaxf(a, b); const float ea = __expf(a - m), eb = __expf(b - m); lb[i] = 0.f; lb[512 + i] = eb / (ea + eb); }
    if (i < NT * 16) { const int t = i >> 4, j = i & 15; float fv = invf.f[0];
#pragma unroll
        for (int q = 1; q < 16; ++q) if (j == q) fv = invf.f[q];
        const double ang = (double)pos[t] * (double)fv;
        double r = ang * 0.15915494309189535; r -= floor(r + 0.5); const float a = (float)(r * 6.283185307179586);
        rope[i] = __cosf(a); rope[NT * 16 + i] = __sinf(a); }
}

__global__ void k_norm_mod(const float* __restrict__ x, const float* __restrict__ g, const float* __restrict__ mod_sh, const float* __restrict__ mod_sc, bf16* __restrict__ out) {
    const int row = blockIdx.x * 4 + (threadIdx.x >> 6), lane = threadIdx.x & 63, b = row / S;
    const float4* xr = (const float4*)(x + (size_t)row * D);
    float4 v[4]; float ss = 0.f;
#pragma unroll
    for (int j = 0; j < 4; ++j) { v[j] = xr[lane + 64 * j]; ss += v[j].x * v[j].x + v[j].y * v[j].y + v[j].z * v[j].z + v[j].w * v[j].w; }
#pragma unroll
    for (int o = 1; o < 64; o <<= 1) ss += __shfl_xor(ss, o);
    const float rstd = rsqrtf(ss * (1.f / D) + EPS);
#pragma unroll
    for (int j = 0; j < 4; ++j) { const int c = (lane + 64 * j) * 4; const float4 gg = *(const float4*)(g + c), sh = *(const float4*)(mod_sh + b * 6144 + c), sc = *(const float4*)(mod_sc + b * 6144 + c);
        ushort4 o; o.x = f2bf(v[j].x * rstd * gg.x * (1.f + sc.x) + sh.x); o.y = f2bf(v[j].y * rstd * gg.y * (1.f + sc.y) + sh.y); o.z = f2bf(v[j].z * rstd * gg.z * (1.f + sc.z) + sh.z); o.w = f2bf(v[j].w * rstd * gg.w * (1.f + sc.w) + sh.w);
        *(ushort4*)(out + (size_t)row * D + c) = o; }
}

struct GemmArgs { const bf16* A; const bf16* Bt; const int* rowlist; const int* cnt; const int* off; float* outf; bf16* outb; const bf16* gate; const float* xin; const float* gvec; const float* bias;
    int lda, ldb, K, ldc, pad0, pad1; };
template <int MODE, int BRI>
__global__ void __launch_bounds__(256) k_gemm(GemmArgs g) {
    __shared__ float As[16][65], Bs[16][65], Bs2[16][65];
    const int tid = threadIdx.x, tx = tid & 15, ty = tid >> 4;
    int m0 = blockIdx.y * 64, n0 = blockIdx.x * 64; int e = 0, cnt = 1 << 30, orow0 = m0;
    const bf16* Bt = g.Bt;
    if (MODE == 4 || MODE == 5) { e = blockIdx.z; cnt = g.cnt[e]; if (m0 >= cnt) return; orow0 = g.off[e] + m0; Bt += (size_t)e * (MODE == 4 ? 2048 : 1024) * g.ldb; }
    const int lr = tid >> 2, lk = (tid & 3) * 4;
    size_t arow;
    if (MODE == 4) { const int slot = m0 + lr; arow = (slot < cnt) ? (size_t)g.rowlist[(size_t)e * CAP + slot] : 0; }
    else if (MODE == 5) arow = (size_t)(orow0 + lr);
    else arow = (size_t)(m0 + lr);
    const bf16* ap = g.A + arow * g.lda + lk;
    int bn = n0 + lr;
    if (MODE == 4) { const int t = n0 >> 6;     const int col = n0 + lr; bn = (col >> 7) * 256 + (col & 127); (void)t; }
    const bf16* bp = Bt + (size_t)bn * g.ldb + lk;
    const bf16* bp2 = bp + (size_t)128 * g.ldb;
    float acc[4][4], acc2[4][4];
#pragma unroll
    for (int i = 0; i < 4; ++i)
#pragma unroll
        for (int j = 0; j < 4; ++j) { acc[i][j] = 0.f; acc2[i][j] = 0.f; }
    for (int k0 = 0; k0 < g.K; k0 += 16) {
        const ushort4 av = *(const ushort4*)(ap + k0), bv = *(const ushort4*)(bp + k0);
        As[lk + 0][lr] = bf2f(av.x); As[lk + 1][lr] = bf2f(av.y); As[lk + 2][lr] = bf2f(av.z); As[lk + 3][lr] = bf2f(av.w);
        Bs[lk + 0][lr] = bf2f(bv.x); Bs[lk + 1][lr] = bf2f(bv.y); Bs[lk + 2][lr] = bf2f(bv.z); Bs[lk + 3][lr] = bf2f(bv.w);
        if (MODE == 4) { const ushort4 cv = *(const ushort4*)(bp2 + k0); Bs2[lk + 0][lr] = bf2f(cv.x); Bs2[lk + 1][lr] = bf2f(cv.y); Bs2[lk + 2][lr] = bf2f(cv.z); Bs2[lk + 3][lr] = bf2f(cv.w); }
        __syncthreads();
#pragma unroll
        for (int kk = 0; kk < 16; ++kk) {
            float a[4], b[4], b2[4];
#pragma unroll
            for (int i = 0; i < 4; ++i) { a[i] = As[kk][ty * 4 + i]; b[i] = Bs[kk][tx * 4 + i]; if (MODE == 4) b2[i] = Bs2[kk][tx * 4 + i]; }
#pragma unroll
            for (int i = 0; i < 4; ++i)
#pragma unroll
                for (int j = 0; j < 4; ++j) { acc[i][j] += a[i] * b[j]; if (MODE == 4) acc2[i][j] += a[i] * b2[j]; }
        }
        __syncthreads();
    }
#pragma unroll
    for (int i = 0; i < 4; ++i) {
        const int rl = ty * 4 + i;
        if ((MODE == 4 || MODE == 5) && m0 + rl >= cnt) continue;
        const size_t row = (MODE == 4 || MODE == 5) ? (size_t)(orow0 + rl) : (size_t)(m0 + rl);
#pragma unroll
        for (int j = 0; j < 4; ++j) {
            const int col = n0 + tx * 4 + j; const float v = acc[i][j];
            if (MODE == 0) g.outb[row * g.ldc + col] = f2bf(v);
            else if (MODE == 1) g.outf[row * g.ldc + col] = v;
            else if (MODE == 2) { const float gt = sigmoidf_(bf2f(g.gate[row * INP + col])) * v; float* o = g.outf + row * g.ldc + col;
                if (BRI == 0) *o = gt; else if (BRI == 1) *o += gt; else { const float s = *o + gt; *o = s; g.outb[row * g.ldc + col] = f2bf(s); } }
            else if (MODE == 3) { const int b = (int)(row / S); g.outf[row * g.ldc + col] = g.xin[row * g.ldc + col] + g.gvec[b * 6144 + col] * v; }
            else if (MODE == 4) { float glu = v + g.bias[e * 2048 + col], lin = acc2[i][j] + g.bias[e * 2048 + 1024 + col];
                glu = fminf(glu, 7.f); lin = fminf(fmaxf(lin, -7.f), 7.f);
                g.outb[row * g.ldc + col] = f2bf(glu * sigmoidf_(1.702f * glu) * (lin + 1.f)); }
            else if (MODE == 5) g.outb[row * g.ldc + col] = f2bf(v + g.bias[e * 1024 + col]);
        }
    }
}

__global__ void __launch_bounds__(128) k_hgrn_naive(const bf16* __restrict__ P, const float* __restrict__ lb, float* __restrict__ oraw) {
    __shared__ float qs[16][128], ks[16][128], fs[16][128];
    const int b = blockIdx.x >> 2, h = blockIdx.x & 3, v = threadIdx.x;
    const float lbv = lb[h * 128 + v];
    float st[128];
#pragma unroll
    for (int d = 0; d < 128; ++d) st[d] = 0.f;
    for (int t0 = 0; t0 < S; t0 += 16) {
        __syncthreads();
        for (int tt = 0; tt < 16; ++tt) { const bf16* pr = P + (size_t)(b * S + t0 + tt) * INP;
            const float z = bf2f(pr[C_HF + h * 128 + v]); const float sg = sigmoidf_(z);
            qs[tt][v] = bf2f(pr[C_HQ + h * 128 + v]); fs[tt][v] = lbv + (1.f - lbv) * sg; ks[tt][v] = (1.f - lbv) * (1.f - sg); }
        __syncthreads();
        for (int tt = 0; tt < 16; ++tt) {
            const float vv = bf2f(P[(size_t)(b * S + t0 + tt) * INP + C_HI + h * 128 + v]);
            float o = 0.f;
#pragma unroll
            for (int d = 0; d < 128; ++d) { st[d] = fs[tt][d] * st[d] + ks[tt][d] * vv; o += qs[tt][d] * st[d]; }
            oraw[(size_t)(b * S + t0 + tt) * 512 + h * 128 + v] = o;
        }
    }
}
__global__ void k_hgrn_out(const float* __restrict__ oraw, const bf16* __restrict__ P, const float* __restrict__ og, bf16* __restrict__ BR) {
    const int idx = blockIdx.x * 4 + (threadIdx.x >> 6), lane = threadIdx.x & 63, t = idx >> 2, h = idx & 3;
    const float o0 = oraw[(size_t)t * 512 + h * 128 + lane], o1 = oraw[(size_t)t * 512 + h * 128 + 64 + lane];
    float ss = o0 * o0 + o1 * o1;
#pragma unroll
    for (int o = 1; o < 64; o <<= 1) ss += __shfl_xor(ss, o);
    const float rstd = rsqrtf(ss * (1.f / 128.f) + EPS);
    const float g0 = bf2f(P[(size_t)t * INP + C_HG + h * 128 + lane]), g1 = bf2f(P[(size_t)t * INP + C_HG + h * 128 + 64 + lane]);
    BR[(size_t)t * 1536 + h * 128 + lane] = f2bf(o0 * rstd * og[lane] * g0 * sigmoidf_(g0));
    BR[(size_t)t * 1536 + h * 128 + 64 + lane] = f2bf(o1 * rstd * og[64 + lane] * g1 * sigmoidf_(g1));
}
__global__ void k_mla_prep(const bf16* __restrict__ P, const float* __restrict__ qg, const float* __restrict__ kvg, bf16* __restrict__ qln, bf16* __restrict__ kvn) {
    const int t = blockIdx.x * 4 + (threadIdx.x >> 6), lane = threadIdx.x & 63; const bf16* pr = P + (size_t)t * INP;
    float q[6], kv[4], s1 = 0.f, s2 = 0.f;
#pragma unroll
    for (int j = 0; j < 6; ++j) { q[j] = bf2f(pr[C_QLAT + lane + 64 * j]); s1 += q[j] * q[j]; }
#pragma unroll
    for (int j = 0; j < 4; ++j) { kv[j] = bf2f(pr[C_KVLAT + lane + 64 * j]); s2 += kv[j] * kv[j]; }
#pragma unroll
    for (int o = 1; o < 64; o <<= 1) { s1 += __shfl_xor(s1, o); s2 += __shfl_xor(s2, o); }
    const float r1 = rsqrtf(s1 * (1.f / 384.f) + EPS), r2 = rsqrtf(s2 * (1.f / 256.f) + EPS);
#pragma unroll
    for (int j = 0; j < 6; ++j) qln[(size_t)t * 384 + lane + 64 * j] = f2bf(q[j] * r1 * qg[lane + 64 * j]);
#pragma unroll
    for (int j = 0; j < 4; ++j) kvn[(size_t)t * 256 + lane + 64 * j] = f2bf(kv[j] * r2 * kvg[lane + 64 * j]);
}
__global__ void k_mla_post(const float* __restrict__ qraw, const float* __restrict__ kvraw, const bf16* __restrict__ P, const float* __restrict__ qng, const float* __restrict__ kng,
                           const float* __restrict__ rope, bf16* __restrict__ Q, bf16* __restrict__ K, bf16* __restrict__ V) {
    const int idx = blockIdx.x * 4 + (threadIdx.x >> 6), lane = threadIdx.x & 63, t = idx >> 3, h = idx & 7, b = t / S, s = t % S;
    const float qa = qraw[(size_t)t * 768 + h * 96 + lane], qb = qraw[(size_t)t * 768 + h * 96 + 64 + (lane & 31)];
    const float ka = kvraw[(size_t)t * 1024 + h * 128 + lane], kb = bf2f(P[(size_t)t * INP + C_KROPE + (lane & 31)]);
    const float va = kvraw[(size_t)t * 1024 + h * 128 + 64 + lane];
    float sq = qa * qa + (lane < 32 ? qb * qb : 0.f), sk = ka * ka + (lane < 32 ? kb * kb : 0.f);
#pragma unroll
    for (int o = 1; o < 64; o <<= 1) { sq += __shfl_xor(sq, o); sk += __shfl_xor(sk, o); }
    const float rq = rsqrtf(sq * (1.f / 96.f) + EPS), rk = rsqrtf(sk * (1.f / 96.f) + EPS);
    const size_t ob = ((size_t)(b * MH + h) * S + s);
    Q[ob * 96 + lane] = f2bf(qa * rq * qng[lane]); K[ob * 96 + lane] = f2bf(ka * rk * kng[lane]); V[((size_t)(b * MH + h) * 64 + lane) * S + s] = f2bf(va);
    const float qn = qb * rq * qng[64 + (lane & 31)], kn = kb * rk * kng[64 + (lane & 31)];
    const float qo = __shfl_xor(qn, 16), ko = __shfl_xor(kn, 16);
    const int i = lane & 15; const float cs = rope[(size_t)t * 16 + i], sn = rope[(size_t)NT * 16 + (size_t)t * 16 + i];
    if (lane < 32) { float qr, kr; if (lane < 16) { qr = qn * cs - qo * sn; kr = kn * cs - ko * sn; } else { qr = qn * cs + qo * sn; kr = kn * cs + ko * sn; }
        Q[ob * 96 + 64 + lane] = f2bf(qr); K[ob * 96 + 64 + lane] = f2bf(kr); }
}
__global__ void __launch_bounds__(64) k_attn_naive(const bf16* __restrict__ Q, const bf16* __restrict__ K, const bf16* __restrict__ V, bf16* __restrict__ BR) {
    __shared__ float ks[16][96], vs[16][64];
    const int bh = blockIdx.y, q0 = blockIdx.x * 64, qi = q0 + threadIdx.x, b = bh >> 3, h = bh & 7;
    float q[96], o[64]; float m = -INFINITY, l = 0.f;
    const bf16* qp = Q + ((size_t)bh * S + qi) * 96;
#pragma unroll
    for (int d = 0; d < 96; ++d) q[d] = bf2f(qp[d]) * 0.10206207261596575f;
#pragma unroll
    for (int d = 0; d < 64; ++d) o[d] = 0.f;
    for (int k0 = 0; k0 < q0 + 64; k0 += 16) {
        __syncthreads();
        for (int i = threadIdx.x; i < 16 * 96; i += 64) ks[i / 96][i % 96] = bf2f(K[((size_t)bh * S + k0) * 96 + i]);
        for (int i = threadIdx.x; i < 16 * 64; i += 64) vs[i & 15][i >> 4] = bf2f(V[((size_t)bh * 64 + (i >> 4)) * S + k0 + (i & 15)]);
        __syncthreads();
        for (int j = 0; j < 16; ++j) {
            if (k0 + j > qi) break;
            float sc = 0.f;
#pragma unroll
            for (int d = 0; d < 96; ++d) sc += q[d] * ks[j][d];
            const float mn = fmaxf(m, sc), corr = __expf(m - mn), p = __expf(sc - mn);
            l = l * corr + p; m = mn;
#pragma unroll
            for (int d = 0; d < 64; ++d) o[d] = o[d] * corr + p * vs[j][d];
        }
    }
    const float inv = 1.f / l; bf16* op = BR + (size_t)(b * S + qi) * 1536 + 512 + h * 64;
#pragma unroll
    for (int d = 0; d < 64; ++d) op[d] = f2bf(o[d] * inv);
}
__global__ void k_pool(const bf16* __restrict__ P, bf16* __restrict__ BR) {
    const int i = blockIdx.x * 256 + threadIdx.x, t = i >> 9, c = i & 511, g = c >> 7, s = t % S, w = 2 << g;
    const int n = (s + 1 < w) ? s + 1 : w; float sum = 0.f;
    for (int j = 0; j < n; ++j) sum += bf2f(P[(size_t)(t - j) * INP + C_POOL + c]);
    const float u = bf2f(P[(size_t)t * INP + C_POOL + c]);
    BR[(size_t)t * 1536 + 1024 + c] = f2bf(sum / (float)n - u);
}
__global__ void k_router(const float* __restrict__ x, const float* __restrict__ g, const float* __restrict__ mod_sh, const float* __restrict__ mod_sc, const float* __restrict__ wr, const float* __restrict__ br,
                         bf16* __restrict__ hn2, int* __restrict__ cnt, int* __restrict__ list, int* __restrict__ tokE, int* __restrict__ tokS, float* __restrict__ tokW) {
    __shared__ float hs[4][1024];
    const int w = threadIdx.x >> 6, row = blockIdx.x * 4 + w, lane = threadIdx.x & 63, b = row / S;
    const float4* xr = (const float4*)(x + (size_t)row * D);
    float4 v[4]; float ss = 0.f;
#pragma unroll
    for (int j = 0; j < 4; ++j) { v[j] = xr[lane + 64 * j]; ss += v[j].x * v[j].x + v[j].y * v[j].y + v[j].z * v[j].z + v[j].w * v[j].w; }
#pragma unroll
    for (int o = 1; o < 64; o <<= 1) ss += __shfl_xor(ss, o);
    const float rstd = rsqrtf(ss * (1.f / D) + EPS);
#pragma unroll
    for (int j = 0; j < 4; ++j) { const int c = (lane + 64 * j) * 4; const float4 gg = *(const float4*)(g + c), sh = *(const float4*)(mod_sh + b * 6144 + c), sc = *(const float4*)(mod_sc + b * 6144 + c);
        float4 hv; hv.x = v[j].x * rstd * gg.x * (1.f + sc.x) + sh.x; hv.y = v[j].y * rstd * gg.y * (1.f + sc.y) + sh.y; hv.z = v[j].z * rstd * gg.z * (1.f + sc.z) + sh.z; hv.w = v[j].w * rstd * gg.w * (1.f + sc.w) + sh.w;
        ushort4 o; o.x = f2bf(hv.x); o.y = f2bf(hv.y); o.z = f2bf(hv.z); o.w = f2bf(hv.w);
        *(ushort4*)(hn2 + (size_t)row * D + c) = o; *(float4*)&hs[w][c] = hv; }
    __syncthreads();
    const int e = lane & 31, half = lane >> 5; float a = 0.f;
    for (int k = half * 512; k < half * 512 + 512; ++k) a += hs[w][k] * wr[k * 32 + e];
    a += __shfl_xor(a, 32); a += br[e];
    float cur = a; float tv[4]; int ti[4];
#pragma unroll
    for (int k = 0; k < 4; ++k) { float mv = cur; int mi = e;
#pragma unroll
        for (int o = 1; o < 32; o <<= 1) { const float ov = __shfl_xor(mv, o); const int oi = __shfl_xor(mi, o); if (ov > mv || (ov == mv && oi < mi)) { mv = ov; mi = oi; } }
        tv[k] = mv; ti[k] = mi; if (e == mi) cur = -INFINITY; }
    const float e1 = __expf(tv[1] - tv[0]), e2 = __expf(tv[2] - tv[0]), e3 = __expf(tv[3] - tv[0]), inv = 1.f / (1.f + e1 + e2 + e3);
    if (lane == 0) {
        const float ww[4] = {inv, e1 * inv, e2 * inv, e3 * inv};
#pragma unroll
        for (int k = 0; k < 4; ++k) { const int slot = atomicAdd(&cnt[ti[k]], 1); list[(size_t)ti[k] * CAP + slot] = row; tokE[row * 4 + k] = ti[k]; tokS[row * 4 + k] = slot; tokW[row * 4 + k] = ww[k]; }
    }
}
__global__ void k_offsets(const int* __restrict__ cnt, int* __restrict__ off) { if (threadIdx.x == 0) { int a = 0; for (int e = 0; e < 32; ++e) { off[e] = a; a += (cnt[e] + 255) & ~255; } off[32] = a; } }
__global__ void k_combine(const float* __restrict__ x1, const float* __restrict__ mod_g2, const bf16* __restrict__ EO, const int* __restrict__ off, const int* __restrict__ tokE, const int* __restrict__ tokS, const float* __restrict__ tokW, float* __restrict__ out) {
    const int row = blockIdx.x, b = row / S, c = threadIdx.x * 4;
    float4 acc = {0.f, 0.f, 0.f, 0.f};
#pragma unroll
    for (int k = 0; k < 4; ++k) { const int e = tokE[row * 4 + k]; const size_t r = (size_t)off[e] + tokS[row * 4 + k]; const float w = tokW[row * 4 + k];
        const ushort4 ev = *(const ushort4*)(EO + r * 1024 + c); acc.x += w * bf2f(ev.x); acc.y += w * bf2f(ev.y); acc.z += w * bf2f(ev.z); acc.w += w * bf2f(ev.w); }
    const float4 xv = *(const float4*)(x1 + (size_t)row * D + c), gg = *(const float4*)(mod_g2 + b * 6144 + c);
    float4 o; o.x = xv.x + gg.x * acc.x; o.y = xv.y + gg.y * acc.y; o.z = xv.z + gg.z * acc.z; o.w = xv.w + gg.w * acc.w;
    *(float4*)(out + (size_t)row * D + c) = o;
}

#define MK_HYBRID 0
#define MK_POOL_IN 1
#define MK_MLA_IN 1
#define MK_ATTN_IN 1
#define MK_HGRN_IN 1
__device__ __forceinline__ unsigned mk_lane_id() { unsigned l; asm volatile("v_mbcnt_lo_u32_b32 %0, -1, 0\n\tv_mbcnt_hi_u32_b32 %0, -1, %0" : "=v"(l)); return l; }
#define GAS __attribute__((address_space(1)))
#define LAS __attribute__((address_space(3)))
#define XB_TMO      128
#define XB_XCNT(j)  (256  + 64 * (j))
#define XB_XSUB(j)  (1280 + 64 * (j))
#define XB_XGEN(j)  (2304 + 64 * (j))
#define XB_TOP      3328
#define XB_TOPGEN   3392
#define XCD_BAR_WORDS 3456
#define XB_SPIN_CAP (1u << 18)

__device__ __forceinline__ unsigned xb_ld(unsigned* p)              { return __hip_atomic_load(p, __ATOMIC_RELAXED, __HIP_MEMORY_SCOPE_AGENT); }
__device__ __forceinline__ unsigned xb_add(unsigned* p, unsigned v) { return __hip_atomic_fetch_add(p, v, __ATOMIC_RELAXED, __HIP_MEMORY_SCOPE_AGENT); }
__device__ __forceinline__ unsigned xb_xcc_id() { return (unsigned)__builtin_amdgcn_s_getreg((3 << 11) | 20) & 0xFu; }
#define XB_SPIN(cond, bar) do { unsigned _sp = 0; while (cond) { __builtin_amdgcn_s_sleep(1); \
    if ((++_sp & 255u) == 0u) { if (xb_ld(&(bar)[XB_TMO])) break; if (_sp > XB_SPIN_CAP) { atomicAdd(&(bar)[XB_TMO], 1u); break; } } } } while (0)

struct XcdBarrier {
    unsigned* bar; unsigned x; int wv;
    volatile LAS unsigned* st;
};

__device__ __forceinline__ bool xb_thread0(int wv) { return wv == 0 && mk_lane_id() == 0u; }
__device__ __forceinline__ XcdBarrier xcd_barrier_post(unsigned* bar, volatile LAS unsigned* st, int wv) {
    XcdBarrier b; b.bar = bar; b.x = xb_xcc_id(); b.st = st; b.wv = wv;
    if (xb_thread0(wv)) (void)xb_add(&bar[XB_XCNT(b.x)], 1u);
    return b;
}
__device__ __forceinline__ void xcd_barrier_complete(unsigned* bar, unsigned x, unsigned& nloc, unsigned& nx) {
    const unsigned G = gridDim.x * gridDim.y * gridDim.z;
    unsigned sum, cnt, mine, sp = 0u;
    for (;;) {
        sum = 0u; cnt = 0u; mine = 0u;
#pragma unroll
        for (unsigned j = 0; j < 16; ++j) { const unsigned c = xb_ld(&bar[XB_XCNT(j)]); sum += c; cnt += (c > 0u) ? 1u : 0u; mine = (j == x) ? c : mine; }
        if (sum == G) break;
        __builtin_amdgcn_s_sleep(1);
        if ((++sp & 255u) == 0u) { if (xb_ld(&bar[XB_TMO])) break; if (sp > XB_SPIN_CAP) { atomicAdd(&bar[XB_TMO], 1u); break; } }
    }
    nloc = mine > 0u ? mine : 1u; nx = cnt > 0u ? cnt : 1u;
}

__device__ __forceinline__ void xcd_barrier(const XcdBarrier& b) {
    asm volatile("s_waitcnt vmcnt(0)" ::: "memory");
    __syncthreads();
    if (xb_thread0(b.wv)) {
        unsigned* bar = b.bar;
        __builtin_amdgcn_s_waitcnt(0);
        unsigned nloc = b.st[0], nx = b.st[1];
        if (nloc == 0u) { xcd_barrier_complete(bar, b.x, nloc, nx); b.st[0] = nloc; b.st[1] = nx; }
        const unsigned old = xb_add(&bar[XB_XSUB(b.x)], 1u);
        const unsigned gen = old / nloc;
        if (old + 1u == (gen + 1u) * nloc) {
            __builtin_amdgcn_fence(__ATOMIC_RELEASE, "agent");
            asm volatile("s_waitcnt vmcnt(0)" ::: "memory");
            const unsigned og = xb_add(&bar[XB_TOP], 1u);
            const unsigned tg = og / nx;
            if (og + 1u == (tg + 1u) * nx) xb_add(&bar[XB_TOPGEN], 1u);
            else XB_SPIN(xb_ld(&bar[XB_TOPGEN]) == tg, bar);
            __builtin_amdgcn_fence(__ATOMIC_ACQUIRE, "agent");
            xb_add(&bar[XB_XGEN(b.x)], 1u);
            asm volatile("s_waitcnt vmcnt(0)" ::: "memory");
        } else {
            XB_SPIN(xb_ld(&bar[XB_XGEN(b.x)]) == gen, bar);
            __builtin_amdgcn_fence(__ATOMIC_ACQUIRE, "agent");
            asm volatile("s_waitcnt vmcnt(0)" ::: "memory");
        }
    }
    __syncthreads();
}
namespace pg8 {
#define PG8_LAS __attribute__((address_space(3)))
typedef unsigned short bf16_t;
typedef short bf16x8 __attribute__((ext_vector_type(8)));
typedef float f32x4 __attribute__((ext_vector_type(4)));
typedef unsigned u32x4 __attribute__((ext_vector_type(4)));
constexpr int BM = 256, BK = 64, HALF = 128, HTB = HALF * BK * 2  , STAGE_BYTES = 8 * HTB, NXCD = 8, WGM = 8;

__host__ __device__ __forceinline__ int lds_byte(int r, int c) { const int st = (r >> 4) * 2 + (c >> 5), rr = r & 15, cc = c & 31, ob = rr * 64 + cc * 2; return st * 1024 + (ob ^ (((ob >> 9) & 1) << 5)); }
__host__ __device__ __forceinline__ void stage_rc(int b, int& R, int& C) { const int st = b / 1024, sb = b % 1024, swz = sb ^ (((sb >> 9) & 1) << 5); R = (st >> 1) * 16 + swz / 64; C = (st & 1) * 32 + (swz % 64) / 2; }
__host__ __device__ __forceinline__ int perm32(int rho) { const int n = rho >> 4, i = rho & 15; return 8 * (i >> 2) + 4 * n + (i & 3); }

struct Unit { int pm, pn, ka, aux, e, gbase, gcnt, pad; };
struct Gemm { const bf16_t* A; const bf16_t* Bt; const int* rowlist; int lda, ldb, K, pad; };

struct StaticOrder {
    int nM, nN, nwg, G, c;
    __host__ __device__ void init(int M, int N, int G_, int c_) { nM = M / BM; nN = N / BM; nwg = nM * nN; G = G_; c = c_; }
    __host__ __device__ bool next(int i, Unit& u) const {
        const long L = (long)i * G + c; if (L >= nwg) return false;
        int wgid = (int)L; { const int q = nwg / NXCD, r = nwg % NXCD, xcd = wgid % NXCD, off = wgid / NXCD; wgid = (xcd < r ? xcd * (q + 1) : r * (q + 1) + (xcd - r) * q) + off; }
        const int nig = WGM * nN, gid = wgid / nig, fm = gid * WGM, gsz = (nM - fm) < WGM ? (nM - fm) : WGM;
        u.pm = fm + ((wgid % nig) % gsz); u.pn = (wgid % nig) / gsz; u.ka = 0; u.aux = 0; u.e = 0; u.gbase = 0; u.gcnt = 0; u.pad = 0; return true;
    }
};

typedef float cvt_f32x2 __attribute__((ext_vector_type(2)));
typedef __bf16 cvt_bf16x2 __attribute__((ext_vector_type(2)));
__device__ __forceinline__ unsigned cvt_pk_bf16(float lo, float hi) { const cvt_f32x2 v = {lo, hi}; return __builtin_bit_cast(unsigned, __builtin_convertvector(v, cvt_bf16x2)); }

template <class Epi, class Sched, bool ALIGN_EPI, bool SP2, bool GATHER, int HOOK = 0>
__device__ __forceinline__ void gemm_phase(PG8_LAS unsigned char* lds, const Gemm g, const Sched& S, const Epi& E, int wave_in) {
    int tid_ = wave_in * 64 + (int)mk_lane_id(); asm volatile("" : "+v"(tid_));
    const int tid = tid_, wid = __builtin_amdgcn_readfirstlane(tid >> 6), lane = tid & 63, wr = wid >> 2, wc = wid & 3, fr = lane & 15, fq = lane >> 4;
    const int K = g.K, nt = K / BK;
    const unsigned ldaB = (unsigned)g.lda * 2u, ldbB = (unsigned)g.ldb * 2u;
    unsigned voffA[2], voffB[2]; int rowA[2];
#pragma unroll
    for (int i = 0; i < 2; ++i) { int R, C; stage_rc(tid * 16 + i * 8192, R, C); const int Rb = Epi::PERM ? ((R & ~31) + perm32(R & 31)) : R;
        rowA[i] = R; voffA[i] = GATHER ? (unsigned)C * 2u : (unsigned)R * ldaB + (unsigned)C * 2u; voffB[i] = (unsigned)Rb * ldbB + (unsigned)C * 2u; }
    const size_t kstep = (size_t)(BK * 2);
    const size_t hstepA = GATHER ? 0 : (size_t)HALF * ldaB, hstepB = (size_t)HALF * ldbB;
    const size_t tstepA = 2 * (size_t)HALF * ldaB, tstepB = 2 * hstepB;
    const unsigned ldsw = (unsigned)wid * 1024u;
    const int aoff = lds_byte(wr * 64 + fr, fq * 8), boff = lds_byte(wc * 32 + fr, fq * 8);
    unsigned gvc[2][2], gvn[2][2];
#define PG8_SA(b, h) (((b) * 2 + (h)) * HTB)
#define PG8_SB(b, h) ((4 + (b) * 2 + (h)) * HTB)
#define PG8_STAGE(bufoff, gbase, voff) do { _Pragma("unroll") for (int _i = 0; _i < 2; ++_i) \
        __builtin_amdgcn_global_load_lds((const unsigned*)((const char*)(gbase) + (voff)[_i]), (PG8_LAS unsigned*)(lds + (bufoff) + ldsw + _i * 8192), 16, 0, 0); } while (0)
#define PG8_STAGEA(bufoff, gbase, h, nx) do { if constexpr (GATHER) { unsigned _vo[2]; _vo[0] = ((nx) ? gvn[h][0] : gvc[h][0]) + voffA[0]; _vo[1] = ((nx) ? gvn[h][1] : gvc[h][1]) + voffA[1]; PG8_STAGE(bufoff, gbase, _vo); } \
        else { PG8_STAGE(bufoff, (const char*)(gbase) + (h) * hstepA, voffA); } } while (0)
#define PG8_GLOAD(dst, u) do { _Pragma("unroll") for (int _h = 0; _h < 2; ++_h) _Pragma("unroll") for (int _i = 0; _i < 2; ++_i) { const int _r = _h * HALF + rowA[_i]; \
        const int _row = (_r < (u).gcnt) ? g.rowlist[(u).gbase + _r] : 0; dst[_h][_i] = (unsigned)_row * ldaB; } } while (0)
#define PG8_LDA(dst, b, h) do { _Pragma("unroll") for (int m = 0; m < 4; ++m) _Pragma("unroll") for (int k = 0; k < 2; ++k) dst[m][k] = *(const PG8_LAS bf16x8*)(lds + PG8_SA(b, h) + aoff + m * 2048 + k * 1024); } while (0)
#define PG8_LDB(dst, b, h) do { _Pragma("unroll") for (int n = 0; n < 2; ++n) _Pragma("unroll") for (int k = 0; k < 2; ++k) dst[n][k] = *(const PG8_LAS bf16x8*)(lds + PG8_SB(b, h) + boff + n * 2048 + k * 1024); } while (0)
#define PG8_MMA(ai, bj, At, Bt) do { __builtin_amdgcn_s_setprio(1); _Pragma("unroll") for (int m = 0; m < 4; ++m) _Pragma("unroll") for (int n = 0; n < 2; ++n) _Pragma("unroll") for (int k = 0; k < 2; ++k) \
        acc[ai][bj][m][n] = __builtin_amdgcn_mfma_f32_16x16x32_bf16(Bt[n][k], At[m][k], acc[ai][bj][m][n], 0, 0, 0); __builtin_amdgcn_s_setprio(0); } while (0)
#define PG8_WAIT_V(n) asm volatile("s_waitcnt vmcnt(" #n ")" ::: "memory")
#define PG8_WAIT_L(n) asm volatile("s_waitcnt lgkmcnt(" #n ")" ::: "memory")
#define PG8_BAR __builtin_amdgcn_s_barrier()
#define PG8_SCHED __builtin_amdgcn_sched_barrier(0)
    Unit cur, nxt; int ui = 0;
    if (!S.next(0, cur)) return;
    f32x4 acc[2][2][4][2];
#pragma unroll
    for (int a = 0; a < 2; ++a)
#pragma unroll
        for (int b = 0; b < 2; ++b)
#pragma unroll
            for (int m = 0; m < 4; ++m)
#pragma unroll
                for (int n = 0; n < 2; ++n) acc[a][b][m][n] = (f32x4){0.f, 0.f, 0.f, 0.f};
    bf16x8 At[4][2], B0[2][2], B1[2][2];
    const char* cA = (const char*)g.A + (GATHER ? (size_t)0 : (size_t)cur.pm * tstepA) + (size_t)cur.ka * 2; const char* cB = (const char*)g.Bt + (size_t)cur.pn * tstepB;
    if constexpr (GATHER) { PG8_GLOAD(gvc, cur); }
#pragma unroll
    for (int h = 0; h < 2; ++h)
#pragma unroll
        for (int i = 0; i < 2; ++i) gvn[h][i] = GATHER ? gvc[h][i] : 0u;
    {
        PG8_STAGE(PG8_SB(0, 0), cB, voffB); PG8_STAGE(PG8_SB(0, 1), cB + hstepB, voffB); PG8_STAGEA(PG8_SA(0, 0), cA, 0, false); PG8_STAGEA(PG8_SA(0, 1), cA, 1, false);
        if (wr == 1) PG8_BAR;
        PG8_WAIT_V(2); PG8_BAR;
        PG8_STAGE(PG8_SB(1, 0), cB + kstep, voffB); PG8_STAGEA(PG8_SA(1, 0), cA + kstep, 0, false); PG8_STAGE(PG8_SB(1, 1), cB + hstepB + kstep, voffB);
        PG8_WAIT_V(6); PG8_BAR;
    }
    for (;;) {
        const bool has_next = S.next(ui + 1, nxt);
        const char* nA = has_next ? (const char*)g.A + (GATHER ? (size_t)0 : (size_t)nxt.pm * tstepA) + (size_t)nxt.ka * 2 : cA; const char* nB = has_next ? (const char*)g.Bt + (size_t)nxt.pn * tstepB : cB;
        if constexpr (GATHER) { if (has_next) { PG8_GLOAD(gvn, nxt); } }
        E.prefetch(cur, wid, lane);
        for (int t = 0; t < nt; t += 2) {
            const bool last = (t == nt - 2);
            if constexpr (HOOK > 0) { if (t > 0 && (t % HOOK) == 0) E.mid(acc, cur, wr, wc, fr, fq, t); }
            const char* a1 = cA + (size_t)(t + 1) * kstep;
            const char* a2 = last ? nA : cA + (size_t)(t + 2) * kstep; const char* b2 = last ? nB : cB + (size_t)(t + 2) * kstep;
            const char* a3 = a2 + kstep; const char* b3 = b2 + kstep;
            PG8_LDB(B0, 0, 0); PG8_LDB(B1, 0, 1); PG8_SCHED; PG8_LDA(At, 0, 0); PG8_STAGEA(PG8_SA(1, 1), a1, 1, false);
            PG8_WAIT_V(8); PG8_WAIT_L(0); PG8_BAR; PG8_MMA(0, 0, At, B0); PG8_MMA(0, 1, At, B1); PG8_BAR; PG8_SCHED;
            PG8_LDA(At, 0, 1); PG8_STAGE(PG8_SB(0, 0), b2, voffB); PG8_STAGE(PG8_SB(0, 1), b2 + hstepB, voffB); PG8_STAGEA(PG8_SA(0, 0), a2, 0, last);
            PG8_WAIT_V(8); PG8_WAIT_L(0); PG8_BAR; PG8_MMA(1, 0, At, B0); PG8_MMA(1, 1, At, B1); PG8_BAR; PG8_SCHED;
            PG8_LDB(B0, 1, 0); PG8_LDB(B1, 1, 1); PG8_SCHED; PG8_LDA(At, 1, 0); PG8_STAGEA(PG8_SA(0, 1), a2, 1, last);
            PG8_WAIT_V(8); PG8_WAIT_L(0); PG8_BAR; PG8_MMA(0, 0, At, B0); PG8_MMA(0, 1, At, B1); PG8_BAR; PG8_SCHED;
            PG8_LDA(At, 1, 1); PG8_STAGE(PG8_SB(1, 0), b3, voffB); PG8_STAGE(PG8_SB(1, 1), b3 + hstepB, voffB); PG8_STAGEA(PG8_SA(1, 0), a3, 0, last);
            PG8_WAIT_V(8); PG8_WAIT_L(0); PG8_BAR; PG8_MMA(1, 0, At, B0); PG8_MMA(1, 1, At, B1); PG8_BAR; PG8_SCHED;
        }
        if constexpr (ALIGN_EPI) { if (wr == 0) PG8_BAR; }
        E(acc, cur, wr, wc, fr, fq);
        if (!has_next) break;
#pragma unroll
        for (int a = 0; a < 2; ++a)
#pragma unroll
            for (int b = 0; b < 2; ++b)
#pragma unroll
                for (int m = 0; m < 4; ++m)
#pragma unroll
                    for (int n = 0; n < 2; ++n) acc[a][b][m][n] = (f32x4){0.f, 0.f, 0.f, 0.f};
        cur = nxt; cA = nA; cB = nB; ++ui;
#pragma unroll
        for (int h = 0; h < 2; ++h)
#pragma unroll
            for (int i = 0; i < 2; ++i) gvc[h][i] = gvn[h][i];
        if constexpr (ALIGN_EPI) { if (wr == 1) PG8_BAR; }
    }
    PG8_WAIT_V(0);
    if constexpr (!ALIGN_EPI) { if (wr == 0) PG8_BAR; }
    PG8_BAR;
#undef PG8_SA
#undef PG8_SB
#undef PG8_STAGE
#undef PG8_STAGEA
#undef PG8_GLOAD
#undef PG8_LDA
#undef PG8_LDB
#undef PG8_MMA
#undef PG8_WAIT_V
#undef PG8_WAIT_L
#undef PG8_BAR
#undef PG8_SCHED
}
}
#ifndef MK_P5PROBE
#define MK_P5PROBE 0
#endif
#ifndef MK_HOOKPROBE
#define MK_HOOKPROBE 0
#endif
typedef unsigned v4u __attribute__((ext_vector_type(4)));
typedef unsigned v2u __attribute__((ext_vector_type(2)));
typedef float f32x4 __attribute__((ext_vector_type(4)));
typedef float f32x16 __attribute__((ext_vector_type(16)));
typedef short bf16x8 __attribute__((ext_vector_type(8)));
#define LDS_WAIT() asm volatile("s_waitcnt lgkmcnt(0)" ::: "memory")
#define VM_WAIT() asm volatile("s_waitcnt vmcnt(0)" ::: "memory")
__device__ __forceinline__ unsigned pk2(float lo, float hi) { return pg8::cvt_pk_bf16(lo, hi); }
__device__ __forceinline__ bf16 f2bf_hw(float x) { return (bf16)(pk2(x, 0.f) & 0xffffu); }
__device__ __forceinline__ float wave_sum(float v) {
#pragma unroll
    for (int o = 1; o < 64; o <<= 1) v += __shfl_xor(v, o);
    return v;
}

__device__ __forceinline__ float bflo(unsigned w) { return __uint_as_float(w << 16); }
__device__ __forceinline__ float bfhi(unsigned w) { return __uint_as_float(w & 0xffff0000u); }
#define MFMA32(a, b, c) __builtin_amdgcn_mfma_f32_32x32x16_bf16((a), (b), (c), 0, 0, 0)
typedef float f32x2 __attribute__((ext_vector_type(2)));
__device__ __forceinline__ f32x2 sq16(const f32x16& a, f32x2 s) {
#pragma unroll
    for (int r = 0; r < 16; r += 2) { const f32x2 p = {a[r], a[r + 1]}; s += p * p; }
    return s;
}

__device__ __forceinline__ void pool_unit(const bf16* __restrict__ P, bf16* __restrict__ BR, int unit, int tid) {
    asm volatile("" : "+v"(tid));
    const int tr = tid >> 6, tc = tid & 63, g = tc >> 4, w = 2 << g;
#pragma unroll 1
    for (int rr = 0; rr < 8; ++rr) {
        const int row = unit * 64 + rr * 8 + tr, s = row & (S - 1), n = (s + 1 < w) ? s + 1 : w;
        const bf16* p = P + (size_t)row * INP + C_POOL + 8 * tc;
        float a[8];
#pragma unroll
        for (int q = 0; q < 8; ++q) a[q] = 0.f;
        v4u wv[16];
#pragma unroll
        for (int j = 0; j < 16; ++j) wv[j] = (j < n) ? *(const GAS v4u*)(p - (size_t)j * INP) : (v4u){0u, 0u, 0u, 0u};
        const v4u u0 = wv[0];
#pragma unroll
        for (int j = 0; j < 16; ++j) { const v4u v = wv[j];
            a[0] += bflo(v.x); a[1] += bfhi(v.x); a[2] += bflo(v.y); a[3] += bfhi(v.y); a[4] += bflo(v.z); a[5] += bfhi(v.z); a[6] += bflo(v.w); a[7] += bfhi(v.w); }
        const float inv = __builtin_amdgcn_rcpf((float)n);
        v4u o; o.x = pk2(a[0] * inv - bflo(u0.x), a[1] * inv - bfhi(u0.x)); o.y = pk2(a[2] * inv - bflo(u0.y), a[3] * inv - bfhi(u0.y));
        o.z = pk2(a[4] * inv - bflo(u0.z), a[5] * inv - bfhi(u0.z)); o.w = pk2(a[6] * inv - bflo(u0.w), a[7] * inv - bfhi(u0.w));
        *(GAS v4u*)(BR + (size_t)row * 1536 + 1024 + 8 * tc) = o;
    }
}

constexpr int MLA_QS = 784, MLA_KS = 528;
__device__ __forceinline__ void mla_unit(const bf16* __restrict__ P, const float* __restrict__ qlat_g, const float* __restrict__ kvlat_g, const bf16* __restrict__ WuqT, const bf16* __restrict__ WukvT,
                                         const float* __restrict__ qn_g, const float* __restrict__ kn_g, const float* __restrict__ rope, bf16* __restrict__ Q, bf16* __restrict__ K, bf16* __restrict__ VT,
                                         LAS unsigned char* lds, int unit, int lane, int wave) {
    asm volatile("" : "+v"(lane));
    LAS unsigned char* qn = lds; LAS unsigned char* kvn = lds + 64 * MLA_QS;
    const int t0 = unit * 64;
#pragma unroll 1
    for (int rb = 0; rb < 2; ++rb) {
        unsigned qv[4][3], kv[4][2];
#pragma unroll
        for (int rr = 0; rr < 4; ++rr) { const bf16* pr = P + (size_t)(t0 + wave * 8 + rb * 4 + rr) * INP;
#pragma unroll
            for (int j = 0; j < 3; ++j) qv[rr][j] = *(const GAS unsigned*)(pr + C_QLAT + 2 * lane + 128 * j);
#pragma unroll
            for (int j = 0; j < 2; ++j) kv[rr][j] = *(const GAS unsigned*)(pr + C_KVLAT + 2 * lane + 128 * j); }
#pragma unroll
        for (int rr = 0; rr < 4; ++rr) {
            const int lr = wave * 8 + rb * 4 + rr; float s1 = 0.f, s2 = 0.f;
#pragma unroll
            for (int j = 0; j < 3; ++j) s1 += bflo(qv[rr][j]) * bflo(qv[rr][j]) + bfhi(qv[rr][j]) * bfhi(qv[rr][j]);
#pragma unroll
            for (int j = 0; j < 2; ++j) s2 += bflo(kv[rr][j]) * bflo(kv[rr][j]) + bfhi(kv[rr][j]) * bfhi(kv[rr][j]);
            s1 = wave_sum(s1); s2 = wave_sum(s2);
            const float r1 = rsqrtf(s1 * (1.f / 384.f) + EPS), r2 = rsqrtf(s2 * (1.f / 256.f) + EPS);
#pragma unroll
            for (int j = 0; j < 3; ++j) { const int c = 2 * lane + 128 * j; *(LAS unsigned*)(qn + lr * MLA_QS + c * 2) = pk2(bflo(qv[rr][j]) * r1 * qlat_g[c], bfhi(qv[rr][j]) * r1 * qlat_g[c + 1]); }
#pragma unroll
            for (int j = 0; j < 2; ++j) { const int c = 2 * lane + 128 * j; *(LAS unsigned*)(kvn + lr * MLA_KS + c * 2) = pk2(bflo(kv[rr][j]) * r2 * kvlat_g[c], bfhi(kv[rr][j]) * r2 * kvlat_g[c + 1]); }
        }
    }
    __syncthreads();
    const int l31 = lane & 31, h5 = lane >> 5;
    {
        f32x16 acc[3][2];
#pragma unroll
        for (int mt = 0; mt < 3; ++mt)
#pragma unroll
            for (int nt = 0; nt < 2; ++nt)
#pragma unroll
                for (int r = 0; r < 16; ++r) acc[mt][nt][r] = 0.f;
        const bf16* wp = WuqT + (size_t)(wave * 96 + l31) * 384 + 8 * h5;
        bf16x8 ar[4][3];
#pragma unroll
        for (int p = 0; p < 3; ++p)
#pragma unroll
            for (int mt = 0; mt < 3; ++mt) ar[p][mt] = *(const GAS bf16x8*)(wp + (size_t)mt * 32 * 384 + 16 * p);
#pragma unroll
        for (int ks = 0; ks < 24; ++ks) {
            if (ks + 3 < 24) {
#pragma unroll
                for (int mt = 0; mt < 3; ++mt) ar[(ks + 3) & 3][mt] = *(const GAS bf16x8*)(wp + (size_t)mt * 32 * 384 + 16 * (ks + 3)); }
            bf16x8 b[2];
#pragma unroll
            for (int nt = 0; nt < 2; ++nt) b[nt] = *(const LAS bf16x8*)(qn + (32 * nt + l31) * MLA_QS + (16 * ks + 8 * h5) * 2);
#pragma unroll
            for (int mt = 0; mt < 3; ++mt)
#pragma unroll
                for (int nt = 0; nt < 2; ++nt) acc[mt][nt] = MFMA32(ar[ks & 3][mt], b[nt], acc[mt][nt]);
        }
#pragma unroll
        for (int nt = 0; nt < 2; ++nt) {
            const int tok = t0 + 32 * nt + l31, b = tok / S, s = tok & (S - 1);
            f32x2 s2 = {0.f, 0.f};
#pragma unroll
            for (int mt = 0; mt < 3; ++mt) s2 = sq16(acc[mt][nt], s2);
            float ss = s2.x + s2.y;
            ss += __shfl_xor(ss, 32);
            const float rstd = rsqrtf(ss * (1.f / 96.f) + EPS);
            bf16* qo = Q + ((size_t)(b * MH + wave) * S + s) * 96;
#pragma unroll
            for (int mt = 0; mt < 2; ++mt)
#pragma unroll
                for (int g = 0; g < 4; ++g) { const int d0 = 32 * mt + 8 * g + 4 * h5; const f32x4 gn = *(const GAS f32x4*)(qn_g + d0);
                    v2u o; o.x = pk2(acc[mt][nt][4 * g] * rstd * gn[0], acc[mt][nt][4 * g + 1] * rstd * gn[1]); o.y = pk2(acc[mt][nt][4 * g + 2] * rstd * gn[2], acc[mt][nt][4 * g + 3] * rstd * gn[3]);
                    *(GAS v2u*)(qo + d0) = o; }
#pragma unroll
            for (int g = 0; g < 2; ++g) { const int i0 = 8 * g + 4 * h5;
                const f32x4 cs = *(const GAS f32x4*)(rope + (size_t)tok * 16 + i0), sn = *(const GAS f32x4*)(rope + (size_t)NT * 16 + (size_t)tok * 16 + i0);
                const f32x4 g1 = *(const GAS f32x4*)(qn_g + 64 + i0), g2 = *(const GAS f32x4*)(qn_g + 80 + i0);
                float o1[4], o2[4];
#pragma unroll
                for (int j = 0; j < 4; ++j) { const float x1 = acc[2][nt][4 * g + j] * rstd * g1[j], x2 = acc[2][nt][8 + 4 * g + j] * rstd * g2[j]; o1[j] = x1 * cs[j] - x2 * sn[j]; o2[j] = x2 * cs[j] + x1 * sn[j]; }
                v2u w1, w2; w1.x = pk2(o1[0], o1[1]); w1.y = pk2(o1[2], o1[3]); w2.x = pk2(o2[0], o2[1]); w2.y = pk2(o2[2], o2[3]);
                *(GAS v2u*)(qo + 64 + i0) = w1; *(GAS v2u*)(qo + 80 + i0) = w2; }
        }
    }
#pragma unroll 1
    for (int pass = 0; pass < 2; ++pass) {
        f32x16 acc[2][2];
#pragma unroll
        for (int mt = 0; mt < 2; ++mt)
#pragma unroll
            for (int nt = 0; nt < 2; ++nt)
#pragma unroll
                for (int r = 0; r < 16; ++r) acc[mt][nt][r] = 0.f;
        const bf16* wp = WukvT + (size_t)(wave * 128 + pass * 64 + l31) * 256 + 8 * h5;
        bf16x8 ar[4][2];
#pragma unroll
        for (int p = 0; p < 3; ++p)
#pragma unroll
            for (int mt = 0; mt < 2; ++mt) ar[p][mt] = *(const GAS bf16x8*)(wp + (size_t)mt * 32 * 256 + 16 * p);
#pragma unroll
        for (int ks = 0; ks < 16; ++ks) {
            if (ks + 3 < 16) {
#pragma unroll
                for (int mt = 0; mt < 2; ++mt) ar[(ks + 3) & 3][mt] = *(const GAS bf16x8*)(wp + (size_t)mt * 32 * 256 + 16 * (ks + 3)); }
            bf16x8 b[2];
#pragma unroll
            for (int nt = 0; nt < 2; ++nt) b[nt] = *(const LAS bf16x8*)(kvn + (32 * nt + l31) * MLA_KS + (16 * ks + 8 * h5) * 2);
#pragma unroll
            for (int mt = 0; mt < 2; ++mt)
#pragma unroll
                for (int nt = 0; nt < 2; ++nt) acc[mt][nt] = MFMA32(ar[ks & 3][mt], b[nt], acc[mt][nt]);
        }
        if (pass == 0) {
#pragma unroll
          for (int nt = 0; nt < 2; ++nt) {
            const int tok = t0 + 32 * nt + l31, b = tok / S, s = tok & (S - 1);
            float kr[16];
#pragma unroll
            for (int g = 0; g < 4; ++g) { const v2u kv = *(const GAS v2u*)(P + (size_t)tok * INP + C_KROPE + 8 * g + 4 * h5); kr[4 * g] = bflo(kv.x); kr[4 * g + 1] = bfhi(kv.x); kr[4 * g + 2] = bflo(kv.y); kr[4 * g + 3] = bfhi(kv.y); }
            f32x2 s2 = {0.f, 0.f};
#pragma unroll
            for (int mt = 0; mt < 2; ++mt) s2 = sq16(acc[mt][nt], s2);
            float ss = s2.x + s2.y;
#pragma unroll
            for (int r = 0; r < 16; ++r) ss += kr[r] * kr[r];
            ss += __shfl_xor(ss, 32);
            const float rstd = rsqrtf(ss * (1.f / 96.f) + EPS);
            bf16* ko = K + ((size_t)(b * MH + wave) * S + s) * 96;
#pragma unroll
            for (int mt = 0; mt < 2; ++mt)
#pragma unroll
                for (int g = 0; g < 4; ++g) { const int d0 = 32 * mt + 8 * g + 4 * h5; const f32x4 gn = *(const GAS f32x4*)(kn_g + d0);
                    v2u o; o.x = pk2(acc[mt][nt][4 * g] * rstd * gn[0], acc[mt][nt][4 * g + 1] * rstd * gn[1]); o.y = pk2(acc[mt][nt][4 * g + 2] * rstd * gn[2], acc[mt][nt][4 * g + 3] * rstd * gn[3]);
                    *(GAS v2u*)(ko + d0) = o; }
#pragma unroll
            for (int g = 0; g < 4; ++g) { const f32x4 gn = *(const GAS f32x4*)(kn_g + 64 + 8 * g + 4 * h5);
#pragma unroll
                for (int j = 0; j < 4; ++j) kr[4 * g + j] *= rstd * gn[j]; }
#pragma unroll
            for (int g = 0; g < 2; ++g) { const f32x4 cs = *(const GAS f32x4*)(rope + (size_t)tok * 16 + 8 * g + 4 * h5), sn = *(const GAS f32x4*)(rope + (size_t)NT * 16 + (size_t)tok * 16 + 8 * g + 4 * h5);
                float o1[4], o2[4];
#pragma unroll
                for (int j = 0; j < 4; ++j) { const float x1 = kr[4 * g + j], x2 = kr[8 + 4 * g + j]; o1[j] = x1 * cs[j] - x2 * sn[j]; o2[j] = x2 * cs[j] + x1 * sn[j]; }
                v2u w1, w2; w1.x = pk2(o1[0], o1[1]); w1.y = pk2(o1[2], o1[3]); w2.x = pk2(o2[0], o2[1]); w2.y = pk2(o2[2], o2[3]);
                *(GAS v2u*)(ko + 64 + 8 * g + 4 * h5) = w1; *(GAS v2u*)(ko + 80 + 8 * g + 4 * h5) = w2; }
          }
        } else {
#pragma unroll
          for (int nt = 0; nt < 2; ++nt) {
            int hq = h5; asm volatile("" : "+v"(hq));
            const int tok = t0 + 32 * nt + l31, b = tok / S, s = tok & (S - 1);
            bf16* vo = VT + ((size_t)(b * MH + wave) * 64 + 4 * hq) * S + s;
#pragma unroll
            for (int mt = 0; mt < 2; ++mt)
#pragma unroll
                for (int r = 0; r < 16; ++r) { const int dv = 32 * mt + (r & 3) + 8 * (r >> 2); vo[(size_t)dv * S] = f2bf_hw(acc[mt][nt][r]); }
          }
        }
    }
    __syncthreads();
}

constexpr int AT_KS = 208, AT_VS = 136;
constexpr int AT_KB = 64 * AT_KS, AT_VB = 64 * AT_VS;
constexpr float AT_C = 0.10206207261596575f * 1.4426950408889634f;
__device__ __forceinline__ void attn_unit(const bf16* __restrict__ Q, const bf16* __restrict__ K, const bf16* __restrict__ VT, bf16* __restrict__ BR, LAS unsigned char* lds, int bh, int qb, int tid, int lane, int wave) {
    asm volatile("" : "+v"(lane), "+v"(tid));
    const int l31 = lane & 31, h5 = lane >> 5;
    const int qw0 = 256 * qb + 32 * wave, ntile = 4 * qb + 4, mytiles = 4 * qb + (wave >> 1) + 1;
    const bf16* Kg = K + (size_t)bh * S * 96; const bf16* Vg = VT + (size_t)bh * 64 * S;
    LAS unsigned char* kbuf = lds; LAS unsigned char* vbuf = lds + 2 * AT_KB;
    bf16x8 qf[6];
    { const bf16* qp = Q + ((size_t)bh * S + qw0 + l31) * 96 + 8 * h5;
#pragma unroll
      for (int ks = 0; ks < 6; ++ks) qf[ks] = *(const GAS bf16x8*)(qp + 16 * ks); }
    f32x16 o[2];
#pragma unroll
    for (int r = 0; r < 16; ++r) { o[0][r] = 0.f; o[1][r] = 0.f; }
    float mrow = -INFINITY, lrow = 0.f;
    const int kc0 = tid, kc1 = tid + 512; const bool k1 = kc1 < 768;
    const unsigned kl0 = (unsigned)((kc0 / 12) * AT_KS + (kc0 % 12) * 16), kl1 = (unsigned)((kc1 / 12) * AT_KS + (kc1 % 12) * 16), vl = (unsigned)((tid >> 3) * AT_VS + (tid & 7) * 16);
    v4u sk0, sk1 = (v4u){0u, 0u, 0u, 0u}, sv;
#define AT_GLOADK(j) do { const bf16* kp = Kg + (size_t)(j) * 64 * 96; sk0 = *(const GAS v4u*)(kp + (size_t)kc0 * 8); if (k1) sk1 = *(const GAS v4u*)(kp + (size_t)kc1 * 8); } while (0)
#define AT_GLOADV(j) do { sv = *(const GAS v4u*)(Vg + (size_t)(tid >> 3) * S + (size_t)(j) * 64 + (tid & 7) * 8); } while (0)
#define AT_LSTOREK(buf) do { LAS unsigned char* kb = kbuf + (buf) * AT_KB; *(LAS v4u*)(kb + kl0) = sk0; if (k1) *(LAS v4u*)(kb + kl1) = sk1; } while (0)
#define AT_LSTOREV(buf) do { LAS unsigned char* vb = vbuf + (buf) * AT_VB + vl; *(LAS v2u*)(vb) = (v2u){sv.x, sv.y}; *(LAS v2u*)(vb + 8) = (v2u){sv.z, sv.w}; } while (0)
#define AT_QK(dst, buf) do { const LAS unsigned char* kb = kbuf + (buf) * AT_KB; _Pragma("unroll") for (int kt = 0; kt < 2; ++kt) { _Pragma("unroll") for (int r = 0; r < 16; ++r) dst[kt][r] = 0.f; \
        _Pragma("unroll") for (int ks = 0; ks < 6; ++ks) { const bf16x8 kf = *(const LAS bf16x8*)(kb + (32 * kt + l31) * AT_KS + (16 * ks + 8 * h5) * 2); dst[kt] = MFMA32(kf, qf[ks], dst[kt]); } } } while (0)
    AT_GLOADK(0); AT_GLOADV(0); AT_LSTOREK(0); AT_LSTOREV(0);
    AT_GLOADK(1); AT_LSTOREK(1);
    __syncthreads();
    f32x16 sa[2], sb[2];
    AT_QK(sa, 0);
    __syncthreads();
#define AT_BODY(SC, SN, J) do { const int j = (J); \
        if (j + 2 < ntile) AT_GLOADK(j + 2); \
        if (j + 1 < ntile) AT_GLOADV(j + 1); \
        if (j + 1 < mytiles) AT_QK(SN, (j + 1) & 1); \
        if (j < mytiles) { \
            const LAS unsigned char* vb = vbuf + (j & 1) * AT_VB; \
            if (j == mytiles - 1) { const int qq = qw0 + l31 - 64 * j; asm volatile("; diagonal tile" ::: "memory");     \
                _Pragma("unroll") for (int kt = 0; kt < 2; ++kt) _Pragma("unroll") for (int r = 0; r < 16; ++r) { const int kk = 32 * kt + (r & 3) + 8 * (r >> 2) + 4 * h5; if (kk > qq) SC[kt][r] = -INFINITY; } } \
            float mx = SC[0][0]; \
            _Pragma("unroll") for (int kt = 0; kt < 2; ++kt) _Pragma("unroll") for (int r = 0; r < 16; ++r) mx = fmaxf(mx, SC[kt][r]); \
            mx = fmaxf(mx, __shfl_xor(mx, 32)); \
            const float mnew = fmaxf(mrow, mx * AT_C), alpha = __builtin_amdgcn_exp2f(mrow - mnew); \
            mrow = mnew; \
            f32x2 ls2 = {0.f, 0.f}; const f32x2 c2 = {AT_C, AT_C}, m2 = {mnew, mnew}; \
            _Pragma("unroll") for (int kt = 0; kt < 2; ++kt) _Pragma("unroll") for (int r = 0; r < 16; r += 2) { f32x2 x = {SC[kt][r], SC[kt][r + 1]}; x = x * c2 - m2; \
                f32x2 pp; pp.x = __builtin_amdgcn_exp2f(x.x); pp.y = __builtin_amdgcn_exp2f(x.y); SC[kt][r] = pp.x; SC[kt][r + 1] = pp.y; ls2 += pp; } \
            lrow = lrow * alpha + (ls2.x + ls2.y); \
            _Pragma("unroll") for (int r = 0; r < 16; ++r) { o[0][r] *= alpha; o[1][r] *= alpha; } \
            _Pragma("unroll") for (int kt = 0; kt < 2; ++kt) _Pragma("unroll") for (int s2 = 0; s2 < 2; ++s2) { \
                union { bf16x8 v; unsigned u[4]; } pf; \
                _Pragma("unroll") for (int q = 0; q < 4; ++q) pf.u[q] = pk2(SC[kt][8 * s2 + 2 * q], SC[kt][8 * s2 + 2 * q + 1]); \
                _Pragma("unroll") for (int dvt = 0; dvt < 2; ++dvt) { union { bf16x8 v; v2u h[2]; } vf; \
                    const LAS unsigned char* vp = vb + (32 * dvt + l31) * AT_VS + (32 * kt + 16 * s2 + 4 * h5) * 2; \
                    vf.h[0] = *(const LAS v2u*)(vp); vf.h[1] = *(const LAS v2u*)(vp + 16); \
                    o[dvt] = MFMA32(vf.v, pf.v, o[dvt]); } } \
        } \
        if (j + 2 < ntile) AT_LSTOREK(j & 1); \
        if (j + 1 < ntile) AT_LSTOREV((j + 1) & 1); \
        __syncthreads(); } while (0)
#pragma unroll 1
    for (int jj = 0; jj < ntile; jj += 2) { AT_BODY(sa, sb, jj); AT_BODY(sb, sa, jj + 1); }
#undef AT_BODY
#undef AT_GLOADK
#undef AT_GLOADV
#undef AT_LSTOREK
#undef AT_LSTOREV
#undef AT_QK
    lrow += __shfl_xor(lrow, 32);
    const float inv = __builtin_amdgcn_rcpf(lrow);
    const int b = bh >> 3, h = bh & 7;
    bf16* op = BR + (size_t)(b * S + qw0 + l31) * 1536 + 512 + h * 64;
#pragma unroll
    for (int dvt = 0; dvt < 2; ++dvt)
#pragma unroll
        for (int g = 0; g < 4; ++g) { v2u w; w.x = pk2(o[dvt][4 * g] * inv, o[dvt][4 * g + 1] * inv); w.y = pk2(o[dvt][4 * g + 2] * inv, o[dvt][4 * g + 3] * inv);
            *(GAS v2u*)(op + 32 * dvt + 8 * g + 4 * h5) = w; }
}
#define MFMA16(a, b, c) __builtin_amdgcn_mfma_f32_16x16x32_bf16((a), (b), (c), 0, 0, 0)
constexpr int HG_VS = 144;
constexpr int HG_QS = 272;
__device__ __forceinline__ void hgrn_gate(float z, float lbv, float l1, float l2, float& lf, float& kv) {
    const float e = __expf(-fabsf(z)), ls = fminf(z, 0.f) - __logf(1.f + e);
    const float rc = __builtin_amdgcn_rcpf(1.f + e), sg = (z >= 0.f) ? rc : e * rc;
    kv = (1.f - lbv) * (1.f - sg);
    const float a = l1 + ls;
    if (lbv > 0.f) { const float mx = fmaxf(a, l2), dd = -fabsf(a - l2); lf = mx + __logf(1.f + __expf(dd)); } else lf = a;
}
struct HgA { unsigned zz[8]; unsigned vp[8]; };
__device__ __forceinline__ void hgrn_a_load(const bf16* __restrict__ P, int unit, int tid, HgA& r) {
    asm volatile("" : "+v"(tid));
    const int bh = unit >> 5, c = unit & 31, b = bh >> 2, h = bh & 3, tok0 = b * S + c * 64, d = tid & 127, seg = tid >> 7;
    const bf16* pz = P + (size_t)(tok0 + seg * 16) * INP + C_HF + h * 128 + d;
    const bf16* pv = P + (size_t)(tok0 + seg * 16) * INP + C_HI + h * 128 + d;
#pragma unroll
    for (int t = 0; t < 8; ++t) { r.zz[t] = (unsigned)pz[(size_t)(2 * t) * INP] | ((unsigned)pz[(size_t)(2 * t + 1) * INP] << 16); r.vp[t] = (unsigned)pv[(size_t)(2 * t) * INP] | ((unsigned)pv[(size_t)(2 * t + 1) * INP] << 16); }
}
__device__ __forceinline__ void hgrn_a_compute(const HgA& r, const float* __restrict__ lb, float* __restrict__ SLOC, float* __restrict__ DEC, LAS unsigned char* lds, int unit, int tid, int lane, int wave) {
    asm volatile("" : "+v"(tid), "+v"(lane));
    const int bh = unit >> 5, h = bh & 3;
    LAS float* tot = (LAS float*)lds;
    LAS unsigned char* vT = lds + 2048;
    LAS unsigned char* kT = vT + 128 * HG_VS;
    const int d = tid & 127, seg = tid >> 7;
    const float lbv = lb[h * 128 + d], l1 = __logf(1.f - lbv), l2 = (lbv > 0.f) ? __logf(lbv) : -INFINITY;
    float cs[16], kv[16]; float run = 0.f;
#pragma unroll
    for (int t = 0; t < 16; ++t) { float lf; hgrn_gate((t & 1) ? bfhi(r.zz[t >> 1]) : bflo(r.zz[t >> 1]), lbv, l1, l2, lf, kv[t]); run += lf; cs[t] = run; }
    tot[seg * 128 + d] = run;
#pragma unroll
    for (int t = 0; t < 8; ++t) *(LAS unsigned*)(vT + d * HG_VS + (seg * 16 + 2 * t) * 2) = r.vp[t];
    __syncthreads();
    float off = 0.f, bl = 0.f;
#pragma unroll
    for (int s = 0; s < 4; ++s) { const float tv = tot[s * 128 + d]; bl += tv; if (s < seg) off += tv; }
#pragma unroll
    for (int t = 0; t < 8; ++t) { const float k0 = kv[2 * t] * __expf(bl - (cs[2 * t] + off)), k1 = kv[2 * t + 1] * __expf(bl - (cs[2 * t + 1] + off));
        *(LAS unsigned*)(kT + d * HG_VS + (seg * 16 + 2 * t) * 2) = pk2(k0, k1); }
    if (seg == 0) DEC[(size_t)unit * 128 + d] = __expf(bl);
    __syncthreads();
    const int l31 = lane & 31, h5 = lane >> 5, mt = wave >> 1;
    f32x16 acc[2];
#pragma unroll
    for (int r2 = 0; r2 < 16; ++r2) { acc[0][r2] = 0.f; acc[1][r2] = 0.f; }
#pragma unroll
    for (int ks = 0; ks < 4; ++ks) {
        const bf16x8 a = *(const LAS bf16x8*)(vT + (32 * mt + l31) * HG_VS + (16 * ks + 8 * h5) * 2);
#pragma unroll
        for (int q = 0; q < 2; ++q) { const int nt = 2 * (wave & 1) + q; const bf16x8 bb = *(const LAS bf16x8*)(kT + (32 * nt + l31) * HG_VS + (16 * ks + 8 * h5) * 2); acc[q] = MFMA32(a, bb, acc[q]); }
    }
    float* so = SLOC + (size_t)unit * 16384;
#pragma unroll
    for (int q = 0; q < 2; ++q) { const int nt = 2 * (wave & 1) + q;
#pragma unroll
        for (int r2 = 0; r2 < 16; ++r2) { const int v = 32 * mt + (r2 & 3) + 8 * (r2 >> 2) + 4 * h5; so[(size_t)v * 128 + 32 * nt + l31] = acc[q][r2]; } }
    __syncthreads();
}
__device__ __forceinline__ void hgrn_a_all(const bf16* __restrict__ P, const float* __restrict__ lb, float* __restrict__ SLOC, float* __restrict__ DEC, LAS unsigned char* lds, int bx, int G, int tid, int lane, int wave) {
    HgA ra, rb; int u = bx;
    if (u < 1024) hgrn_a_load(P, u, tid, ra);
    while (u < 1024) {
        const int u2 = u + G, u3 = u2 + G;
        if (u2 < 1024) hgrn_a_load(P, u2, tid, rb);
        hgrn_a_compute(ra, lb, SLOC, DEC, lds, u, tid, lane, wave);
        if (u2 >= 1024) break;
        if (u3 < 1024) hgrn_a_load(P, u3, tid, ra);
        hgrn_a_compute(rb, lb, SLOC, DEC, lds, u2, tid, lane, wave);
        u = u3;
    }
}
__device__ __forceinline__ void hgrn_scan_unit(const float* __restrict__ SLOC, const float* __restrict__ DEC, bf16* __restrict__ ST, int unit, int tid) {
    asm volatile("" : "+v"(tid));
    const int bh = unit >> 3, idx = (unit & 7) * 2048 + tid * 4, d = idx & 127;
    f32x4 st = {0.f, 0.f, 0.f, 0.f};
    const float* sp = SLOC + (size_t)bh * 32 * 16384 + idx; const float* dp = DEC + (size_t)bh * 32 * 128 + d; bf16* op = ST + (size_t)bh * 32 * 16384 + idx;
#pragma unroll 1
    for (int cb = 0; cb < 32; cb += 16) {
        f32x4 sl[16], dc[16];
#pragma unroll
        for (int c = 0; c < 16; ++c) { sl[c] = *(const GAS f32x4*)(sp + (size_t)(cb + c) * 16384); dc[c] = *(const GAS f32x4*)(dp + (cb + c) * 128); }
#pragma unroll
        for (int c = 0; c < 16; ++c) {
            v2u o; o.x = pk2(st[0], st[1]); o.y = pk2(st[2], st[3]);
            *(GAS v2u*)(op + (size_t)(cb + c) * 16384) = o;
            st = dc[c] * st + sl[c];
        }
    }
}
__device__ __forceinline__ void hgrn_c_unit(const bf16* __restrict__ P, const float* __restrict__ lb, const bf16* __restrict__ ST, const float* __restrict__ og, bf16* __restrict__ BR, LAS unsigned char* lds, int unit, int tid, int lane, int wave) {
    asm volatile("" : "+v"(tid), "+v"(lane));
    const int bh = unit >> 5, c = unit & 31, b = bh >> 2, h = bh & 3, tok0 = b * S + c * 64;
    LAS float* bcum = (LAS float*)lds;
    LAS unsigned char* q0 = lds + 32768;
    LAS unsigned char* qi = q0 + 64 * HG_QS;
    LAS unsigned char* kr = qi + 64 * HG_QS;
    LAS unsigned char* vT = kr + 64 * HG_QS;
    LAS unsigned char* at = vT + 128 * HG_VS;
    LAS float* tot = (LAS float*)(at + 64 * HG_VS);
    LAS float* ob = (LAS float*)lds;
    const int d = tid & 127, seg = tid >> 7;
    const int l31 = lane & 31, h5 = lane >> 5, mtw = wave >> 2, ntw = wave & 3;
    unsigned zq[16], vp[8]; v4u gq0, gq1; bf16x8 stf[8];
    {
        const bf16* pz = P + (size_t)(tok0 + seg * 16) * INP + C_HF + h * 128 + d;
        const bf16* pq = P + (size_t)(tok0 + seg * 16) * INP + C_HQ + h * 128 + d;
        const bf16* pv = P + (size_t)(tok0 + seg * 16) * INP + C_HI + h * 128 + d;
#pragma unroll
        for (int t = 0; t < 16; ++t) zq[t] = (unsigned)pz[(size_t)t * INP] | ((unsigned)pq[(size_t)t * INP] << 16);
#pragma unroll
        for (int t = 0; t < 8; ++t) vp[t] = (unsigned)pv[(size_t)(2 * t) * INP] | ((unsigned)pv[(size_t)(2 * t + 1) * INP] << 16);
        const bf16* pg = P + (size_t)(tok0 + (tid >> 3)) * INP + C_HG + h * 128 + (tid & 7) * 16;
        gq0 = *(const GAS v4u*)pg; gq1 = *(const GAS v4u*)(pg + 8);
        if (c > 0) { const bf16* sp = ST + (size_t)unit * 16384 + (size_t)(32 * ntw + l31) * 128 + 8 * h5;
#pragma unroll
            for (int ks = 0; ks < 8; ++ks) stf[ks] = *(const GAS bf16x8*)(sp + 16 * ks); }
        else {
#pragma unroll
            for (int ks = 0; ks < 8; ++ks) stf[ks] = (bf16x8){0, 0, 0, 0, 0, 0, 0, 0}; }
    }
    {
        const float lbv = lb[h * 128 + d], l1 = __logf(1.f - lbv), l2 = (lbv > 0.f) ? __logf(lbv) : -INFINITY;
        float cs[16], kv[16]; float run = 0.f;
#pragma unroll
        for (int t = 0; t < 16; ++t) { float lf; hgrn_gate(bflo(zq[t]), lbv, l1, l2, lf, kv[t]); run += lf; cs[t] = run; }
        tot[seg * 128 + d] = run;
#pragma unroll
        for (int t = 0; t < 8; ++t) *(LAS unsigned*)(vT + d * HG_VS + (seg * 16 + 2 * t) * 2) = vp[t];
        for (int i = tid; i < 64 * HG_VS / 4; i += 512) ((LAS unsigned*)at)[i] = 0u;
        __syncthreads();
        float off = 0.f;
#pragma unroll
        for (int s = 0; s < 4; ++s) { const float tv = tot[s * 128 + d]; if (s < seg) off += tv; }
#pragma unroll
        for (int t = 0; t < 16; ++t) { const int tt = seg * 16 + t; const float qv = bfhi(zq[t]);
            bcum[tt * 128 + d] = cs[t] + off;
            *(LAS bf16*)(q0 + tt * HG_QS + d * 2) = f2bf_hw(qv * __expf(cs[t] + off));
            *(LAS bf16*)(qi + tt * HG_QS + d * 2) = f2bf_hw(qv * __expf(cs[t]));
            *(LAS bf16*)(kr + tt * HG_QS + d * 2) = f2bf_hw(kv[t]); }
    }
    __syncthreads();
    {
        const int l15 = lane & 15, g4 = lane >> 4;
#pragma unroll 1
        for (int blk = wave; blk < 10; blk += 8) {
            const int i = (blk >= 6) ? 3 : (blk >= 3) ? 2 : (blk >= 1) ? 1 : 0, j = blk - ((i * (i + 1)) >> 1);
            f32x4 acc = {0.f, 0.f, 0.f, 0.f};
#pragma unroll
            for (int ks = 0; ks < 4; ++ks) {
                const int dd = 32 * ks + 8 * g4;
                const bf16x8 a = *(const LAS bf16x8*)(qi + (16 * i + l15) * HG_QS + dd * 2);
                const v4u kw = *(const LAS v4u*)(kr + (16 * j + l15) * HG_QS + dd * 2);
                const f32x4 b0 = *(const LAS f32x4*)(bcum + (16 * j + l15) * 128 + dd), b1 = *(const LAS f32x4*)(bcum + (16 * j + l15) * 128 + dd + 4);
                f32x4 r0 = {0.f, 0.f, 0.f, 0.f}, r1 = {0.f, 0.f, 0.f, 0.f};
                if (i > 0) { r0 = *(const LAS f32x4*)(bcum + (16 * i - 1) * 128 + dd); r1 = *(const LAS f32x4*)(bcum + (16 * i - 1) * 128 + dd + 4); }
                union { bf16x8 v; unsigned u[4]; } kf;
                kf.u[0] = pk2(bflo(kw.x) * __expf(r0[0] - b0[0]), bfhi(kw.x) * __expf(r0[1] - b0[1])); kf.u[1] = pk2(bflo(kw.y) * __expf(r0[2] - b0[2]), bfhi(kw.y) * __expf(r0[3] - b0[3]));
                kf.u[2] = pk2(bflo(kw.z) * __expf(r1[0] - b1[0]), bfhi(kw.z) * __expf(r1[1] - b1[1])); kf.u[3] = pk2(bflo(kw.w) * __expf(r1[2] - b1[2]), bfhi(kw.w) * __expf(r1[3] - b1[3]));
                acc = MFMA16(a, kf.v, acc);
            }
#pragma unroll
            for (int r = 0; r < 4; ++r) { const int tl = 4 * g4 + r; float v = acc[r]; if (i == j && l15 > tl) v = 0.f; *(LAS bf16*)(at + (16 * i + tl) * HG_VS + (16 * j + l15) * 2) = f2bf_hw(v); }
        }
    }
    __syncthreads();
    {
        const int mt = mtw, nt = ntw;
        f32x16 acc;
#pragma unroll
        for (int r = 0; r < 16; ++r) acc[r] = 0.f;
#pragma unroll
        for (int ks = 0; ks < 4; ++ks) { const bf16x8 a = *(const LAS bf16x8*)(at + (32 * mt + l31) * HG_VS + (16 * ks + 8 * h5) * 2), bb = *(const LAS bf16x8*)(vT + (32 * nt + l31) * HG_VS + (16 * ks + 8 * h5) * 2); acc = MFMA32(a, bb, acc); }
        if (c > 0) {
#pragma unroll
            for (int ks = 0; ks < 8; ++ks) { const bf16x8 a = *(const LAS bf16x8*)(q0 + (32 * mt + l31) * HG_QS + (16 * ks + 8 * h5) * 2); acc = MFMA32(a, stf[ks], acc); } }
        __syncthreads();
#pragma unroll
        for (int r = 0; r < 16; ++r) { const int t = 32 * mt + (r & 3) + 8 * (r >> 2) + 4 * h5; ob[t * 132 + 32 * nt + l31] = acc[r]; }
    }
    __syncthreads();
    {
        const int t = tid >> 3, v0 = (tid & 7) * 16;
        f32x4 o4[4]; float ss = 0.f;
#pragma unroll
        for (int q = 0; q < 4; ++q) { o4[q] = *(const LAS f32x4*)(ob + t * 132 + v0 + 4 * q); ss += (o4[q][0] * o4[q][0] + o4[q][1] * o4[q][1]) + (o4[q][2] * o4[q][2] + o4[q][3] * o4[q][3]); }
        ss += __shfl_xor(ss, 1); ss += __shfl_xor(ss, 2); ss += __shfl_xor(ss, 4);
        const float rstd = rsqrtf(ss * (1.f / 128.f) + EPS);
        const v4u g0 = gq0, g1 = gq1;
        float gv[16]; gv[0] = bflo(g0.x); gv[1] = bfhi(g0.x); gv[2] = bflo(g0.y); gv[3] = bfhi(g0.y); gv[4] = bflo(g0.z); gv[5] = bfhi(g0.z); gv[6] = bflo(g0.w); gv[7] = bfhi(g0.w);
        gv[8] = bflo(g1.x); gv[9] = bfhi(g1.x); gv[10] = bflo(g1.y); gv[11] = bfhi(g1.y); gv[12] = bflo(g1.z); gv[13] = bfhi(g1.z); gv[14] = bflo(g1.w); gv[15] = bfhi(g1.w);
        float ov[16];
#pragma unroll
        for (int q = 0; q < 4; ++q) { const f32x4 gn = *(const GAS f32x4*)(og + v0 + 4 * q);
#pragma unroll
            for (int jj = 0; jj < 4; ++jj) { const float gg = gv[4 * q + jj]; ov[4 * q + jj] = o4[q][jj] * rstd * gn[jj] * gg * __builtin_amdgcn_rcpf(1.f + __expf(-gg)); } }
        v4u w0, w1; w0.x = pk2(ov[0], ov[1]); w0.y = pk2(ov[2], ov[3]); w0.z = pk2(ov[4], ov[5]); w0.w = pk2(ov[6], ov[7]); w1.x = pk2(ov[8], ov[9]); w1.y = pk2(ov[10], ov[11]); w1.z = pk2(ov[12], ov[13]); w1.w = pk2(ov[14], ov[15]);
        bf16* po = BR + (size_t)(tok0 + t) * 1536 + h * 128 + v0;
        *(GAS v4u*)po = w0; *(GAS v4u*)(po + 8) = w1;
    }
    __syncthreads();
}
constexpr int NWAVES = 8, NTHR = 512;
constexpr int RING_OFF = 0, RING_BYTES = 131072, LDSCTL_OFF = RING_BYTES, LDS_BYTES = 147456;
constexpr int LW_BAR = 0, LW_TP = 16, LW_CNT = 64, LW_LCNT = 96, LW_BASE = 128, LW_ENTE = 256, LW_ENTW = 512, LW_RANK = 768, LW_BIAS = 1024;
constexpr int CW_Q = 1024, CW_PD = 1088;
constexpr int LW_CONV = 8;
constexpr int CW_BAR = 4096;
constexpr int NPH_L = 10, PH_FINAL = 1 + L * NPH_L, NPH = PH_FINAL + 1;

struct MkArgs { const void* in[28]; float* out; unsigned char* ws; float invf[16]; int ph_lo, ph_hi, li, pad; };
typedef const MkArgs __attribute__((address_space(4))) CMkArgs;
#define KA_PTR(name) CMkArgs* name = (CMkArgs*)__builtin_amdgcn_kernarg_segment_ptr(); asm volatile("" : "+s"(name))

using pg8::Unit; using pg8::u32x4; using pg8::cvt_pk_bf16;
constexpr int GATE_TILE0 = 13;
__device__ __forceinline__ size_t gt_off(int g, int pm, int pn4, int chunk, int tid) { return ((((size_t)(g * 64 + pm) * 4 + pn4) * 16 + chunk) * 512 + tid) * 8; }
struct EpiP {
    static constexpr bool PERM = true; bf16* O; int ldc; bf16* GT;
    __device__ __forceinline__ void prefetch(const Unit&, int, int) const {}
    __device__ __forceinline__ void operator()(const f32x4 (&acc)[2][2][4][2], const Unit& u, int wr, int wc, int fr, int fq) const {
        const int row0 = u.pm * 256 + wr * 64 + fr, col0 = u.pn * 256 + wc * 32 + 8 * fq;
        const bool gate = (GT != nullptr) && u.pn >= GATE_TILE0; const int gi = (u.pn - GATE_TILE0) >> 2, pn4 = (u.pn - GATE_TILE0) & 3, tid = (wr * 4 + wc) * 64 + fq * 16 + fr;
#pragma unroll
        for (int ai = 0; ai < 2; ++ai)
#pragma unroll
            for (int m = 0; m < 4; ++m) { bf16* rowp = O + (size_t)(row0 + ai * 128 + m * 16) * ldc + col0;
#pragma unroll
                for (int bj = 0; bj < 2; ++bj) { f32x4 v0 = acc[ai][bj][m][0], v1 = acc[ai][bj][m][1];
                    u32x4 w; w.x = cvt_pk_bf16(v0[0], v0[1]); w.y = cvt_pk_bf16(v0[2], v0[3]); w.z = cvt_pk_bf16(v1[0], v1[1]); w.w = cvt_pk_bf16(v1[2], v1[3]);
                    if (gate) *(u32x4*)(GT + gt_off(gi, u.pm, pn4, (ai * 4 + m) * 2 + bj, tid)) = w; else *(u32x4*)(rowp + bj * 128) = w; } }
    }
};
struct EpiBranch {
    static constexpr bool PERM = true; const bf16* GT; bf16* MB;
    __device__ __forceinline__ void prefetch(const Unit&, int, int) const {}
    __device__ __forceinline__ static void unpack8(const u32x4 w, float (&g)[8]) { g[0] = __uint_as_float(w.x << 16); g[1] = __uint_as_float(w.x & 0xffff0000u); g[2] = __uint_as_float(w.y << 16); g[3] = __uint_as_float(w.y & 0xffff0000u);
        g[4] = __uint_as_float(w.z << 16); g[5] = __uint_as_float(w.z & 0xffff0000u); g[6] = __uint_as_float(w.w << 16); g[7] = __uint_as_float(w.w & 0xffff0000u); }
    __device__ __forceinline__ static float em(float x) { return __expf(-fminf(fmaxf(x, -30.f), 30.f)); }
    __device__ __forceinline__ void mid(f32x4 (&acc)[2][2][4][2], const Unit& u, int wr, int wc, int fr, int fq, int t) const {
        asm volatile("" : "+v"(fr), "+v"(fq));
        const int gnum = (t == 8) ? 0 : 1, tid = (wr * 4 + wc) * 64 + fq * 16 + fr;
        const bf16* gn0 = GT + gt_off(gnum, u.pm, u.pn, 0, tid); const bf16* gd0 = GT + gt_off(gnum + 1, u.pm, u.pn, 0, tid);
#pragma unroll
        for (int ai = 0; ai < 2; ++ai)
#pragma unroll
            for (int m = 0; m < 4; ++m)
#pragma unroll
                for (int bj = 0; bj < 2; ++bj) { const int ch = (ai * 4 + m) * 2 + bj; float gn[8], gd[8]; unpack8(*(const u32x4*)(gn0 + (size_t)ch * 4096), gn); unpack8(*(const u32x4*)(gd0 + (size_t)ch * 4096), gd);
#pragma unroll
                    for (int j = 0; j < 4; ++j) { acc[ai][bj][m][0][j] *= (1.f + em(gd[j])) * __builtin_amdgcn_rcpf(1.f + em(gn[j])); acc[ai][bj][m][1][j] *= (1.f + em(gd[4 + j])) * __builtin_amdgcn_rcpf(1.f + em(gn[4 + j])); } }
    }
    __device__ __forceinline__ void operator()(const f32x4 (&acc)[2][2][4][2], const Unit& u, int wr, int wc, int fr, int fq) const {
        const int row0 = u.pm * 256 + wr * 64 + fr, col0 = u.pn * 256 + wc * 32 + 8 * fq, tid = (wr * 4 + wc) * 64 + fq * 16 + fr;
        const bf16* gc0 = GT + gt_off(2, u.pm, u.pn, 0, tid);
#pragma unroll
        for (int ai = 0; ai < 2; ++ai)
#pragma unroll
            for (int m = 0; m < 4; ++m) { const size_t row = (size_t)(row0 + ai * 128 + m * 16);
#pragma unroll
                for (int bj = 0; bj < 2; ++bj) { const int col = col0 + bj * 128; float gc[8]; unpack8(*(const u32x4*)(gc0 + (size_t)((ai * 4 + m) * 2 + bj) * 4096), gc);
                    f32x4 v0 = acc[ai][bj][m][0], v1 = acc[ai][bj][m][1];
#pragma unroll
                    for (int j = 0; j < 4; ++j) { v0[j] *= __builtin_amdgcn_rcpf(1.f + em(gc[j])); v1[j] *= __builtin_amdgcn_rcpf(1.f + em(gc[4 + j])); }
                    u32x4 w; w.x = cvt_pk_bf16(v0[0], v0[1]); w.y = cvt_pk_bf16(v0[2], v0[3]); w.z = cvt_pk_bf16(v1[0], v1[1]); w.w = cvt_pk_bf16(v1[2], v1[3]); *(u32x4*)(MB + row * 1024 + col) = w; } }
    }
};
struct EpiOut {
    static constexpr bool PERM = false; const float* xin; const float* gvec; float* out;
    __device__ __forceinline__ void prefetch(const Unit&, int, int) const {}
    __device__ __forceinline__ void operator()(const f32x4 (&acc)[2][2][4][2], const Unit& u, int wr, int wc, int fr, int fq) const {
        const int row0 = u.pm * 256 + wr * 64 + fr, col0 = u.pn * 256 + wc * 32 + 4 * fq;
#pragma unroll
        for (int ai = 0; ai < 2; ++ai)
#pragma unroll
            for (int m = 0; m < 4; ++m) { const size_t row = (size_t)(row0 + ai * 128 + m * 16); const int b = (int)(row / S);
#pragma unroll
                for (int bj = 0; bj < 2; ++bj)
#pragma unroll
                    for (int n = 0; n < 2; ++n) { const int col = col0 + bj * 128 + 16 * n;
                        const f32x4 xv = *(const f32x4*)(xin + row * 1024 + col), gv = *(const f32x4*)(gvec + b * 6144 + col);
                        *(f32x4*)(out + row * 1024 + col) = xv + gv * acc[ai][bj][m][n]; } }
    }
};
struct EpiMoe1 {
    static constexpr bool PERM = true; const float* b1; bf16* ACT; LAS float* bl;
    typedef float f2 __attribute__((ext_vector_type(2)));
    __device__ __forceinline__ void prefetch(const Unit& u, int wid, int lane) const {
        if (wid < 4) { const float* src = b1 + u.e * 2048 + (wid >> 1) * 1024 + u.aux * 128 + (wid & 1) * 64 + lane;
            __builtin_amdgcn_global_load_lds((const unsigned*)src, (LAS unsigned*)(bl + wid * 64), 4, 0, 0); } }
    __device__ __forceinline__ static f2 act2(f2 g, f2 l) {
        const f2 c7 = {7.f, 7.f}, cm7 = {-7.f, -7.f}, one = {1.f, 1.f}, ck = {-1.702f * 1.4426950408889634f, -1.702f * 1.4426950408889634f};
        g = __builtin_elementwise_min(g, c7); l = __builtin_elementwise_min(__builtin_elementwise_max(l, cm7), c7);
        const f2 x = g * ck; f2 ex; ex.x = __builtin_amdgcn_exp2f(x.x); ex.y = __builtin_amdgcn_exp2f(x.y);
        const f2 d = ex + one; f2 r; r.x = __builtin_amdgcn_rcpf(d.x); r.y = __builtin_amdgcn_rcpf(d.y);
        return (g * r) * (l + one);
    }
    __device__ __forceinline__ void operator()(const f32x4 (&acc)[2][2][4][2], const Unit& u, int wr, int wc, int fr, int fq) const {
        const int row0 = u.pm * 256 + wr * 64 + fr, lc = wc * 32 + 8 * fq, ccol = u.aux * 128 + lc;
        const f32x4 bg0 = *(const LAS f32x4*)(bl + lc), bg1 = *(const LAS f32x4*)(bl + lc + 4), bl0 = *(const LAS f32x4*)(bl + 128 + lc), bl1 = *(const LAS f32x4*)(bl + 128 + lc + 4);
#pragma unroll
        for (int ai = 0; ai < 2; ++ai)
#pragma unroll
            for (int m = 0; m < 4; ++m) { const size_t row = (size_t)(row0 + ai * 128 + m * 16);
                const f32x4 g0 = acc[ai][0][m][0] + bg0, g1 = acc[ai][0][m][1] + bg1, l0 = acc[ai][1][m][0] + bl0, l1 = acc[ai][1][m][1] + bl1;
                const f2 o0 = act2((f2){g0[0], g0[1]}, (f2){l0[0], l0[1]}), o1 = act2((f2){g0[2], g0[3]}, (f2){l0[2], l0[3]}), o2 = act2((f2){g1[0], g1[1]}, (f2){l1[0], l1[1]}), o3 = act2((f2){g1[2], g1[3]}, (f2){l1[2], l1[3]});
                u32x4 w; w.x = cvt_pk_bf16(o0.x, o0.y); w.y = cvt_pk_bf16(o1.x, o1.y); w.z = cvt_pk_bf16(o2.x, o2.y); w.w = cvt_pk_bf16(o3.x, o3.y);
                *(u32x4*)(ACT + row * 1024 + ccol) = w; }
    }
};
struct EpiMoe2 {
    static constexpr bool PERM = true; const float* b2; bf16* EO; LAS float* bl;
    __device__ __forceinline__ void prefetch(const Unit& u, int wid, int lane) const {
        if (wid < 4) __builtin_amdgcn_global_load_lds((const unsigned*)(b2 + u.e * 1024 + u.aux * 256 + wid * 64 + lane), (LAS unsigned*)(bl + wid * 64), 4, 0, 0); }
    __device__ __forceinline__ void operator()(const f32x4 (&acc)[2][2][4][2], const Unit& u, int wr, int wc, int fr, int fq) const {
        const int row0 = u.pm * 256 + wr * 64 + fr, lc = wc * 32 + 8 * fq, col0 = u.aux * 256 + lc;
        f32x4 bv[2][2];
#pragma unroll
        for (int bj = 0; bj < 2; ++bj) { bv[bj][0] = *(const LAS f32x4*)(bl + lc + bj * 128); bv[bj][1] = *(const LAS f32x4*)(bl + lc + bj * 128 + 4); }
#pragma unroll
        for (int ai = 0; ai < 2; ++ai)
#pragma unroll
            for (int m = 0; m < 4; ++m) { bf16* rowp = EO + (size_t)(row0 + ai * 128 + m * 16) * 1024 + col0;
#pragma unroll
                for (int bj = 0; bj < 2; ++bj) { const f32x4 v0 = acc[ai][bj][m][0] + bv[bj][0], v1 = acc[ai][bj][m][1] + bv[bj][1];
                    u32x4 w; w.x = cvt_pk_bf16(v0[0], v0[1]); w.y = cvt_pk_bf16(v0[2], v0[3]); w.z = cvt_pk_bf16(v1[0], v1[1]); w.w = cvt_pk_bf16(v1[2], v1[3]);
                    *(u32x4*)(rowp + bj * 128) = w; } }
    }
};
struct MoeOrder {
    const LAS int* tp; const LAS int* cn; int NTn, G, c, rev;
    __device__ __forceinline__ bool next(int i, Unit& u) const {
        const int total = tp[32] * NTn; int Lx;
        if ((G & 7) == 0) { const int x = c & 7, j = c >> 3, lo = (int)(((long)total * x) >> 3), hi = (int)(((long)total * (x + 1)) >> 3); Lx = lo + i * (G >> 3) + j; if (Lx >= hi) return false;
            if (rev) Lx = hi - 1 - (Lx - lo); }
        else { Lx = i * G + c; if (Lx >= total) return false; }
        int e = 0;
        for (int q = 1; q < 32; ++q) if (Lx >= tp[q] * NTn) e = q;
        const int t0 = tp[e], r = Lx - t0 * NTn, mt = r / NTn, nt = r - mt * NTn;
        u.pm = __builtin_amdgcn_readfirstlane(t0 + mt); u.pn = __builtin_amdgcn_readfirstlane(e * NTn + nt); u.ka = 0; u.aux = __builtin_amdgcn_readfirstlane(nt); u.e = __builtin_amdgcn_readfirstlane(e);
        u.gbase = __builtin_amdgcn_readfirstlane(e * CAP + mt * 256); u.gcnt = __builtin_amdgcn_readfirstlane(cn[e] - mt * 256); u.pad = 0;
        return true;
    }
};
struct TrItem { const float* W; bf16* WT; int K, N, mode, row_off, ldk, koff, k0, n0; };
__device__ __forceinline__ void tr_load(const TrItem& t, float (&wv)[32], int lane) {
#pragma unroll
    for (int i = 0; i < 32; ++i) wv[i] = __builtin_nontemporal_load(t.W + (size_t)(t.k0 + 2 * i + (lane >> 5)) * t.N + t.n0 + (lane & 31));
}
__device__ __forceinline__ void tr_store(const TrItem& t, const float (&wv)[32], LAS float* scr, int lane) {
#pragma unroll
    for (int i = 0; i < 32; ++i) scr[(2 * i + (lane >> 5)) * 33 + (lane & 31)] = wv[i];
    LDS_WAIT(); asm volatile("" ::: "memory");
    const int c = lane & 7;
#pragma unroll
    for (int j = 0; j < 4; ++j) { const int n = (lane >> 3) + 8 * j; const LAS float* s = scr + (8 * c) * 33 + n;
        v4u o; o.x = pk2(s[0 * 33], s[1 * 33]); o.y = pk2(s[2 * 33], s[3 * 33]); o.z = pk2(s[4 * 33], s[5 * 33]); o.w = pk2(s[6 * 33], s[7 * 33]);
        const int nn = t.n0 + n; int r = nn; if (t.mode == 1) { const int half = nn >> 10, cc = nn & 1023; r = (cc >> 7) * 256 + half * 128 + (cc & 127); }
        if (t.mode == 2) r = (nn < 3232) ? nn : nn + 96;
        __builtin_nontemporal_store(o, (GAS v4u*)(t.WT + (size_t)(t.row_off + r) * t.ldk + t.koff + t.k0 + 8 * c)); }
    LDS_WAIT(); asm volatile("" ::: "memory");
}
constexpr int TI_IN = 16 * 197, TI_UQ = 6 * 24, TI_UKV = 4 * 32, TI_BR = 8 * 32, TI_OUT = 16 * 32, TI_E1 = 16 * 64, TI_E2 = 16 * 32;
constexpr int TA0 = TI_IN, TA1 = TA0 + TI_UQ, TA2 = TA1 + TI_UKV, TA3 = TA2 + TI_BR, TA4 = TA3 + TI_BR, TA5 = TA4 + TI_OUT, TA6 = TA5 + NE * TI_E1, TA7 = TA6 + NE * TI_E2, TR_NTOT = L * TA7, CONV_B = 16;
static_assert(L == 2 && TR_NTOT % CONV_B == 0 && TA5 % CONV_B == 0 && TA6 % CONV_B == 0 && TA7 % CONV_B == 0, "conversion queue layout");
__device__ __forceinline__ void tr_setup(CMkArgs* ap, int it, TrItem& t) {
    unsigned char* ws = ap->ws;
    const int l = it >= TA7 ? 1 : 0; int r = it - l * TA7, q;
    if (r < TA0) { q = r; t = TrItem{(const float*)ap->in[7] + (size_t)l * 1024 * INW, (bf16*)(ws + WS_WINT) + (size_t)l * INP * 1024, 1024, INW, 2, 0, 1024, 0, 0, 0}; }
    else if (r < TA1) { q = r - TA0; t = TrItem{(const float*)ap->in[12] + (size_t)l * 384 * 768, (bf16*)(ws + WS_WUQT) + (size_t)l * 768 * 384, 384, 768, 0, 0, 384, 0, 0, 0}; }
    else if (r < TA2) { q = r - TA1; t = TrItem{(const float*)ap->in[13] + (size_t)l * 256 * 1024, (bf16*)(ws + WS_WUKVT) + (size_t)l * 1024 * 256, 256, 1024, 0, 0, 256, 0, 0, 0}; }
    else if (r < TA3) { q = r - TA2; t = TrItem{(const float*)ap->in[18] + (size_t)l * 512 * 1024, (bf16*)(ws + WS_WBRT) + (size_t)l * 1024 * 1536, 512, 1024, 0, 0, 1536, 0, 0, 0}; }
    else if (r < TA4) { q = r - TA3; t = TrItem{(const float*)ap->in[19] + (size_t)l * 512 * 1024, (bf16*)(ws + WS_WBRT) + (size_t)l * 1024 * 1536, 512, 1024, 0, 0, 1536, 512, 0, 0}; }
    else if (r < TA5) { q = r - TA4; t = TrItem{(const float*)ap->in[21] + (size_t)l * 1024 * 1024, (bf16*)(ws + WS_WOUTT) + (size_t)l * 1024 * 1024, 1024, 1024, 0, 0, 1024, 0, 0, 0}; }
    else if (r < TA6) { r -= TA5; const int e = r / TI_E1; q = r - e * TI_E1; const int b = l * NE + e; t = TrItem{(const float*)ap->in[24] + (size_t)b * 1024 * 2048, (bf16*)(ws + WS_W1T) + (size_t)b * 2048 * 1024, 1024, 2048, 1, 0, 1024, 0, 0, 0}; }
    else { r -= TA6; const int e = r / TI_E2; q = r - e * TI_E2; const int b = l * NE + e; t = TrItem{(const float*)ap->in[26] + (size_t)b * 1024 * 1024, (bf16*)(ws + WS_W2T) + (size_t)b * 1024 * 1024, 1024, 1024, 0, 0, 1024, 0, 0, 0}; }
    const int nblk = t.N / 32, kb = q / nblk; t.k0 = 64 * kb; t.n0 = 32 * (q - kb * nblk);
}
#ifndef MK_BG_CLAIM
#define MK_BG_CLAIM 32
#endif
__device__ __forceinline__ void conv_service(CMkArgs* ap, LAS unsigned char* lds, int tid, int lane, int wave, unsigned need, const unsigned* stop, unsigned stop_val) {
    asm volatile("" : "+v"(tid), "+v"(lane));
    unsigned* qh = (unsigned*)(ap->ws + WS_CTL) + CW_Q;
    LAS unsigned* slot = (LAS unsigned*)(lds + LDSCTL_OFF) + LW_CONV;
    LAS float* scr = (LAS float*)(lds + wave * 8448);
    const bool pre = (stop == nullptr);
    unsigned nxt = 0xFFFFFFFFu;
#define CONV_CLAIM() do { nxt = 0xFFFFFFFFu; \
        const bool go_ = stop != nullptr && __hip_atomic_load(stop, __ATOMIC_RELAXED, __HIP_MEMORY_SCOPE_AGENT) < stop_val; \
        if (go_ || __hip_atomic_load(qh, __ATOMIC_RELAXED, __HIP_MEMORY_SCOPE_AGENT) < need) { const unsigned i_ = __hip_atomic_fetch_add(qh, pre ? 16u : (unsigned)MK_BG_CLAIM, __ATOMIC_RELAXED, __HIP_MEMORY_SCOPE_AGENT); if (i_ < (unsigned)TR_NTOT) nxt = i_; } } while (0)
    if (tid == 0) CONV_CLAIM();
    for (int n = 0;; ++n) {
        if (tid == 0) slot[n & 1] = nxt;
        __syncthreads();
        const unsigned idx = __builtin_amdgcn_readfirstlane(slot[n & 1]);
        if (idx == 0xFFFFFFFFu) break;
        if (pre && tid == 0) CONV_CLAIM();
        { TrItem ta, tb; float va[32], vb[32];
          tr_setup(ap, (int)idx + wave, ta); tr_load(ta, va, lane);
          tr_setup(ap, (int)idx + 8 + wave, tb); tr_load(tb, vb, lane);
#if MK_BG_CLAIM > 16
          TrItem tc, td; float vc[32], vd[32]; const bool c_ok = !pre && (int)idx + 16 < TR_NTOT, d_ok = c_ok && MK_BG_CLAIM > 24;
          if (c_ok) { tr_setup(ap, (int)idx + 16 + wave, tc); tr_load(tc, vc, lane); }
          if (d_ok) { tr_setup(ap, (int)idx + 24 + wave, td); tr_load(td, vd, lane); }
#endif
          tr_store(ta, va, scr, lane); tr_store(tb, vb, scr, lane);
#if MK_BG_CLAIM > 16
          if (c_ok) tr_store(tc, vc, scr, lane);
          if (d_ok) tr_store(td, vd, scr, lane);
#endif
        }
        if (!pre && tid == 0) CONV_CLAIM();
    }
#undef CONV_CLAIM
}
__device__ __forceinline__ void phase_prologue(CMkArgs* ap, LAS unsigned char* lds, int tid, int lane, int wave, int G, int bx) {
    asm volatile("" : "+v"(tid), "+v"(lane));
    unsigned char* ws = ap->ws;
    const float* c = (const float*)ap->in[1]; const int* pos = (const int*)ap->in[2]; const float* ada_w = (const float*)ap->in[3]; const float* ada_b = (const float*)ap->in[4];
    const float* w_in = (const float*)ap->in[7]; const float* hgrn_lb = (const float*)ap->in[8]; const float* w_uq = (const float*)ap->in[12]; const float* w_ukv = (const float*)ap->in[13];
    const float* w_pool = (const float*)ap->in[16]; const float* pool_scale = (const float*)ap->in[17]; const float* w_br_a = (const float*)ap->in[18]; const float* w_br_b = (const float*)ap->in[19]; const float* w_br_c = (const float*)ap->in[20];
    const float* w_out = (const float*)ap->in[21]; const float* w_exp1 = (const float*)ap->in[24]; const float* w_exp2 = (const float*)ap->in[26];
    float* mod = (float*)(ws + WS_MOD); float* lb = (float*)(ws + WS_LB); float* rope = (float*)(ws + WS_ROPE);
    bf16 *WinT = (bf16*)(ws + WS_WINT), *WuqT = (bf16*)(ws + WS_WUQT), *WukvT = (bf16*)(ws + WS_WUKVT), *WbrT = (bf16*)(ws + WS_WBRT), *WoutT = (bf16*)(ws + WS_WOUTT), *W1T = (bf16*)(ws + WS_W1T), *W2T = (bf16*)(ws + WS_W2T);
    if (bx < 192) {
        LAS float* cs = (LAS float*)(lds + 67584);
        LAS float* part = (LAS float*)(lds + 100352);
        for (int i = tid; i < 8192; i += NTHR) { const float v = c[i]; cs[i] = v / (1.f + __expf(-v)); }
        __syncthreads();
        for (int u = bx; u < 192; u += G) {
            const int l = u / 96, j = (u - l * 96) * 64 + lane;
            const float* w = ada_w + (size_t)l * 1024 * 6144 + (size_t)(wave * 128) * 6144 + j;
            float acc[8];
#pragma unroll
            for (int b = 0; b < 8; ++b) acc[b] = 0.f;
#pragma unroll 16
            for (int k = 0; k < 128; ++k) { const float wv = w[(size_t)k * 6144];
#pragma unroll
                for (int b = 0; b < 8; ++b) acc[b] += cs[b * 1024 + wave * 128 + k] * wv; }
#pragma unroll
            for (int b = 0; b < 8; ++b) part[(wave * 8 + b) * 64 + lane] = acc[b];
            __syncthreads();
            { const int b = tid >> 6; float s = 0.f;
#pragma unroll
              for (int w8 = 0; w8 < 8; ++w8) s += part[(w8 * 8 + b) * 64 + lane];
              mod[(size_t)l * 8 * 6144 + b * 6144 + j] = s + ada_b[l * 6144 + j]; }
            __syncthreads();
        }
        if (tid == 0) __hip_atomic_fetch_add((unsigned*)(ws + WS_CTL) + CW_PD, 1u, __ATOMIC_RELAXED, __HIP_MEMORY_SCOPE_AGENT);
    }
    const int gw = bx * NWAVES + wave, NGW = G * NWAVES, gt = bx * NTHR + tid, NGT = G * NTHR;
    for (int i = gt; i < 512; i += NGT) { const float p = hgrn_lb[i], q = hgrn_lb[512 + i]; const float m = fmaxf(p, q); const float ea = __expf(p - m), eb = __expf(q - m); lb[i] = 0.f; lb[512 + i] = eb / (ea + eb); }
    for (int i = gt; i < NT * 16; i += NGT) { const int t = i >> 4, j = i & 15; float fv = ap->invf[0];
#pragma unroll
        for (int q = 1; q < 16; ++q) if (j == q) fv = ap->invf[q];
        const double ang = (double)pos[t] * (double)fv; double r = ang * 0.15915494309189535; r -= floor(r + 0.5); const float an = (float)(r * 6.283185307179586);
        rope[i] = __cosf(an); rope[NT * 16 + i] = __sinf(an); }
    for (int i = gt; i < L * 96 * 128; i += NGT) { const int l = i / (96 * 128), r = i - l * 96 * 128; *(GAS v4u*)(WinT + (size_t)l * INP * 1024 + (size_t)3232 * 1024 + (size_t)r * 8) = (v4u){0u, 0u, 0u, 0u}; }
    for (int task = gw; task < L * 1024; task += NGW) {
        const int l = task >> 10, g = (task >> 8) & 3, nb = (task >> 4) & 15, c0 = (task & 15) * 8;
        const float* wb = w_br_c + (size_t)l * 512 * 1024 + (size_t)g * 128 * 1024 + nb * 64 + lane; const float* sc = pool_scale + l * 512 + g * 128;
        const float* wp = w_pool + ((size_t)l * 4 + g) * 128 * 128 + (size_t)c0 * 128;
        float acc[8];
#pragma unroll
        for (int q = 0; q < 8; ++q) acc[q] = 0.f;
#pragma unroll 16
        for (int d = 0; d < 128; ++d) { const float w = wb[(size_t)d * 1024] * sc[d];
#pragma unroll
            for (int q = 0; q < 8; ++q) acc[q] += wp[q * 128 + d] * w; }
        v4u o; o.x = pk2(acc[0], acc[1]); o.y = pk2(acc[2], acc[3]); o.z = pk2(acc[4], acc[5]); o.w = pk2(acc[6], acc[7]);
        *(GAS v4u*)(WbrT + (size_t)l * 1024 * 1536 + (size_t)(nb * 64 + lane) * 1536 + 1024 + g * 128 + c0) = o;
    }
    conv_service(ap, lds, tid, lane, wave, (unsigned)TA5, bx >= 192 ? (const unsigned*)(ws + WS_CTL) + CW_PD : nullptr, (unsigned)(G < 192 ? G : 192));
}

template <int MODE>
__device__ __forceinline__ void phase_rows(const float* xin, float* xout, const float* gain, const float* mod_sh, const float* mod_sc, const float* mod_g2, bf16* HN,
                                           const bf16* EO, const int* tokE, const int* tokS, const float* tokW, const LAS int* tp, int lane, int gw, int NGW) {
    asm volatile("" : "+v"(lane));
    for (int row = gw; row < NT; row += NGW) {
        const int b = row / S;
        const GAS f32x4* xr = (const GAS f32x4*)(xin + (size_t)row * D);
        f32x4 v[4];
#pragma unroll
        for (int j = 0; j < 4; ++j) v[j] = xr[lane + 64 * j];
        if (MODE != 0) {
            f32x4 acc[4];
#pragma unroll
            for (int j = 0; j < 4; ++j) acc[j] = (f32x4){0.f, 0.f, 0.f, 0.f};
#pragma unroll
            for (int k = 0; k < 4; ++k) { const int e = tokE[row * 4 + k]; const size_t r = (size_t)tp[e] * 256 + tokS[row * 4 + k]; const float w = tokW[row * 4 + k];
                const GAS v2u* er = (const GAS v2u*)(EO + r * 1024);
#pragma unroll
                for (int j = 0; j < 4; ++j) { const v2u ev = er[lane + 64 * j];
                    acc[j][0] += w * __uint_as_float(ev.x << 16); acc[j][1] += w * __uint_as_float(ev.x & 0xffff0000u); acc[j][2] += w * __uint_as_float(ev.y << 16); acc[j][3] += w * __uint_as_float(ev.y & 0xffff0000u); } }
#pragma unroll
            for (int j = 0; j < 4; ++j) { const f32x4 gg = *(const GAS f32x4*)(mod_g2 + b * 6144 + (lane + 64 * j) * 4); v[j] = v[j] + gg * acc[j]; *(GAS f32x4*)(xout + (size_t)row * D + (lane + 64 * j) * 4) = v[j]; }
        }
        if (MODE != 2) {
            float ss = 0.f;
#pragma unroll
            for (int j = 0; j < 4; ++j) ss += (v[j][0] * v[j][0] + v[j][1] * v[j][1]) + (v[j][2] * v[j][2] + v[j][3] * v[j][3]);
            const float rstd = rsqrtf(wave_sum(ss) * (1.f / D) + EPS);
#pragma unroll
            for (int j = 0; j < 4; ++j) { const int cc = (lane + 64 * j) * 4; const f32x4 gg = *(const GAS f32x4*)(gain + cc), sh = *(const GAS f32x4*)(mod_sh + b * 6144 + cc), sc = *(const GAS f32x4*)(mod_sc + b * 6144 + cc);
                const f32x4 h = v[j] * rstd * gg * (sc + 1.f) + sh; v2u o; o.x = pk2(h[0], h[1]); o.y = pk2(h[2], h[3]);
                *(GAS v2u*)(HN + (size_t)row * D + cc) = o; }
        }
    }
}
__device__ __forceinline__ void load_tp(const int* cnt, LAS int* tp, LAS int* cn, int tid) {
    if (tid < 32) cn[tid] = __hip_atomic_load(cnt + tid, __ATOMIC_RELAXED, __HIP_MEMORY_SCOPE_AGENT);
    __syncthreads();
    if (tid == 0) { int acc = 0; tp[0] = 0;
        for (int q = 0; q < 32; ++q) { acc += (cn[q] + 255) >> 8; tp[q + 1] = acc; } }
    __syncthreads();
}

__device__ __forceinline__ void phase_router(const float* x1, const float* gain, const float* mod_sh, const float* mod_sc, const float* wr, const float* br, bf16* hn2, int* cnt, int* list, int* tokE, int* tokS, float* tokW,
                                             LAS unsigned char* lds, int tid, int lane, int wave, int G, int bx) {
    asm volatile("" : "+v"(tid), "+v"(lane));
    LAS float* tile = (LAS float*)(lds + RING_OFF);
    LAS int* lw = (LAS int*)(lds + LDSCTL_OFF);
    LAS int* entE = lw + LW_ENTE; LAS float* entW = (LAS float*)(lw + LW_ENTW); LAS int* rank = lw + LW_RANK; LAS int* lcnt = lw + LW_LCNT; LAS int* base = lw + LW_BASE;
    const int l31 = lane & 31, h5 = lane >> 5;
    float breg[64];
#pragma unroll
    for (int j = 0; j < 64; ++j) breg[j] = wr[(size_t)(128 * wave + 2 * j + h5) * 32 + l31];
    if (tid < 32) lcnt[tid] = 0;
    __syncthreads();
    for (int bt = bx; bt < NT / 64; bt += G) {
#pragma unroll 1
      for (int hb = 0; hb < 2; ++hb) {
        const int row0 = bt * 64 + hb * 32 + wave * 4, b = row0 / S;
        int ln = lane; asm volatile("" : "+v"(ln));
#pragma unroll 1
        for (int rp = 0; rp < 2; ++rp) {
        f32x4 v[2][4];
#pragma unroll
        for (int rr = 0; rr < 2; ++rr)
#pragma unroll
            for (int j = 0; j < 4; ++j) v[rr][j] = ((const GAS f32x4*)(x1 + (size_t)(row0 + 2 * rp + rr) * D))[ln + 64 * j];
#pragma unroll
        for (int rr = 0; rr < 2; ++rr) {
            const int lr = wave * 4 + 2 * rp + rr, row = row0 + 2 * rp + rr;
            int l2 = ln; asm volatile("" : "+v"(l2));
            float ss = 0.f;
#pragma unroll
            for (int j = 0; j < 4; ++j) ss += (v[rr][j][0] * v[rr][j][0] + v[rr][j][1] * v[rr][j][1]) + (v[rr][j][2] * v[rr][j][2] + v[rr][j][3] * v[rr][j][3]);
            const float rstd = rsqrtf(wave_sum(ss) * (1.f / D) + EPS);
#pragma unroll
            for (int j = 0; j < 4; ++j) { const int cc = (l2 + 64 * j) * 4; const f32x4 gg = *(const GAS f32x4*)(gain + cc), sh = *(const GAS f32x4*)(mod_sh + b * 6144 + cc), sc = *(const GAS f32x4*)(mod_sc + b * 6144 + cc);
                const f32x4 hv = v[rr][j] * rstd * gg * (sc + 1.f) + sh; v2u o; o.x = pk2(hv[0], hv[1]); o.y = pk2(hv[2], hv[3]);
                *(GAS v2u*)(hn2 + (size_t)row * D + cc) = o;
#pragma unroll
                for (int q = 0; q < 4; ++q) tile[lr * 1024 + ((cc + q) ^ lr)] = hv[q]; }
        }
        }
        __syncthreads();
        f32x16 acc;
#pragma unroll
        for (int r = 0; r < 16; ++r) acc[r] = 0.f;
#pragma unroll
        for (int j = 0; j < 64; ++j) { const float a = tile[l31 * 1024 + ((128 * wave + 2 * j + h5) ^ l31)]; acc = __builtin_amdgcn_mfma_f32_32x32x2f32(a, breg[j], acc, 0, 0, 0);
            if ((j & 7) == 7) __builtin_amdgcn_sched_barrier(0); }
        __syncthreads();
#pragma unroll
        for (int r = 0; r < 16; ++r) tile[(wave * 32 + (r & 3) + 8 * (r >> 2) + 4 * h5) * 32 + l31] = acc[r];
        __syncthreads();
#pragma unroll 1
        for (int rr = 0; rr < 4; ++rr) {
            const int lr = wave * 4 + rr, er = hb * 32 + lr; float cur = br[l31];
#pragma unroll
            for (int w8 = 0; w8 < 8; ++w8) cur += tile[(w8 * 32 + lr) * 32 + l31];
            float tv[4]; int ti[4];
#pragma unroll
            for (int k = 0; k < 4; ++k) { float mv = cur; int mi = l31;
#pragma unroll
                for (int o = 1; o < 32; o <<= 1) { const float ov = __shfl_xor(mv, o); const int oi = __shfl_xor(mi, o); if (ov > mv || (ov == mv && oi < mi)) { mv = ov; mi = oi; } }
                tv[k] = mv; ti[k] = mi; if (l31 == mi) cur = -INFINITY; }
            const float e1 = __expf(tv[1] - tv[0]), e2 = __expf(tv[2] - tv[0]), e3 = __expf(tv[3] - tv[0]), inv = 1.f / (1.f + e1 + e2 + e3);
            if (lane == 0) { entE[er * 4 + 0] = ti[0]; entE[er * 4 + 1] = ti[1]; entE[er * 4 + 2] = ti[2]; entE[er * 4 + 3] = ti[3];
                entW[er * 4 + 0] = inv; entW[er * 4 + 1] = e1 * inv; entW[er * 4 + 2] = e2 * inv; entW[er * 4 + 3] = e3 * inv; }
        }
        __syncthreads();
      }
        if (tid < 256) rank[tid] = __hip_atomic_fetch_add(lcnt + entE[tid], 1, __ATOMIC_RELAXED, __HIP_MEMORY_SCOPE_WORKGROUP);
        __syncthreads();
        if (tid < 32) { const int n = lcnt[tid]; base[tid] = n ? __hip_atomic_fetch_add(cnt + tid, n, __ATOMIC_RELAXED, __HIP_MEMORY_SCOPE_AGENT) : 0; lcnt[tid] = 0; }
        __syncthreads();
        if (tid < 256) { const int e = entE[tid], slot = base[e] + rank[tid], row = bt * 64 + (tid >> 2);
            list[(size_t)e * CAP + slot] = row; tokE[row * 4 + (tid & 3)] = e; tokS[row * 4 + (tid & 3)] = slot; tokW[row * 4 + (tid & 3)] = entW[tid]; }
        __syncthreads();
    }
}

__device__ __forceinline__ int moe_workers(int total, int G) { const int gx = G >> 3, nmax = (total + 7) >> 3, rounds = (nmax + gx - 1) / gx; int jw = rounds > 0 ? (nmax + rounds - 1) / rounds : gx; return jw < 1 ? 1 : (jw > gx ? gx : jw); }
__device__ __forceinline__ bool moe_early(int total, int jw, int bx) { const int x = bx & 7, j = bx >> 3, lo = (int)(((long)total * x) >> 3), hi = (int)(((long)total * (x + 1)) >> 3), nmax = (total + 7) >> 3;
    const int mine = (hi - lo - j + jw - 1) / jw, maxr = (nmax + jw - 1) / jw; return mine < maxr; }
__global__ void __launch_bounds__(NTHR, 2) mk_fwd(MkArgs a) {
    extern __shared__ __attribute__((aligned(16))) unsigned char lds_raw[];
    LAS unsigned char* lds = (LAS unsigned char*)lds_raw;
    const int G = gridDim.x, bx = blockIdx.x, wave_s = __builtin_amdgcn_readfirstlane((int)threadIdx.x >> 6);
#define PH_LOCALS int tid = wave_s * 64 + (int)mk_lane_id(); asm volatile("" : "+v"(tid)); const int lane = tid & 63, wave = __builtin_amdgcn_readfirstlane(tid >> 6), gw = bx * NWAVES + wave, NGW = G * NWAVES; (void)lane; (void)gw; (void)NGW
    { PH_LOCALS; for (int u = tid; u < (LDS_BYTES - LDSCTL_OFF) / 4; u += NTHR) ((LAS unsigned*)(lds + LDSCTL_OFF))[u] = 0u; }
    __syncthreads();
    int lo, hi; XcdBarrier bar;
    { PH_LOCALS; KA_PTR(ka); lo = ka->ph_lo; hi = ka->ph_hi; bar = xcd_barrier_post((unsigned*)(ka->ws + WS_CTL) + CW_BAR + ka->li * XCD_BAR_WORDS, (volatile LAS unsigned*)(lds + LDSCTL_OFF) + LW_BAR, wave_s); }
    LAS int* lw = (LAS int*)(lds + LDSCTL_OFF); LAS int* tp = lw + LW_TP; LAS int* cn = lw + LW_CNT;
#ifndef MK_PHMASK
#define MK_PHMASK 0xFFFFFFFFu
#endif
#ifndef MK_DUP
#define MK_DUP 0u
#endif
#define NREP(p) (((MK_DUP >> (p)) & 1u) ? 2 : 1)
#ifndef MK_DUPSUB
#define MK_DUPSUB 0xFFu
#endif
#define SUBEN(bit) (rep_ == 0 || ((MK_DUPSUB >> (bit)) & 1u))
#define PHEN(p) ((MK_PHMASK >> (p)) & 1u)
#define IN(k) (lo <= (k) && (k) < hi)
#ifndef MK_HOOKPROBE
#define MK_HOOKPROBE 0
#endif
#ifndef MK_DUPBAR
#define MK_DUPBAR 0
#endif
#define SEAM(k) do { if (IN(k) && IN((k) + 1)) { xcd_barrier(bar); if (MK_DUPBAR) xcd_barrier(bar); } } while (0)
#define WSP(T, off) ((T*)(ws + (off)))
    if (PHEN(31) && IN(0)) for (int rep_ = 0; rep_ < NREP(31); ++rep_) { PH_LOCALS; KA_PTR(ka); phase_prologue(ka, lds, tid, lane, wave, G, bx); VM_WAIT(); __syncthreads(); }
    SEAM(0);
    for (int l = 0; l < L; ++l) {
        const int pb = 1 + l * NPH_L;
        if (PHEN(0) && IN(pb + 0)) for (int rep_ = 0; rep_ < NREP(0); ++rep_) { PH_LOCALS; KA_PTR(ka); unsigned char* ws = ka->ws; const float* modl = WSP(float, WS_MOD) + (size_t)l * 8 * 6144; const float* norm1_g = (const float*)ka->in[5] + l * D;
            if (l == 0) phase_rows<0>((const float*)ka->in[0], nullptr, norm1_g, modl + 0, modl + 1024, nullptr, WSP(bf16, WS_HN), nullptr, nullptr, nullptr, nullptr, tp, lane, gw, NGW);
            else { load_tp(WSP(int, WS_CTL) + CW_CNT + (l - 1) * 64, tp, cn, tid); int* tokE = WSP(int, WS_TOK);
                phase_rows<1>(WSP(float, WS_XA), WSP(float, WS_XB), norm1_g, modl + 0, modl + 1024, modl - 8 * 6144 + 5120, WSP(bf16, WS_HN), WSP(bf16, WS_EO), tokE, tokE + NT * 4, (const float*)(tokE + NT * 8), tp, lane, gw, NGW); }
        }
        SEAM(pb + 0);
        if (PHEN(1) && IN(pb + 1)) for (int rep_ = 0; rep_ < NREP(1); ++rep_) { PH_LOCALS; KA_PTR(ka); unsigned char* ws = ka->ws;
#if defined(MK_DBG) && MK_DBG
            if (bx == 0 && tid == 0 && l == MK_DBG_L) WSP(unsigned, WS_CTL)[1030] = (MK_DBG == 1) ? __hip_atomic_load(WSP(unsigned, WS_CTL) + CW_Q, __ATOMIC_RELAXED, __HIP_MEMORY_SCOPE_AGENT) : (unsigned)__builtin_amdgcn_s_memrealtime();
#endif
            const int GW = (G >= 232 && (G & 7) == 0) ? 232 : G; unsigned* pd = WSP(unsigned, WS_CTL) + CW_PD + 64 * (1 + 3 * l);
            if (bx < GW) {
                pg8::Gemm g{WSP(bf16, WS_HN), WSP(bf16, WS_WINT) + (size_t)l * INP * 1024, nullptr, 1024, 1024, 1024, 0}; pg8::StaticOrder So; So.init(NT, INP, GW, bx);
                EpiP E{WSP(bf16, WS_P), INP, WSP(bf16, WS_GT)};
                pg8::gemm_phase<EpiP, pg8::StaticOrder, true, true, false>(lds + RING_OFF, g, So, E, wave);
                if (tid == 0) __hip_atomic_fetch_add(pd, 1u, __ATOMIC_RELAXED, __HIP_MEMORY_SCOPE_AGENT);
                if (((NT / 256) * (INP / 256) - bx + GW - 1) / GW < ((NT / 256) * (INP / 256) + GW - 1) / GW) conv_service(ka, lds, tid, lane, wave, 0u, pd, (unsigned)GW);
            } else conv_service(ka, lds, tid, lane, wave, 0u, pd, (unsigned)GW);
        }
        SEAM(pb + 1);
#if defined(MK_DBG) && MK_DBG
        { PH_LOCALS; KA_PTR(ka); unsigned char* ws = ka->ws; if (bx == 0 && tid == 0 && l == MK_DBG_L) WSP(unsigned, WS_CTL)[1031] = (MK_DBG == 1) ? __hip_atomic_load(WSP(unsigned, WS_CTL) + CW_Q, __ATOMIC_RELAXED, __HIP_MEMORY_SCOPE_AGENT) : (unsigned)__builtin_amdgcn_s_memrealtime(); }
#endif
        if (PHEN(2) && IN(pb + 2)) for (int rep_ = 0; rep_ < NREP(2); ++rep_) { PH_LOCALS; KA_PTR(ka); unsigned char* ws = ka->ws;
#if MK_HGRN_IN
            if (SUBEN(2)) hgrn_a_all(WSP(bf16, WS_P), WSP(float, WS_LB) + l * 512, WSP(float, WS_SLOC), WSP(float, WS_DEC), lds + RING_OFF, bx, G, tid, lane, wave);
#endif
#if MK_MLA_IN
            if (SUBEN(3)) for (int u = bx; u < NT / 64; u += G)
                mla_unit(WSP(bf16, WS_P), (const float*)ka->in[10] + l * 384, (const float*)ka->in[11] + l * 256, WSP(bf16, WS_WUQT) + (size_t)l * 768 * 384, WSP(bf16, WS_WUKVT) + (size_t)l * 1024 * 256,
                         (const float*)ka->in[14] + l * 96, (const float*)ka->in[15] + l * 96, WSP(float, WS_ROPE), WSP(bf16, WS_Q), WSP(bf16, WS_K), WSP(bf16, WS_V), lds + RING_OFF, u, lane, wave);
#endif
#if MK_POOL_IN
            if (SUBEN(4)) for (int u = bx; u < NT / 64; u += G) pool_unit(WSP(bf16, WS_P), WSP(bf16, WS_BR), u, tid);
#endif
        }
        SEAM(pb + 2);
        if (PHEN(3) && IN(pb + 3)) for (int rep_ = 0; rep_ < NREP(3); ++rep_) { PH_LOCALS; KA_PTR(ka); unsigned char* ws = ka->ws;
#if MK_HGRN_IN
            for (int u = bx; u < 256; u += G) hgrn_scan_unit(WSP(float, WS_SLOC), WSP(float, WS_DEC), WSP(bf16, WS_ST), u, tid);
#endif
        }
        SEAM(pb + 3);
        if (PHEN(4) && IN(pb + 4)) for (int rep_ = 0; rep_ < NREP(4); ++rep_) { PH_LOCALS; KA_PTR(ka); unsigned char* ws = ka->ws;
#if MK_ATTN_IN
            if (SUBEN(0)) for (int p = bx; p < 256; p += G) {
                attn_unit(WSP(bf16, WS_Q), WSP(bf16, WS_K), WSP(bf16, WS_V), WSP(bf16, WS_BR), lds + RING_OFF, p & 63, 7 - (p >> 6), tid, lane, wave);
                attn_unit(WSP(bf16, WS_Q), WSP(bf16, WS_K), WSP(bf16, WS_V), WSP(bf16, WS_BR), lds + RING_OFF, p & 63, p >> 6, tid, lane, wave);
            }
#endif
#if MK_HGRN_IN
            if (SUBEN(1)) for (int u = bx; u < 1024; u += G) hgrn_c_unit(WSP(bf16, WS_P), WSP(float, WS_LB) + l * 512, WSP(bf16, WS_ST), (const float*)ka->in[9] + l * 128, WSP(bf16, WS_BR), lds + RING_OFF, u, tid, lane, wave);
#endif
        }
        SEAM(pb + 4);
        if (PHEN(5) && IN(pb + 5)) for (int rep_ = 0; rep_ < NREP(5); ++rep_) { PH_LOCALS; KA_PTR(ka); unsigned char* ws = ka->ws;
            pg8::Gemm g{WSP(bf16, WS_BR), WSP(bf16, WS_WBRT) + (size_t)l * 1024 * 1536, nullptr, 1536, 1536, 1536, 0}; pg8::StaticOrder So; So.init(NT, 1024, G, bx);
#if MK_P5PROBE
            if (rep_ == 1) { EpiP E2{WSP(bf16, WS_MERGF), 1024, nullptr}; pg8::gemm_phase<EpiP, pg8::StaticOrder, false, true, false, 0>(lds + RING_OFF, g, So, E2, wave); } else
#endif
            { EpiBranch E{WSP(bf16, WS_GT), WSP(bf16, WS_MERGB)};
            pg8::gemm_phase<EpiBranch, pg8::StaticOrder, false, true, false, 8>(lds + RING_OFF, g, So, E, wave); }
        }
        SEAM(pb + 5);
        if (PHEN(6) && IN(pb + 6)) for (int rep_ = 0; rep_ < NREP(6); ++rep_) { PH_LOCALS; KA_PTR(ka); unsigned char* ws = ka->ws; const float* xin = (l == 0) ? (const float*)ka->in[0] : WSP(float, WS_XB);
            pg8::Gemm g{WSP(bf16, WS_MERGB), WSP(bf16, WS_WOUTT) + (size_t)l * 1024 * 1024, nullptr, 1024, 1024, 1024, 0}; pg8::StaticOrder So; So.init(NT, 1024, G, bx);
            EpiOut E{xin, WSP(float, WS_MOD) + (size_t)l * 8 * 6144 + 2048, WSP(float, WS_XA)};
            pg8::gemm_phase<EpiOut, pg8::StaticOrder, false, true, false>(lds + RING_OFF, g, So, E, wave);
        }
        SEAM(pb + 6);
        if (PHEN(7) && IN(pb + 7)) for (int rep_ = 0; rep_ < NREP(7); ++rep_) { PH_LOCALS; KA_PTR(ka); unsigned char* ws = ka->ws; const float* modl = WSP(float, WS_MOD) + (size_t)l * 8 * 6144; int* tokE = WSP(int, WS_TOK);
            if (rep_ == 1) tokE = WSP(int, WS_KVRAW);
            phase_router(WSP(float, WS_XA), (const float*)ka->in[6] + l * D, modl + 3072, modl + 4096, (const float*)ka->in[22] + (size_t)l * 1024 * 32, (const float*)ka->in[23] + l * 32, WSP(bf16, WS_HN2),
                         WSP(int, WS_CTL) + (rep_ == 1 ? 2048 : CW_CNT) + l * 64, rep_ == 1 ? WSP(int, WS_QRAW) : WSP(int, WS_LIST), tokE, tokE + NT * 4, (float*)(tokE + NT * 8), lds, tid, lane, wave, G, bx);
            conv_service(ka, lds, tid, lane, wave, (unsigned)(l * TA7 + TA6), nullptr, 0u); }
        SEAM(pb + 7);
        if (PHEN(8) && IN(pb + 8)) for (int rep_ = 0; rep_ < NREP(8); ++rep_) { PH_LOCALS; KA_PTR(ka); unsigned char* ws = ka->ws;
            load_tp(WSP(int, WS_CTL) + CW_CNT + l * 64, tp, cn, tid);
            const int jw = moe_workers(tp[32] * 8, G); unsigned* pd = WSP(unsigned, WS_CTL) + CW_PD + 64 * (2 + 3 * l); const bool worker = (bx >> 3) < jw || (G & 7) != 0;
            if (worker) {
                pg8::Gemm g{WSP(bf16, WS_HN2), WSP(bf16, WS_W1T) + (size_t)l * NE * 2048 * 1024, WSP(int, WS_LIST), 1024, 1024, 1024, 0}; MoeOrder So{tp, cn, 8, (G & 7) ? G : 8 * jw, bx, 0};
                EpiMoe1 E{(const float*)ka->in[25] + (size_t)l * NE * 2048, WSP(bf16, WS_ACT), (LAS float*)(lw + LW_BIAS)};
                pg8::gemm_phase<EpiMoe1, MoeOrder, true, true, true>(lds + RING_OFF, g, So, E, wave);
                if (tid == 0) __hip_atomic_fetch_add(pd, 1u, __ATOMIC_RELAXED, __HIP_MEMORY_SCOPE_AGENT);
            }
            conv_service(ka, lds, tid, lane, wave, (unsigned)((l + 1) * TA7), (worker && !moe_early(tp[32] * 8, jw, bx)) ? nullptr : pd, (unsigned)(8 * jw));
        }
        SEAM(pb + 8);
        if (PHEN(9) && IN(pb + 9)) for (int rep_ = 0; rep_ < NREP(9); ++rep_) { PH_LOCALS; KA_PTR(ka); unsigned char* ws = ka->ws;
            load_tp(WSP(int, WS_CTL) + CW_CNT + l * 64, tp, cn, tid);
            const int jw = moe_workers(tp[32] * 4, G); unsigned* pd = WSP(unsigned, WS_CTL) + CW_PD + 64 * (3 + 3 * l); const bool worker = (bx >> 3) < jw || (G & 7) != 0;
            if (worker) {
                pg8::Gemm g{WSP(bf16, WS_ACT), WSP(bf16, WS_W2T) + (size_t)l * NE * 1024 * 1024, nullptr, 1024, 1024, 1024, 0}; MoeOrder So{tp, cn, 4, (G & 7) ? G : 8 * jw, bx, 1};
                EpiMoe2 E{(const float*)ka->in[27] + (size_t)l * NE * 1024, WSP(bf16, WS_EO), (LAS float*)(lw + LW_BIAS)};
                pg8::gemm_phase<EpiMoe2, MoeOrder, true, true, false>(lds + RING_OFF, g, So, E, wave);
                if (tid == 0) __hip_atomic_fetch_add(pd, 1u, __ATOMIC_RELAXED, __HIP_MEMORY_SCOPE_AGENT);
            }
            conv_service(ka, lds, tid, lane, wave, (unsigned)(l + 1 < L ? (l + 1) * TA7 + TA5 : 0), (worker && !moe_early(tp[32] * 4, jw, bx)) ? nullptr : pd, (unsigned)(8 * jw));
        }
        SEAM(pb + 9);
    }
    if (PHEN(30) && IN(PH_FINAL)) for (int rep_ = 0; rep_ < NREP(30); ++rep_) { PH_LOCALS; KA_PTR(ka); unsigned char* ws = ka->ws; load_tp(WSP(int, WS_CTL) + CW_CNT + (L - 1) * 64, tp, cn, tid); int* tokE = WSP(int, WS_TOK);
        phase_rows<2>(WSP(float, WS_XA), ka->out, nullptr, nullptr, nullptr, WSP(float, WS_MOD) + (size_t)(L - 1) * 8 * 6144 + 5120, nullptr, WSP(bf16, WS_EO), tokE, tokE + NT * 4, (const float*)(tokE + NT * 8), tp, lane, gw, NGW); }
#if defined(MK_DBG) && MK_DBG
    xcd_barrier(bar);
    { PH_LOCALS; KA_PTR(ka); unsigned char* ws = ka->ws; const unsigned d = __hip_atomic_load(WSP(unsigned, WS_CTL) + 1031, __ATOMIC_RELAXED, __HIP_MEMORY_SCOPE_AGENT) - __hip_atomic_load(WSP(unsigned, WS_CTL) + 1030, __ATOMIC_RELAXED, __HIP_MEMORY_SCOPE_AGENT);
      const unsigned K = d * (unsigned)MK_DBG_SCALE; for (unsigned i = bx * NTHR + tid; i < K && i < (unsigned)NT * 1024u; i += G * NTHR) ka->out[i] = 0.f; }
#endif
#undef IN
#undef SEAM
}
static void launch_mk(const MkArgs& base, int lo, int hi, int li, int grid, hipStream_t stream) {
    MkArgs a = base; a.ph_lo = lo; a.ph_hi = hi; a.li = li; a.pad = 0;
    hipLaunchKernelGGL(mk_fwd, dim3(grid), dim3(NTHR), LDS_BYTES, stream, a);
}
extern "C" void kernel_launch(void* const* d_in, const int* in_sizes, int n_in, void* d_out, int out_size, void* d_ws, size_t ws_size, hipStream_t stream) {
    static int grid = 0;
    if (grid == 0) {
        if (ws_size < WS_END || n_in != 28) { fprintf(stderr, "kernel_launch: bad ws/inputs: %zu < %zu, n_in %d\n", ws_size, (size_t)WS_END, n_in); grid = -1; return; }
        int dev = 0, cus = 0, per_cu = 0;
        if (hipGetDevice(&dev) != hipSuccess || hipDeviceGetAttribute(&cus, hipDeviceAttributeMultiprocessorCount, dev) != hipSuccess) { grid = -1; return; }
        if (hipFuncSetAttribute((const void*)mk_fwd, hipFuncAttributeMaxDynamicSharedMemorySize, LDS_BYTES) != hipSuccess) { fprintf(stderr, "kernel_launch: hipFuncSetAttribute failed\n"); grid = -1; return; }
        if (hipOccupancyMaxActiveBlocksPerMultiprocessor(&per_cu, (const void*)mk_fwd, NTHR, LDS_BYTES) != hipSuccess || per_cu < 1) { fprintf(stderr, "kernel_launch: occupancy query says %d\n", per_cu); (void)hipGetLastError(); grid = -1; return; }
        grid = cus;
    }
    if (grid < 0) return;
    unsigned char* ws = (unsigned char*)d_ws;
    (void)hipMemsetAsync(ws + WS_CTL, 0, 1 * MiB, stream);
    MkArgs a{};
    for (int i = 0; i < 28; ++i) a.in[i] = d_in[i];
    a.out = (float*)d_out; a.ws = ws;
    for (int j = 0; j < 16; ++j) a.invf[j] = (float)(1.0 / pow(10000.0, (double)j / 16.0));
#if MK_HYBRID
    const float* onorm_g = (const float*)d_in[9]; const float* qlat_g = (const float*)d_in[10]; const float* kvlat_g = (const float*)d_in[11]; const float* qn_g = (const float*)d_in[14]; const float* kn_g = (const float*)d_in[15];
    float* lb = (float*)(ws + WS_LB); float* rope = (float*)(ws + WS_ROPE);
    bf16 *WuqT = (bf16*)(ws + WS_WUQT), *WukvT = (bf16*)(ws + WS_WUKVT), *P = (bf16*)(ws + WS_P), *Qb = (bf16*)(ws + WS_Q), *Kb = (bf16*)(ws + WS_K), *Vb = (bf16*)(ws + WS_V), *BR = (bf16*)(ws + WS_BR), *QLN = (bf16*)(ws + WS_QLN), *KVN = (bf16*)(ws + WS_KVN);
    float *ORAW = (float*)(ws + WS_ORAW), *QRAW = (float*)(ws + WS_QRAW), *KVRAW = (float*)(ws + WS_KVRAW);
    int li = 0;
    for (int l = 0; l < L; ++l) {
        const int pb = 1 + l * NPH_L;
        launch_mk(a, l == 0 ? 0 : pb - 5, pb + 2, li++, grid, stream);
#if !MK_HGRN_IN
        k_hgrn_naive<<<NB * HH, 128, 0, stream>>>(P, lb + l * 512, ORAW);
        k_hgrn_out<<<NT * 4 / 4, 256, 0, stream>>>(ORAW, P, onorm_g + l * 128, BR);
#endif
#if !MK_MLA_IN
        k_mla_prep<<<NT / 4, 256, 0, stream>>>(P, qlat_g + l * 384, kvlat_g + l * 256, QLN, KVN);
        { GemmArgs g{}; g.A = QLN; g.Bt = WuqT + (size_t)l * 768 * 384; g.lda = 384; g.ldb = 384; g.K = 384; g.outf = QRAW; g.ldc = 768;
          k_gemm<1, 0><<<dim3(768 / 64, NT / 64), 256, 0, stream>>>(g); }
        { GemmArgs g{}; g.A = KVN; g.Bt = WukvT + (size_t)l * 1024 * 256; g.lda = 256; g.ldb = 256; g.K = 256; g.outf = KVRAW; g.ldc = 1024;
          k_gemm<1, 0><<<dim3(1024 / 64, NT / 64), 256, 0, stream>>>(g); }
        k_mla_post<<<NT * 8 / 4, 256, 0, stream>>>(QRAW, KVRAW, P, qn_g + l * 96, kn_g + l * 96, rope, Qb, Kb, Vb);
#endif
#if !MK_POOL_IN
        k_pool<<<NT * 512 / 256, 256, 0, stream>>>(P, BR);
#endif
#if MK_MLA_IN || MK_POOL_IN || MK_HGRN_IN
        launch_mk(a, pb + 2, pb + 3, li++, grid, stream);
#endif
#if MK_HGRN_IN
        launch_mk(a, pb + 3, pb + 4, li++, grid, stream);
#endif
#if MK_ATTN_IN || MK_HGRN_IN
        launch_mk(a, pb + 4, pb + 5, li++, grid, stream);
#else
        k_attn_naive<<<dim3(S / 64, NB * MH), 64, 0, stream>>>(Qb, Kb, Vb, BR);
#endif
    }
    launch_mk(a, 1 + (L - 1) * NPH_L + 5, NPH, li++, grid, stream);
#else
    launch_mk(a, 0, NPH, 0, grid, stream);
#endif
}
```

```cpp
#include <hip/hip_runtime.h>
#include <stdint.h>
#include <cstdio>
#include <cmath>

typedef unsigned short bf16;
__device__ __forceinline__ float bf2f(bf16 v) { return __uint_as_float(((unsigned)v) << 16); }
__device__ __forceinline__ bf16 f2bf(float f) { unsigned u = __float_as_uint(f); return (bf16)((u + 0x7fffu + ((u >> 16) & 1u)) >> 16); }
__device__ __forceinline__ float sigmoidf_(float x) { return 1.f / (1.f + __expf(-x)); }

constexpr int D = 1024, NB = 8, S = 2048, NT = NB * S, L = 2;
constexpr int HH = 4, HDK = 128, HW = 512, HCH = 64;
constexpr int MH = 8, MNOPE = 64, MROPE = 32, MQK = 96, MV = 64, MQR = 384, MKVR = 256, MW = 512;
constexpr int PW = 512;
constexpr int NE = 32, TOPK = 4, FF = 1024;
constexpr int INW = 6304, INP = 6400;
constexpr int C_HQ = 0, C_HF = 512, C_HI = 1024, C_HG = 1536, C_QLAT = 2048, C_KVLAT = 2432, C_KROPE = 2688, C_POOL = 2720, C_GA = 3232, C_GB = 4256, C_GC = 5280;
constexpr float EPS = 1e-6f;
constexpr int CAP = NT;
constexpr int MAXROWS = NT * TOPK + NE * 256;

constexpr size_t MiB = 1u << 20;
constexpr size_t WS_CTL = 0;
constexpr size_t WS_MOD = 1 * MiB;
constexpr size_t WS_LB = 2 * MiB;
constexpr size_t WS_ROPE = 3 * MiB;
constexpr size_t WS_WINT = 6 * MiB;
constexpr size_t WS_WUQT = 32 * MiB;
constexpr size_t WS_WUKVT = 34 * MiB;
constexpr size_t WS_WBRT = 36 * MiB;
constexpr size_t WS_WOUTT = 42 * MiB;
constexpr size_t WS_W1T = 48 * MiB;
constexpr size_t WS_W2T = 304 * MiB;
constexpr size_t WS_HN = 432 * MiB;
constexpr size_t WS_P = 464 * MiB;
constexpr size_t WS_Q = 664 * MiB;
constexpr size_t WS_K = 688 * MiB;
constexpr size_t WS_V = 712 * MiB;
constexpr size_t WS_BR = 728 * MiB;
constexpr size_t WS_MERGF = 776 * MiB;
constexpr size_t WS_MERGB = 840 * MiB;
constexpr size_t WS_XA = 872 * MiB;
constexpr size_t WS_XB = 936 * MiB;
constexpr size_t WS_HN2 = 1000 * MiB;
constexpr size_t WS_LIST = 1032 * MiB;
constexpr size_t WS_TOK = 1034 * MiB;
constexpr size_t WS_ACT = 1036 * MiB;
constexpr size_t WS_EO = 1180 * MiB;
constexpr size_t WS_ORAW = 1324 * MiB;
constexpr size_t WS_QLN = 1356 * MiB;
constexpr size_t WS_KVN = 1368 * MiB;
constexpr size_t WS_QRAW = 1376 * MiB;
constexpr size_t WS_KVRAW = 1424 * MiB;
constexpr size_t WS_SLOC = 1488 * MiB;
constexpr size_t WS_ST = 1552 * MiB;
constexpr size_t WS_DEC = 1584 * MiB;
constexpr size_t WS_GT = 1585 * MiB;
constexpr size_t WS_END = 1681 * MiB;
constexpr int CW_CNT = 64;
constexpr int CW_OFF = 256;

template <int MODE>
__global__ void k_transpose(const float* __restrict__ in, bf16* __restrict__ out, int K, int N, int NP, int rowoff, size_t ibs, size_t obs) {
    __shared__ float t[32][33];
    const int n0 = blockIdx.x * 32, k0 = blockIdx.y * 32, tx = threadIdx.x & 31, ty = threadIdx.x >> 5;
    const float* ip = in + (size_t)blockIdx.z * ibs; bf16* op = out + (size_t)blockIdx.z * obs;
#pragma unroll
    for (int j = 0; j < 4; ++j) t[ty + 8 * j][tx] = ip[(size_t)(k0 + ty + 8 * j) * N + n0 + tx];
    __syncthreads();
#pragma unroll
    for (int j = 0; j < 4; ++j) {
        int n = n0 + ty + 8 * j; int r = n;
        if (MODE == 1) { const int half = n >> 10, c = n & 1023; r = (c >> 7) * 256 + half * 128 + (c & 127); }
        op[(size_t)(rowoff + r) * K + k0 + tx] = f2bf(t[tx][ty + 8 * j]);
    }
}
__global__ void k_zero_bf16(bf16* p, size_t n) { size_t i = (size_t)blockIdx.x * blockDim.x + threadIdx.x; if (i < n) p[i] = 0; }

__global__ void k_fold_pool(const float* __restrict__ w_pool, const float* __restrict__ scale, const float* __restrict__ w_br_c, bf16* __restrict__ wbrt) {
    const int l = blockIdx.z, k = blockIdx.y, n = blockIdx.x * 256 + threadIdx.x, g = k >> 7, c = k & 127;
    const float* wp = w_pool + ((size_t)l * 4 + g) * 128 * 128 + (size_t)c * 128; const float* sc = scale + l * 512 + g * 128; const float* wb = w_br_c + (size_t)l * 512 * 1024 + (size_t)g * 128 * 1024;
    float a = 0.f;
    for (int d = 0; d < 128; ++d) a += wp[d] * sc[d] * wb[(size_t)d * 1024 + n];
    wbrt[(size_t)l * 3072 * 512 + (size_t)(2048 + n) * 512 + k] = f2bf(a);
}
__global__ void k_adaln(const float* __restrict__ c, const float* __restrict__ ada_w, const float* __restrict__ ada_b, float* __restrict__ mod) {
    __shared__ float cs[8][1024];
    for (int i = threadIdx.x; i < 8192; i += 256) { float v = c[i]; cs[i >> 10][i & 1023] = v / (1.f + __expf(-v)); }
    __syncthreads();
    const int l = blockIdx.y, j = blockIdx.x * 256 + threadIdx.x;
    const float* w = ada_w + (size_t)l * 1024 * 6144 + j;
    float a0 = 0, a1 = 0, a2 = 0, a3 = 0, a4 = 0, a5 = 0, a6 = 0, a7 = 0;
    for (int k = 0; k < 1024; ++k) { const float wv = w[(size_t)k * 6144];
        a0 += cs[0][k] * wv; a1 += cs[1][k] * wv; a2 += cs[2][k] * wv; a3 += cs[3][k] * wv; a4 += cs[4][k] * wv; a5 += cs[5][k] * wv; a6 += cs[6][k] * wv; a7 += cs[7][k] * wv; }
    const float bb = ada_b[l * 6144 + j]; float* m = mod + (size_t)l * 8 * 6144 + j;
    m[0 * 6144] = a0 + bb; m[1 * 6144] = a1 + bb; m[2 * 6144] = a2 + bb; m[3 * 6144] = a3 + bb; m[4 * 6144] = a4 + bb; m[5 * 6144] = a5 + bb; m[6 * 6144] = a6 + bb; m[7 * 6144] = a7 + bb;
}
struct InvF { float f[16]; };
__global__ void k_misc(const float* __restrict__ hgrn_lb, const int* __restrict__ pos, float* __restrict__ lb, float* __restrict__ rope, InvF invf) {
    const int i = blockIdx.x * 256 + threadIdx.x;
    if (i < 512) { const float a = hgrn_lb[i], b = hgrn_lb[512 + i]; const float m = fmaxf(a, b); const float ea = __expf(a - m), eb = __expf(b - m); lb[i] = 0.f; lb[512 + i] = eb / (ea + eb); }
    if (i < NT * 16) { const int t = i >> 4, j = i & 15; float fv = invf.f[0];
#pragma unroll
        for (int q = 1; q < 16; ++q) if (j == q) fv = invf.f[q];
        const double ang = (double)pos[t] * (double)fv;
        double r = ang * 0.15915494309189535; r -= floor(r + 0.5); const float a = (float)(r * 6.283185307179586);
        rope[i] = __cosf(a); rope[NT * 16 + i] = __sinf(a); }
}

__global__ void k_norm_mod(const float* __restrict__ x, const float* __restrict__ g, const float* __restrict__ mod_sh, const float* __restrict__ mod_sc, bf16* __restrict__ out) {
    const int row = blockIdx.x * 4 + (threadIdx.x >> 6), lane = threadIdx.x & 63, b = row / S;
    const float4* xr = (const float4*)(x + (size_t)row * D);
    float4 v[4]; float ss = 0.f;
#pragma unroll
    for (int j = 0; j < 4; ++j) { v[j] = xr[lane + 64 * j]; ss += v[j].x * v[j].x + v[j].y * v[j].y + v[j].z * v[j].z + v[j].w * v[j].w; }
#pragma unroll
    for (int o = 1; o < 64; o <<= 1) ss += __shfl_xor(ss, o);
    const float rstd = rsqrtf(ss * (1.f / D) + EPS);
#pragma unroll
    for (int j = 0; j < 4; ++j) { const int c = (lane + 64 * j) * 4; const float4 gg = *(const float4*)(g + c), sh = *(const float4*)(mod_sh + b * 6144 + c), sc = *(const float4*)(mod_sc + b * 6144 + c);
        ushort4 o; o.x = f2bf(v[j].x * rstd * gg.x * (1.f + sc.x) + sh.x); o.y = f2bf(v[j].y * rstd * gg.y * (1.f + sc.y) + sh.y); o.z = f2bf(v[j].z * rstd * gg.z * (1.f + sc.z) + sh.z); o.w = f2bf(v[j].w * rstd * gg.w * (1.f + sc.w) + sh.w);
        *(ushort4*)(out + (size_t)row * D + c) = o; }
}

struct GemmArgs { const bf16* A; const bf16* Bt; const int* rowlist; const int* cnt; const int* off; float* outf; bf16* outb; const bf16* gate; const float* xin; const float* gvec; const float* bias;
    int lda, ldb, K, ldc, pad0, pad1; };
template <int MODE, int BRI>
__global__ void __launch_bounds__(256) k_gemm(GemmArgs g) {
    __shared__ float As[16][65], Bs[16][65], Bs2[16][65];
    const int tid = threadIdx.x, tx = tid & 15, ty = tid >> 4;
    int m0 = blockIdx.y * 64, n0 = blockIdx.x * 64; int e = 0, cnt = 1 << 30, orow0 = m0;
    const bf16* Bt = g.Bt;
    if (MODE == 4 || MODE == 5) { e = blockIdx.z; cnt = g.cnt[e]; if (m0 >= cnt) return; orow0 = g.off[e] + m0; Bt += (size_t)e * (MODE == 4 ? 2048 : 1024) * g.ldb; }
    const int lr = tid >> 2, lk = (tid & 3) * 4;
    size_t arow;
    if (MODE == 4) { const int slot = m0 + lr; arow = (slot < cnt) ? (size_t)g.rowlist[(size_t)e * CAP + slot] : 0; }
    else if (MODE == 5) arow = (size_t)(orow0 + lr);
    else arow = (size_t)(m0 + lr);
    const bf16* ap = g.A + arow * g.lda + lk;
    int bn = n0 + lr;
    if (MODE == 4) { const int t = n0 >> 6;     const int col = n0 + lr; bn = (col >> 7) * 256 + (col & 127); (void)t; }
    const bf16* bp = Bt + (size_t)bn * g.ldb + lk;
    const bf16* bp2 = bp + (size_t)128 * g.ldb;
    float acc[4][4], acc2[4][4];
#pragma unroll
    for (int i = 0; i < 4; ++i)
#pragma unroll
        for (int j = 0; j < 4; ++j) { acc[i][j] = 0.f; acc2[i][j] = 0.f; }
    for (int k0 = 0; k0 < g.K; k0 += 16) {
        const ushort4 av = *(const ushort4*)(ap + k0), bv = *(const ushort4*)(bp + k0);
        As[lk + 0][lr] = bf2f(av.x); As[lk + 1][lr] = bf2f(av.y); As[lk + 2][lr] = bf2f(av.z); As[lk + 3][lr] = bf2f(av.w);
        Bs[lk + 0][lr] = bf2f(bv.x); Bs[lk + 1][lr] = bf2f(bv.y); Bs[lk + 2][lr] = bf2f(bv.z); Bs[lk + 3][lr] = bf2f(bv.w);
        if (MODE == 4) { const ushort4 cv = *(const ushort4*)(bp2 + k0); Bs2[lk + 0][lr] = bf2f(cv.x); Bs2[lk + 1][lr] = bf2f(cv.y); Bs2[lk + 2][lr] = bf2f(cv.z); Bs2[lk + 3][lr] = bf2f(cv.w); }
        __syncthreads();
#pragma unroll
        for (int kk = 0; kk < 16; ++kk) {
            float a[4], b[4], b2[4];
#pragma unroll
            for (int i = 0; i < 4; ++i) { a[i] = As[kk][ty * 4 + i]; b[i] = Bs[kk][tx * 4 + i]; if (MODE == 4) b2[i] = Bs2[kk][tx * 4 + i]; }
#pragma unroll
            for (int i = 0; i < 4; ++i)
#pragma unroll
                for (int j = 0; j < 4; ++j) { acc[i][j] += a[i] * b[j]; if (MODE == 4) acc2[i][j] += a[i] * b2[j]; }
        }
        __syncthreads();
    }
#pragma unroll
    for (int i = 0; i < 4; ++i) {
        const int rl = ty * 4 + i;
        if ((MODE == 4 || MODE == 5) && m0 + rl >= cnt) continue;
        const size_t row = (MODE == 4 || MODE == 5) ? (size_t)(orow0 + rl) : (size_t)(m0 + rl);
#pragma unroll
        for (int j = 0; j < 4; ++j) {
            const int col = n0 + tx * 4 + j; const float v = acc[i][j];
            if (MODE == 0) g.outb[row * g.ldc + col] = f2bf(v);
            else if (MODE == 1) g.outf[row * g.ldc + col] = v;
            else if (MODE == 2) { const float gt = sigmoidf_(bf2f(g.gate[row * INP + col])) * v; float* o = g.outf + row * g.ldc + col;
                if (BRI == 0) *o = gt; else if (BRI == 1) *o += gt; else { const float s = *o + gt; *o = s; g.outb[row * g.ldc + col] = f2bf(s); } }
            else if (MODE == 3) { const int b = (int)(row / S); g.outf[row * g.ldc + col] = g.xin[row * g.ldc + col] + g.gvec[b * 6144 + col] * v; }
            else if (MODE == 4) { float glu = v + g.bias[e * 2048 + col], lin = acc2[i][j] + g.bias[e * 2048 + 1024 + col];
                glu = fminf(glu, 7.f); lin = fminf(fmaxf(lin, -7.f), 7.f);
                g.outb[row * g.ldc + col] = f2bf(glu * sigmoidf_(1.702f * glu) * (lin + 1.f)); }
            else if (MODE == 5) g.outb[row * g.ldc + col] = f2bf(v + g.bias[e * 1024 + col]);
        }
    }
}

__global__ void __launch_bounds__(128) k_hgrn_naive(const bf16* __restrict__ P, const float* __restrict__ lb, float* __restrict__ oraw) {
    __shared__ float qs[16][128], ks[16][128], fs[16][128];
    const int b = blockIdx.x >> 2, h = blockIdx.x & 3, v = threadIdx.x;
    const float lbv = lb[h * 128 + v];
    float st[128];
#pragma unroll
    for (int d = 0; d < 128; ++d) st[d] = 0.f;
    for (int t0 = 0; t0 < S; t0 += 16) {
        __syncthreads();
        for (int tt = 0; tt < 16; ++tt) { const bf16* pr = P + (size_t)(b * S + t0 + tt) * INP;
            const float z = bf2f(pr[C_HF + h * 128 + v]); const float sg = sigmoidf_(z);
            qs[tt][v] = bf2f(pr[C_HQ + h * 128 + v]); fs[tt][v] = lbv + (1.f - lbv) * sg; ks[tt][v] = (1.f - lbv) * (1.f - sg); }
        __syncthreads();
        for (int tt = 0; tt < 16; ++tt) {
            const float vv = bf2f(P[(size_t)(b * S + t0 + tt) * INP + C_HI + h * 128 + v]);
            float o = 0.f;
#pragma unroll
            for (int d = 0; d < 128; ++d) { st[d] = fs[tt][d] * st[d] + ks[tt][d] * vv; o += qs[tt][d] * st[d]; }
            oraw[(size_t)(b * S + t0 + tt) * 512 + h * 128 + v] = o;
        }
    }
}
__global__ void k_hgrn_out(const float* __restrict__ oraw, const bf16* __restrict__ P, const float* __restrict__ og, bf16* __restrict__ BR) {
    const int idx = blockIdx.x * 4 + (threadIdx.x >> 6), lane = threadIdx.x & 63, t = idx >> 2, h = idx & 3;
    const float o0 = oraw[(size_t)t * 512 + h * 128 + lane], o1 = oraw[(size_t)t * 512 + h * 128 + 64 + lane];
    float ss = o0 * o0 + o1 * o1;
#pragma unroll
    for (int o = 1; o < 64; o <<= 1) ss += __shfl_xor(ss, o);
    const float rstd = rsqrtf(ss * (1.f / 128.f) + EPS);
    const float g0 = bf2f(P[(size_t)t * INP + C_HG + h * 128 + lane]), g1 = bf2f(P[(size_t)t * INP + C_HG + h * 128 + 64 + lane]);
    BR[(size_t)t * 1536 + h * 128 + lane] = f2bf(o0 * rstd * og[lane] * g0 * sigmoidf_(g0));
    BR[(size_t)t * 1536 + h * 128 + 64 + lane] = f2bf(o1 * rstd * og[64 + lane] * g1 * sigmoidf_(g1));
}
__global__ void k_mla_prep(const bf16* __restrict__ P, const float* __restrict__ qg, const float* __restrict__ kvg, bf16* __restrict__ qln, bf16* __restrict__ kvn) {
    const int t = blockIdx.x * 4 + (threadIdx.x >> 6), lane = threadIdx.x & 63; const bf16* pr = P + (size_t)t * INP;
    float q[6], kv[4], s1 = 0.f, s2 = 0.f;
#pragma unroll
    for (int j = 0; j < 6; ++j) { q[j] = bf2f(pr[C_QLAT + lane + 64 * j]); s1 += q[j] * q[j]; }
#pragma unroll
    for (int j = 0; j < 4; ++j) { kv[j] = bf2f(pr[C_KVLAT + lane + 64 * j]); s2 += kv[j] * kv[j]; }
#pragma unroll
    for (int o = 1; o < 64; o <<= 1) { s1 += __shfl_xor(s1, o); s2 += __shfl_xor(s2, o); }
    const float r1 = rsqrtf(s1 * (1.f / 384.f) + EPS), r2 = rsqrtf(s2 * (1.f / 256.f) + EPS);
#pragma unroll
    for (int j = 0; j < 6; ++j) qln[(size_t)t * 384 + lane + 64 * j] = f2bf(q[j] * r1 * qg[lane + 64 * j]);
#pragma unroll
    for (int j = 0; j < 4; ++j) kvn[(size_t)t * 256 + lane + 64 * j] = f2bf(kv[j] * r2 * kvg[lane + 64 * j]);
}
__global__ void k_mla_post(const float* __restrict__ qraw, const float* __restrict__ kvraw, const bf16* __restrict__ P, const float* __restrict__ qng, const float* __restrict__ kng,
                           const float* __restrict__ rope, bf16* __restrict__ Q, bf16* __restrict__ K, bf16* __restrict__ V) {
    const int idx = blockIdx.x * 4 + (threadIdx.x >> 6), lane = threadIdx.x & 63, t = idx >> 3, h = idx & 7, b = t / S, s = t % S;
    const float qa = qraw[(size_t)t * 768 + h * 96 + lane], qb = qraw[(size_t)t * 768 + h * 96 + 64 + (lane & 31)];
    const float ka = kvraw[(size_t)t * 1024 + h * 128 + lane], kb = bf2f(P[(size_t)t * INP + C_KROPE + (lane & 31)]);
    const float va = kvraw[(size_t)t * 1024 + h * 128 + 64 + lane];
    float sq = qa * qa + (lane < 32 ? qb * qb : 0.f), sk = ka * ka + (lane < 32 ? kb * kb : 0.f);
#pragma unroll
    for (int o = 1; o < 64; o <<= 1) { sq += __shfl_xor(sq, o); sk += __shfl_xor(sk, o); }
    const float rq = rsqrtf(sq * (1.f / 96.f) + EPS), rk = rsqrtf(sk * (1.f / 96.f) + EPS);
    const size_t ob = ((size_t)(b * MH + h) * S + s);
    Q[ob * 96 + lane] = f2bf(qa * rq * qng[lane]); K[ob * 96 + lane] = f2bf(ka * rk * kng[lane]); V[((size_t)(b * MH + h) * 64 + lane) * S + s] = f2bf(va);
    const float qn = qb * rq * qng[64 + (lane & 31)], kn = kb * rk * kng[64 + (lane & 31)];
    const float qo = __shfl_xor(qn, 16), ko = __shfl_xor(kn, 16);
    const int i = lane & 15; const float cs = rope[(size_t)t * 16 + i], sn = rope[(size_t)NT * 16 + (size_t)t * 16 + i];
    if (lane < 32) { float qr, kr; if (lane < 16) { qr = qn * cs - qo * sn; kr = kn * cs - ko * sn; } else { qr = qn * cs + qo * sn; kr = kn * cs + ko * sn; }
        Q[ob * 96 + 64 + lane] = f2bf(qr); K[ob * 96 + 64 + lane] = f2bf(kr); }
}
__global__ void __launch_bounds__(64) k_attn_naive(const bf16* __restrict__ Q, const bf16* __restrict__ K, const bf16* __restrict__ V, bf16* __restrict__ BR) {
    __shared__ float ks[16][96], vs[16][64];
    const int bh = blockIdx.y, q0 = blockIdx.x * 64, qi = q0 + threadIdx.x, b = bh >> 3, h = bh & 7;
    float q[96], o[64]; float m = -INFINITY, l = 0.f;
    const bf16* qp = Q + ((size_t)bh * S + qi) * 96;
#pragma unroll
    for (int d = 0; d < 96; ++d) q[d] = bf2f(qp[d]) * 0.10206207261596575f;
#pragma unroll
    for (int d = 0; d < 64; ++d) o[d] = 0.f;
    for (int k0 = 0; k0 < q0 + 64; k0 += 16) {
        __syncthreads();
        for (int i = threadIdx.x; i < 16 * 96; i += 64) ks[i / 96][i % 96] = bf2f(K[((size_t)bh * S + k0) * 96 + i]);
        for (int i = threadIdx.x; i < 16 * 64; i += 64) vs[i & 15][i >> 4] = bf2f(V[((size_t)bh * 64 + (i >> 4)) * S + k0 + (i & 15)]);
        __syncthreads();
        for (int j = 0; j < 16; ++j) {
            if (k0 + j > qi) break;
            float sc = 0.f;
#pragma unroll
            for (int d = 0; d < 96; ++d) sc += q[d] * ks[j][d];
            const float mn = fmaxf(m, sc), corr = __expf(m - mn), p = __expf(sc - mn);
            l = l * corr + p; m = mn;
#pragma unroll
            for (int d = 0; d < 64; ++d) o[d] = o[d] * corr + p * vs[j][d];
        }
    }
    const float inv = 1.f / l; bf16* op = BR + (size_t)(b * S + qi) * 1536 + 512 + h * 64;
#pragma unroll
    for (int d = 0; d < 64; ++d) op[d] = f2bf(o[d] * inv);
}
__global__ void k_pool(const bf16* __restrict__ P, bf16* __restrict__ BR) {
    const int i = blockIdx.x * 256 + threadIdx.x, t = i >> 9, c = i & 511, g = c >> 7, s = t % S, w = 2 << g;
    const int n = (s + 1 < w) ? s + 1 : w; float sum = 0.f;
    for (int j = 0; j < n; ++j) sum += bf2f(P[(size_t)(t - j) * INP + C_POOL + c]);
    const float u = bf2f(P[(size_t)t * INP + C_POOL + c]);
    BR[(size_t)t * 1536 + 1024 + c] = f2bf(sum / (float)n - u);
}
__global__ void k_router(const float* __restrict__ x, const float* __restrict__ g, const float* __restrict__ mod_sh, const float* __restrict__ mod_sc, const float* __restrict__ wr, const float* __restrict__ br,
                         bf16* __restrict__ hn2, int* __restrict__ cnt, int* __restrict__ list, int* __restrict__ tokE, int* __restrict__ tokS, float* __restrict__ tokW) {
    __shared__ float hs[4][1024];
    const int w = threadIdx.x >> 6, row = blockIdx.x * 4 + w, lane = threadIdx.x & 63, b = row / S;
    const float4* xr = (const float4*)(x + (size_t)row * D);
    float4 v[4]; float ss = 0.f;
#pragma unroll
    for (int j = 0; j < 4; ++j) { v[j] = xr[lane + 64 * j]; ss += v[j].x * v[j].x + v[j].y * v[j].y + v[j].z * v[j].z + v[j].w * v[j].w; }
#pragma unroll
    for (int o = 1; o < 64; o <<= 1) ss += __shfl_xor(ss, o);
    const float rstd = rsqrtf(ss * (1.f / D) + EPS);
#pragma unroll
    for (int j = 0; j < 4; ++j) { const int c = (lane + 64 * j) * 4; const float4 gg = *(const float4*)(g + c), sh = *(const float4*)(mod_sh + b * 6144 + c), sc = *(const float4*)(mod_sc + b * 6144 + c);
        float4 hv; hv.x = v[j].x * rstd * gg.x * (1.f + sc.x) + sh.x; hv.y = v[j].y * rstd * gg.y * (1.f + sc.y) + sh.y; hv.z = v[j].z * rstd * gg.z * (1.f + sc.z) + sh.z; hv.w = v[j].w * rstd * gg.w * (1.f + sc.w) + sh.w;
        ushort4 o; o.x = f2bf(hv.x); o.y = f2bf(hv.y); o.z = f2bf(hv.z); o.w = f2bf(hv.w);
        *(ushort4*)(hn2 + (size_t)row * D + c) = o; *(float4*)&hs[w][c] = hv; }
    __syncthreads();
    const int e = lane & 31, half = lane >> 5; float a = 0.f;
    for (int k = half * 512; k < half * 512 + 512; ++k) a += hs[w][k] * wr[k * 32 + e];
    a += __shfl_xor(a, 32); a += br[e];
    float cur = a; float tv[4]; int ti[4];
#pragma unroll
    for (int k = 0; k < 4; ++k) { float mv = cur; int mi = e;
#pragma unroll
        for (int o = 1; o < 32; o <<= 1) { const float ov = __shfl_xor(mv, o); const int oi = __shfl_xor(mi, o); if (ov > mv || (ov == mv && oi < mi)) { mv = ov; mi = oi; } }
        tv[k] = mv; ti[k] = mi; if (e == mi) cur = -INFINITY; }
    const float e1 = __expf(tv[1] - tv[0]), e2 = __expf(tv[2] - tv[0]), e3 = __expf(tv[3] - tv[0]), inv = 1.f / (1.f + e1 + e2 + e3);
    if (lane == 0) {
        const float ww[4] = {inv, e1 * inv, e2 * inv, e3 * inv};
#pragma unroll
        for (int k = 0; k < 4; ++k) { const int slot = atomicAdd(&cnt[ti[k]], 1); list[(size_t)ti[k] * CAP + slot] = row; tokE[row * 4 + k] = ti[k]; tokS[row * 4 + k] = slot; tokW[row * 4 + k] = ww[k]; }
    }
}
__global__ void k_offsets(const int* __restrict__ cnt, int* __restrict__ off) { if (threadIdx.x == 0) { int a = 0; for (int e = 0; e < 32; ++e) { off[e] = a; a += (cnt[e] + 255) & ~255; } off[32] = a; } }
__global__ void k_combine(const float* __restrict__ x1, const float* __restrict__ mod_g2, const bf16* __restrict__ EO, const int* __restrict__ off, const int* __restrict__ tokE, const int* __restrict__ tokS, const float* __restrict__ tokW, float* __restrict__ out) {
    const int row = blockIdx.x, b = row / S, c = threadIdx.x * 4;
    float4 acc = {0.f, 0.f, 0.f, 0.f};
#pragma unroll
    for (int k = 0; k < 4; ++k) { const int e = tokE[row * 4 + k]; const size_t r = (size_t)off[e] + tokS[row * 4 + k]; const float w = tokW[row * 4 + k];
        const ushort4 ev = *(const ushort4*)(EO + r * 1024 + c); acc.x += w * bf2f(ev.x); acc.y += w * bf2f(ev.y); acc.z += w * bf2f(ev.z); acc.w += w * bf2f(ev.w); }
    const float4 xv = *(const float4*)(x1 + (size_t)row * D + c), gg = *(const float4*)(mod_g2 + b * 6144 + c);
    float4 o; o.x = xv.x + gg.x * acc.x; o.y = xv.y + gg.y * acc.y; o.z = xv.z + gg.z * acc.z; o.w = xv.w + gg.w * acc.w;
    *(float4*)(out + (size_t)row * D + c) = o;
}

#define MK_HYBRID 0
#define MK_POOL_IN 1
#define MK_MLA_IN 1
#define MK_ATTN_IN 1
#define MK_HGRN_IN 1
#define MK_INPROJ_W 200
__device__ __forceinline__ unsigned mk_lane_id() { unsigned l; asm volatile("v_mbcnt_lo_u32_b32 %0, -1, 0\n\tv_mbcnt_hi_u32_b32 %0, -1, %0" : "=v"(l)); return l; }
#define GAS __attribute__((address_space(1)))
#define LAS __attribute__((address_space(3)))
#define XB_TMO      128
#define XB_XCNT(j)  (256  + 64 * (j))
#define XB_XSUB(j)  (1280 + 64 * (j))
#define XB_XGEN(j)  (2304 + 64 * (j))
#define XB_TOP      3328
#define XB_TOPGEN   3392
#define XCD_BAR_WORDS 3456
#define XB_SPIN_CAP (1u << 18)

__device__ __forceinline__ unsigned xb_ld(unsigned* p)              { return __hip_atomic_load(p, __ATOMIC_RELAXED, __HIP_MEMORY_SCOPE_AGENT); }
__device__ __forceinline__ unsigned xb_add(unsigned* p, unsigned v) { return __hip_atomic_fetch_add(p, v, __ATOMIC_RELAXED, __HIP_MEMORY_SCOPE_AGENT); }
__device__ __forceinline__ unsigned xb_xcc_id() { return (unsigned)__builtin_amdgcn_s_getreg((3 << 11) | 20) & 0xFu; }
#define XB_SPIN(cond, bar) do { unsigned _sp = 0; while (cond) { __builtin_amdgcn_s_sleep(1); \
    if ((++_sp & 255u) == 0u) { if (xb_ld(&(bar)[XB_TMO])) break; if (_sp > XB_SPIN_CAP) { atomicAdd(&(bar)[XB_TMO], 1u); break; } } } } while (0)

struct XcdBarrier {
    unsigned* bar; unsigned x; int wv;
    volatile LAS unsigned* st;
};

__device__ __forceinline__ bool xb_thread0(int wv) { return wv == 0 && mk_lane_id() == 0u; }
__device__ __forceinline__ XcdBarrier xcd_barrier_post(unsigned* bar, volatile LAS unsigned* st, int wv) {
    XcdBarrier b; b.bar = bar; b.x = xb_xcc_id(); b.st = st; b.wv = wv;
    if (xb_thread0(wv)) (void)xb_add(&bar[XB_XCNT(b.x)], 1u);
    return b;
}
__device__ __forceinline__ void xcd_barrier_complete(unsigned* bar, unsigned x, unsigned& nloc, unsigned& nx) {
    const unsigned G = gridDim.x * gridDim.y * gridDim.z;
    unsigned sum, cnt, mine, sp = 0u;
    for (;;) {
        sum = 0u; cnt = 0u; mine = 0u;
#pragma unroll
        for (unsigned j = 0; j < 16; ++j) { const unsigned c = xb_ld(&bar[XB_XCNT(j)]); sum += c; cnt += (c > 0u) ? 1u : 0u; mine = (j == x) ? c : mine; }
        if (sum == G) break;
        __builtin_amdgcn_s_sleep(1);
        if ((++sp & 255u) == 0u) { if (xb_ld(&bar[XB_TMO])) break; if (sp > XB_SPIN_CAP) { atomicAdd(&bar[XB_TMO], 1u); break; } }
    }
    nloc = mine > 0u ? mine : 1u; nx = cnt > 0u ? cnt : 1u;
}

__device__ __forceinline__ void xcd_barrier(const XcdBarrier& b) {
    asm volatile("s_waitcnt vmcnt(0)" ::: "memory");
    __syncthreads();
    if (xb_thread0(b.wv)) {
        unsigned* bar = b.bar;
        __builtin_amdgcn_s_waitcnt(0);
        unsigned nloc = b.st[0], nx = b.st[1];
        if (nloc == 0u) { xcd_barrier_complete(bar, b.x, nloc, nx); b.st[0] = nloc; b.st[1] = nx; }
        const unsigned old = xb_add(&bar[XB_XSUB(b.x)], 1u);
        const unsigned gen = old / nloc;
        if (old + 1u == (gen + 1u) * nloc) {
            __builtin_amdgcn_fence(__ATOMIC_RELEASE, "agent");
            asm volatile("s_waitcnt vmcnt(0)" ::: "memory");
            const unsigned og = xb_add(&bar[XB_TOP], 1u);
            const unsigned tg = og / nx;
            if (og + 1u == (tg + 1u) * nx) xb_add(&bar[XB_TOPGEN], 1u);
            else XB_SPIN(xb_ld(&bar[XB_TOPGEN]) == tg, bar);
            __builtin_amdgcn_fence(__ATOMIC_ACQUIRE, "agent");
            xb_add(&bar[XB_XGEN(b.x)], 1u);
            asm volatile("s_waitcnt vmcnt(0)" ::: "memory");
        } else {
            XB_SPIN(xb_ld(&bar[XB_XGEN(b.x)]) == gen, bar);
            __builtin_amdgcn_fence(__ATOMIC_ACQUIRE, "agent");
            asm volatile("s_waitcnt vmcnt(0)" ::: "memory");
        }
    }
    __syncthreads();
}
namespace pg8 {
#define PG8_LAS __attribute__((address_space(3)))
typedef unsigned short bf16_t;
typedef short bf16x8 __attribute__((ext_vector_type(8)));
typedef float f32x4 __attribute__((ext_vector_type(4)));
typedef unsigned u32x4 __attribute__((ext_vector_type(4)));
constexpr int BM = 256, BK = 64, HALF = 128, HTB = HALF * BK * 2  , STAGE_BYTES = 8 * HTB, NXCD = 8, WGM = 8;

__host__ __device__ __forceinline__ int lds_byte(int r, int c) { const int st = (r >> 4) * 2 + (c >> 5), rr = r & 15, cc = c & 31, ob = rr * 64 + cc * 2; return st * 1024 + (ob ^ (((ob >> 9) & 1) << 5)); }
__host__ __device__ __forceinline__ void stage_rc(int b, int& R, int& C) { const int st = b / 1024, sb = b % 1024, swz = sb ^ (((sb >> 9) & 1) << 5); R = (st >> 1) * 16 + swz / 64; C = (st & 1) * 32 + (swz % 64) / 2; }
__host__ __device__ __forceinline__ int perm32(int rho) { const int n = rho >> 4, i = rho & 15; return 8 * (i >> 2) + 4 * n + (i & 3); }

struct Unit { int pm, pn, ka, aux, e, gbase, gcnt, pad; };
struct Gemm { const bf16_t* A; const bf16_t* Bt; const int* rowlist; int lda, ldb, K, pad; };

struct StaticOrder {
    int nM, nN, nwg, G, c;
    __host__ __device__ void init(int M, int N, int G_, int c_) { nM = M / BM; nN = N / BM; nwg = nM * nN; G = G_; c = c_; }
    __host__ __device__ bool next(int i, Unit& u) const {
        const long L = (long)i * G + c; if (L >= nwg) return false;
        int wgid = (int)L; { const int q = nwg / NXCD, r = nwg % NXCD, xcd = wgid % NXCD, off = wgid / NXCD; wgid = (xcd < r ? xcd * (q + 1) : r * (q + 1) + (xcd - r) * q) + off; }
        const int nig = WGM * nN, gid = wgid / nig, fm = gid * WGM, gsz = (nM - fm) < WGM ? (nM - fm) : WGM;
        u.pm = fm + ((wgid % nig) % gsz); u.pn = (wgid % nig) / gsz; u.ka = 0; u.aux = 0; u.e = 0; u.gbase = 0; u.gcnt = 0; u.pad = 0; return true;
    }
};

typedef float cvt_f32x2 __attribute__((ext_vector_type(2)));
typedef __bf16 cvt_bf16x2 __attribute__((ext_vector_type(2)));
__device__ __forceinline__ unsigned cvt_pk_bf16(float lo, float hi) { const cvt_f32x2 v = {lo, hi}; return __builtin_bit_cast(unsigned, __builtin_convertvector(v, cvt_bf16x2)); }

template <class Epi, class Sched, bool ALIGN_EPI, bool SP2, bool GATHER, int HOOK = 0>
__device__ __forceinline__ void gemm_phase(PG8_LAS unsigned char* lds, const Gemm g, const Sched& S, const Epi& E, int wave_in) {
    int tid_ = wave_in * 64 + (int)mk_lane_id(); asm volatile("" : "+v"(tid_));
    const int tid = tid_, wid = __builtin_amdgcn_readfirstlane(tid >> 6), lane = tid & 63, wr = wid >> 2, wc = wid & 3, fr = lane & 15, fq = lane >> 4;
    const int K = g.K, nt = K / BK;
    const unsigned ldaB = (unsigned)g.lda * 2u, ldbB = (unsigned)g.ldb * 2u;
    unsigned voffA[2], voffB[2]; int rowA[2];
#pragma unroll
    for (int i = 0; i < 2; ++i) { int R, C; stage_rc(tid * 16 + i * 8192, R, C); const int Rb = Epi::PERM ? ((R & ~31) + perm32(R & 31)) : R;
        rowA[i] = R; voffA[i] = GATHER ? (unsigned)C * 2u : (unsigned)R * ldaB + (unsigned)C * 2u; voffB[i] = (unsigned)Rb * ldbB + (unsigned)C * 2u; }
    const size_t kstep = (size_t)(BK * 2);
    const size_t hstepA = GATHER ? 0 : (size_t)HALF * ldaB, hstepB = (size_t)HALF * ldbB;
    const size_t tstepA = 2 * (size_t)HALF * ldaB, tstepB = 2 * hstepB;
    const unsigned ldsw = (unsigned)wid * 1024u;
    const int aoff = lds_byte(wr * 64 + fr, fq * 8), boff = lds_byte(wc * 32 + fr, fq * 8);
    unsigned gvc[2][2], gvn[2][2];
#define PG8_SA(b, h) (((b) * 2 + (h)) * HTB)
#define PG8_SB(b, h) ((4 + (b) * 2 + (h)) * HTB)
#define PG8_STAGE(bufoff, gbase, voff) do { _Pragma("unroll") for (int _i = 0; _i < 2; ++_i) \
        __builtin_amdgcn_global_load_lds((const unsigned*)((const char*)(gbase) + (voff)[_i]), (PG8_LAS unsigned*)(lds + (bufoff) + ldsw + _i * 8192), 16, 0, 0); } while (0)
#define PG8_STAGEA(bufoff, gbase, h, nx) do { if constexpr (GATHER) { unsigned _vo[2]; _vo[0] = ((nx) ? gvn[h][0] : gvc[h][0]) + voffA[0]; _vo[1] = ((nx) ? gvn[h][1] : gvc[h][1]) + voffA[1]; PG8_STAGE(bufoff, gbase, _vo); } \
        else { PG8_STAGE(bufoff, (const char*)(gbase) + (h) * hstepA, voffA); } } while (0)
#define PG8_GLOAD(dst, u) do { _Pragma("unroll") for (int _h = 0; _h < 2; ++_h) _Pragma("unroll") for (int _i = 0; _i < 2; ++_i) { const int _r = _h * HALF + rowA[_i]; \
        const int _row = (_r < (u).gcnt) ? g.rowlist[(u).gbase + _r] : 0; dst[_h][_i] = (unsigned)_row * ldaB; } } while (0)
#define PG8_LDA(dst, b, h) do { _Pragma("unroll") for (int m = 0; m < 4; ++m) _Pragma("unroll") for (int k = 0; k < 2; ++k) dst[m][k] = *(const PG8_LAS bf16x8*)(lds + PG8_SA(b, h) + aoff + m * 2048 + k * 1024); } while (0)
#define PG8_LDB(dst, b, h) do { _Pragma("unroll") for (int n = 0; n < 2; ++n) _Pragma("unroll") for (int k = 0; k < 2; ++k) dst[n][k] = *(const PG8_LAS bf16x8*)(lds + PG8_SB(b, h) + boff + n * 2048 + k * 1024); } while (0)
#define PG8_MMA(ai, bj, At, Bt) do { __builtin_amdgcn_s_setprio(1); _Pragma("unroll") for (int m = 0; m < 4; ++m) _Pragma("unroll") for (int n = 0; n < 2; ++n) _Pragma("unroll") for (int k = 0; k < 2; ++k) \
        acc[ai][bj][m][n] = __builtin_amdgcn_mfma_f32_16x16x32_bf16(Bt[n][k], At[m][k], acc[ai][bj][m][n], 0, 0, 0); __builtin_amdgcn_s_setprio(0); } while (0)
#define PG8_WAIT_V(n) asm volatile("s_waitcnt vmcnt(" #n ")" ::: "memory")
#define PG8_WAIT_L(n) asm volatile("s_waitcnt lgkmcnt(" #n ")" ::: "memory")
#define PG8_BAR __builtin_amdgcn_s_barrier()
#define PG8_SCHED __builtin_amdgcn_sched_barrier(0)
    Unit cur, nxt; int ui = 0;
    if (!S.next(0, cur)) return;
    f32x4 acc[2][2][4][2];
#pragma unroll
    for (int a = 0; a < 2; ++a)
#pragma unroll
        for (int b = 0; b < 2; ++b)
#pragma unroll
            for (int m = 0; m < 4; ++m)
#pragma unroll
                for (int n = 0; n < 2; ++n) acc[a][b][m][n] = (f32x4){0.f, 0.f, 0.f, 0.f};
    bf16x8 At[4][2], B0[2][2], B1[2][2];
    const char* cA = (const char*)g.A + (GATHER ? (size_t)0 : (size_t)cur.pm * tstepA) + (size_t)cur.ka * 2; const char* cB = (const char*)g.Bt + (size_t)cur.pn * tstepB;
    if constexpr (GATHER) { PG8_GLOAD(gvc, cur); }
#pragma unroll
    for (int h = 0; h < 2; ++h)
#pragma unroll
        for (int i = 0; i < 2; ++i) gvn[h][i] = GATHER ? gvc[h][i] : 0u;
    {
        PG8_STAGE(PG8_SB(0, 0), cB, voffB); PG8_STAGE(PG8_SB(0, 1), cB + hstepB, voffB); PG8_STAGEA(PG8_SA(0, 0), cA, 0, false); PG8_STAGEA(PG8_SA(0, 1), cA, 1, false);
        if (wr == 1) PG8_BAR;
        PG8_WAIT_V(2); PG8_BAR;
        PG8_STAGE(PG8_SB(1, 0), cB + kstep, voffB); PG8_STAGEA(PG8_SA(1, 0), cA + kstep, 0, false); PG8_STAGE(PG8_SB(1, 1), cB + hstepB + kstep, voffB);
        PG8_WAIT_V(6); PG8_BAR;
    }
    for (;;) {
        const bool has_next = S.next(ui + 1, nxt);
        const char* nA = has_next ? (const char*)g.A + (GATHER ? (size_t)0 : (size_t)nxt.pm * tstepA) + (size_t)nxt.ka * 2 : cA; const char* nB = has_next ? (const char*)g.Bt + (size_t)nxt.pn * tstepB : cB;
        if constexpr (GATHER) { if (has_next) { PG8_GLOAD(gvn, nxt); } }
        E.prefetch(cur, wid, lane);
        for (int t = 0; t < nt; t += 2) {
            const bool last = (t == nt - 2);
            if constexpr (HOOK > 0) { if (t > 0 && (t % HOOK) == 0) E.mid(acc, cur, wr, wc, fr, fq, t); }
            const char* a1 = cA + (size_t)(t + 1) * kstep;
            const char* a2 = last ? nA : cA + (size_t)(t + 2) * kstep; const char* b2 = last ? nB : cB + (size_t)(t + 2) * kstep;
            const char* a3 = a2 + kstep; const char* b3 = b2 + kstep;
            PG8_LDB(B0, 0, 0); PG8_LDB(B1, 0, 1); PG8_SCHED; PG8_LDA(At, 0, 0); PG8_STAGEA(PG8_SA(1, 1), a1, 1, false);
            PG8_WAIT_V(8); PG8_WAIT_L(0); PG8_BAR; PG8_MMA(0, 0, At, B0); PG8_MMA(0, 1, At, B1); PG8_BAR; PG8_SCHED;
            PG8_LDA(At, 0, 1); PG8_STAGE(PG8_SB(0, 0), b2, voffB); PG8_STAGE(PG8_SB(0, 1), b2 + hstepB, voffB); PG8_STAGEA(PG8_SA(0, 0), a2, 0, last);
            PG8_WAIT_V(8); PG8_WAIT_L(0); PG8_BAR; PG8_MMA(1, 0, At, B0); PG8_MMA(1, 1, At, B1); PG8_BAR; PG8_SCHED;
            PG8_LDB(B0, 1, 0); PG8_LDB(B1, 1, 1); PG8_SCHED; PG8_LDA(At, 1, 0); PG8_STAGEA(PG8_SA(0, 1), a2, 1, last);
            PG8_WAIT_V(8); PG8_WAIT_L(0); PG8_BAR; PG8_MMA(0, 0, At, B0); PG8_MMA(0, 1, At, B1); PG8_BAR; PG8_SCHED;
            PG8_LDA(At, 1, 1); PG8_STAGE(PG8_SB(1, 0), b3, voffB); PG8_STAGE(PG8_SB(1, 1), b3 + hstepB, voffB); PG8_STAGEA(PG8_SA(1, 0), a3, 0, last);
            PG8_WAIT_V(8); PG8_WAIT_L(0); PG8_BAR; PG8_MMA(1, 0, At, B0); PG8_MMA(1, 1, At, B1); PG8_BAR; PG8_SCHED;
        }
        if constexpr (ALIGN_EPI) { if (wr == 0) PG8_BAR; }
        E(acc, cur, wr, wc, fr, fq);
        if (!has_next) break;
#pragma unroll
        for (int a = 0; a < 2; ++a)
#pragma unroll
            for (int b = 0; b < 2; ++b)
#pragma unroll
                for (int m = 0; m < 4; ++m)
#pragma unroll
                    for (int n = 0; n < 2; ++n) acc[a][b][m][n] = (f32x4){0.f, 0.f, 0.f, 0.f};
        cur = nxt; cA = nA; cB = nB; ++ui;
#pragma unroll
        for (int h = 0; h < 2; ++h)
#pragma unroll
            for (int i = 0; i < 2; ++i) gvc[h][i] = gvn[h][i];
        if constexpr (ALIGN_EPI) { if (wr == 1) PG8_BAR; }
    }
    PG8_WAIT_V(0);
    if constexpr (!ALIGN_EPI) { if (wr == 0) PG8_BAR; }
    PG8_BAR;
#undef PG8_SA
#undef PG8_SB
#undef PG8_STAGE
#undef PG8_STAGEA
#undef PG8_GLOAD
#undef PG8_LDA
#undef PG8_LDB
#undef PG8_MMA
#undef PG8_WAIT_V
#undef PG8_WAIT_L
#undef PG8_BAR
#undef PG8_SCHED
}
}
#ifndef MK_P5PROBE
#define MK_P5PROBE 0
#endif
#ifndef MK_HOOKPROBE
#define MK_HOOKPROBE 0
#endif
typedef unsigned v4u __attribute__((ext_vector_type(4)));
typedef unsigned v2u __attribute__((ext_vector_type(2)));
typedef float f32x4 __attribute__((ext_vector_type(4)));
typedef float f32x16 __attribute__((ext_vector_type(16)));
typedef short bf16x8 __attribute__((ext_vector_type(8)));
#define LDS_WAIT() asm volatile("s_waitcnt lgkmcnt(0)" ::: "memory")
#define VM_WAIT() asm volatile("s_waitcnt vmcnt(0)" ::: "memory")
__device__ __forceinline__ unsigned pk2(float lo, float hi) { return pg8::cvt_pk_bf16(lo, hi); }
__device__ __forceinline__ bf16 f2bf_hw(float x) { return (bf16)(pk2(x, 0.f) & 0xffffu); }
__device__ __forceinline__ float wave_sum(float v) {
#pragma unroll
    for (int o = 1; o < 64; o <<= 1) v += __shfl_xor(v, o);
    return v;
}

__device__ __forceinline__ float bflo(unsigned w) { return __uint_as_float(w << 16); }
__device__ __forceinline__ float bfhi(unsigned w) { return __uint_as_float(w & 0xffff0000u); }
#define MFMA32(a, b, c) __builtin_amdgcn_mfma_f32_32x32x16_bf16((a), (b), (c), 0, 0, 0)
typedef float f32x2 __attribute__((ext_vector_type(2)));
__device__ __forceinline__ f32x2 sq16(const f32x16& a, f32x2 s) {
#pragma unroll
    for (int r = 0; r < 16; r += 2) { const f32x2 p = {a[r], a[r + 1]}; s += p * p; }
    return s;
}

__device__ __forceinline__ void pool_unit(const bf16* __restrict__ P, bf16* __restrict__ BR, int unit, int tid) {
    asm volatile("" : "+v"(tid));
    const int tr = tid >> 6, tc = tid & 63, g = tc >> 4, w = 2 << g;
#pragma unroll 1
    for (int rr = 0; rr < 8; ++rr) {
        const int row = unit * 64 + rr * 8 + tr, s = row & (S - 1), n = (s + 1 < w) ? s + 1 : w;
        const bf16* p = P + (size_t)row * INP + C_POOL + 8 * tc;
        float a[8];
#pragma unroll
        for (int q = 0; q < 8; ++q) a[q] = 0.f;
        v4u wv[16];
#pragma unroll
        for (int j = 0; j < 16; ++j) wv[j] = (j < n) ? *(const GAS v4u*)(p - (size_t)j * INP) : (v4u){0u, 0u, 0u, 0u};
        const v4u u0 = wv[0];
#pragma unroll
        for (int j = 0; j < 16; ++j) { const v4u v = wv[j];
            a[0] += bflo(v.x); a[1] += bfhi(v.x); a[2] += bflo(v.y); a[3] += bfhi(v.y); a[4] += bflo(v.z); a[5] += bfhi(v.z); a[6] += bflo(v.w); a[7] += bfhi(v.w); }
        const float inv = __builtin_amdgcn_rcpf((float)n);
        v4u o; o.x = pk2(a[0] * inv - bflo(u0.x), a[1] * inv - bfhi(u0.x)); o.y = pk2(a[2] * inv - bflo(u0.y), a[3] * inv - bfhi(u0.y));
        o.z = pk2(a[4] * inv - bflo(u0.z), a[5] * inv - bfhi(u0.z)); o.w = pk2(a[6] * inv - bflo(u0.w), a[7] * inv - bfhi(u0.w));
        *(GAS v4u*)(BR + (size_t)row * 1536 + 1024 + 8 * tc) = o;
    }
}

constexpr int MLA_QS = 784, MLA_KS = 528;
__device__ __forceinline__ void mla_unit(const bf16* __restrict__ P, const float* __restrict__ qlat_g, const float* __restrict__ kvlat_g, const bf16* __restrict__ WuqT, const bf16* __restrict__ WukvT,
                                         const float* __restrict__ qn_g, const float* __restrict__ kn_g, const float* __restrict__ rope, bf16* __restrict__ Q, bf16* __restrict__ K, bf16* __restrict__ VT,
                                         LAS unsigned char* lds, int unit, int lane, int wave) {
    asm volatile("" : "+v"(lane));
    LAS unsigned char* qn = lds; LAS unsigned char* kvn = lds + 64 * MLA_QS;
    const int t0 = unit * 64;
#pragma unroll 1
    for (int rb = 0; rb < 2; ++rb) {
        unsigned qv[4][3], kv[4][2];
#pragma unroll
        for (int rr = 0; rr < 4; ++rr) { const bf16* pr = P + (size_t)(t0 + wave * 8 + rb * 4 + rr) * INP;
#pragma unroll
            for (int j = 0; j < 3; ++j) qv[rr][j] = *(const GAS unsigned*)(pr + C_QLAT + 2 * lane + 128 * j);
#pragma unroll
            for (int j = 0; j < 2; ++j) kv[rr][j] = *(const GAS unsigned*)(pr + C_KVLAT + 2 * lane + 128 * j); }
#pragma unroll
        for (int rr = 0; rr < 4; ++rr) {
            const int lr = wave * 8 + rb * 4 + rr; float s1 = 0.f, s2 = 0.f;
#pragma unroll
            for (int j = 0; j < 3; ++j) s1 += bflo(qv[rr][j]) * bflo(qv[rr][j]) + bfhi(qv[rr][j]) * bfhi(qv[rr][j]);
#pragma unroll
            for (int j = 0; j < 2; ++j) s2 += bflo(kv[rr][j]) * bflo(kv[rr][j]) + bfhi(kv[rr][j]) * bfhi(kv[rr][j]);
            s1 = wave_sum(s1); s2 = wave_sum(s2);
            const float r1 = rsqrtf(s1 * (1.f / 384.f) + EPS), r2 = rsqrtf(s2 * (1.f / 256.f) + EPS);
#pragma unroll
            for (int j = 0; j < 3; ++j) { const int c = 2 * lane + 128 * j; *(LAS unsigned*)(qn + lr * MLA_QS + c * 2) = pk2(bflo(qv[rr][j]) * r1 * qlat_g[c], bfhi(qv[rr][j]) * r1 * qlat_g[c + 1]); }
#pragma unroll
            for (int j = 0; j < 2; ++j) { const int c = 2 * lane + 128 * j; *(LAS unsigned*)(kvn + lr * MLA_KS + c * 2) = pk2(bflo(kv[rr][j]) * r2 * kvlat_g[c], bfhi(kv[rr][j]) * r2 * kvlat_g[c + 1]); }
        }
    }
    __syncthreads();
    const int l31 = lane & 31, h5 = lane >> 5;
    {
        f32x16 acc[3][2];
#pragma unroll
        for (int mt = 0; mt < 3; ++mt)
#pragma unroll
            for (int nt = 0; nt < 2; ++nt)
#pragma unroll
                for (int r = 0; r < 16; ++r) acc[mt][nt][r] = 0.f;
        const bf16* wp = WuqT + (size_t)(wave * 96 + l31) * 384 + 8 * h5;
        bf16x8 ar[4][3];
#pragma unroll
        for (int p = 0; p < 3; ++p)
#pragma unroll
            for (int mt = 0; mt < 3; ++mt) ar[p][mt] = *(const GAS bf16x8*)(wp + (size_t)mt * 32 * 384 + 16 * p);
#pragma unroll
        for (int ks = 0; ks < 24; ++ks) {
            if (ks + 3 < 24) {
#pragma unroll
                for (int mt = 0; mt < 3; ++mt) ar[(ks + 3) & 3][mt] = *(const GAS bf16x8*)(wp + (size_t)mt * 32 * 384 + 16 * (ks + 3)); }
            bf16x8 b[2];
#pragma unroll
            for (int nt = 0; nt < 2; ++nt) b[nt] = *(const LAS bf16x8*)(qn + (32 * nt + l31) * MLA_QS + (16 * ks + 8 * h5) * 2);
#pragma unroll
            for (int mt = 0; mt < 3; ++mt)
#pragma unroll
                for (int nt = 0; nt < 2; ++nt) acc[mt][nt] = MFMA32(ar[ks & 3][mt], b[nt], acc[mt][nt]);
        }
#pragma unroll
        for (int nt = 0; nt < 2; ++nt) {
            const int tok = t0 + 32 * nt + l31, b = tok / S, s = tok & (S - 1);
            f32x2 s2 = {0.f, 0.f};
#pragma unroll
            for (int mt = 0; mt < 3; ++mt) s2 = sq16(acc[mt][nt], s2);
            float ss = s2.x + s2.y;
            ss += __shfl_xor(ss, 32);
            const float rstd = rsqrtf(ss * (1.f / 96.f) + EPS);
            bf16* qo = Q + ((size_t)(b * MH + wave) * S + s) * 96;
#pragma unroll
            for (int mt = 0; mt < 2; ++mt)
#pragma unroll
                for (int g = 0; g < 4; ++g) { const int d0 = 32 * mt + 8 * g + 4 * h5; const f32x4 gn = *(const GAS f32x4*)(qn_g + d0);
                    v2u o; o.x = pk2(acc[mt][nt][4 * g] * rstd * gn[0], acc[mt][nt][4 * g + 1] * rstd * gn[1]); o.y = pk2(acc[mt][nt][4 * g + 2] * rstd * gn[2], acc[mt][nt][4 * g + 3] * rstd * gn[3]);
                    *(GAS v2u*)(qo + d0) = o; }
#pragma unroll
            for (int g = 0; g < 2; ++g) { const int i0 = 8 * g + 4 * h5;
                const f32x4 cs = *(const GAS f32x4*)(rope + (size_t)tok * 16 + i0), sn = *(const GAS f32x4*)(rope + (size_t)NT * 16 + (size_t)tok * 16 + i0);
                const f32x4 g1 = *(const GAS f32x4*)(qn_g + 64 + i0), g2 = *(const GAS f32x4*)(qn_g + 80 + i0);
                float o1[4], o2[4];
#pragma unroll
                for (int j = 0; j < 4; ++j) { const float x1 = acc[2][nt][4 * g + j] * rstd * g1[j], x2 = acc[2][nt][8 + 4 * g + j] * rstd * g2[j]; o1[j] = x1 * cs[j] - x2 * sn[j]; o2[j] = x2 * cs[j] + x1 * sn[j]; }
                v2u w1, w2; w1.x = pk2(o1[0], o1[1]); w1.y = pk2(o1[2], o1[3]); w2.x = pk2(o2[0], o2[1]); w2.y = pk2(o2[2], o2[3]);
                *(GAS v2u*)(qo + 64 + i0) = w1; *(GAS v2u*)(qo + 80 + i0) = w2; }
        }
    }
#pragma unroll 1
    for (int pass = 0; pass < 2; ++pass) {
        f32x16 acc[2][2];
#pragma unroll
        for (int mt = 0; mt < 2; ++mt)
#pragma unroll
            for (int nt = 0; nt < 2; ++nt)
#pragma unroll
                for (int r = 0; r < 16; ++r) acc[mt][nt][r] = 0.f;
        const bf16* wp = WukvT + (size_t)(wave * 128 + pass * 64 + l31) * 256 + 8 * h5;
        bf16x8 ar[4][2];
#pragma unroll
        for (int p = 0; p < 3; ++p)
#pragma unroll
            for (int mt = 0; mt < 2; ++mt) ar[p][mt] = *(const GAS bf16x8*)(wp + (size_t)mt * 32 * 256 + 16 * p);
#pragma unroll
        for (int ks = 0; ks < 16; ++ks) {
            if (ks + 3 < 16) {
#pragma unroll
                for (int mt = 0; mt < 2; ++mt) ar[(ks + 3) & 3][mt] = *(const GAS bf16x8*)(wp + (size_t)mt * 32 * 256 + 16 * (ks + 3)); }
            bf16x8 b[2];
#pragma unroll
            for (int nt = 0; nt < 2; ++nt) b[nt] = *(const LAS bf16x8*)(kvn + (32 * nt + l31) * MLA_KS + (16 * ks + 8 * h5) * 2);
#pragma unroll
            for (int mt = 0; mt < 2; ++mt)
#pragma unroll
                for (int nt = 0; nt < 2; ++nt) acc[mt][nt] = MFMA32(ar[ks & 3][mt], b[nt], acc[mt][nt]);
        }
        if (pass == 0) {
#pragma unroll
          for (int nt = 0; nt < 2; ++nt) {
            const int tok = t0 + 32 * nt + l31, b = tok / S, s = tok & (S - 1);
            float kr[16];
#pragma unroll
            for (int g = 0; g < 4; ++g) { const v2u kv = *(const GAS v2u*)(P + (size_t)tok * INP + C_KROPE + 8 * g + 4 * h5); kr[4 * g] = bflo(kv.x); kr[4 * g + 1] = bfhi(kv.x); kr[4 * g + 2] = bflo(kv.y); kr[4 * g + 3] = bfhi(kv.y); }
            f32x2 s2 = {0.f, 0.f};
#pragma unroll
            for (int mt = 0; mt < 2; ++mt) s2 = sq16(acc[mt][nt], s2);
            float ss = s2.x + s2.y;
#pragma unroll
            for (int r = 0; r < 16; ++r) ss += kr[r] * kr[r];
            ss += __shfl_xor(ss, 32);
            const float rstd = rsqrtf(ss * (1.f / 96.f) + EPS);
            bf16* ko = K + ((size_t)(b * MH + wave) * S + s) * 96;
#pragma unroll
            for (int mt = 0; mt < 2; ++mt)
#pragma unroll
                for (int g = 0; g < 4; ++g) { const int d0 = 32 * mt + 8 * g + 4 * h5; const f32x4 gn = *(const GAS f32x4*)(kn_g + d0);
                    v2u o; o.x = pk2(acc[mt][nt][4 * g] * rstd * gn[0], acc[mt][nt][4 * g + 1] * rstd * gn[1]); o.y = pk2(acc[mt][nt][4 * g + 2] * rstd * gn[2], acc[mt][nt][4 * g + 3] * rstd * gn[3]);
                    *(GAS v2u*)(ko + d0) = o; }
#pragma unroll
            for (int g = 0; g < 4; ++g) { const f32x4 gn = *(const GAS f32x4*)(kn_g + 64 + 8 * g + 4 * h5);
#pragma unroll
                for (int j = 0; j < 4; ++j) kr[4 * g + j] *= rstd * gn[j]; }
#pragma unroll
            for (int g = 0; g < 2; ++g) { const f32x4 cs = *(const GAS f32x4*)(rope + (size_t)tok * 16 + 8 * g + 4 * h5), sn = *(const GAS f32x4*)(rope + (size_t)NT * 16 + (size_t)tok * 16 + 8 * g + 4 * h5);
                float o1[4], o2[4];
#pragma unroll
                for (int j = 0; j < 4; ++j) { const float x1 = kr[4 * g + j], x2 = kr[8 + 4 * g + j]; o1[j] = x1 * cs[j] - x2 * sn[j]; o2[j] = x2 * cs[j] + x1 * sn[j]; }
                v2u w1, w2; w1.x = pk2(o1[0], o1[1]); w1.y = pk2(o1[2], o1[3]); w2.x = pk2(o2[0], o2[1]); w2.y = pk2(o2[2], o2[3]);
                *(GAS v2u*)(ko + 64 + 8 * g + 4 * h5) = w1; *(GAS v2u*)(ko + 80 + 8 * g + 4 * h5) = w2; }
          }
        } else {
#pragma unroll
          for (int nt = 0; nt < 2; ++nt) {
            int hq = h5; asm volatile("" : "+v"(hq));
            const int tok = t0 + 32 * nt + l31, b = tok / S, s = tok & (S - 1);
            bf16* vo = VT + ((size_t)(b * MH + wave) * 64 + 4 * hq) * S + s;
#pragma unroll
            for (int mt = 0; mt < 2; ++mt)
#pragma unroll
                for (int r = 0; r < 16; ++r) { const int dv = 32 * mt + (r & 3) + 8 * (r >> 2); vo[(size_t)dv * S] = f2bf_hw(acc[mt][nt][r]); }
          }
        }
    }
    __syncthreads();
}

constexpr int AT_KS = 208, AT_VS = 136;
constexpr int AT_KB = 64 * AT_KS, AT_VB = 64 * AT_VS;
constexpr float AT_C = 0.10206207261596575f * 1.4426950408889634f;
__device__ __forceinline__ void attn_unit(const bf16* __restrict__ Q, const bf16* __restrict__ K, const bf16* __restrict__ VT, bf16* __restrict__ BR, LAS unsigned char* lds, int bh, int qb, int tid, int lane, int wave) {
    asm volatile("" : "+v"(lane), "+v"(tid));
    const int l31 = lane & 31, h5 = lane >> 5;
    const int qw0 = 256 * qb + 32 * wave, ntile = 4 * qb + 4, mytiles = 4 * qb + (wave >> 1) + 1;
    const bf16* Kg = K + (size_t)bh * S * 96; const bf16* Vg = VT + (size_t)bh * 64 * S;
    LAS unsigned char* kbuf = lds; LAS unsigned char* vbuf = lds + 2 * AT_KB;
    bf16x8 qf[6];
    { const bf16* qp = Q + ((size_t)bh * S + qw0 + l31) * 96 + 8 * h5;
#pragma unroll
      for (int ks = 0; ks < 6; ++ks) qf[ks] = *(const GAS bf16x8*)(qp + 16 * ks); }
    f32x16 o[2];
#pragma unroll
    for (int r = 0; r < 16; ++r) { o[0][r] = 0.f; o[1][r] = 0.f; }
    float mrow = -INFINITY, lrow = 0.f;
    const int kc0 = tid, kc1 = tid + 512; const bool k1 = kc1 < 768;
    const unsigned kl0 = (unsigned)((kc0 / 12) * AT_KS + (kc0 % 12) * 16), kl1 = (unsigned)((kc1 / 12) * AT_KS + (kc1 % 12) * 16), vl = (unsigned)((tid >> 3) * AT_VS + (tid & 7) * 16);
    v4u sk0, sk1 = (v4u){0u, 0u, 0u, 0u}, sv;
#define AT_GLOADK(j) do { const bf16* kp = Kg + (size_t)(j) * 64 * 96; sk0 = *(const GAS v4u*)(kp + (size_t)kc0 * 8); if (k1) sk1 = *(const GAS v4u*)(kp + (size_t)kc1 * 8); } while (0)
#define AT_GLOADV(j) do { sv = *(const GAS v4u*)(Vg + (size_t)(tid >> 3) * S + (size_t)(j) * 64 + (tid & 7) * 8); } while (0)
#define AT_LSTOREK(buf) do { LAS unsigned char* kb = kbuf + (buf) * AT_KB; *(LAS v4u*)(kb + kl0) = sk0; if (k1) *(LAS v4u*)(kb + kl1) = sk1; } while (0)
#define AT_LSTOREV(buf) do { LAS unsigned char* vb = vbuf + (buf) * AT_VB + vl; *(LAS v2u*)(vb) = (v2u){sv.x, sv.y}; *(LAS v2u*)(vb + 8) = (v2u){sv.z, sv.w}; } while (0)
#define AT_QK(dst, buf) do { const LAS unsigned char* kb = kbuf + (buf) * AT_KB; _Pragma("unroll") for (int kt = 0; kt < 2; ++kt) { _Pragma("unroll") for (int r = 0; r < 16; ++r) dst[kt][r] = 0.f; \
        _Pragma("unroll") for (int ks = 0; ks < 6; ++ks) { const bf16x8 kf = *(const LAS bf16x8*)(kb + (32 * kt + l31) * AT_KS + (16 * ks + 8 * h5) * 2); dst[kt] = MFMA32(kf, qf[ks], dst[kt]); } } } while (0)
    AT_GLOADK(0); AT_GLOADV(0); AT_LSTOREK(0); AT_LSTOREV(0);
    AT_GLOADK(1); AT_LSTOREK(1);
    __syncthreads();
    f32x16 sa[2], sb[2];
    AT_QK(sa, 0);
    __syncthreads();
#define AT_BODY(SC, SN, J) do { const int j = (J); \
        if (j + 2 < ntile) AT_GLOADK(j + 2); \
        if (j + 1 < ntile) AT_GLOADV(j + 1); \
        if (j + 1 < mytiles) AT_QK(SN, (j + 1) & 1); \
        if (j < mytiles) { \
            const LAS unsigned char* vb = vbuf + (j & 1) * AT_VB; \
            if (j == mytiles - 1) { const int qq = qw0 + l31 - 64 * j; asm volatile("; diagonal tile" ::: "memory");     \
                _Pragma("unroll") for (int kt = 0; kt < 2; ++kt) _Pragma("unroll") for (int r = 0; r < 16; ++r) { const int kk = 32 * kt + (r & 3) + 8 * (r >> 2) + 4 * h5; if (kk > qq) SC[kt][r] = -INFINITY; } } \
            float mx = SC[0][0]; \
            _Pragma("unroll") for (int kt = 0; kt < 2; ++kt) _Pragma("unroll") for (int r = 0; r < 16; ++r) mx = fmaxf(mx, SC[kt][r]); \
            mx = fmaxf(mx, __shfl_xor(mx, 32)); \
            const float mnew = fmaxf(mrow, mx * AT_C), alpha = __builtin_amdgcn_exp2f(mrow - mnew); \
            mrow = mnew; \
            f32x2 ls2 = {0.f, 0.f}; const f32x2 c2 = {AT_C, AT_C}, m2 = {mnew, mnew}; \
            _Pragma("unroll") for (int kt = 0; kt < 2; ++kt) _Pragma("unroll") for (int r = 0; r < 16; r += 2) { f32x2 x = {SC[kt][r], SC[kt][r + 1]}; x = x * c2 - m2; \
                f32x2 pp; pp.x = __builtin_amdgcn_exp2f(x.x); pp.y = __builtin_amdgcn_exp2f(x.y); SC[kt][r] = pp.x; SC[kt][r + 1] = pp.y; ls2 += pp; } \
            lrow = lrow * alpha + (ls2.x + ls2.y); \
            _Pragma("unroll") for (int r = 0; r < 16; ++r) { o[0][r] *= alpha; o[1][r] *= alpha; } \
            _Pragma("unroll") for (int kt = 0; kt < 2; ++kt) _Pragma("unroll") for (int s2 = 0; s2 < 2; ++s2) { \
                union { bf16x8 v; unsigned u[4]; } pf; \
                _Pragma("unroll") for (int q = 0; q < 4; ++q) pf.u[q] = pk2(SC[kt][8 * s2 + 2 * q], SC[kt][8 * s2 + 2 * q + 1]); \
                _Pragma("unroll") for (int dvt = 0; dvt < 2; ++dvt) { union { bf16x8 v; v2u h[2]; } vf; \
                    const LAS unsigned char* vp = vb + (32 * dvt + l31) * AT_VS + (32 * kt + 16 * s2 + 4 * h5) * 2; \
                    vf.h[0] = *(const LAS v2u*)(vp); vf.h[1] = *(const LAS v2u*)(vp + 16); \
                    o[dvt] = MFMA32(vf.v, pf.v, o[dvt]); } } \
        } \
        if (j + 2 < ntile) AT_LSTOREK(j & 1); \
        if (j + 1 < ntile) AT_LSTOREV((j + 1) & 1); \
        __syncthreads(); } while (0)
#pragma unroll 1
    for (int jj = 0; jj < ntile; jj += 2) { AT_BODY(sa, sb, jj); AT_BODY(sb, sa, jj + 1); }
#undef AT_BODY
#undef AT_GLOADK
#undef AT_GLOADV
#undef AT_LSTOREK
#undef AT_LSTOREV
#undef AT_QK
    lrow += __shfl_xor(lrow, 32);
    const float inv = __builtin_amdgcn_rcpf(lrow);
    const int b = bh >> 3, h = bh & 7;
    bf16* op = BR + (size_t)(b * S + qw0 + l31) * 1536 + 512 + h * 64;
#pragma unroll
    for (int dvt = 0; dvt < 2; ++dvt)
#pragma unroll
        for (int g = 0; g < 4; ++g) { v2u w; w.x = pk2(o[dvt][4 * g] * inv, o[dvt][4 * g + 1] * inv); w.y = pk2(o[dvt][4 * g + 2] * inv, o[dvt][4 * g + 3] * inv);
            *(GAS v2u*)(op + 32 * dvt + 8 * g + 4 * h5) = w; }
}
#define MFMA16(a, b, c) __builtin_amdgcn_mfma_f32_16x16x32_bf16((a), (b), (c), 0, 0, 0)
constexpr int HG_VS = 144;
constexpr int HG_QS = 272;
__device__ __forceinline__ void hgrn_gate(float z, float lbv, float l1, float l2, float& lf, float& kv) {
    const float e = __expf(-fabsf(z)), ls = fminf(z, 0.f) - __logf(1.f + e);
    const float rc = __builtin_amdgcn_rcpf(1.f + e), sg = (z >= 0.f) ? rc : e * rc;
    kv = (1.f - lbv) * (1.f - sg);
    const float a = l1 + ls;
    if (lbv > 0.f) { const float mx = fmaxf(a, l2), dd = -fabsf(a - l2); lf = mx + __logf(1.f + __expf(dd)); } else lf = a;
}
struct HgA { unsigned zz[8]; unsigned vp[8]; };
__device__ __forceinline__ void hgrn_a_load(const bf16* __restrict__ P, int unit, int tid, HgA& r) {
    asm volatile("" : "+v"(tid));
    const int bh = unit >> 5, c = unit & 31, b = bh >> 2, h = bh & 3, tok0 = b * S + c * 64, d = tid & 127, seg = tid >> 7;
    const bf16* pz = P + (size_t)(tok0 + seg * 16) * INP + C_HF + h * 128 + d;
    const bf16* pv = P + (size_t)(tok0 + seg * 16) * INP + C_HI + h * 128 + d;
#pragma unroll
    for (int t = 0; t < 8; ++t) { r.zz[t] = (unsigned)pz[(size_t)(2 * t) * INP] | ((unsigned)pz[(size_t)(2 * t + 1) * INP] << 16); r.vp[t] = (unsigned)pv[(size_t)(2 * t) * INP] | ((unsigned)pv[(size_t)(2 * t + 1) * INP] << 16); }
}
__device__ __forceinline__ void hgrn_a_compute(const HgA& r, const float* __restrict__ lb, float* __restrict__ SLOC, float* __restrict__ DEC, LAS unsigned char* lds, int unit, int tid, int lane, int wave) {
    asm volatile("" : "+v"(tid), "+v"(lane));
    const int bh = unit >> 5, h = bh & 3;
    LAS float* tot = (LAS float*)lds;
    LAS unsigned char* vT = lds + 2048;
    LAS unsigned char* kT = vT + 128 * HG_VS;
    const int d = tid & 127, seg = tid >> 7;
    const float lbv = lb[h * 128 + d], l1 = __logf(1.f - lbv), l2 = (lbv > 0.f) ? __logf(lbv) : -INFINITY;
    float cs[16], kv[16]; float run = 0.f;
#pragma unroll
    for (int t = 0; t < 16; ++t) { float lf; hgrn_gate((t & 1) ? bfhi(r.zz[t >> 1]) : bflo(r.zz[t >> 1]), lbv, l1, l2, lf, kv[t]); run += lf; cs[t] = run; }
    tot[seg * 128 + d] = run;
#pragma unroll
    for (int t = 0; t < 8; ++t) *(LAS unsigned*)(vT + d * HG_VS + (seg * 16 + 2 * t) * 2) = r.vp[t];
    __syncthreads();
    float off = 0.f, bl = 0.f;
#pragma unroll
    for (int s = 0; s < 4; ++s) { const float tv = tot[s * 128 + d]; bl += tv; if (s < seg) off += tv; }
#pragma unroll
    for (int t = 0; t < 8; ++t) { const float k0 = kv[2 * t] * __expf(bl - (cs[2 * t] + off)), k1 = kv[2 * t + 1] * __expf(bl - (cs[2 * t + 1] + off));
        *(LAS unsigned*)(kT + d * HG_VS + (seg * 16 + 2 * t) * 2) = pk2(k0, k1); }
    if (seg == 0) DEC[(size_t)unit * 128 + d] = __expf(bl);
    __syncthreads();
    const int l31 = lane & 31, h5 = lane >> 5, mt = wave >> 1;
    f32x16 acc[2];
#pragma unroll
    for (int r2 = 0; r2 < 16; ++r2) { acc[0][r2] = 0.f; acc[1][r2] = 0.f; }
#pragma unroll
    for (int ks = 0; ks < 4; ++ks) {
        const bf16x8 a = *(const LAS bf16x8*)(vT + (32 * mt + l31) * HG_VS + (16 * ks + 8 * h5) * 2);
#pragma unroll
        for (int q = 0; q < 2; ++q) { const int nt = 2 * (wave & 1) + q; const bf16x8 bb = *(const LAS bf16x8*)(kT + (32 * nt + l31) * HG_VS + (16 * ks + 8 * h5) * 2); acc[q] = MFMA32(a, bb, acc[q]); }
    }
    float* so = SLOC + (size_t)unit * 16384;
#pragma unroll
    for (int q = 0; q < 2; ++q) { const int nt = 2 * (wave & 1) + q;
#pragma unroll
        for (int r2 = 0; r2 < 16; ++r2) { const int v = 32 * mt + (r2 & 3) + 8 * (r2 >> 2) + 4 * h5; so[(size_t)v * 128 + 32 * nt + l31] = acc[q][r2]; } }
    __syncthreads();
}
__device__ __forceinline__ void hgrn_a_all(const bf16* __restrict__ P, const float* __restrict__ lb, float* __restrict__ SLOC, float* __restrict__ DEC, LAS unsigned char* lds, int bx, int G, int tid, int lane, int wave) {
    HgA ra, rb; int u = bx;
    if (u < 1024) hgrn_a_load(P, u, tid, ra);
    while (u < 1024) {
        const int u2 = u + G, u3 = u2 + G;
        if (u2 < 1024) hgrn_a_load(P, u2, tid, rb);
        hgrn_a_compute(ra, lb, SLOC, DEC, lds, u, tid, lane, wave);
        if (u2 >= 1024) break;
        if (u3 < 1024) hgrn_a_load(P, u3, tid, ra);
        hgrn_a_compute(rb, lb, SLOC, DEC, lds, u2, tid, lane, wave);
        u = u3;
    }
}
__device__ __forceinline__ void hgrn_scan_unit(const float* __restrict__ SLOC, const float* __restrict__ DEC, bf16* __restrict__ ST, int unit, int tid) {
    asm volatile("" : "+v"(tid));
    const int bh = unit >> 3, idx = (unit & 7) * 2048 + tid * 4, d = idx & 127;
    f32x4 st = {0.f, 0.f, 0.f, 0.f};
    const float* sp = SLOC + (size_t)bh * 32 * 16384 + idx; const float* dp = DEC + (size_t)bh * 32 * 128 + d; bf16* op = ST + (size_t)bh * 32 * 16384 + idx;
#pragma unroll 1
    for (int cb = 0; cb < 32; cb += 16) {
        f32x4 sl[16], dc[16];
#pragma unroll
        for (int c = 0; c < 16; ++c) { sl[c] = *(const GAS f32x4*)(sp + (size_t)(cb + c) * 16384); dc[c] = *(const GAS f32x4*)(dp + (cb + c) * 128); }
#pragma unroll
        for (int c = 0; c < 16; ++c) {
            v2u o; o.x = pk2(st[0], st[1]); o.y = pk2(st[2], st[3]);
            *(GAS v2u*)(op + (size_t)(cb + c) * 16384) = o;
            st = dc[c] * st + sl[c];
        }
    }
}
__device__ __forceinline__ void hgrn_c_unit(const bf16* __restrict__ P, const float* __restrict__ lb, const bf16* __restrict__ ST, const float* __restrict__ og, bf16* __restrict__ BR, LAS unsigned char* lds, int unit, int tid, int lane, int wave) {
    asm volatile("" : "+v"(tid), "+v"(lane));
    const int bh = unit >> 5, c = unit & 31, b = bh >> 2, h = bh & 3, tok0 = b * S + c * 64;
    LAS float* bcum = (LAS float*)lds;
    LAS unsigned char* q0 = lds + 32768;
    LAS unsigned char* qi = q0 + 64 * HG_QS;
    LAS unsigned char* kr = qi + 64 * HG_QS;
    LAS unsigned char* vT = kr + 64 * HG_QS;
    LAS unsigned char* at = vT + 128 * HG_VS;
    LAS float* tot = (LAS float*)(at + 64 * HG_VS);
    LAS float* ob = (LAS float*)lds;
    const int d = tid & 127, seg = tid >> 7;
    const int l31 = lane & 31, h5 = lane >> 5, mtw = wave >> 2, ntw = wave & 3;
    unsigned zq[16], vp[8]; v4u gq0, gq1; bf16x8 stf[8];
    {
        const bf16* pz = P + (size_t)(tok0 + seg * 16) * INP + C_HF + h * 128 + d;
        const bf16* pq = P + (size_t)(tok0 + seg * 16) * INP + C_HQ + h * 128 + d;
        const bf16* pv = P + (size_t)(tok0 + seg * 16) * INP + C_HI + h * 128 + d;
#pragma unroll
        for (int t = 0; t < 16; ++t) zq[t] = (unsigned)pz[(size_t)t * INP] | ((unsigned)pq[(size_t)t * INP] << 16);
#pragma unroll
        for (int t = 0; t < 8; ++t) vp[t] = (unsigned)pv[(size_t)(2 * t) * INP] | ((unsigned)pv[(size_t)(2 * t + 1) * INP] << 16);
        const bf16* pg = P + (size_t)(tok0 + (tid >> 3)) * INP + C_HG + h * 128 + (tid & 7) * 16;
        gq0 = *(const GAS v4u*)pg; gq1 = *(const GAS v4u*)(pg + 8);
        if (c > 0) { const bf16* sp = ST + (size_t)unit * 16384 + (size_t)(32 * ntw + l31) * 128 + 8 * h5;
#pragma unroll
            for (int ks = 0; ks < 8; ++ks) stf[ks] = *(const GAS bf16x8*)(sp + 16 * ks); }
        else {
#pragma unroll
            for (int ks = 0; ks < 8; ++ks) stf[ks] = (bf16x8){0, 0, 0, 0, 0, 0, 0, 0}; }
    }
    {
        const float lbv = lb[h * 128 + d], l1 = __logf(1.f - lbv), l2 = (lbv > 0.f) ? __logf(lbv) : -INFINITY;
        float cs[16], kv[16]; float run = 0.f;
#pragma unroll
        for (int t = 0; t < 16; ++t) { float lf; hgrn_gate(bflo(zq[t]), lbv, l1, l2, lf, kv[t]); run += lf; cs[t] = run; }
        tot[seg * 128 + d] = run;
#pragma unroll
        for (int t = 0; t < 8; ++t) *(LAS unsigned*)(vT + d * HG_VS + (seg * 16 + 2 * t) * 2) = vp[t];
        for (int i = tid; i < 64 * HG_VS / 4; i += 512) ((LAS unsigned*)at)[i] = 0u;
        __syncthreads();
        float off = 0.f;
#pragma unroll
        for (int s = 0; s < 4; ++s) { const float tv = tot[s * 128 + d]; if (s < seg) off += tv; }
#pragma unroll
        for (int t = 0; t < 16; ++t) { const int tt = seg * 16 + t; const float qv = bfhi(zq[t]);
            bcum[tt * 128 + d] = cs[t] + off;
            *(LAS bf16*)(q0 + tt * HG_QS + d * 2) = f2bf_hw(qv * __expf(cs[t] + off));
            *(LAS bf16*)(qi + tt * HG_QS + d * 2) = f2bf_hw(qv * __expf(cs[t]));
            *(LAS bf16*)(kr + tt * HG_QS + d * 2) = f2bf_hw(kv[t]); }
    }
    __syncthreads();
    {
        const int l15 = lane & 15, g4 = lane >> 4;
#pragma unroll 1
        for (int blk = wave; blk < 10; blk += 8) {
            const int i = (blk >= 6) ? 3 : (blk >= 3) ? 2 : (blk >= 1) ? 1 : 0, j = blk - ((i * (i + 1)) >> 1);
            f32x4 acc = {0.f, 0.f, 0.f, 0.f};
#pragma unroll
            for (int ks = 0; ks < 4; ++ks) {
                const int dd = 32 * ks + 8 * g4;
                const bf16x8 a = *(const LAS bf16x8*)(qi + (16 * i + l15) * HG_QS + dd * 2);
                const v4u kw = *(const LAS v4u*)(kr + (16 * j + l15) * HG_QS + dd * 2);
                const f32x4 b0 = *(const LAS f32x4*)(bcum + (16 * j + l15) * 128 + dd), b1 = *(const LAS f32x4*)(bcum + (16 * j + l15) * 128 + dd + 4);
                f32x4 r0 = {0.f, 0.f, 0.f, 0.f}, r1 = {0.f, 0.f, 0.f, 0.f};
                if (i > 0) { r0 = *(const LAS f32x4*)(bcum + (16 * i - 1) * 128 + dd); r1 = *(const LAS f32x4*)(bcum + (16 * i - 1) * 128 + dd + 4); }
                union { bf16x8 v; unsigned u[4]; } kf;
                kf.u[0] = pk2(bflo(kw.x) * __expf(r0[0] - b0[0]), bfhi(kw.x) * __expf(r0[1] - b0[1])); kf.u[1] = pk2(bflo(kw.y) * __expf(r0[2] - b0[2]), bfhi(kw.y) * __expf(r0[3] - b0[3]));
                kf.u[2] = pk2(bflo(kw.z) * __expf(r1[0] - b1[0]), bfhi(kw.z) * __expf(r1[1] - b1[1])); kf.u[3] = pk2(bflo(kw.w) * __expf(r1[2] - b1[2]), bfhi(kw.w) * __expf(r1[3] - b1[3]));
                acc = MFMA16(a, kf.v, acc);
            }
#pragma unroll
            for (int r = 0; r < 4; ++r) { const int tl = 4 * g4 + r; float v = acc[r]; if (i == j && l15 > tl) v = 0.f; *(LAS bf16*)(at + (16 * i + tl) * HG_VS + (16 * j + l15) * 2) = f2bf_hw(v); }
        }
    }
    __syncthreads();
    {
        const int mt = mtw, nt = ntw;
        f32x16 acc;
#pragma unroll
        for (int r = 0; r < 16; ++r) acc[r] = 0.f;
#pragma unroll
        for (int ks = 0; ks < 4; ++ks) { const bf16x8 a = *(const LAS bf16x8*)(at + (32 * mt + l31) * HG_VS + (16 * ks + 8 * h5) * 2), bb = *(const LAS bf16x8*)(vT + (32 * nt + l31) * HG_VS + (16 * ks + 8 * h5) * 2); acc = MFMA32(a, bb, acc); }
        if (c > 0) {
#pragma unroll
            for (int ks = 0; ks < 8; ++ks) { const bf16x8 a = *(const LAS bf16x8*)(q0 + (32 * mt + l31) * HG_QS + (16 * ks + 8 * h5) * 2); acc = MFMA32(a, stf[ks], acc); } }
        __syncthreads();
#pragma unroll
        for (int r = 0; r < 16; ++r) { const int t = 32 * mt + (r & 3) + 8 * (r >> 2) + 4 * h5; ob[t * 132 + 32 * nt + l31] = acc[r]; }
    }
    __syncthreads();
    {
        const int t = tid >> 3, v0 = (tid & 7) * 16;
        f32x4 o4[4]; float ss = 0.f;
#pragma unroll
        for (int q = 0; q < 4; ++q) { o4[q] = *(const LAS f32x4*)(ob + t * 132 + v0 + 4 * q); ss += (o4[q][0] * o4[q][0] + o4[q][1] * o4[q][1]) + (o4[q][2] * o4[q][2] + o4[q][3] * o4[q][3]); }
        ss += __shfl_xor(ss, 1); ss += __shfl_xor(ss, 2); ss += __shfl_xor(ss, 4);
        const float rstd = rsqrtf(ss * (1.f / 128.f) + EPS);
        const v4u g0 = gq0, g1 = gq1;
        float gv[16]; gv[0] = bflo(g0.x); gv[1] = bfhi(g0.x); gv[2] = bflo(g0.y); gv[3] = bfhi(g0.y); gv[4] = bflo(g0.z); gv[5] = bfhi(g0.z); gv[6] = bflo(g0.w); gv[7] = bfhi(g0.w);
        gv[8] = bflo(g1.x); gv[9] = bfhi(g1.x); gv[10] = bflo(g1.y); gv[11] = bfhi(g1.y); gv[12] = bflo(g1.z); gv[13] = bfhi(g1.z); gv[14] = bflo(g1.w); gv[15] = bfhi(g1.w);
        float ov[16];
#pragma unroll
        for (int q = 0; q < 4; ++q) { const f32x4 gn = *(const GAS f32x4*)(og + v0 + 4 * q);
#pragma unroll
            for (int jj = 0; jj < 4; ++jj) { const float gg = gv[4 * q + jj]; ov[4 * q + jj] = o4[q][jj] * rstd * gn[jj] * gg * __builtin_amdgcn_rcpf(1.f + __expf(-gg)); } }
        v4u w0, w1; w0.x = pk2(ov[0], ov[1]); w0.y = pk2(ov[2], ov[3]); w0.z = pk2(ov[4], ov[5]); w0.w = pk2(ov[6], ov[7]); w1.x = pk2(ov[8], ov[9]); w1.y = pk2(ov[10], ov[11]); w1.z = pk2(ov[12], ov[13]); w1.w = pk2(ov[14], ov[15]);
        bf16* po = BR + (size_t)(tok0 + t) * 1536 + h * 128 + v0;
        *(GAS v4u*)po = w0; *(GAS v4u*)(po + 8) = w1;
    }
    __syncthreads();
}
constexpr int NWAVES = 8, NTHR = 512;
constexpr int RING_OFF = 0, RING_BYTES = 131072, LDSCTL_OFF = RING_BYTES, LDS_BYTES = 147456;
constexpr int LW_BAR = 0, LW_TP = 16, LW_CNT = 64, LW_LCNT = 96, LW_BASE = 128, LW_ENTE = 256, LW_ENTW = 512, LW_RANK = 768, LW_BIAS = 1024;
constexpr int CW_Q = 1024, CW_PD = 1088;
constexpr int LW_CONV = 8;
constexpr int CW_BAR = 4096;
constexpr int NPH_L = 10, PH_FINAL = 1 + L * NPH_L, NPH = PH_FINAL + 1;

struct MkArgs { const void* in[28]; float* out; unsigned char* ws; float invf[16]; int ph_lo, ph_hi, li, pad; };
typedef const MkArgs __attribute__((address_space(4))) CMkArgs;
#define KA_PTR(name) CMkArgs* name = (CMkArgs*)__builtin_amdgcn_kernarg_segment_ptr(); asm volatile("" : "+s"(name))

using pg8::Unit; using pg8::u32x4; using pg8::cvt_pk_bf16;
constexpr int GATE_TILE0 = 13;
__device__ __forceinline__ size_t gt_off(int g, int pm, int pn4, int chunk, int tid) { return ((((size_t)(g * 64 + pm) * 4 + pn4) * 16 + chunk) * 512 + tid) * 8; }
struct EpiP {
    static constexpr bool PERM = true; bf16* O; int ldc; bf16* GT;
    __device__ __forceinline__ void prefetch(const Unit&, int, int) const {}
    __device__ __forceinline__ void operator()(const f32x4 (&acc)[2][2][4][2], const Unit& u, int wr, int wc, int fr, int fq) const {
        const int row0 = u.pm * 256 + wr * 64 + fr, col0 = u.pn * 256 + wc * 32 + 8 * fq;
        const bool gate = (GT != nullptr) && u.pn >= GATE_TILE0; const int gi = (u.pn - GATE_TILE0) >> 2, pn4 = (u.pn - GATE_TILE0) & 3, tid = (wr * 4 + wc) * 64 + fq * 16 + fr;
#pragma unroll
        for (int ai = 0; ai < 2; ++ai)
#pragma unroll
            for (int m = 0; m < 4; ++m) { bf16* rowp = O + (size_t)(row0 + ai * 128 + m * 16) * ldc + col0;
#pragma unroll
                for (int bj = 0; bj < 2; ++bj) { f32x4 v0 = acc[ai][bj][m][0], v1 = acc[ai][bj][m][1];
                    u32x4 w; w.x = cvt_pk_bf16(v0[0], v0[1]); w.y = cvt_pk_bf16(v0[2], v0[3]); w.z = cvt_pk_bf16(v1[0], v1[1]); w.w = cvt_pk_bf16(v1[2], v1[3]);
                    if (gate) *(u32x4*)(GT + gt_off(gi, u.pm, pn4, (ai * 4 + m) * 2 + bj, tid)) = w; else *(u32x4*)(rowp + bj * 128) = w; } }
    }
};
struct EpiBranch {
    static constexpr bool PERM = true; const bf16* GT; bf16* MB;
    __device__ __forceinline__ void prefetch(const Unit&, int, int) const {}
    __device__ __forceinline__ static void unpack8(const u32x4 w, float (&g)[8]) { g[0] = __uint_as_float(w.x << 16); g[1] = __uint_as_float(w.x & 0xffff0000u); g[2] = __uint_as_float(w.y << 16); g[3] = __uint_as_float(w.y & 0xffff0000u);
        g[4] = __uint_as_float(w.z << 16); g[5] = __uint_as_float(w.z & 0xffff0000u); g[6] = __uint_as_float(w.w << 16); g[7] = __uint_as_float(w.w & 0xffff0000u); }
    __device__ __forceinline__ static float em(float x) { return __expf(-fminf(fmaxf(x, -30.f), 30.f)); }
    __device__ __forceinline__ void mid(f32x4 (&acc)[2][2][4][2], const Unit& u, int wr, int wc, int fr, int fq, int t) const {
        asm volatile("" : "+v"(fr), "+v"(fq));
        const int gnum = (t == 8) ? 0 : 1, tid = (wr * 4 + wc) * 64 + fq * 16 + fr;
        const bf16* gn0 = GT + gt_off(gnum, u.pm, u.pn, 0, tid); const bf16* gd0 = GT + gt_off(gnum + 1, u.pm, u.pn, 0, tid);
#pragma unroll
        for (int ai = 0; ai < 2; ++ai)
#pragma unroll
            for (int m = 0; m < 4; ++m)
#pragma unroll
                for (int bj = 0; bj < 2; ++bj) { const int ch = (ai * 4 + m) * 2 + bj; float gn[8], gd[8]; unpack8(*(const u32x4*)(gn0 + (size_t)ch * 4096), gn); unpack8(*(const u32x4*)(gd0 + (size_t)ch * 4096), gd);
#pragma unroll
                    for (int j = 0; j < 4; ++j) { acc[ai][bj][m][0][j] *= (1.f + em(gd[j])) * __builtin_amdgcn_rcpf(1.f + em(gn[j])); acc[ai][bj][m][1][j] *= (1.f + em(gd[4 + j])) * __builtin_amdgcn_rcpf(1.f + em(gn[4 + j])); } }
    }
    __device__ __forceinline__ void operator()(const f32x4 (&acc)[2][2][4][2], const Unit& u, int wr, int wc, int fr, int fq) const {
        const int row0 = u.pm * 256 + wr * 64 + fr, col0 = u.pn * 256 + wc * 32 + 8 * fq, tid = (wr * 4 + wc) * 64 + fq * 16 + fr;
        const bf16* gc0 = GT + gt_off(2, u.pm, u.pn, 0, tid);
#pragma unroll
        for (int ai = 0; ai < 2; ++ai)
#pragma unroll
            for (int m = 0; m < 4; ++m) { const size_t row = (size_t)(row0 + ai * 128 + m * 16);
#pragma unroll
                for (int bj = 0; bj < 2; ++bj) { const int col = col0 + bj * 128; float gc[8]; unpack8(*(const u32x4*)(gc0 + (size_t)((ai * 4 + m) * 2 + bj) * 4096), gc);
                    f32x4 v0 = acc[ai][bj][m][0], v1 = acc[ai][bj][m][1];
#pragma unroll
                    for (int j = 0; j < 4; ++j) { v0[j] *= __builtin_amdgcn_rcpf(1.f + em(gc[j])); v1[j] *= __builtin_amdgcn_rcpf(1.f + em(gc[4 + j])); }
                    u32x4 w; w.x = cvt_pk_bf16(v0[0], v0[1]); w.y = cvt_pk_bf16(v0[2], v0[3]); w.z = cvt_pk_bf16(v1[0], v1[1]); w.w = cvt_pk_bf16(v1[2], v1[3]); *(u32x4*)(MB + row * 1024 + col) = w; } }
    }
};
struct EpiOut {
    static constexpr bool PERM = false; const float* xin; const float* gvec; float* out;
    __device__ __forceinline__ void prefetch(const Unit&, int, int) const {}
    __device__ __forceinline__ void operator()(const f32x4 (&acc)[2][2][4][2], const Unit& u, int wr, int wc, int fr, int fq) const {
        const int row0 = u.pm * 256 + wr * 64 + fr, col0 = u.pn * 256 + wc * 32 + 4 * fq;
#pragma unroll
        for (int ai = 0; ai < 2; ++ai)
#pragma unroll
            for (int m = 0; m < 4; ++m) { const size_t row = (size_t)(row0 + ai * 128 + m * 16); const int b = (int)(row / S);
#pragma unroll
                for (int bj = 0; bj < 2; ++bj)
#pragma unroll
                    for (int n = 0; n < 2; ++n) { const int col = col0 + bj * 128 + 16 * n;
                        const f32x4 xv = *(const f32x4*)(xin + row * 1024 + col), gv = *(const f32x4*)(gvec + b * 6144 + col);
                        *(f32x4*)(out + row * 1024 + col) = xv + gv * acc[ai][bj][m][n]; } }
    }
};
struct EpiMoe1 {
    static constexpr bool PERM = true; const float* b1; bf16* ACT; LAS float* bl;
    typedef float f2 __attribute__((ext_vector_type(2)));
    __device__ __forceinline__ void prefetch(const Unit& u, int wid, int lane) const {
        if (wid < 4) { const float* src = b1 + u.e * 2048 + (wid >> 1) * 1024 + u.aux * 128 + (wid & 1) * 64 + lane;
            __builtin_amdgcn_global_load_lds((const unsigned*)src, (LAS unsigned*)(bl + wid * 64), 4, 0, 0); } }
    __device__ __forceinline__ static f2 act2(f2 g, f2 l) {
        const f2 c7 = {7.f, 7.f}, cm7 = {-7.f, -7.f}, one = {1.f, 1.f}, ck = {-1.702f * 1.4426950408889634f, -1.702f * 1.4426950408889634f};
        g = __builtin_elementwise_min(g, c7); l = __builtin_elementwise_min(__builtin_elementwise_max(l, cm7), c7);
        const f2 x = g * ck; f2 ex; ex.x = __builtin_amdgcn_exp2f(x.x); ex.y = __builtin_amdgcn_exp2f(x.y);
        const f2 d = ex + one; f2 r; r.x = __builtin_amdgcn_rcpf(d.x); r.y = __builtin_amdgcn_rcpf(d.y);
        return (g * r) * (l + one);
    }
    __device__ __forceinline__ void operator()(const f32x4 (&acc)[2][2][4][2], const Unit& u, int wr, int wc, int fr, int fq) const {
        const int row0 = u.pm * 256 + wr * 64 + fr, lc = wc * 32 + 8 * fq, ccol = u.aux * 128 + lc;
        const f32x4 bg0 = *(const LAS f32x4*)(bl + lc), bg1 = *(const LAS f32x4*)(bl + lc + 4), bl0 = *(const LAS f32x4*)(bl + 128 + lc), bl1 = *(const LAS f32x4*)(bl + 128 + lc + 4);
#pragma unroll
        for (int ai = 0; ai < 2; ++ai)
#pragma unroll
            for (int m = 0; m < 4; ++m) { const size_t row = (size_t)(row0 + ai * 128 + m * 16);
                const f32x4 g0 = acc[ai][0][m][0] + bg0, g1 = acc[ai][0][m][1] + bg1, l0 = acc[ai][1][m][0] + bl0, l1 = acc[ai][1][m][1] + bl1;
                const f2 o0 = act2((f2){g0[0], g0[1]}, (f2){l0[0], l0[1]}), o1 = act2((f2){g0[2], g0[3]}, (f2){l0[2], l0[3]}), o2 = act2((f2){g1[0], g1[1]}, (f2){l1[0], l1[1]}), o3 = act2((f2){g1[2], g1[3]}, (f2){l1[2], l1[3]});
                u32x4 w; w.x = cvt_pk_bf16(o0.x, o0.y); w.y = cvt_pk_bf16(o1.x, o1.y); w.z = cvt_pk_bf16(o2.x, o2.y); w.w = cvt_pk_bf16(o3.x, o3.y);
                *(u32x4*)(ACT + row * 1024 + ccol) = w; }
    }
};
struct EpiMoe2 {
    static constexpr bool PERM = true; const float* b2; bf16* EO; LAS float* bl;
    __device__ __forceinline__ void prefetch(const Unit& u, int wid, int lane) const {
        if (wid < 4) __builtin_amdgcn_global_load_lds((const unsigned*)(b2 + u.e * 1024 + u.aux * 256 + wid * 64 + lane), (LAS unsigned*)(bl + wid * 64), 4, 0, 0); }
    __device__ __forceinline__ void operator()(const f32x4 (&acc)[2][2][4][2], const Unit& u, int wr, int wc, int fr, int fq) const {
        const int row0 = u.pm * 256 + wr * 64 + fr, lc = wc * 32 + 8 * fq, col0 = u.aux * 256 + lc;
        f32x4 bv[2][2];
#pragma unroll
        for (int bj = 0; bj < 2; ++bj) { bv[bj][0] = *(const LAS f32x4*)(bl + lc + bj * 128); bv[bj][1] = *(const LAS f32x4*)(bl + lc + bj * 128 + 4); }
#pragma unroll
        for (int ai = 0; ai < 2; ++ai)
#pragma unroll
            for (int m = 0; m < 4; ++m) { bf16* rowp = EO + (size_t)(row0 + ai * 128 + m * 16) * 1024 + col0;
#pragma unroll
                for (int bj = 0; bj < 2; ++bj) { const f32x4 v0 = acc[ai][bj][m][0] + bv[bj][0], v1 = acc[ai][bj][m][1] + bv[bj][1];
                    u32x4 w; w.x = cvt_pk_bf16(v0[0], v0[1]); w.y = cvt_pk_bf16(v0[2], v0[3]); w.z = cvt_pk_bf16(v1[0], v1[1]); w.w = cvt_pk_bf16(v1[2], v1[3]);
                    *(u32x4*)(rowp + bj * 128) = w; } }
    }
};
struct MoeOrder {
    const LAS int* tp; const LAS int* cn; int NTn, G, c, rev;
    __device__ __forceinline__ bool next(int i, Unit& u) const {
        const int total = tp[32] * NTn; int Lx;
        if ((G & 7) == 0) { const int x = c & 7, j = c >> 3, lo = (int)(((long)total * x) >> 3), hi = (int)(((long)total * (x + 1)) >> 3); Lx = lo + i * (G >> 3) + j; if (Lx >= hi) return false;
            if (rev) Lx = hi - 1 - (Lx - lo); }
        else { Lx = i * G + c; if (Lx >= total) return false; }
        int e = 0;
        for (int q = 1; q < 32; ++q) if (Lx >= tp[q] * NTn) e = q;
        const int t0 = tp[e], r = Lx - t0 * NTn, mt = r / NTn, nt = r - mt * NTn;
        u.pm = __builtin_amdgcn_readfirstlane(t0 + mt); u.pn = __builtin_amdgcn_readfirstlane(e * NTn + nt); u.ka = 0; u.aux = __builtin_amdgcn_readfirstlane(nt); u.e = __builtin_amdgcn_readfirstlane(e);
        u.gbase = __builtin_amdgcn_readfirstlane(e * CAP + mt * 256); u.gcnt = __builtin_amdgcn_readfirstlane(cn[e] - mt * 256); u.pad = 0;
        return true;
    }
};
struct TrItem { const float* W; bf16* WT; int K, N, mode, row_off, ldk, koff, k0, n0; };
__device__ __forceinline__ void tr_load(const TrItem& t, float (&wv)[32], int lane) {
#pragma unroll
    for (int i = 0; i < 32; ++i) wv[i] = __builtin_nontemporal_load(t.W + (size_t)(t.k0 + 2 * i + (lane >> 5)) * t.N + t.n0 + (lane & 31));
}
__device__ __forceinline__ void tr_store(const TrItem& t, const float (&wv)[32], LAS float* scr, int lane) {
#pragma unroll
    for (int i = 0; i < 32; ++i) scr[(2 * i + (lane >> 5)) * 33 + (lane & 31)] = wv[i];
    LDS_WAIT(); asm volatile("" ::: "memory");
    const int c = lane & 7;
#pragma unroll
    for (int j = 0; j < 4; ++j) { const int n = (lane >> 3) + 8 * j; const LAS float* s = scr + (8 * c) * 33 + n;
        v4u o; o.x = pk2(s[0 * 33], s[1 * 33]); o.y = pk2(s[2 * 33], s[3 * 33]); o.z = pk2(s[4 * 33], s[5 * 33]); o.w = pk2(s[6 * 33], s[7 * 33]);
        const int nn = t.n0 + n; int r = nn; if (t.mode == 1) { const int half = nn >> 10, cc = nn & 1023; r = (cc >> 7) * 256 + half * 128 + (cc & 127); }
        if (t.mode == 2) r = (nn < 3232) ? nn : nn + 96;
        __builtin_nontemporal_store(o, (GAS v4u*)(t.WT + (size_t)(t.row_off + r) * t.ldk + t.koff + t.k0 + 8 * c)); }
    LDS_WAIT(); asm volatile("" ::: "memory");
}
constexpr int TI_IN = 16 * 197, TI_UQ = 6 * 24, TI_UKV = 4 * 32, TI_BR = 8 * 32, TI_OUT = 16 * 32, TI_E1 = 16 * 64, TI_E2 = 16 * 32;
constexpr int TA0 = TI_IN, TA1 = TA0 + TI_UQ, TA2 = TA1 + TI_UKV, TA3 = TA2 + TI_BR, TA4 = TA3 + TI_BR, TA5 = TA4 + TI_OUT, TA6 = TA5 + NE * TI_E1, TA7 = TA6 + NE * TI_E2, TR_NTOT = L * TA7, CONV_B = 16;
static_assert(L == 2 && TR_NTOT % CONV_B == 0 && TA5 % CONV_B == 0 && TA6 % CONV_B == 0 && TA7 % CONV_B == 0, "conversion queue layout");
__device__ __forceinline__ void tr_setup(CMkArgs* ap, int it, TrItem& t) {
    unsigned char* ws = ap->ws;
    const int l = it >= TA7 ? 1 : 0; int r = it - l * TA7, q;
    if (r < TA0) { q = r; t = TrItem{(const float*)ap->in[7] + (size_t)l * 1024 * INW, (bf16*)(ws + WS_WINT) + (size_t)l * INP * 1024, 1024, INW, 2, 0, 1024, 0, 0, 0}; }
    else if (r < TA1) { q = r - TA0; t = TrItem{(const float*)ap->in[12] + (size_t)l * 384 * 768, (bf16*)(ws + WS_WUQT) + (size_t)l * 768 * 384, 384, 768, 0, 0, 384, 0, 0, 0}; }
    else if (r < TA2) { q = r - TA1; t = TrItem{(const float*)ap->in[13] + (size_t)l * 256 * 1024, (bf16*)(ws + WS_WUKVT) + (size_t)l * 1024 * 256, 256, 1024, 0, 0, 256, 0, 0, 0}; }
    else if (r < TA3) { q = r - TA2; t = TrItem{(const float*)ap->in[18] + (size_t)l * 512 * 1024, (bf16*)(ws + WS_WBRT) + (size_t)l * 1024 * 1536, 512, 1024, 0, 0, 1536, 0, 0, 0}; }
    else if (r < TA4) { q = r - TA3; t = TrItem{(const float*)ap->in[19] + (size_t)l * 512 * 1024, (bf16*)(ws + WS_WBRT) + (size_t)l * 1024 * 1536, 512, 1024, 0, 0, 1536, 512, 0, 0}; }
    else if (r < TA5) { q = r - TA4; t = TrItem{(const float*)ap->in[21] + (size_t)l * 1024 * 1024, (bf16*)(ws + WS_WOUTT) + (size_t)l * 1024 * 1024, 1024, 1024, 0, 0, 1024, 0, 0, 0}; }
    else if (r < TA6) { r -= TA5; const int e = r / TI_E1; q = r - e * TI_E1; const int b = l * NE + e; t = TrItem{(const float*)ap->in[24] + (size_t)b * 1024 * 2048, (bf16*)(ws + WS_W1T) + (size_t)b * 2048 * 1024, 1024, 2048, 1, 0, 1024, 0, 0, 0}; }
    else { r -= TA6; const int e = r / TI_E2; q = r - e * TI_E2; const int b = l * NE + e; t = TrItem{(const float*)ap->in[26] + (size_t)b * 1024 * 1024, (bf16*)(ws + WS_W2T) + (size_t)b * 1024 * 1024, 1024, 1024, 0, 0, 1024, 0, 0, 0}; }
    const int nblk = t.N / 32, kb = q / nblk; t.k0 = 64 * kb; t.n0 = 32 * (q - kb * nblk);
}
#ifndef MK_INPROJ_W
#define MK_INPROJ_W 232
#endif
#ifndef MK_BG_CLAIM
#define MK_BG_CLAIM 32
#endif
__device__ __forceinline__ void conv_service(CMkArgs* ap, LAS unsigned char* lds, int tid, int lane, int wave, unsigned need, const unsigned* stop, unsigned stop_val) {
    asm volatile("" : "+v"(tid), "+v"(lane));
    unsigned* qh = (unsigned*)(ap->ws + WS_CTL) + CW_Q;
    LAS unsigned* slot = (LAS unsigned*)(lds + LDSCTL_OFF) + LW_CONV;
    LAS float* scr = (LAS float*)(lds + wave * 8448);
    const bool pre = (stop == nullptr);
    unsigned nxt = 0xFFFFFFFFu;
#define CONV_CLAIM() do { nxt = 0xFFFFFFFFu; \
        const bool go_ = stop != nullptr && __hip_atomic_load(stop, __ATOMIC_RELAXED, __HIP_MEMORY_SCOPE_AGENT) < stop_val; \
        if (go_ || __hip_atomic_load(qh, __ATOMIC_RELAXED, __HIP_MEMORY_SCOPE_AGENT) < need) { const unsigned i_ = __hip_atomic_fetch_add(qh, pre ? 16u : (unsigned)MK_BG_CLAIM, __ATOMIC_RELAXED, __HIP_MEMORY_SCOPE_AGENT); if (i_ < (unsigned)TR_NTOT) nxt = i_; } } while (0)
    if (tid == 0) CONV_CLAIM();
    for (int n = 0;; ++n) {
        if (tid == 0) slot[n & 1] = nxt;
        __syncthreads();
        const unsigned idx = __builtin_amdgcn_readfirstlane(slot[n & 1]);
        if (idx == 0xFFFFFFFFu) break;
        if (pre && tid == 0) CONV_CLAIM();
        { TrItem ta, tb; float va[32], vb[32];
          tr_setup(ap, (int)idx + wave, ta); tr_load(ta, va, lane);
          tr_setup(ap, (int)idx + 8 + wave, tb); tr_load(tb, vb, lane);
#if MK_BG_CLAIM > 16
          TrItem tc, td; float vc[32], vd[32]; const bool c_ok = !pre && (int)idx + 16 < TR_NTOT, d_ok = c_ok && MK_BG_CLAIM > 24;
          if (c_ok) { tr_setup(ap, (int)idx + 16 + wave, tc); tr_load(tc, vc, lane); }
          if (d_ok) { tr_setup(ap, (int)idx + 24 + wave, td); tr_load(td, vd, lane); }
#endif
          tr_store(ta, va, scr, lane); tr_store(tb, vb, scr, lane);
#if MK_BG_CLAIM > 16
          if (c_ok) tr_store(tc, vc, scr, lane);
          if (d_ok) tr_store(td, vd, scr, lane);
#endif
        }
        if (!pre && tid == 0) CONV_CLAIM();
    }
#undef CONV_CLAIM
}
__device__ __forceinline__ void phase_prologue(CMkArgs* ap, LAS unsigned char* lds, int tid, int lane, int wave, int G, int bx) {
    asm volatile("" : "+v"(tid), "+v"(lane));
    unsigned char* ws = ap->ws;
    const float* c = (const float*)ap->in[1]; const int* pos = (const int*)ap->in[2]; const float* ada_w = (const float*)ap->in[3]; const float* ada_b = (const float*)ap->in[4];
    const float* w_in = (const float*)ap->in[7]; const float* hgrn_lb = (const float*)ap->in[8]; const float* w_uq = (const float*)ap->in[12]; const float* w_ukv = (const float*)ap->in[13];
    const float* w_pool = (const float*)ap->in[16]; const float* pool_scale = (const float*)ap->in[17]; const float* w_br_a = (const float*)ap->in[18]; const float* w_br_b = (const float*)ap->in[19]; const float* w_br_c = (const float*)ap->in[20];
    const float* w_out = (const float*)ap->in[21]; const float* w_exp1 = (const float*)ap->in[24]; const float* w_exp2 = (const float*)ap->in[26];
    float* mod = (float*)(ws + WS_MOD); float* lb = (float*)(ws + WS_LB); float* rope = (float*)(ws + WS_ROPE);
    bf16 *WinT = (bf16*)(ws + WS_WINT), *WuqT = (bf16*)(ws + WS_WUQT), *WukvT = (bf16*)(ws + WS_WUKVT), *WbrT = (bf16*)(ws + WS_WBRT), *WoutT = (bf16*)(ws + WS_WOUTT), *W1T = (bf16*)(ws + WS_W1T), *W2T = (bf16*)(ws + WS_W2T);
    if (bx < 192) {
        LAS float* cs = (LAS float*)(lds + 67584);
        LAS float* part = (LAS float*)(lds + 100352);
        for (int i = tid; i < 8192; i += NTHR) { const float v = c[i]; cs[i] = v / (1.f + __expf(-v)); }
        __syncthreads();
        for (int u = bx; u < 192; u += G) {
            const int l = u / 96, j = (u - l * 96) * 64 + lane;
            const float* w = ada_w + (size_t)l * 1024 * 6144 + (size_t)(wave * 128) * 6144 + j;
            float acc[8];
#pragma unroll
            for (int b = 0; b < 8; ++b) acc[b] = 0.f;
#pragma unroll 16
            for (int k = 0; k < 128; ++k) { const float wv = w[(size_t)k * 6144];
#pragma unroll
                for (int b = 0; b < 8; ++b) acc[b] += cs[b * 1024 + wave * 128 + k] * wv; }
#pragma unroll
            for (int b = 0; b < 8; ++b) part[(wave * 8 + b) * 64 + lane] = acc[b];
            __syncthreads();
            { const int b = tid >> 6; float s = 0.f;
#pragma unroll
              for (int w8 = 0; w8 < 8; ++w8) s += part[(w8 * 8 + b) * 64 + lane];
              mod[(size_t)l * 8 * 6144 + b * 6144 + j] = s + ada_b[l * 6144 + j]; }
            __syncthreads();
        }
        if (tid == 0) __hip_atomic_fetch_add((unsigned*)(ws + WS_CTL) + CW_PD, 1u, __ATOMIC_RELAXED, __HIP_MEMORY_SCOPE_AGENT);
    }
    const int gw = bx * NWAVES + wave, NGW = G * NWAVES, gt = bx * NTHR + tid, NGT = G * NTHR;
    for (int i = gt; i < 512; i += NGT) { const float p = hgrn_lb[i], q = hgrn_lb[512 + i]; const float m = fmaxf(p, q); const float ea = __expf(p - m), eb = __expf(q - m); lb[i] = 0.f; lb[512 + i] = eb / (ea + eb); }
    for (int i = gt; i < NT * 16; i += NGT) { const int t = i >> 4, j = i & 15; float fv = ap->invf[0];
#pragma unroll
        for (int q = 1; q < 16; ++q) if (j == q) fv = ap->invf[q];
        const double ang = (double)pos[t] * (double)fv; double r = ang * 0.15915494309189535; r -= floor(r + 0.5); const float an = (float)(r * 6.283185307179586);
        rope[i] = __cosf(an); rope[NT * 16 + i] = __sinf(an); }
    for (int i = gt; i < L * 96 * 128; i += NGT) { const int l = i / (96 * 128), r = i - l * 96 * 128; *(GAS v4u*)(WinT + (size_t)l * INP * 1024 + (size_t)3232 * 1024 + (size_t)r * 8) = (v4u){0u, 0u, 0u, 0u}; }
    for (int task = gw; task < L * 1024; task += NGW) {
        const int l = task >> 10, g = (task >> 8) & 3, nb = (task >> 4) & 15, c0 = (task & 15) * 8;
        const float* wb = w_br_c + (size_t)l * 512 * 1024 + (size_t)g * 128 * 1024 + nb * 64 + lane; const float* sc = pool_scale + l * 512 + g * 128;
        const float* wp = w_pool + ((size_t)l * 4 + g) * 128 * 128 + (size_t)c0 * 128;
        float acc[8];
#pragma unroll
        for (int q = 0; q < 8; ++q) acc[q] = 0.f;
#pragma unroll 16
        for (int d = 0; d < 128; ++d) { const float w = wb[(size_t)d * 1024] * sc[d];
#pragma unroll
            for (int q = 0; q < 8; ++q) acc[q] += wp[q * 128 + d] * w; }
        v4u o; o.x = pk2(acc[0], acc[1]); o.y = pk2(acc[2], acc[3]); o.z = pk2(acc[4], acc[5]); o.w = pk2(acc[6], acc[7]);
        *(GAS v4u*)(WbrT + (size_t)l * 1024 * 1536 + (size_t)(nb * 64 + lane) * 1536 + 1024 + g * 128 + c0) = o;
    }
    conv_service(ap, lds, tid, lane, wave, (unsigned)TA5, bx >= 192 ? (const unsigned*)(ws + WS_CTL) + CW_PD : nullptr, (unsigned)(G < 192 ? G : 192));
}

template <int MODE>
__device__ __forceinline__ void phase_rows(const float* xin, float* xout, const float* gain, const float* mod_sh, const float* mod_sc, const float* mod_g2, bf16* HN,
                                           const bf16* EO, const int* tokE, const int* tokS, const float* tokW, const LAS int* tp, int lane, int gw, int NGW) {
    asm volatile("" : "+v"(lane));
    for (int row = gw; row < NT; row += NGW) {
        const int b = row / S;
        const GAS f32x4* xr = (const GAS f32x4*)(xin + (size_t)row * D);
        f32x4 v[4];
#pragma unroll
        for (int j = 0; j < 4; ++j) v[j] = xr[lane + 64 * j];
        if (MODE != 0) {
            f32x4 acc[4];
#pragma unroll
            for (int j = 0; j < 4; ++j) acc[j] = (f32x4){0.f, 0.f, 0.f, 0.f};
#pragma unroll
            for (int k = 0; k < 4; ++k) { const int e = tokE[row * 4 + k]; const size_t r = (size_t)tp[e] * 256 + tokS[row * 4 + k]; const float w = tokW[row * 4 + k];
                const GAS v2u* er = (const GAS v2u*)(EO + r * 1024);
#pragma unroll
                for (int j = 0; j < 4; ++j) { const v2u ev = er[lane + 64 * j];
                    acc[j][0] += w * __uint_as_float(ev.x << 16); acc[j][1] += w * __uint_as_float(ev.x & 0xffff0000u); acc[j][2] += w * __uint_as_float(ev.y << 16); acc[j][3] += w * __uint_as_float(ev.y & 0xffff0000u); } }
#pragma unroll
            for (int j = 0; j < 4; ++j) { const f32x4 gg = *(const GAS f32x4*)(mod_g2 + b * 6144 + (lane + 64 * j) * 4); v[j] = v[j] + gg * acc[j]; *(GAS f32x4*)(xout + (size_t)row * D + (lane + 64 * j) * 4) = v[j]; }
        }
        if (MODE != 2) {
            float ss = 0.f;
#pragma unroll
            for (int j = 0; j < 4; ++j) ss += (v[j][0] * v[j][0] + v[j][1] * v[j][1]) + (v[j][2] * v[j][2] + v[j][3] * v[j][3]);
            const float rstd = rsqrtf(wave_sum(ss) * (1.f / D) + EPS);
#pragma unroll
            for (int j = 0; j < 4; ++j) { const int cc = (lane + 64 * j) * 4; const f32x4 gg = *(const GAS f32x4*)(gain + cc), sh = *(const GAS f32x4*)(mod_sh + b * 6144 + cc), sc = *(const GAS f32x4*)(mod_sc + b * 6144 + cc);
                const f32x4 h = v[j] * rstd * gg * (sc + 1.f) + sh; v2u o; o.x = pk2(h[0], h[1]); o.y = pk2(h[2], h[3]);
                *(GAS v2u*)(HN + (size_t)row * D + cc) = o; }
        }
    }
}
__device__ __forceinline__ void load_tp(const int* cnt, LAS int* tp, LAS int* cn, int tid) {
    if (tid < 32) cn[tid] = __hip_atomic_load(cnt + tid, __ATOMIC_RELAXED, __HIP_MEMORY_SCOPE_AGENT);
    __syncthreads();
    if (tid == 0) { int acc = 0; tp[0] = 0;
        for (int q = 0; q < 32; ++q) { acc += (cn[q] + 255) >> 8; tp[q + 1] = acc; } }
    __syncthreads();
}

__device__ __forceinline__ void phase_router(const float* x1, const float* gain, const float* mod_sh, const float* mod_sc, const float* wr, const float* br, bf16* hn2, int* cnt, int* list, int* tokE, int* tokS, float* tokW,
                                             LAS unsigned char* lds, int tid, int lane, int wave, int G, int bx) {
    asm volatile("" : "+v"(tid), "+v"(lane));
    LAS float* tile = (LAS float*)(lds + RING_OFF);
    LAS int* lw = (LAS int*)(lds + LDSCTL_OFF);
    LAS int* entE = lw + LW_ENTE; LAS float* entW = (LAS float*)(lw + LW_ENTW); LAS int* rank = lw + LW_RANK; LAS int* lcnt = lw + LW_LCNT; LAS int* base = lw + LW_BASE;
    const int l31 = lane & 31, h5 = lane >> 5;
    float breg[64];
#pragma unroll
    for (int j = 0; j < 64; ++j) breg[j] = wr[(size_t)(128 * wave + 2 * j + h5) * 32 + l31];
    if (tid < 32) lcnt[tid] = 0;
    __syncthreads();
    for (int bt = bx; bt < NT / 64; bt += G) {
#pragma unroll 1
      for (int hb = 0; hb < 2; ++hb) {
        const int row0 = bt * 64 + hb * 32 + wave * 4, b = row0 / S;
        int ln = lane; asm volatile("" : "+v"(ln));
#pragma unroll 1
        for (int rp = 0; rp < 2; ++rp) {
        f32x4 v[2][4];
#pragma unroll
        for (int rr = 0; rr < 2; ++rr)
#pragma unroll
            for (int j = 0; j < 4; ++j) v[rr][j] = ((const GAS f32x4*)(x1 + (size_t)(row0 + 2 * rp + rr) * D))[ln + 64 * j];
#pragma unroll
        for (int rr = 0; rr < 2; ++rr) {
            const int lr = wave * 4 + 2 * rp + rr, row = row0 + 2 * rp + rr;
            int l2 = ln; asm volatile("" : "+v"(l2));
            float ss = 0.f;
#pragma unroll
            for (int j = 0; j < 4; ++j) ss += (v[rr][j][0] * v[rr][j][0] + v[rr][j][1] * v[rr][j][1]) + (v[rr][j][2] * v[rr][j][2] + v[rr][j][3] * v[rr][j][3]);
            const float rstd = rsqrtf(wave_sum(ss) * (1.f / D) + EPS);
#pragma unroll
            for (int j = 0; j < 4; ++j) { const int cc = (l2 + 64 * j) * 4; const f32x4 gg = *(const GAS f32x4*)(gain + cc), sh = *(const GAS f32x4*)(mod_sh + b * 6144 + cc), sc = *(const GAS f32x4*)(mod_sc + b * 6144 + cc);
                const f32x4 hv = v[rr][j] * rstd * gg * (sc + 1.f) + sh; v2u o; o.x = pk2(hv[0], hv[1]); o.y = pk2(hv[2], hv[3]);
                *(GAS v2u*)(hn2 + (size_t)row * D + cc) = o;
#pragma unroll
                for (int q = 0; q < 4; ++q) tile[lr * 1024 + ((cc + q) ^ lr)] = hv[q]; }
        }
        }
        __syncthreads();
        f32x16 acc;
#pragma unroll
        for (int r = 0; r < 16; ++r) acc[r] = 0.f;
#pragma unroll
        for (int j = 0; j < 64; ++j) { const float a = tile[l31 * 1024 + ((128 * wave + 2 * j + h5) ^ l31)]; acc = __builtin_amdgcn_mfma_f32_32x32x2f32(a, breg[j], acc, 0, 0, 0);
            if ((j & 7) == 7) __builtin_amdgcn_sched_barrier(0); }
        __syncthreads();
#pragma unroll
        for (int r = 0; r < 16; ++r) tile[(wave * 32 + (r & 3) + 8 * (r >> 2) + 4 * h5) * 32 + l31] = acc[r];
        __syncthreads();
#pragma unroll 1
        for (int rr = 0; rr < 4; ++rr) {
            const int lr = wave * 4 + rr, er = hb * 32 + lr; float cur = br[l31];
#pragma unroll
            for (int w8 = 0; w8 < 8; ++w8) cur += tile[(w8 * 32 + lr) * 32 + l31];
            float tv[4]; int ti[4];
#pragma unroll
            for (int k = 0; k < 4; ++k) { float mv = cur; int mi = l31;
#pragma unroll
                for (int o = 1; o < 32; o <<= 1) { const float ov = __shfl_xor(mv, o); const int oi = __shfl_xor(mi, o); if (ov > mv || (ov == mv && oi < mi)) { mv = ov; mi = oi; } }
                tv[k] = mv; ti[k] = mi; if (l31 == mi) cur = -INFINITY; }
            const float e1 = __expf(tv[1] - tv[0]), e2 = __expf(tv[2] - tv[0]), e3 = __expf(tv[3] - tv[0]), inv = 1.f / (1.f + e1 + e2 + e3);
            if (lane == 0) { entE[er * 4 + 0] = ti[0]; entE[er * 4 + 1] = ti[1]; entE[er * 4 + 2] = ti[2]; entE[er * 4 + 3] = ti[3];
                entW[er * 4 + 0] = inv; entW[er * 4 + 1] = e1 * inv; entW[er * 4 + 2] = e2 * inv; entW[er * 4 + 3] = e3 * inv; }
        }
        __syncthreads();
      }
        if (tid < 256) rank[tid] = __hip_atomic_fetch_add(lcnt + entE[tid], 1, __ATOMIC_RELAXED, __HIP_MEMORY_SCOPE_WORKGROUP);
        __syncthreads();
        if (tid < 32) { const int n = lcnt[tid]; base[tid] = n ? __hip_atomic_fetch_add(cnt + tid, n, __ATOMIC_RELAXED, __HIP_MEMORY_SCOPE_AGENT) : 0; lcnt[tid] = 0; }
        __syncthreads();
        if (tid < 256) { const int e = entE[tid], slot = base[e] + rank[tid], row = bt * 64 + (tid >> 2);
            list[(size_t)e * CAP + slot] = row; tokE[row * 4 + (tid & 3)] = e; tokS[row * 4 + (tid & 3)] = slot; tokW[row * 4 + (tid & 3)] = entW[tid]; }
        __syncthreads();
    }
}

__device__ __forceinline__ int moe_workers(int total, int G) { const int gx = G >> 3, nmax = (total + 7) >> 3, rounds = (nmax + gx - 1) / gx; int jw = rounds > 0 ? (nmax + rounds - 1) / rounds : gx; return jw < 1 ? 1 : (jw > gx ? gx : jw); }
__device__ __forceinline__ bool moe_early(int total, int jw, int bx) { const int x = bx & 7, j = bx >> 3, lo = (int)(((long)total * x) >> 3), hi = (int)(((long)total * (x + 1)) >> 3), nmax = (total + 7) >> 3;
    const int mine = (hi - lo - j + jw - 1) / jw, maxr = (nmax + jw - 1) / jw; return mine < maxr; }
__global__ void __launch_bounds__(NTHR, 2) mk_fwd(MkArgs a) {
    extern __shared__ __attribute__((aligned(16))) unsigned char lds_raw[];
    LAS unsigned char* lds = (LAS unsigned char*)lds_raw;
    const int G = gridDim.x, bx = blockIdx.x, wave_s = __builtin_amdgcn_readfirstlane((int)threadIdx.x >> 6);
#define PH_LOCALS int tid = wave_s * 64 + (int)mk_lane_id(); asm volatile("" : "+v"(tid)); const int lane = tid & 63, wave = __builtin_amdgcn_readfirstlane(tid >> 6), gw = bx * NWAVES + wave, NGW = G * NWAVES; (void)lane; (void)gw; (void)NGW
    { PH_LOCALS; for (int u = tid; u < (LDS_BYTES - LDSCTL_OFF) / 4; u += NTHR) ((LAS unsigned*)(lds + LDSCTL_OFF))[u] = 0u; }
    __syncthreads();
    int lo, hi; XcdBarrier bar;
    { PH_LOCALS; KA_PTR(ka); lo = ka->ph_lo; hi = ka->ph_hi; bar = xcd_barrier_post((unsigned*)(ka->ws + WS_CTL) + CW_BAR + ka->li * XCD_BAR_WORDS, (volatile LAS unsigned*)(lds + LDSCTL_OFF) + LW_BAR, wave_s); }
    LAS int* lw = (LAS int*)(lds + LDSCTL_OFF); LAS int* tp = lw + LW_TP; LAS int* cn = lw + LW_CNT;
#ifndef MK_PHMASK
#define MK_PHMASK 0xFFFFFFFFu
#endif
#ifndef MK_DUP
#define MK_DUP 0u
#endif
#define NREP(p) (((MK_DUP >> (p)) & 1u) ? 2 : 1)
#ifndef MK_DUPSUB
#define MK_DUPSUB 0xFFu
#endif
#define SUBEN(bit) (rep_ == 0 || ((MK_DUPSUB >> (bit)) & 1u))
#define PHEN(p) ((MK_PHMASK >> (p)) & 1u)
#define IN(k) (lo <= (k) && (k) < hi)
#ifndef MK_HOOKPROBE
#define MK_HOOKPROBE 0
#endif
#ifndef MK_DUPBAR
#define MK_DUPBAR 0
#endif
#define SEAM(k) do { if (IN(k) && IN((k) + 1)) { xcd_barrier(bar); if (MK_DUPBAR) xcd_barrier(bar); } } while (0)
#define WSP(T, off) ((T*)(ws + (off)))
    if (PHEN(31) && IN(0)) for (int rep_ = 0; rep_ < NREP(31); ++rep_) { PH_LOCALS; KA_PTR(ka); phase_prologue(ka, lds, tid, lane, wave, G, bx); VM_WAIT(); __syncthreads(); }
    SEAM(0);
    for (int l = 0; l < L; ++l) {
        const int pb = 1 + l * NPH_L;
        if (PHEN(0) && IN(pb + 0)) for (int rep_ = 0; rep_ < NREP(0); ++rep_) { PH_LOCALS; KA_PTR(ka); unsigned char* ws = ka->ws; const float* modl = WSP(float, WS_MOD) + (size_t)l * 8 * 6144; const float* norm1_g = (const float*)ka->in[5] + l * D;
            if (l == 0) phase_rows<0>((const float*)ka->in[0], nullptr, norm1_g, modl + 0, modl + 1024, nullptr, WSP(bf16, WS_HN), nullptr, nullptr, nullptr, nullptr, tp, lane, gw, NGW);
            else { load_tp(WSP(int, WS_CTL) + CW_CNT + (l - 1) * 64, tp, cn, tid); int* tokE = WSP(int, WS_TOK);
                phase_rows<1>(WSP(float, WS_XA), WSP(float, WS_XB), norm1_g, modl + 0, modl + 1024, modl - 8 * 6144 + 5120, WSP(bf16, WS_HN), WSP(bf16, WS_EO), tokE, tokE + NT * 4, (const float*)(tokE + NT * 8), tp, lane, gw, NGW); }
        }
        SEAM(pb + 0);
        if (PHEN(1) && IN(pb + 1)) for (int rep_ = 0; rep_ < NREP(1); ++rep_) { PH_LOCALS; KA_PTR(ka); unsigned char* ws = ka->ws;
#if defined(MK_DBG) && MK_DBG
            if (bx == 0 && tid == 0 && l == MK_DBG_L) WSP(unsigned, WS_CTL)[1030] = (MK_DBG == 1) ? __hip_atomic_load(WSP(unsigned, WS_CTL) + CW_Q, __ATOMIC_RELAXED, __HIP_MEMORY_SCOPE_AGENT) : (unsigned)__builtin_amdgcn_s_memrealtime();
#endif
            const int GW = (G >= 232 && (G & 7) == 0) ? MK_INPROJ_W : G; unsigned* pd = WSP(unsigned, WS_CTL) + CW_PD + 64 * (1 + 3 * l);
            if (bx < GW) {
                pg8::Gemm g{WSP(bf16, WS_HN), WSP(bf16, WS_WINT) + (size_t)l * INP * 1024, nullptr, 1024, 1024, 1024, 0}; pg8::StaticOrder So; So.init(NT, INP, GW, bx);
                EpiP E{WSP(bf16, WS_P), INP, WSP(bf16, WS_GT)};
                pg8::gemm_phase<EpiP, pg8::StaticOrder, true, true, false>(lds + RING_OFF, g, So, E, wave);
                if (tid == 0) __hip_atomic_fetch_add(pd, 1u, __ATOMIC_RELAXED, __HIP_MEMORY_SCOPE_AGENT);
                if (((NT / 256) * (INP / 256) - bx + GW - 1) / GW < ((NT / 256) * (INP / 256) + GW - 1) / GW) conv_service(ka, lds, tid, lane, wave, 0u, pd, (unsigned)GW);
            } else conv_service(ka, lds, tid, lane, wave, 0u, pd, (unsigned)GW);
        }
        SEAM(pb + 1);
#if defined(MK_DBG) && MK_DBG
        { PH_LOCALS; KA_PTR(ka); unsigned char* ws = ka->ws; if (bx == 0 && tid == 0 && l == MK_DBG_L) WSP(unsigned, WS_CTL)[1031] = (MK_DBG == 1) ? __hip_atomic_load(WSP(unsigned, WS_CTL) + CW_Q, __ATOMIC_RELAXED, __HIP_MEMORY_SCOPE_AGENT) : (unsigned)__builtin_amdgcn_s_memrealtime(); }
#endif
        if (PHEN(2) && IN(pb + 2)) for (int rep_ = 0; rep_ < NREP(2); ++rep_) { PH_LOCALS; KA_PTR(ka); unsigned char* ws = ka->ws;
#if MK_HGRN_IN
            if (SUBEN(2)) hgrn_a_all(WSP(bf16, WS_P), WSP(float, WS_LB) + l * 512, WSP(float, WS_SLOC), WSP(float, WS_DEC), lds + RING_OFF, bx, G, tid, lane, wave);
#endif
#if MK_MLA_IN
            if (SUBEN(3)) for (int u = bx; u < NT / 64; u += G)
                mla_unit(WSP(bf16, WS_P), (const float*)ka->in[10] + l * 384, (const float*)ka->in[11] + l * 256, WSP(bf16, WS_WUQT) + (size_t)l * 768 * 384, WSP(bf16, WS_WUKVT) + (size_t)l * 1024 * 256,
                         (const float*)ka->in[14] + l * 96, (const float*)ka->in[15] + l * 96, WSP(float, WS_ROPE), WSP(bf16, WS_Q), WSP(bf16, WS_K), WSP(bf16, WS_V), lds + RING_OFF, u, lane, wave);
#endif
#if MK_POOL_IN
            if (SUBEN(4)) for (int u = bx; u < NT / 64; u += G) pool_unit(WSP(bf16, WS_P), WSP(bf16, WS_BR), u, tid);
#endif
        }
        SEAM(pb + 2);
        if (PHEN(3) && IN(pb + 3)) for (int rep_ = 0; rep_ < NREP(3); ++rep_) { PH_LOCALS; KA_PTR(ka); unsigned char* ws = ka->ws;
#if MK_HGRN_IN
            for (int u = bx; u < 256; u += G) hgrn_scan_unit(WSP(float, WS_SLOC), WSP(float, WS_DEC), WSP(bf16, WS_ST), u, tid);
#endif
        }
        SEAM(pb + 3);
        if (PHEN(4) && IN(pb + 4)) for (int rep_ = 0; rep_ < NREP(4); ++rep_) { PH_LOCALS; KA_PTR(ka); unsigned char* ws = ka->ws;
#if MK_ATTN_IN
            if (SUBEN(0)) for (int p = bx; p < 256; p += G) {
                attn_unit(WSP(bf16, WS_Q), WSP(bf16, WS_K), WSP(bf16, WS_V), WSP(bf16, WS_BR), lds + RING_OFF, p & 63, 7 - (p >> 6), tid, lane, wave);
                attn_unit(WSP(bf16, WS_Q), WSP(bf16, WS_K), WSP(bf16, WS_V), WSP(bf16, WS_BR), lds + RING_OFF, p & 63, p >> 6, tid, lane, wave);
            }
#endif
#if MK_HGRN_IN
            if (SUBEN(1)) for (int u = bx; u < 1024; u += G) hgrn_c_unit(WSP(bf16, WS_P), WSP(float, WS_LB) + l * 512, WSP(bf16, WS_ST), (const float*)ka->in[9] + l * 128, WSP(bf16, WS_BR), lds + RING_OFF, u, tid, lane, wave);
#endif
        }
        SEAM(pb + 4);
        if (PHEN(5) && IN(pb + 5)) for (int rep_ = 0; rep_ < NREP(5); ++rep_) { PH_LOCALS; KA_PTR(ka); unsigned char* ws = ka->ws;
            pg8::Gemm g{WSP(bf16, WS_BR), WSP(bf16, WS_WBRT) + (size_t)l * 1024 * 1536, nullptr, 1536, 1536, 1536, 0}; pg8::StaticOrder So; So.init(NT, 1024, G, bx);
#if MK_P5PROBE
            if (rep_ == 1) { EpiP E2{WSP(bf16, WS_MERGF), 1024, nullptr}; pg8::gemm_phase<EpiP, pg8::StaticOrder, false, true, false, 0>(lds + RING_OFF, g, So, E2, wave); } else
#endif
            { EpiBranch E{WSP(bf16, WS_GT), WSP(bf16, WS_MERGB)};
            pg8::gemm_phase<EpiBranch, pg8::StaticOrder, false, true, false, 8>(lds + RING_OFF, g, So, E, wave); }
        }
        SEAM(pb + 5);
        if (PHEN(6) && IN(pb + 6)) for (int rep_ = 0; rep_ < NREP(6); ++rep_) { PH_LOCALS; KA_PTR(ka); unsigned char* ws = ka->ws; const float* xin = (l == 0) ? (const float*)ka->in[0] : WSP(float, WS_XB);
            pg8::Gemm g{WSP(bf16, WS_MERGB), WSP(bf16, WS_WOUTT) + (size_t)l * 1024 * 1024, nullptr, 1024, 1024, 1024, 0}; pg8::StaticOrder So; So.init(NT, 1024, G, bx);
            EpiOut E{xin, WSP(float, WS_MOD) + (size_t)l * 8 * 6144 + 2048, WSP(float, WS_XA)};
            pg8::gemm_phase<EpiOut, pg8::StaticOrder, false, true, false>(lds + RING_OFF, g, So, E, wave);
        }
        SEAM(pb + 6);
        if (PHEN(7) && IN(pb + 7)) for (int rep_ = 0; rep_ < NREP(7); ++rep_) { PH_LOCALS; KA_PTR(ka); unsigned char* ws = ka->ws; const float* modl = WSP(float, WS_MOD) + (size_t)l * 8 * 6144; int* tokE = WSP(int, WS_TOK);
            if (rep_ == 1) tokE = WSP(int, WS_KVRAW);
            phase_router(WSP(float, WS_XA), (const float*)ka->in[6] + l * D, modl + 3072, modl + 4096, (const float*)ka->in[22] + (size_t)l * 1024 * 32, (const float*)ka->in[23] + l * 32, WSP(bf16, WS_HN2),
                         WSP(int, WS_CTL) + (rep_ == 1 ? 2048 : CW_CNT) + l * 64, rep_ == 1 ? WSP(int, WS_QRAW) : WSP(int, WS_LIST), tokE, tokE + NT * 4, (float*)(tokE + NT * 8), lds, tid, lane, wave, G, bx);
            conv_service(ka, lds, tid, lane, wave, (unsigned)(l * TA7 + TA6), nullptr, 0u); }
        SEAM(pb + 7);
        if (PHEN(8) && IN(pb + 8)) for (int rep_ = 0; rep_ < NREP(8); ++rep_) { PH_LOCALS; KA_PTR(ka); unsigned char* ws = ka->ws;
            load_tp(WSP(int, WS_CTL) + CW_CNT + l * 64, tp, cn, tid);
            const int jw = moe_workers(tp[32] * 8, G); unsigned* pd = WSP(unsigned, WS_CTL) + CW_PD + 64 * (2 + 3 * l); const bool worker = (bx >> 3) < jw || (G & 7) != 0;
            if (worker) {
                pg8::Gemm g{WSP(bf16, WS_HN2), WSP(bf16, WS_W1T) + (size_t)l * NE * 2048 * 1024, WSP(int, WS_LIST), 1024, 1024, 1024, 0}; MoeOrder So{tp, cn, 8, (G & 7) ? G : 8 * jw, bx, 0};
                EpiMoe1 E{(const float*)ka->in[25] + (size_t)l * NE * 2048, WSP(bf16, WS_ACT), (LAS float*)(lw + LW_BIAS)};
                pg8::gemm_phase<EpiMoe1, MoeOrder, true, true, true>(lds + RING_OFF, g, So, E, wave);
                if (tid == 0) __hip_atomic_fetch_add(pd, 1u, __ATOMIC_RELAXED, __HIP_MEMORY_SCOPE_AGENT);
            }
            conv_service(ka, lds, tid, lane, wave, (unsigned)((l + 1) * TA7), (worker && !moe_early(tp[32] * 8, jw, bx)) ? nullptr : pd, (unsigned)(8 * jw));
        }
        SEAM(pb + 8);
        if (PHEN(9) && IN(pb + 9)) for (int rep_ = 0; rep_ < NREP(9); ++rep_) { PH_LOCALS; KA_PTR(ka); unsigned char* ws = ka->ws;
            load_tp(WSP(int, WS_CTL) + CW_CNT + l * 64, tp, cn, tid);
            const int jw = moe_workers(tp[32] * 4, G); unsigned* pd = WSP(unsigned, WS_CTL) + CW_PD + 64 * (3 + 3 * l); const bool worker = (bx >> 3) < jw || (G & 7) != 0;
            if (worker) {
                pg8::Gemm g{WSP(bf16, WS_ACT), WSP(bf16, WS_W2T) + (size_t)l * NE * 1024 * 1024, nullptr, 1024, 1024, 1024, 0}; MoeOrder So{tp, cn, 4, (G & 7) ? G : 8 * jw, bx, 1};
                EpiMoe2 E{(const float*)ka->in[27] + (size_t)l * NE * 1024, WSP(bf16, WS_EO), (LAS float*)(lw + LW_BIAS)};
                pg8::gemm_phase<EpiMoe2, MoeOrder, true, true, false>(lds + RING_OFF, g, So, E, wave);
                if (tid == 0) __hip_atomic_fetch_add(pd, 1u, __ATOMIC_RELAXED, __HIP_MEMORY_SCOPE_AGENT);
            }
            conv_service(ka, lds, tid, lane, wave, (unsigned)(l + 1 < L ? (l + 1) * TA7 + TA5 : 0), (worker && !moe_early(tp[32] * 4, jw, bx)) ? nullptr : pd, (unsigned)(8 * jw));
        }
        SEAM(pb + 9);
    }
    if (PHEN(30) && IN(PH_FINAL)) for (int rep_ = 0; rep_ < NREP(30); ++rep_) { PH_LOCALS; KA_PTR(ka); unsigned char* ws = ka->ws; load_tp(WSP(int, WS_CTL) + CW_CNT + (L - 1) * 64, tp, cn, tid); int* tokE = WSP(int, WS_TOK);
        phase_rows<2>(WSP(float, WS_XA), ka->out, nullptr, nullptr, nullptr, WSP(float, WS_MOD) + (size_t)(L - 1) * 8 * 6144 + 5120, nullptr, WSP(bf16, WS_EO), tokE, tokE + NT * 4, (const float*)(tokE + NT * 8), tp, lane, gw, NGW); }
#if defined(MK_DBG) && MK_DBG
    xcd_barrier(bar);
    { PH_LOCALS; KA_PTR(ka); unsigned char* ws = ka->ws; const unsigned d = __hip_atomic_load(WSP(unsigned, WS_CTL) + 1031, __ATOMIC_RELAXED, __HIP_MEMORY_SCOPE_AGENT) - __hip_atomic_load(WSP(unsigned, WS_CTL) + 1030, __ATOMIC_RELAXED, __HIP_MEMORY_SCOPE_AGENT);
      const unsigned K = d * (unsigned)MK_DBG_SCALE; for (unsigned i = bx * NTHR + tid; i < K && i < (unsigned)NT * 1024u; i += G * NTHR) ka->out[i] = 0.f; }
#endif
#undef IN
#undef SEAM
}
static void launch_mk(const MkArgs& base, int lo, int hi, int li, int grid, hipStream_t stream) {
    MkArgs a = base; a.ph_lo = lo; a.ph_hi = hi; a.li = li; a.pad = 0;
    hipLaunchKernelGGL(mk_fwd, dim3(grid), dim3(NTHR), LDS_BYTES, stream, a);
}
extern "C" void kernel_launch(void* const* d_in, const int* in_sizes, int n_in, void* d_out, int out_size, void* d_ws, size_t ws_size, hipStream_t stream) {
    static int grid = 0;
    if (grid == 0) {
        if (ws_size < WS_END || n_in != 28) { fprintf(stderr, "kernel_launch: bad ws/inputs: %zu < %zu, n_in %d\n", ws_size, (size_t)WS_END, n_in); grid = -1; return; }
        int dev = 0, cus = 0, per_cu = 0;
        if (hipGetDevice(&dev) != hipSuccess || hipDeviceGetAttribute(&cus, hipDeviceAttributeMultiprocessorCount, dev) != hipSuccess) { grid = -1; return; }
        if (hipFuncSetAttribute((const void*)mk_fwd, hipFuncAttributeMaxDynamicSharedMemorySize, LDS_BYTES) != hipSuccess) { fprintf(stderr, "kernel_launch: hipFuncSetAttribute failed\n"); grid = -1; return; }
        if (hipOccupancyMaxActiveBlocksPerMultiprocessor(&per_cu, (const void*)mk_fwd, NTHR, LDS_BYTES) != hipSuccess || per_cu < 1) { fprintf(stderr, "kernel_launch: occupancy query says %d\n", per_cu); (void)hipGetLastError(); grid = -1; return; }
        grid = cus;
    }
    if (grid < 0) return;
    unsigned char* ws = (unsigned char*)d_ws;
    (void)hipMemsetAsync(ws + WS_CTL, 0, 1 * MiB, stream);
    MkArgs a{};
    for (int i = 0; i < 28; ++i) a.in[i] = d_in[i];
    a.out = (float*)d_out; a.ws = ws;
    for (int j = 0; j < 16; ++j) a.invf[j] = (float)(1.0 / pow(10000.0, (double)j / 16.0));
#if MK_HYBRID
    const float* onorm_g = (const float*)d_in[9]; const float* qlat_g = (const float*)d_in[10]; const float* kvlat_g = (const float*)d_in[11]; const float* qn_g = (const float*)d_in[14]; const float* kn_g = (const float*)d_in[15];
    float* lb = (float*)(ws + WS_LB); float* rope = (float*)(ws + WS_ROPE);
    bf16 *WuqT = (bf16*)(ws + WS_WUQT), *WukvT = (bf16*)(ws + WS_WUKVT), *P = (bf16*)(ws + WS_P), *Qb = (bf16*)(ws + WS_Q), *Kb = (bf16*)(ws + WS_K), *Vb = (bf16*)(ws + WS_V), *BR = (bf16*)(ws + WS_BR), *QLN = (bf16*)(ws + WS_QLN), *KVN = (bf16*)(ws + WS_KVN);
    float *ORAW = (float*)(ws + WS_ORAW), *QRAW = (float*)(ws + WS_QRAW), *KVRAW = (float*)(ws + WS_KVRAW);
    int li = 0;
    for (int l = 0; l < L; ++l) {
        const int pb = 1 + l * NPH_L;
        launch_mk(a, l == 0 ? 0 : pb - 5, pb + 2, li++, grid, stream);
#if !MK_HGRN_IN
        k_hgrn_naive<<<NB * HH, 128, 0, stream>>>(P, lb + l * 512, ORAW);
        k_hgrn_out<<<NT * 4 / 4, 256, 0, stream>>>(ORAW, P, onorm_g + l * 128, BR);
#endif
#if !MK_MLA_IN
        k_mla_prep<<<NT / 4, 256, 0, stream>>>(P, qlat_g + l * 384, kvlat_g + l * 256, QLN, KVN);
        { GemmArgs g{}; g.A = QLN; g.Bt = WuqT + (size_t)l * 768 * 384; g.lda = 384; g.ldb = 384; g.K = 384; g.outf = QRAW; g.ldc = 768;
          k_gemm<1, 0><<<dim3(768 / 64, NT / 64), 256, 0, stream>>>(g); }
        { GemmArgs g{}; g.A = KVN; g.Bt = WukvT + (size_t)l * 1024 * 256; g.lda = 256; g.ldb = 256; g.K = 256; g.outf = KVRAW; g.ldc = 1024;
          k_gemm<1, 0><<<dim3(1024 / 64, NT / 64), 256, 0, stream>>>(g); }
        k_mla_post<<<NT * 8 / 4, 256, 0, stream>>>(QRAW, KVRAW, P, qn_g + l * 96, kn_g + l * 96, rope, Qb, Kb, Vb);
#endif
#if !MK_POOL_IN
        k_pool<<<NT * 512 / 256, 256, 0, stream>>>(P, BR);
#endif
#if MK_MLA_IN || MK_POOL_IN || MK_HGRN_IN
        launch_mk(a, pb + 2, pb + 3, li++, grid, stream);
#endif
#if MK_HGRN_IN
        launch_mk(a, pb + 3, pb + 4, li++, grid, stream);
#endif
#if MK_ATTN_IN || MK_HGRN_IN
        launch_mk(a, pb + 4, pb + 5, li++, grid, stream);
#else
        k_attn_naive<<<dim3(S / 64, NB * MH), 64, 0, stream>>>(Qb, Kb, Vb, BR);
#endif
    }
    launch_mk(a, 1 + (L - 1) * NPH_L + 5, NPH, li++, grid, stream);
#else
    launch_mk(a, 0, NPH, 0, grid, stream);
#endif
}
```

```cpp
#include <hip/hip_runtime.h>
#include <stdint.h>
#include <cstdio>
#include <cmath>

typedef unsigned short bf16;
__device__ __forceinline__ float bf2f(bf16 v) { return __uint_as_float(((unsigned)v) << 16); }
__device__ __forceinline__ bf16 f2bf(float f) { unsigned u = __float_as_uint(f); return (bf16)((u + 0x7fffu + ((u >> 16) & 1u)) >> 16); }
__device__ __forceinline__ float sigmoidf_(float x) { return 1.f / (1.f + __expf(-x)); }

constexpr int D = 1024, NB = 8, S = 2048, NT = NB * S, L = 2;
constexpr int HH = 4, HDK = 128, HW = 512, HCH = 64;
constexpr int MH = 8, MNOPE = 64, MROPE = 32, MQK = 96, MV = 64, MQR = 384, MKVR = 256, MW = 512;
constexpr int PW = 512;
constexpr int NE = 32, TOPK = 4, FF = 1024;
constexpr int INW = 6304, INP = 6400;
constexpr int C_HQ = 0, C_HF = 512, C_HI = 1024, C_HG = 1536, C_QLAT = 2048, C_KVLAT = 2432, C_KROPE = 2688, C_POOL = 2720, C_GA = 3232, C_GB = 4256, C_GC = 5280;
constexpr float EPS = 1e-6f;
constexpr int CAP = NT;
constexpr int MAXROWS = NT * TOPK + NE * 256;

constexpr size_t MiB = 1u << 20;
constexpr size_t WS_CTL = 0;
constexpr size_t WS_MOD = 1 * MiB;
constexpr size_t WS_LB = 2 * MiB;
constexpr size_t WS_ROPE = 3 * MiB;
constexpr size_t WS_WINT = 6 * MiB;
constexpr size_t WS_WUQT = 32 * MiB;
constexpr size_t WS_WUKVT = 34 * MiB;
constexpr size_t WS_WBRT = 36 * MiB;
constexpr size_t WS_WOUTT = 42 * MiB;
constexpr size_t WS_W1T = 48 * MiB;
constexpr size_t WS_W2T = 304 * MiB;
constexpr size_t WS_HN = 432 * MiB;
constexpr size_t WS_P = 464 * MiB;
constexpr size_t WS_Q = 664 * MiB;
constexpr size_t WS_K = 688 * MiB;
constexpr size_t WS_V = 712 * MiB;
constexpr size_t WS_BR = 728 * MiB;
constexpr size_t WS_MERGF = 776 * MiB;
constexpr size_t WS_MERGB = 840 * MiB;
constexpr size_t WS_XA = 872 * MiB;
constexpr size_t WS_XB = 936 * MiB;
constexpr size_t WS_HN2 = 1000 * MiB;
constexpr size_t WS_LIST = 1032 * MiB;
constexpr size_t WS_TOK = 1034 * MiB;
constexpr size_t WS_ACT = 1036 * MiB;
constexpr size_t WS_EO = 1180 * MiB;
constexpr size_t WS_ORAW = 1324 * MiB;
constexpr size_t WS_QLN = 1356 * MiB;
constexpr size_t WS_KVN = 1368 * MiB;
constexpr size_t WS_QRAW = 1376 * MiB;
constexpr size_t WS_KVRAW = 1424 * MiB;
constexpr size_t WS_SLOC = 1488 * MiB;
constexpr size_t WS_ST = 1552 * MiB;
constexpr size_t WS_DEC = 1584 * MiB;
constexpr size_t WS_GT = 1585 * MiB;
constexpr size_t WS_END = 1681 * MiB;
constexpr int CW_CNT = 64;
constexpr int CW_OFF = 256;

template <int MODE>
__global__ void k_transpose(const float* __restrict__ in, bf16* __restrict__ out, int K, int N, int NP, int rowoff, size_t ibs, size_t obs) {
    __shared__ float t[32][33];
    const int n0 = blockIdx.x * 32, k0 = blockIdx.y * 32, tx = threadIdx.x & 31, ty = threadIdx.x >> 5;
    const float* ip = in + (size_t)blockIdx.z * ibs; bf16* op = out + (size_t)blockIdx.z * obs;
#pragma unroll
    for (int j = 0; j < 4; ++j) t[ty + 8 * j][tx] = ip[(size_t)(k0 + ty + 8 * j) * N + n0 + tx];
    __syncthreads();
#pragma unroll
    for (int j = 0; j < 4; ++j) {
        int n = n0 + ty + 8 * j; int r = n;
        if (MODE == 1) { const int half = n >> 10, c = n & 1023; r = (c >> 7) * 256 + half * 128 + (c & 127); }
        op[(size_t)(rowoff + r) * K + k0 + tx] = f2bf(t[tx][ty + 8 * j]);
    }
}
__global__ void k_zero_bf16(bf16* p, size_t n) { size_t i = (size_t)blockIdx.x * blockDim.x + threadIdx.x; if (i < n) p[i] = 0; }

__global__ void k_fold_pool(const float* __restrict__ w_pool, const float* __restrict__ scale, const float* __restrict__ w_br_c, bf16* __restrict__ wbrt) {
    const int l = blockIdx.z, k = blockIdx.y, n = blockIdx.x * 256 + threadIdx.x, g = k >> 7, c = k & 127;
    const float* wp = w_pool + ((size_t)l * 4 + g) * 128 * 128 + (size_t)c * 128; const float* sc = scale + l * 512 + g * 128; const float* wb = w_br_c + (size_t)l * 512 * 1024 + (size_t)g * 128 * 1024;
    float a = 0.f;
    for (int d = 0; d < 128; ++d) a += wp[d] * sc[d] * wb[(size_t)d * 1024 + n];
    wbrt[(size_t)l * 3072 * 512 + (size_t)(2048 + n) * 512 + k] = f2bf(a);
}
__global__ void k_adaln(const float* __restrict__ c, const float* __restrict__ ada_w, const float* __restrict__ ada_b, float* __restrict__ mod) {
    __shared__ float cs[8][1024];
    for (int i = threadIdx.x; i < 8192; i += 256) { float v = c[i]; cs[i >> 10][i & 1023] = v / (1.f + __expf(-v)); }
    __syncthreads();
    const int l = blockIdx.y, j = blockIdx.x * 256 + threadIdx.x;
    const float* w = ada_w + (size_t)l * 1024 * 6144 + j;
    float a0 = 0, a1 = 0, a2 = 0, a3 = 0, a4 = 0, a5 = 0, a6 = 0, a7 = 0;
    for (int k = 0; k < 1024; ++k) { const float wv = w[(size_t)k * 6144];
        a0 += cs[0][k] * wv; a1 += cs[1][k] * wv; a2 += cs[2][k] * wv; a3 += cs[3][k] * wv; a4 += cs[4][k] * wv; a5 += cs[5][k] * wv; a6 += cs[6][k] * wv; a7 += cs[7][k] * wv; }
    const float bb = ada_b[l * 6144 + j]; float* m = mod + (size_t)l * 8 * 6144 + j;
    m[0 * 6144] = a0 + bb; m[1 * 6144] = a1 + bb; m[2 * 6144] = a2 + bb; m[3 * 6144] = a3 + bb; m[4 * 6144] = a4 + bb; m[5 * 6144] = a5 + bb; m[6 * 6144] = a6 + bb; m[7 * 6144] = a7 + bb;
}
struct InvF { float f[16]; };
__global__ void k_misc(const float* __restrict__ hgrn_lb, const int* __restrict__ pos, float* __restrict__ lb, float* __restrict__ rope, InvF invf) {
    const int i = blockIdx.x * 256 + threadIdx.x;
    if (i < 512) { const float a = hgrn_lb[i], b = hgrn_lb[512 + i]; const float m = fmaxf(a, b); const float ea = __expf(a - m), eb = __expf(b - m); lb[i] = 0.f; lb[512 + i] = eb / (ea + eb); }
    if (i < NT * 16) { const int t = i >> 4, j = i & 15; float fv = invf.f[0];
#pragma unroll
        for (int q = 1; q < 16; ++q) if (j == q) fv = invf.f[q];
        const double ang = (double)pos[t] * (double)fv;
        double r = ang * 0.15915494309189535; r -= floor(r + 0.5); const float a = (float)(r * 6.283185307179586);
        rope[i] = __cosf(a); rope[NT * 16 + i] = __sinf(a); }
}

__global__ void k_norm_mod(const float* __restrict__ x, const float* __restrict__ g, const float* __restrict__ mod_sh, const float* __restrict__ mod_sc, bf16* __restrict__ out) {
    const int row = blockIdx.x * 4 + (threadIdx.x >> 6), lane = threadIdx.x & 63, b = row / S;
    const float4* xr = (const float4*)(x + (size_t)row * D);
    float4 v[4]; float ss = 0.f;
#pragma unroll
    for (int j = 0; j < 4; ++j) { v[j] = xr[lane + 64 * j]; ss += v[j].x * v[j].x + v[j].y * v[j].y + v[j].z * v[j].z + v[j].w * v[j].w; }
#pragma unroll
    for (int o = 1; o < 64; o <<= 1) ss += __shfl_xor(ss, o);
    const float rstd = rsqrtf(ss * (1.f / D) + EPS);
#pragma unroll
    for (int j = 0; j < 4; ++j) { const int c = (lane + 64 * j) * 4; const float4 gg = *(const float4*)(g + c), sh = *(const float4*)(mod_sh + b * 6144 + c), sc = *(const float4*)(mod_sc + b * 6144 + c);
        ushort4 o; o.x = f2bf(v[j].x * rstd * gg.x * (1.f + sc.x) + sh.x); o.y = f2bf(v[j].y * rstd * gg.y * (1.f + sc.y) + sh.y); o.z = f2bf(v[j].z * rstd * gg.z * (1.f + sc.z) + sh.z); o.w = f2bf(v[j].w * rstd * gg.w * (1.f + sc.w) + sh.w);
        *(ushort4*)(out + (size_t)row * D + c) = o; }
}

struct GemmArgs { const bf16* A; const bf16* Bt; const int* rowlist; const int* cnt; const int* off; float* outf; bf16* outb; const bf16* gate; const float* xin; const float* gvec; const float* bias;
    int lda, ldb, K, ldc, pad0, pad1; };
template <int MODE, int BRI>
__global__ void __launch_bounds__(256) k_gemm(GemmArgs g) {
    __shared__ float As[16][65], Bs[16][65], Bs2[16][65];
    const int tid = threadIdx.x, tx = tid & 15, ty = tid >> 4;
    int m0 = blockIdx.y * 64, n0 = blockIdx.x * 64; int e = 0, cnt = 1 << 30, orow0 = m0;
    const bf16* Bt = g.Bt;
    if (MODE == 4 || MODE == 5) { e = blockIdx.z; cnt = g.cnt[e]; if (m0 >= cnt) return; orow0 = g.off[e] + m0; Bt += (size_t)e * (MODE == 4 ? 2048 : 1024) * g.ldb; }
    const int lr = tid >> 2, lk = (tid & 3) * 4;
    size_t arow;
    if (MODE == 4) { const int slot = m0 + lr; arow = (slot < cnt) ? (size_t)g.rowlist[(size_t)e * CAP + slot] : 0; }
    else if (MODE == 5) arow = (size_t)(orow0 + lr);
    else arow = (size_t)(m0 + lr);
    const bf16* ap = g.A + arow * g.lda + lk;
    int bn = n0 + lr;
    if (MODE == 4) { const int t = n0 >> 6;     const int col = n0 + lr; bn = (col >> 7) * 256 + (col & 127); (void)t; }
    const bf16* bp = Bt + (size_t)bn * g.ldb + lk;
    const bf16* bp2 = bp + (size_t)128 * g.ldb;
    float acc[4][4], acc2[4][4];
#pragma unroll
    for (int i = 0; i < 4; ++i)
#pragma unroll
        for (int j = 0; j < 4; ++j) { acc[i][j] = 0.f; acc2[i][j] = 0.f; }
    for (int k0 = 0; k0 < g.K; k0 += 16) {
        const ushort4 av = *(const ushort4*)(ap + k0), bv = *(const ushort4*)(bp + k0);
        As[lk + 0][lr] = bf2f(av.x); As[lk + 1][lr] = bf2f(av.y); As[lk + 2][lr] = bf2f(av.z); As[lk + 3][lr] = bf2f(av.w);
        Bs[lk + 0][lr] = bf2f(bv.x); Bs[lk + 1][lr] = bf2f(bv.y); Bs[lk + 2][lr] = bf2f(bv.z); Bs[lk + 3][lr] = bf2f(bv.w);
        if (MODE == 4) { const ushort4 cv = *(const ushort4*)(bp2 + k0); Bs2[lk + 0][lr] = bf2f(cv.x); Bs2[lk + 1][lr] = bf2f(cv.y); Bs2[lk + 2][lr] = bf2f(cv.z); Bs2[lk + 3][lr] = bf2f(cv.w); }
        __syncthreads();
#pragma unroll
        for (int kk = 0; kk < 16; ++kk) {
            float a[4], b[4], b2[4];
#pragma unroll
            for (int i = 0; i < 4; ++i) { a[i] = As[kk][ty * 4 + i]; b[i] = Bs[kk][tx * 4 + i]; if (MODE == 4) b2[i] = Bs2[kk][tx * 4 + i]; }
#pragma unroll
            for (int i = 0; i < 4; ++i)
#pragma unroll
                for (int j = 0; j < 4; ++j) { acc[i][j] += a[i] * b[j]; if (MODE == 4) acc2[i][j] += a[i] * b2[j]; }
        }
        __syncthreads();
    }
#pragma unroll
    for (int i = 0; i < 4; ++i) {
        const int rl = ty * 4 + i;
        if ((MODE == 4 || MODE == 5) && m0 + rl >= cnt) continue;
        const size_t row = (MODE == 4 || MODE == 5) ? (size_t)(orow0 + rl) : (size_t)(m0 + rl);
#pragma unroll
        for (int j = 0; j < 4; ++j) {
            const int col = n0 + tx * 4 + j; const float v = acc[i][j];
            if (MODE == 0) g.outb[row * g.ldc + col] = f2bf(v);
            else if (MODE == 1) g.outf[row * g.ldc + col] = v;
            else if (MODE == 2) { const float gt = sigmoidf_(bf2f(g.gate[row * INP + col])) * v; float* o = g.outf + row * g.ldc + col;
                if (BRI == 0) *o = gt; else if (BRI == 1) *o += gt; else { const float s = *o + gt; *o = s; g.outb[row * g.ldc + col] = f2bf(s); } }
            else if (MODE == 3) { const int b = (int)(row / S); g.outf[row * g.ldc + col] = g.xin[row * g.ldc + col] + g.gvec[b * 6144 + col] * v; }
            else if (MODE == 4) { float glu = v + g.bias[e * 2048 + col], lin = acc2[i][j] + g.bias[e * 2048 + 1024 + col];
                glu = fminf(glu, 7.f); lin = fminf(fmaxf(lin, -7.f), 7.f);
                g.outb[row * g.ldc + col] = f2bf(glu * sigmoidf_(1.702f * glu) * (lin + 1.f)); }
            else if (MODE == 5) g.outb[row * g.ldc + col] = f2bf(v + g.bias[e * 1024 + col]);
        }
    }
}

__global__ void __launch_bounds__(128) k_hgrn_naive(const bf16* __restrict__ P, const float* __restrict__ lb, float* __restrict__ oraw) {
    __shared__ float qs[16][128], ks[16][128], fs[16][128];
    const int b = blockIdx.x >> 2, h = blockIdx.x & 3, v = threadIdx.x;
    const float lbv = lb[h * 128 + v];
    float st[128];
#pragma unroll
    for (int d = 0; d < 128; ++d) st[d] = 0.f;
    for (int t0 = 0; t0 < S; t0 += 16) {
        __syncthreads();
        for (int tt = 0; tt < 16; ++tt) { const bf16* pr = P + (size_t)(b * S + t0 + tt) * INP;
            const float z = bf2f(pr[C_HF + h * 128 + v]); const float sg = sigmoidf_(z);
            qs[tt][v] = bf2f(pr[C_HQ + h * 128 + v]); fs[tt][v] = lbv + (1.f - lbv) * sg; ks[tt][v] = (1.f - lbv) * (1.f - sg); }
        __syncthreads();
        for (int tt = 0; tt < 16; ++tt) {
            const float vv = bf2f(P[(size_t)(b * S + t0 + tt) * INP + C_HI + h * 128 + v]);
            float o = 0.f;
#pragma unroll
            for (int d = 0; d < 128; ++d) { st[d] = fs[tt][d] * st[d] + ks[tt][d] * vv; o += qs[tt][d] * st[d]; }
            oraw[(size_t)(b * S + t0 + tt) * 512 + h * 128 + v] = o;
        }
    }
}
__global__ void k_hgrn_out(const float* __restrict__ oraw, const bf16* __restrict__ P, const float* __restrict__ og, bf16* __restrict__ BR) {
    const int idx = blockIdx.x * 4 + (threadIdx.x >> 6), lane = threadIdx.x & 63, t = idx >> 2, h = idx & 3;
    const float o0 = oraw[(size_t)t * 512 + h * 128 + lane], o1 = oraw[(size_t)t * 512 + h * 128 + 64 + lane];
    float ss = o0 * o0 + o1 * o1;
#pragma unroll
    for (int o = 1; o < 64; o <<= 1) ss += __shfl_xor(ss, o);
    const float rstd = rsqrtf(ss * (1.f / 128.f) + EPS);
    const float g0 = bf2f(P[(size_t)t * INP + C_HG + h * 128 + lane]), g1 = bf2f(P[(size_t)t * INP + C_HG + h * 128 + 64 + lane]);
    BR[(size_t)t * 1536 + h * 128 + lane] = f2bf(o0 * rstd * og[lane] * g0 * sigmoidf_(g0));
    BR[(size_t)t * 1536 + h * 128 + 64 + lane] = f2bf(o1 * rstd * og[64 + lane] * g1 * sigmoidf_(g1));
}
__global__ void k_mla_prep(const bf16* __restrict__ P, const float* __restrict__ qg, const float* __restrict__ kvg, bf16* __restrict__ qln, bf16* __restrict__ kvn) {
    const int t = blockIdx.x * 4 + (threadIdx.x >> 6), lane = threadIdx.x & 63; const bf16* pr = P + (size_t)t * INP;
    float q[6], kv[4], s1 = 0.f, s2 = 0.f;
#pragma unroll
    for (int j = 0; j < 6; ++j) { q[j] = bf2f(pr[C_QLAT + lane + 64 * j]); s1 += q[j] * q[j]; }
#pragma unroll
    for (int j = 0; j < 4; ++j) { kv[j] = bf2f(pr[C_KVLAT + lane + 64 * j]); s2 += kv[j] * kv[j]; }
#pragma unroll
    for (int o = 1; o < 64; o <<= 1) { s1 += __shfl_xor(s1, o); s2 += __shfl_xor(s2, o); }
    const float r1 = rsqrtf(s1 * (1.f / 384.f) + EPS), r2 = rsqrtf(s2 * (1.f / 256.f) + EPS);
#pragma unroll
    for (int j = 0; j < 6; ++j) qln[(size_t)t * 384 + lane + 64 * j] = f2bf(q[j] * r1 * qg[lane + 64 * j]);
#pragma unroll
    for (int j = 0; j < 4; ++j) kvn[(size_t)t * 256 + lane + 64 * j] = f2bf(kv[j] * r2 * kvg[lane + 64 * j]);
}
__global__ void k_mla_post(const float* __restrict__ qraw, const float* __restrict__ kvraw, const bf16* __restrict__ P, const float* __restrict__ qng, const float* __restrict__ kng,
                           const float* __restrict__ rope, bf16* __restrict__ Q, bf16* __restrict__ K, bf16* __restrict__ V) {
    const int idx = blockIdx.x * 4 + (threadIdx.x >> 6), lane = threadIdx.x & 63, t = idx >> 3, h = idx & 7, b = t / S, s = t % S;
    const float qa = qraw[(size_t)t * 768 + h * 96 + lane], qb = qraw[(size_t)t * 768 + h * 96 + 64 + (lane & 31)];
    const float ka = kvraw[(size_t)t * 1024 + h * 128 + lane], kb = bf2f(P[(size_t)t * INP + C_KROPE + (lane & 31)]);
    const float va = kvraw[(size_t)t * 1024 + h * 128 + 64 + lane];
    float sq = qa * qa + (lane < 32 ? qb * qb : 0.f), sk = ka * ka + (lane < 32 ? kb * kb : 0.f);
#pragma unroll
    for (int o = 1; o < 64; o <<= 1) { sq += __shfl_xor(sq, o); sk += __shfl_xor(sk, o); }
    const float rq = rsqrtf(sq * (1.f / 96.f) + EPS), rk = rsqrtf(sk * (1.f / 96.f) + EPS);
    const size_t ob = ((size_t)(b * MH + h) * S + s);
    Q[ob * 96 + lane] = f2bf(qa * rq * qng[lane]); K[ob * 96 + lane] = f2bf(ka * rk * kng[lane]); V[((size_t)(b * MH + h) * 64 + lane) * S + s] = f2bf(va);
    const float qn = qb * rq * qng[64 + (lane & 31)], kn = kb * rk * kng[64 + (lane & 31)];
    const float qo = __shfl_xor(qn, 16), ko = __shfl_xor(kn, 16);
    const int i = lane & 15; const float cs = rope[(size_t)t * 16 + i], sn = rope[(size_t)NT * 16 + (size_t)t * 16 + i];
    if (lane < 32) { float qr, kr; if (lane < 16) { qr = qn * cs - qo * sn; kr = kn * cs - ko * sn; } else { qr = qn * cs + qo * sn; kr = kn * cs + ko * sn; }
        Q[ob * 96 + 64 + lane] = f2bf(qr); K[ob * 96 + 64 + lane] = f2bf(kr); }
}
__global__ void __launch_bounds__(64) k_attn_naive(const bf16* __restrict__ Q, const bf16* __restrict__ K, const bf16* __restrict__ V, bf16* __restrict__ BR) {
    __shared__ float ks[16][96], vs[16][64];
    const int bh = blockIdx.y, q0 = blockIdx.x * 64, qi = q0 + threadIdx.x, b = bh >> 3, h = bh & 7;
    float q[96], o[64]; float m = -INFINITY, l = 0.f;
    const bf16* qp = Q + ((size_t)bh * S + qi) * 96;
#pragma unroll
    for (int d = 0; d < 96; ++d) q[d] = bf2f(qp[d]) * 0.10206207261596575f;
#pragma unroll
    for (int d = 0; d < 64; ++d) o[d] = 0.f;
    for (int k0 = 0; k0 < q0 + 64; k0 += 16) {
        __syncthreads();
        for (int i = threadIdx.x; i < 16 * 96; i += 64) ks[i / 96][i % 96] = bf2f(K[((size_t)bh * S + k0) * 96 + i]);
        for (int i = threadIdx.x; i < 16 * 64; i += 64) vs[i & 15][i >> 4] = bf2f(V[((size_t)bh * 64 + (i >> 4)) * S + k0 + (i & 15)]);
        __syncthreads();
        for (int j = 0; j < 16; ++j) {
            if (k0 + j > qi) break;
            float sc = 0.f;
#pragma unroll
            for (int d = 0; d < 96; ++d) sc += q[d] * ks[j][d];
            const float mn = fmaxf(m, sc), corr = __expf(m - mn), p = __expf(sc - mn);
            l = l * corr + p; m = mn;
#pragma unroll
            for (int d = 0; d < 64; ++d) o[d] = o[d] * corr + p * vs[j][d];
        }
    }
    const float inv = 1.f / l; bf16* op = BR + (size_t)(b * S + qi) * 1536 + 512 + h * 64;
#pragma unroll
    for (int d = 0; d < 64; ++d) op[d] = f2bf(o[d] * inv);
}
__global__ void k_pool(const bf16* __restrict__ P, bf16* __restrict__ BR) {
    const int i = blockIdx.x * 256 + threadIdx.x, t = i >> 9, c = i & 511, g = c >> 7, s = t % S, w = 2 << g;
    const int n = (s + 1 < w) ? s + 1 : w; float sum = 0.f;
    for (int j = 0; j < n; ++j) sum += bf2f(P[(size_t)(t - j) * INP + C_POOL + c]);
    const float u = bf2f(P[(size_t)t * INP + C_POOL + c]);
    BR[(size_t)t * 1536 + 1024 + c] = f2bf(sum / (float)n - u);
}
__global__ void k_router(const float* __restrict__ x, const float* __restrict__ g, const float* __restrict__ mod_sh, const float* __restrict__ mod_sc, const float* __restrict__ wr, const float* __restrict__ br,
                         bf16* __restrict__ hn2, int* __restrict__ cnt, int* __restrict__ list, int* __restrict__ tokE, int* __restrict__ tokS, float* __restrict__ tokW) {
    __shared__ float hs[4][1024];
    const int w = threadIdx.x >> 6, row = blockIdx.x * 4 + w, lane = threadIdx.x & 63, b = row / S;
    const float4* xr = (const float4*)(x + (size_t)row * D);
    float4 v[4]; float ss = 0.f;
#pragma unroll
    for (int j = 0; j < 4; ++j) { v[j] = xr[lane + 64 * j]; ss += v[j].x * v[j].x + v[j].y * v[j].y + v[j].z * v[j].z + v[j].w * v[j].w; }
#pragma unroll
    for (int o = 1; o < 64; o <<= 1) ss += __shfl_xor(ss, o);
    const float rstd = rsqrtf(ss * (1.f / D) + EPS);
#pragma unroll
    for (int j = 0; j < 4; ++j) { const int c = (lane + 64 * j) * 4; const float4 gg = *(const float4*)(g + c), sh = *(const float4*)(mod_sh + b * 6144 + c), sc = *(const float4*)(mod_sc + b * 6144 + c);
        float4 hv; hv.x = v[j].x * rstd * gg.x * (1.f + sc.x) + sh.x; hv.y = v[j].y * rstd * gg.y * (1.f + sc.y) + sh.y; hv.z = v[j].z * rstd * gg.z * (1.f + sc.z) + sh.z; hv.w = v[j].w * rstd * gg.w * (1.f + sc.w) + sh.w;
        ushort4 o; o.x = f2bf(hv.x); o.y = f2bf(hv.y); o.z = f2bf(hv.z); o.w = f2bf(hv.w);
        *(ushort4*)(hn2 + (size_t)row * D + c) = o; *(float4*)&hs[w][c] = hv; }
    __syncthreads();
    const int e = lane & 31, half = lane >> 5; float a = 0.f;
    for (int k = half * 512; k < half * 512 + 512; ++k) a += hs[w][k] * wr[k * 32 + e];
    a += __shfl_xor(a, 32); a += br[e];
    float cur = a; float tv[4]; int ti[4];
#pragma unroll
    for (int k = 0; k < 4; ++k) { float mv = cur; int mi = e;
#pragma unroll
        for (int o = 1; o < 32; o <<= 1) { const float ov = __shfl_xor(mv, o); const int oi = __shfl_xor(mi, o); if (ov > mv || (ov == mv && oi < mi)) { mv = ov; mi = oi; } }
        tv[k] = mv; ti[k] = mi; if (e == mi) cur = -INFINITY; }
    const float e1 = __expf(tv[1] - tv[0]), e2 = __expf(tv[2] - tv[0]), e3 = __expf(tv[3] - tv[0]), inv = 1.f / (1.f + e1 + e2 + e3);
    if (lane == 0) {
        const float ww[4] = {inv, e1 * inv, e2 * inv, e3 * inv};
#pragma unroll
        for (int k = 0; k < 4; ++k) { const int slot = atomicAdd(&cnt[ti[k]], 1); list[(size_t)ti[k] * CAP + slot] = row; tokE[row * 4 + k] = ti[k]; tokS[row * 4 + k] = slot; tokW[row * 4 + k] = ww[k]; }
    }
}
__global__ void k_offsets(const int* __restrict__ cnt, int* __restrict__ off) { if (threadIdx.x == 0) { int a = 0; for (int e = 0; e < 32; ++e) { off[e] = a; a += (cnt[e] + 255) & ~255; } off[32] = a; } }
__global__ void k_combine(const float* __restrict__ x1, const float* __restrict__ mod_g2, const bf16* __restrict__ EO, const int* __restrict__ off, const int* __restrict__ tokE, const int* __restrict__ tokS, const float* __restrict__ tokW, float* __restrict__ out) {
    const int row = blockIdx.x, b = row / S, c = threadIdx.x * 4;
    float4 acc = {0.f, 0.f, 0.f, 0.f};
#pragma unroll
    for (int k = 0; k < 4; ++k) { const int e = tokE[row * 4 + k]; const size_t r = (size_t)off[e] + tokS[row * 4 + k]; const float w = tokW[row * 4 + k];
        const ushort4 ev = *(const ushort4*)(EO + r * 1024 + c); acc.x += w * bf2f(ev.x); acc.y += w * bf2f(ev.y); acc.z += w * bf2f(ev.z); acc.w += w * bf2f(ev.w); }
    const float4 xv = *(const float4*)(x1 + (size_t)row * D + c), gg = *(const float4*)(mod_g2 + b * 6144 + c);
    float4 o; o.x = xv.x + gg.x * acc.x; o.y = xv.y + gg.y * acc.y; o.z = xv.z + gg.z * acc.z; o.w = xv.w + gg.w * acc.w;
    *(float4*)(out + (size_t)row * D + c) = o;
}

#define MK_HYBRID 0
#define MK_POOL_IN 1
#define MK_MLA_IN 1
#define MK_ATTN_IN 1
#define MK_HGRN_IN 1
__device__ __forceinline__ unsigned mk_lane_id() { unsigned l; asm volatile("v_mbcnt_lo_u32_b32 %0, -1, 0\n\tv_mbcnt_hi_u32_b32 %0, -1, %0" : "=v"(l)); return l; }
#define GAS __attribute__((address_space(1)))
#define LAS __attribute__((address_space(3)))
#define XB_TMO      128
#define XB_XCNT(j)  (256  + 64 * (j))
#define XB_XSUB(j)  (1280 + 64 * (j))
#define XB_XGEN(j)  (2304 + 64 * (j))
#define XB_TOP      3328
#define XB_TOPGEN   3392
#define XCD_BAR_WORDS 3456
#define XB_SPIN_CAP (1u << 18)

__device__ __forceinline__ unsigned xb_ld(unsigned* p)              { return __hip_atomic_load(p, __ATOMIC_RELAXED, __HIP_MEMORY_SCOPE_AGENT); }
__device__ __forceinline__ unsigned xb_add(unsigned* p, unsigned v) { return __hip_atomic_fetch_add(p, v, __ATOMIC_RELAXED, __HIP_MEMORY_SCOPE_AGENT); }
__device__ __forceinline__ unsigned xb_xcc_id() { return (unsigned)__builtin_amdgcn_s_getreg((3 << 11) | 20) & 0xFu; }
#define XB_SPIN(cond, bar) do { unsigned _sp = 0; while (cond) { __builtin_amdgcn_s_sleep(1); \
    if ((++_sp & 255u) == 0u) { if (xb_ld(&(bar)[XB_TMO])) break; if (_sp > XB_SPIN_CAP) { atomicAdd(&(bar)[XB_TMO], 1u); break; } } } } while (0)

struct XcdBarrier {
    unsigned* bar; unsigned x; int wv;
    volatile LAS unsigned* st;
};

__device__ __forceinline__ bool xb_thread0(int wv) { return wv == 0 && mk_lane_id() == 0u; }
__device__ __forceinline__ XcdBarrier xcd_barrier_post(unsigned* bar, volatile LAS unsigned* st, int wv) {
    XcdBarrier b; b.bar = bar; b.x = xb_xcc_id(); b.st = st; b.wv = wv;
    if (xb_thread0(wv)) (void)xb_add(&bar[XB_XCNT(b.x)], 1u);
    return b;
}
__device__ __forceinline__ void xcd_barrier_complete(unsigned* bar, unsigned x, unsigned& nloc, unsigned& nx) {
    const unsigned G = gridDim.x * gridDim.y * gridDim.z;
    unsigned sum, cnt, mine, sp = 0u;
    for (;;) {
        sum = 0u; cnt = 0u; mine = 0u;
#pragma unroll
        for (unsigned j = 0; j < 16; ++j) { const unsigned c = xb_ld(&bar[XB_XCNT(j)]); sum += c; cnt += (c > 0u) ? 1u : 0u; mine = (j == x) ? c : mine; }
        if (sum == G) break;
        __builtin_amdgcn_s_sleep(1);
        if ((++sp & 255u) == 0u) { if (xb_ld(&bar[XB_TMO])) break; if (sp > XB_SPIN_CAP) { atomicAdd(&bar[XB_TMO], 1u); break; } }
    }
    nloc = mine > 0u ? mine : 1u; nx = cnt > 0u ? cnt : 1u;
}

__device__ __forceinline__ void xcd_barrier(const XcdBarrier& b) {
    asm volatile("s_waitcnt vmcnt(0)" ::: "memory");
    __syncthreads();
    if (xb_thread0(b.wv)) {
        unsigned* bar = b.bar;
        __builtin_amdgcn_s_waitcnt(0);
        unsigned nloc = b.st[0], nx = b.st[1];
        if (nloc == 0u) { xcd_barrier_complete(bar, b.x, nloc, nx); b.st[0] = nloc; b.st[1] = nx; }
        const unsigned old = xb_add(&bar[XB_XSUB(b.x)], 1u);
        const unsigned gen = old / nloc;
        if (old + 1u == (gen + 1u) * nloc) {
            __builtin_amdgcn_fence(__ATOMIC_RELEASE, "agent");
            asm volatile("s_waitcnt vmcnt(0)" ::: "memory");
            const unsigned og = xb_add(&bar[XB_TOP], 1u);
            const unsigned tg = og / nx;
            if (og + 1u == (tg + 1u) * nx) xb_add(&bar[XB_TOPGEN], 1u);
            else XB_SPIN(xb_ld(&bar[XB_TOPGEN]) == tg, bar);
            __builtin_amdgcn_fence(__ATOMIC_ACQUIRE, "agent");
            xb_add(&bar[XB_XGEN(b.x)], 1u);
            asm volatile("s_waitcnt vmcnt(0)" ::: "memory");
        } else {
            XB_SPIN(xb_ld(&bar[XB_XGEN(b.x)]) == gen, bar);
            __builtin_amdgcn_fence(__ATOMIC_ACQUIRE, "agent");
            asm volatile("s_waitcnt vmcnt(0)" ::: "memory");
        }
    }
    __syncthreads();
}
namespace pg8 {
#define PG8_LAS __attribute__((address_space(3)))
typedef unsigned short bf16_t;
typedef short bf16x8 __attribute__((ext_vector_type(8)));
typedef float f32x4 __attribute__((ext_vector_type(4)));
typedef unsigned u32x4 __attribute__((ext_vector_type(4)));
constexpr int BM = 256, BK = 64, HALF = 128, HTB = HALF * BK * 2  , STAGE_BYTES = 8 * HTB, NXCD = 8, WGM = 8;

__host__ __device__ __forceinline__ int lds_byte(int r, int c) { const int st = (r >> 4) * 2 + (c >> 5), rr = r & 15, cc = c & 31, ob = rr * 64 + cc * 2; return st * 1024 + (ob ^ (((ob >> 9) & 1) << 5)); }
__host__ __device__ __forceinline__ void stage_rc(int b, int& R, int& C) { const int st = b / 1024, sb = b % 1024, swz = sb ^ (((sb >> 9) & 1) << 5); R = (st >> 1) * 16 + swz / 64; C = (st & 1) * 32 + (swz % 64) / 2; }
__host__ __device__ __forceinline__ int perm32(int rho) { const int n = rho >> 4, i = rho & 15; return 8 * (i >> 2) + 4 * n + (i & 3); }

struct Unit { int pm, pn, ka, aux, e, gbase, gcnt, pad; };
struct Gemm { const bf16_t* A; const bf16_t* Bt; const int* rowlist; int lda, ldb, K, pad; };

struct StaticOrder {
    int nM, nN, nwg, G, c;
    __host__ __device__ void init(int M, int N, int G_, int c_) { nM = M / BM; nN = N / BM; nwg = nM * nN; G = G_; c = c_; }
    __host__ __device__ bool next(int i, Unit& u) const {
        const long L = (long)i * G + c; if (L >= nwg) return false;
        int wgid = (int)L; { const int q = nwg / NXCD, r = nwg % NXCD, xcd = wgid % NXCD, off = wgid / NXCD; wgid = (xcd < r ? xcd * (q + 1) : r * (q + 1) + (xcd - r) * q) + off; }
        const int nig = WGM * nN, gid = wgid / nig, fm = gid * WGM, gsz = (nM - fm) < WGM ? (nM - fm) : WGM;
        u.pm = fm + ((wgid % nig) % gsz); u.pn = (wgid % nig) / gsz; u.ka = 0; u.aux = 0; u.e = 0; u.gbase = 0; u.gcnt = 0; u.pad = 0; return true;
    }
};

typedef float cvt_f32x2 __attribute__((ext_vector_type(2)));
typedef __bf16 cvt_bf16x2 __attribute__((ext_vector_type(2)));
__device__ __forceinline__ unsigned cvt_pk_bf16(float lo, float hi) { const cvt_f32x2 v = {lo, hi}; return __builtin_bit_cast(unsigned, __builtin_convertvector(v, cvt_bf16x2)); }

template <class Epi, class Sched, bool ALIGN_EPI, bool SP2, bool GATHER, int HOOK = 0>
__device__ __forceinline__ void gemm_phase(PG8_LAS unsigned char* lds, const Gemm g, const Sched& S, const Epi& E, int wave_in) {
    int tid_ = wave_in * 64 + (int)mk_lane_id(); asm volatile("" : "+v"(tid_));
    const int tid = tid_, wid = __builtin_amdgcn_readfirstlane(tid >> 6), lane = tid & 63, wr = wid >> 2, wc = wid & 3, fr = lane & 15, fq = lane >> 4;
    const int K = g.K, nt = K / BK;
    const unsigned ldaB = (unsigned)g.lda * 2u, ldbB = (unsigned)g.ldb * 2u;
    unsigned voffA[2], voffB[2]; int rowA[2];
#pragma unroll
    for (int i = 0; i < 2; ++i) { int R, C; stage_rc(tid * 16 + i * 8192, R, C); const int Rb = Epi::PERM ? ((R & ~31) + perm32(R & 31)) : R;
        rowA[i] = R; voffA[i] = GATHER ? (unsigned)C * 2u : (unsigned)R * ldaB + (unsigned)C * 2u; voffB[i] = (unsigned)Rb * ldbB + (unsigned)C * 2u; }
    const size_t kstep = (size_t)(BK * 2);
    const size_t hstepA = GATHER ? 0 : (size_t)HALF * ldaB, hstepB = (size_t)HALF * ldbB;
    const size_t tstepA = 2 * (size_t)HALF * ldaB, tstepB = 2 * hstepB;
    const unsigned ldsw = (unsigned)wid * 1024u;
    const int aoff = lds_byte(wr * 64 + fr, fq * 8), boff = lds_byte(wc * 32 + fr, fq * 8);
    unsigned gvc[2][2], gvn[2][2];
#define PG8_SA(b, h) (((b) * 2 + (h)) * HTB)
#define PG8_SB(b, h) ((4 + (b) * 2 + (h)) * HTB)
#define PG8_STAGE(bufoff, gbase, voff) do { _Pragma("unroll") for (int _i = 0; _i < 2; ++_i) \
        __builtin_amdgcn_global_load_lds((const unsigned*)((const char*)(gbase) + (voff)[_i]), (PG8_LAS unsigned*)(lds + (bufoff) + ldsw + _i * 8192), 16, 0, 0); } while (0)
#define PG8_STAGEA(bufoff, gbase, h, nx) do { if constexpr (GATHER) { unsigned _vo[2]; _vo[0] = ((nx) ? gvn[h][0] : gvc[h][0]) + voffA[0]; _vo[1] = ((nx) ? gvn[h][1] : gvc[h][1]) + voffA[1]; PG8_STAGE(bufoff, gbase, _vo); } \
        else { PG8_STAGE(bufoff, (const char*)(gbase) + (h) * hstepA, voffA); } } while (0)
#define PG8_GLOAD(dst, u) do { _Pragma("unroll") for (int _h = 0; _h < 2; ++_h) _Pragma("unroll") for (int _i = 0; _i < 2; ++_i) { const int _r = _h * HALF + rowA[_i]; \
        const int _row = (_r < (u).gcnt) ? g.rowlist[(u).gbase + _r] : 0; dst[_h][_i] = (unsigned)_row * ldaB; } } while (0)
#define PG8_LDA(dst, b, h) do { _Pragma("unroll") for (int m = 0; m < 4; ++m) _Pragma("unroll") for (int k = 0; k < 2; ++k) dst[m][k] = *(const PG8_LAS bf16x8*)(lds + PG8_SA(b, h) + aoff + m * 2048 + k * 1024); } while (0)
#define PG8_LDB(dst, b, h) do { _Pragma("unroll") for (int n = 0; n < 2; ++n) _Pragma("unroll") for (int k = 0; k < 2; ++k) dst[n][k] = *(const PG8_LAS bf16x8*)(lds + PG8_SB(b, h) + boff + n * 2048 + k * 1024); } while (0)
#define PG8_MMA(ai, bj, At, Bt) do { __builtin_amdgcn_s_setprio(1); _Pragma("unroll") for (int m = 0; m < 4; ++m) _Pragma("unroll") for (int n = 0; n < 2; ++n) _Pragma("unroll") for (int k = 0; k < 2; ++k) \
        acc[ai][bj][m][n] = __builtin_amdgcn_mfma_f32_16x16x32_bf16(Bt[n][k], At[m][k], acc[ai][bj][m][n], 0, 0, 0); __builtin_amdgcn_s_setprio(0); } while (0)
#define PG8_WAIT_V(n) asm volatile("s_waitcnt vmcnt(" #n ")" ::: "memory")
#define PG8_WAIT_L(n) asm volatile("s_waitcnt lgkmcnt(" #n ")" ::: "memory")
#define PG8_BAR __builtin_amdgcn_s_barrier()
#define PG8_SCHED __builtin_amdgcn_sched_barrier(0)
    Unit cur, nxt; int ui = 0;
    if (!S.next(0, cur)) return;
    f32x4 acc[2][2][4][2];
#pragma unroll
    for (int a = 0; a < 2; ++a)
#pragma unroll
        for (int b = 0; b < 2; ++b)
#pragma unroll
            for (int m = 0; m < 4; ++m)
#pragma unroll
                for (int n = 0; n < 2; ++n) acc[a][b][m][n] = (f32x4){0.f, 0.f, 0.f, 0.f};
    bf16x8 At[4][2], B0[2][2], B1[2][2];
    const char* cA = (const char*)g.A + (GATHER ? (size_t)0 : (size_t)cur.pm * tstepA) + (size_t)cur.ka * 2; const char* cB = (const char*)g.Bt + (size_t)cur.pn * tstepB;
    if constexpr (GATHER) { PG8_GLOAD(gvc, cur); }
#pragma unroll
    for (int h = 0; h < 2; ++h)
#pragma unroll
        for (int i = 0; i < 2; ++i) gvn[h][i] = GATHER ? gvc[h][i] : 0u;
    {
        PG8_STAGE(PG8_SB(0, 0), cB, voffB); PG8_STAGE(PG8_SB(0, 1), cB + hstepB, voffB); PG8_STAGEA(PG8_SA(0, 0), cA, 0, false); PG8_STAGEA(PG8_SA(0, 1), cA, 1, false);
        if (wr == 1) PG8_BAR;
        PG8_WAIT_V(2); PG8_BAR;
        PG8_STAGE(PG8_SB(1, 0), cB + kstep, voffB); PG8_STAGEA(PG8_SA(1, 0), cA + kstep, 0, false); PG8_STAGE(PG8_SB(1, 1), cB + hstepB + kstep, voffB);
        PG8_WAIT_V(6); PG8_BAR;
    }
    for (;;) {
        const bool has_next = S.next(ui + 1, nxt);
        const char* nA = has_next ? (const char*)g.A + (GATHER ? (size_t)0 : (size_t)nxt.pm * tstepA) + (size_t)nxt.ka * 2 : cA; const char* nB = has_next ? (const char*)g.Bt + (size_t)nxt.pn * tstepB : cB;
        if constexpr (GATHER) { if (has_next) { PG8_GLOAD(gvn, nxt); } }
        E.prefetch(cur, wid, lane);
        for (int t = 0; t < nt; t += 2) {
            const bool last = (t == nt - 2);
            if constexpr (HOOK > 0) { if (t > 0 && (t % HOOK) == 0) E.mid(acc, cur, wr, wc, fr, fq, t); }
            const char* a1 = cA + (size_t)(t + 1) * kstep;
            const char* a2 = last ? nA : cA + (size_t)(t + 2) * kstep; const char* b2 = last ? nB : cB + (size_t)(t + 2) * kstep;
            const char* a3 = a2 + kstep; const char* b3 = b2 + kstep;
            PG8_LDB(B0, 0, 0); PG8_LDB(B1, 0, 1); PG8_SCHED; PG8_LDA(At, 0, 0); PG8_STAGEA(PG8_SA(1, 1), a1, 1, false);
            PG8_WAIT_V(8); PG8_WAIT_L(0); PG8_BAR; PG8_MMA(0, 0, At, B0); PG8_MMA(0, 1, At, B1); PG8_BAR; PG8_SCHED;
            PG8_LDA(At, 0, 1); PG8_STAGE(PG8_SB(0, 0), b2, voffB); PG8_STAGE(PG8_SB(0, 1), b2 + hstepB, voffB); PG8_STAGEA(PG8_SA(0, 0), a2, 0, last);
            PG8_WAIT_V(8); PG8_WAIT_L(0); PG8_BAR; PG8_MMA(1, 0, At, B0); PG8_MMA(1, 1, At, B1); PG8_BAR; PG8_SCHED;
            PG8_LDB(B0, 1, 0); PG8_LDB(B1, 1, 1); PG8_SCHED; PG8_LDA(At, 1, 0); PG8_STAGEA(PG8_SA(0, 1), a2, 1, last);
            PG8_WAIT_V(8); PG8_WAIT_L(0); PG8_BAR; PG8_MMA(0, 0, At, B0); PG8_MMA(0, 1, At, B1); PG8_BAR; PG8_SCHED;
            PG8_LDA(At, 1, 1); PG8_STAGE(PG8_SB(1, 0), b3, voffB); PG8_STAGE(PG8_SB(1, 1), b3 + hstepB, voffB); PG8_STAGEA(PG8_SA(1, 0), a3, 0, last);
            PG8_WAIT_V(8); PG8_WAIT_L(0); PG8_BAR; PG8_MMA(1, 0, At, B0); PG8_MMA(1, 1, At, B1); PG8_BAR; PG8_SCHED;
        }
        if constexpr (ALIGN_EPI) { if (wr == 0) PG8_BAR; }
        E(acc, cur, wr, wc, fr, fq);
        if (!has_next) break;
#pragma unroll
        for (int a = 0; a < 2; ++a)
#pragma unroll
            for (int b = 0; b < 2; ++b)
#pragma unroll
                for (int m = 0; m < 4; ++m)
#pragma unroll
                    for (int n = 0; n < 2; ++n) acc[a][b][m][n] = (f32x4){0.f, 0.f, 0.f, 0.f};
        cur = nxt; cA = nA; cB = nB; ++ui;
#pragma unroll
        for (int h = 0; h < 2; ++h)
#pragma unroll
            for (int i = 0; i < 2; ++i) gvc[h][i] = gvn[h][i];
        if constexpr (ALIGN_EPI) { if (wr == 1) PG8_BAR; }
    }
    PG8_WAIT_V(0);
    if constexpr (!ALIGN_EPI) { if (wr == 0) PG8_BAR; }
    PG8_BAR;
#undef PG8_SA
#undef PG8_SB
#undef PG8_STAGE
#undef PG8_STAGEA
#undef PG8_GLOAD
#undef PG8_LDA
#undef PG8_LDB
#undef PG8_MMA
#undef PG8_WAIT_V
#undef PG8_WAIT_L
#undef PG8_BAR
#undef PG8_SCHED
}
}
#ifndef MK_P5PROBE
#define MK_P5PROBE 0
#endif
#ifndef MK_HOOKPROBE
#define MK_HOOKPROBE 0
#endif
typedef unsigned v4u __attribute__((ext_vector_type(4)));
typedef unsigned v2u __attribute__((ext_vector_type(2)));
typedef float f32x4 __attribute__((ext_vector_type(4)));
typedef float f32x16 __attribute__((ext_vector_type(16)));
typedef short bf16x8 __attribute__((ext_vector_type(8)));
#define LDS_WAIT() asm volatile("s_waitcnt lgkmcnt(0)" ::: "memory")
#define VM_WAIT() asm volatile("s_waitcnt vmcnt(0)" ::: "memory")
__device__ __forceinline__ unsigned pk2(float lo, float hi) { return pg8::cvt_pk_bf16(lo, hi); }
__device__ __forceinline__ bf16 f2bf_hw(float x) { return (bf16)(pk2(x, 0.f) & 0xffffu); }
__device__ __forceinline__ float wave_sum(float v) {
#pragma unroll
    for (int o = 1; o < 64; o <<= 1) v += __shfl_xor(v, o);
    return v;
}

__device__ __forceinline__ float bflo(unsigned w) { return __uint_as_float(w << 16); }
__device__ __forceinline__ float bfhi(unsigned w) { return __uint_as_float(w & 0xffff0000u); }
#define MFMA32(a, b, c) __builtin_amdgcn_mfma_f32_32x32x16_bf16((a), (b), (c), 0, 0, 0)
typedef float f32x2 __attribute__((ext_vector_type(2)));
__device__ __forceinline__ f32x2 sq16(const f32x16& a, f32x2 s) {
#pragma unroll
    for (int r = 0; r < 16; r += 2) { const f32x2 p = {a[r], a[r + 1]}; s += p * p; }
    return s;
}

__device__ __forceinline__ void pool_unit(const bf16* __restrict__ P, bf16* __restrict__ BR, int unit, int tid) {
    asm volatile("" : "+v"(tid));
    const int tr = tid >> 6, tc = tid & 63, g = tc >> 4, w = 2 << g;
    const int r0 = unit * 64 + tr * 8, s0 = r0 & (S - 1);
    const bf16* p = P + (size_t)r0 * INP + C_POOL + 8 * tc;
    v4u x[23];
#pragma unroll
    for (int k = -15; k <= 7; ++k) x[k + 15] = (k >= 1 - w && s0 + k >= 0) ? *(const GAS v4u*)(p + (ptrdiff_t)k * INP) : (v4u){0u, 0u, 0u, 0u};
    float sm[8];
#pragma unroll
    for (int q = 0; q < 8; ++q) sm[q] = 0.f;
#pragma unroll
    for (int j = 0; j < 16; ++j) { const v4u v = x[15 - j];
        sm[0] += bflo(v.x); sm[1] += bfhi(v.x); sm[2] += bflo(v.y); sm[3] += bfhi(v.y); sm[4] += bflo(v.z); sm[5] += bfhi(v.z); sm[6] += bflo(v.w); sm[7] += bfhi(v.w); }
#pragma unroll
    for (int rr = 0; rr < 8; ++rr) {
        if (rr > 0) {
            const v4u vn = x[15 + rr];
            const v4u v2 = x[15 + rr - 2], v4 = x[15 + rr - 4], v8 = x[15 + rr - 8], v16 = x[15 + rr - 16];
            v4u vo; vo.x = (g == 0) ? v2.x : (g == 1) ? v4.x : (g == 2) ? v8.x : v16.x; vo.y = (g == 0) ? v2.y : (g == 1) ? v4.y : (g == 2) ? v8.y : v16.y;
            vo.z = (g == 0) ? v2.z : (g == 1) ? v4.z : (g == 2) ? v8.z : v16.z; vo.w = (g == 0) ? v2.w : (g == 1) ? v4.w : (g == 2) ? v8.w : v16.w;
            sm[0] += bflo(vn.x) - bflo(vo.x); sm[1] += bfhi(vn.x) - bfhi(vo.x); sm[2] += bflo(vn.y) - bflo(vo.y); sm[3] += bfhi(vn.y) - bfhi(vo.y);
            sm[4] += bflo(vn.z) - bflo(vo.z); sm[5] += bfhi(vn.z) - bfhi(vo.z); sm[6] += bflo(vn.w) - bflo(vo.w); sm[7] += bfhi(vn.w) - bfhi(vo.w);
        }
        const int sp = s0 + rr, n = (sp + 1 < w) ? sp + 1 : w;
        const float inv = __builtin_amdgcn_rcpf((float)n);
        const v4u u0 = x[15 + rr];
        v4u o; o.x = pk2(sm[0] * inv - bflo(u0.x), sm[1] * inv - bfhi(u0.x)); o.y = pk2(sm[2] * inv - bflo(u0.y), sm[3] * inv - bfhi(u0.y));
        o.z = pk2(sm[4] * inv - bflo(u0.z), sm[5] * inv - bfhi(u0.z)); o.w = pk2(sm[6] * inv - bflo(u0.w), sm[7] * inv - bfhi(u0.w));
        *(GAS v4u*)(BR + (size_t)(r0 + rr) * 1536 + 1024 + 8 * tc) = o;
    }
}

constexpr int MLA_XS = 80;
constexpr int MLA_QS = 784, MLA_KS = 528;
__device__ __forceinline__ void mla_unit(const bf16* __restrict__ P, const float* __restrict__ qlat_g, const float* __restrict__ kvlat_g, const bf16* __restrict__ WuqT, const bf16* __restrict__ WukvT,
                                         const float* __restrict__ qn_g, const float* __restrict__ kn_g, const float* __restrict__ rope, bf16* __restrict__ Q, bf16* __restrict__ K, bf16* __restrict__ VT,
                                         LAS unsigned char* lds, int unit, int lane, int wave) {
    asm volatile("" : "+v"(lane));
    LAS unsigned char* qn = lds; LAS unsigned char* kvn = lds + 64 * MLA_QS;
    const int t0 = unit * 64;
    LAS unsigned char* xw = lds + 64 * MLA_QS + 64 * MLA_KS + wave * (32 * MLA_XS);
#define MLA_FLUSH(rowp, mt_) do { _Pragma("unroll") for (int i_ = 0; i_ < 2; ++i_) { const int c_ = lane + 64 * i_; const v4u x_ = *(const LAS v4u*)(xw + (c_ >> 2) * MLA_XS + (c_ & 3) * 16); \
        *(GAS v4u*)((rowp) + (size_t)(c_ >> 2) * 96 + (mt_) * 32 + (c_ & 3) * 8) = x_; } } while (0)
#pragma unroll 1
    for (int rb = 0; rb < 2; ++rb) {
        unsigned qv[4][3], kv[4][2];
#pragma unroll
        for (int rr = 0; rr < 4; ++rr) { const bf16* pr = P + (size_t)(t0 + wave * 8 + rb * 4 + rr) * INP;
#pragma unroll
            for (int j = 0; j < 3; ++j) qv[rr][j] = *(const GAS unsigned*)(pr + C_QLAT + 2 * lane + 128 * j);
#pragma unroll
            for (int j = 0; j < 2; ++j) kv[rr][j] = *(const GAS unsigned*)(pr + C_KVLAT + 2 * lane + 128 * j); }
#pragma unroll
        for (int rr = 0; rr < 4; ++rr) {
            const int lr = wave * 8 + rb * 4 + rr; float s1 = 0.f, s2 = 0.f;
#pragma unroll
            for (int j = 0; j < 3; ++j) s1 += bflo(qv[rr][j]) * bflo(qv[rr][j]) + bfhi(qv[rr][j]) * bfhi(qv[rr][j]);
#pragma unroll
            for (int j = 0; j < 2; ++j) s2 += bflo(kv[rr][j]) * bflo(kv[rr][j]) + bfhi(kv[rr][j]) * bfhi(kv[rr][j]);
            s1 = wave_sum(s1); s2 = wave_sum(s2);
            const float r1 = rsqrtf(s1 * (1.f / 384.f) + EPS), r2 = rsqrtf(s2 * (1.f / 256.f) + EPS);
#pragma unroll
            for (int j = 0; j < 3; ++j) { const int c = 2 * lane + 128 * j; *(LAS unsigned*)(qn + lr * MLA_QS + c * 2) = pk2(bflo(qv[rr][j]) * r1 * qlat_g[c], bfhi(qv[rr][j]) * r1 * qlat_g[c + 1]); }
#pragma unroll
            for (int j = 0; j < 2; ++j) { const int c = 2 * lane + 128 * j; *(LAS unsigned*)(kvn + lr * MLA_KS + c * 2) = pk2(bflo(kv[rr][j]) * r2 * kvlat_g[c], bfhi(kv[rr][j]) * r2 * kvlat_g[c + 1]); }
        }
    }
    __syncthreads();
    const int l31 = lane & 31, h5 = lane >> 5;
    {
        f32x16 acc[3][2];
#pragma unroll
        for (int mt = 0; mt < 3; ++mt)
#pragma unroll
            for (int nt = 0; nt < 2; ++nt)
#pragma unroll
                for (int r = 0; r < 16; ++r) acc[mt][nt][r] = 0.f;
        const bf16* wp = WuqT + (size_t)wave * (3 * 24 * 512) + (size_t)lane * 8;
        bf16x8 ar[4][3];
#pragma unroll
        for (int p = 0; p < 3; ++p)
#pragma unroll
            for (int mt = 0; mt < 3; ++mt) ar[p][mt] = *(const GAS bf16x8*)(wp + (size_t)(mt * 24 + p) * 512);
#pragma unroll
        for (int ks = 0; ks < 24; ++ks) {
            if (ks + 3 < 24) {
#pragma unroll
                for (int mt = 0; mt < 3; ++mt) ar[(ks + 3) & 3][mt] = *(const GAS bf16x8*)(wp + (size_t)(mt * 24 + ks + 3) * 512); }
            bf16x8 b[2];
#pragma unroll
            for (int nt = 0; nt < 2; ++nt) b[nt] = *(const LAS bf16x8*)(qn + (32 * nt + l31) * MLA_QS + (16 * ks + 8 * h5) * 2);
#pragma unroll
            for (int mt = 0; mt < 3; ++mt)
#pragma unroll
                for (int nt = 0; nt < 2; ++nt) acc[mt][nt] = MFMA32(ar[ks & 3][mt], b[nt], acc[mt][nt]);
        }
#pragma unroll
        for (int nt = 0; nt < 2; ++nt) {
            const int tok = t0 + 32 * nt + l31, b = tok / S, s = tok & (S - 1);
            f32x2 s2 = {0.f, 0.f};
#pragma unroll
            for (int mt = 0; mt < 3; ++mt) s2 = sq16(acc[mt][nt], s2);
            float ss = s2.x + s2.y;
            ss += __shfl_xor(ss, 32);
            const float rstd = rsqrtf(ss * (1.f / 96.f) + EPS);
            bf16* qo = Q + ((size_t)((t0 + 32 * nt) / S * MH + wave) * S + ((t0 + 32 * nt) & (S - 1))) * 96;
            (void)b; (void)s;
#pragma unroll
            for (int mt = 0; mt < 2; ++mt) {
#pragma unroll
                for (int g = 0; g < 4; ++g) { const int d0 = 32 * mt + 8 * g + 4 * h5; const f32x4 gn = *(const GAS f32x4*)(qn_g + d0);
                    v2u o; o.x = pk2(acc[mt][nt][4 * g] * rstd * gn[0], acc[mt][nt][4 * g + 1] * rstd * gn[1]); o.y = pk2(acc[mt][nt][4 * g + 2] * rstd * gn[2], acc[mt][nt][4 * g + 3] * rstd * gn[3]);
                    *(LAS v2u*)(xw + l31 * MLA_XS + (8 * g + 4 * h5) * 2) = o; }
                MLA_FLUSH(qo, mt); }
#pragma unroll
            for (int g = 0; g < 2; ++g) { const int i0 = 8 * g + 4 * h5;
                const f32x4 cs = *(const GAS f32x4*)(rope + (size_t)tok * 16 + i0), sn = *(const GAS f32x4*)(rope + (size_t)NT * 16 + (size_t)tok * 16 + i0);
                const f32x4 g1 = *(const GAS f32x4*)(qn_g + 64 + i0), g2 = *(const GAS f32x4*)(qn_g + 80 + i0);
                float o1[4], o2[4];
#pragma unroll
                for (int j = 0; j < 4; ++j) { const float x1 = acc[2][nt][4 * g + j] * rstd * g1[j], x2 = acc[2][nt][8 + 4 * g + j] * rstd * g2[j]; o1[j] = x1 * cs[j] - x2 * sn[j]; o2[j] = x2 * cs[j] + x1 * sn[j]; }
                v2u w1, w2; w1.x = pk2(o1[0], o1[1]); w1.y = pk2(o1[2], o1[3]); w2.x = pk2(o2[0], o2[1]); w2.y = pk2(o2[2], o2[3]);
                *(LAS v2u*)(xw + l31 * MLA_XS + i0 * 2) = w1; *(LAS v2u*)(xw + l31 * MLA_XS + 32 + i0 * 2) = w2; }
            MLA_FLUSH(qo, 2);
        }
    }
#pragma unroll 1
    for (int pass = 0; pass < 2; ++pass) {
        f32x16 acc[2][2];
#pragma unroll
        for (int mt = 0; mt < 2; ++mt)
#pragma unroll
            for (int nt = 0; nt < 2; ++nt)
#pragma unroll
                for (int r = 0; r < 16; ++r) acc[mt][nt][r] = 0.f;
        const bf16* wp = WukvT + (size_t)(wave * 2 + pass) * (2 * 16 * 512) + (size_t)lane * 8;
        bf16x8 ar[4][2];
#pragma unroll
        for (int p = 0; p < 3; ++p)
#pragma unroll
            for (int mt = 0; mt < 2; ++mt) ar[p][mt] = *(const GAS bf16x8*)(wp + (size_t)(mt * 16 + p) * 512);
#pragma unroll
        for (int ks = 0; ks < 16; ++ks) {
            if (ks + 3 < 16) {
#pragma unroll
                for (int mt = 0; mt < 2; ++mt) ar[(ks + 3) & 3][mt] = *(const GAS bf16x8*)(wp + (size_t)(mt * 16 + ks + 3) * 512); }
            bf16x8 b[2];
#pragma unroll
            for (int nt = 0; nt < 2; ++nt) b[nt] = *(const LAS bf16x8*)(kvn + (32 * nt + l31) * MLA_KS + (16 * ks + 8 * h5) * 2);
#pragma unroll
            for (int mt = 0; mt < 2; ++mt)
#pragma unroll
                for (int nt = 0; nt < 2; ++nt) acc[mt][nt] = MFMA32(ar[ks & 3][mt], b[nt], acc[mt][nt]);
        }
        if (pass == 0) {
#pragma unroll
          for (int nt = 0; nt < 2; ++nt) {
            const int tok = t0 + 32 * nt + l31, b = tok / S, s = tok & (S - 1);
            float kr[16];
#pragma unroll
            for (int g = 0; g < 4; ++g) { const v2u kv = *(const GAS v2u*)(P + (size_t)tok * INP + C_KROPE + 8 * g + 4 * h5); kr[4 * g] = bflo(kv.x); kr[4 * g + 1] = bfhi(kv.x); kr[4 * g + 2] = bflo(kv.y); kr[4 * g + 3] = bfhi(kv.y); }
            f32x2 s2 = {0.f, 0.f};
#pragma unroll
            for (int mt = 0; mt < 2; ++mt) s2 = sq16(acc[mt][nt], s2);
            float ss = s2.x + s2.y;
#pragma unroll
            for (int r = 0; r < 16; ++r) ss += kr[r] * kr[r];
            ss += __shfl_xor(ss, 32);
            const float rstd = rsqrtf(ss * (1.f / 96.f) + EPS);
            bf16* ko = K + ((size_t)((t0 + 32 * nt) / S * MH + wave) * S + ((t0 + 32 * nt) & (S - 1))) * 96;
            (void)b; (void)s;
#pragma unroll
            for (int mt = 0; mt < 2; ++mt) {
#pragma unroll
                for (int g = 0; g < 4; ++g) { const int d0 = 32 * mt + 8 * g + 4 * h5; const f32x4 gn = *(const GAS f32x4*)(kn_g + d0);
                    v2u o; o.x = pk2(acc[mt][nt][4 * g] * rstd * gn[0], acc[mt][nt][4 * g + 1] * rstd * gn[1]); o.y = pk2(acc[mt][nt][4 * g + 2] * rstd * gn[2], acc[mt][nt][4 * g + 3] * rstd * gn[3]);
                    *(LAS v2u*)(xw + l31 * MLA_XS + (8 * g + 4 * h5) * 2) = o; }
                MLA_FLUSH(ko, mt); }
#pragma unroll
            for (int g = 0; g < 4; ++g) { const f32x4 gn = *(const GAS f32x4*)(kn_g + 64 + 8 * g + 4 * h5);
#pragma unroll
                for (int j = 0; j < 4; ++j) kr[4 * g + j] *= rstd * gn[j]; }
#pragma unroll
            for (int g = 0; g < 2; ++g) { const f32x4 cs = *(const GAS f32x4*)(rope + (size_t)tok * 16 + 8 * g + 4 * h5), sn = *(const GAS f32x4*)(rope + (size_t)NT * 16 + (size_t)tok * 16 + 8 * g + 4 * h5);
                float o1[4], o2[4];
#pragma unroll
                for (int j = 0; j < 4; ++j) { const float x1 = kr[4 * g + j], x2 = kr[8 + 4 * g + j]; o1[j] = x1 * cs[j] - x2 * sn[j]; o2[j] = x2 * cs[j] + x1 * sn[j]; }
                v2u w1, w2; w1.x = pk2(o1[0], o1[1]); w1.y = pk2(o1[2], o1[3]); w2.x = pk2(o2[0], o2[1]); w2.y = pk2(o2[2], o2[3]);
                *(LAS v2u*)(xw + l31 * MLA_XS + (8 * g + 4 * h5) * 2) = w1; *(LAS v2u*)(xw + l31 * MLA_XS + 32 + (8 * g + 4 * h5) * 2) = w2; }
            MLA_FLUSH(ko, 2);
          }
        } else {
#pragma unroll
          for (int nt = 0; nt < 2; ++nt) {
            int hq = h5; asm volatile("" : "+v"(hq));
            const int tok = t0 + 32 * nt + l31, b = tok / S, s = tok & (S - 1);
            bf16* vo = VT + ((size_t)(b * MH + wave) * 64 + 4 * hq) * S + s;
#pragma unroll
            for (int mt = 0; mt < 2; ++mt)
#pragma unroll
                for (int r = 0; r < 16; ++r) { const int dv = 32 * mt + (r & 3) + 8 * (r >> 2); vo[(size_t)dv * S] = f2bf_hw(acc[mt][nt][r]); }
          }
        }
    }
#undef MLA_FLUSH
    __syncthreads();
}

constexpr int AT_KS = 208, AT_VS = 136;
constexpr int AT_KB = 64 * AT_KS, AT_VB = 64 * AT_VS;
constexpr float AT_C = 0.10206207261596575f * 1.4426950408889634f;
__device__ __forceinline__ void attn_unit(const bf16* __restrict__ Q, const bf16* __restrict__ K, const bf16* __restrict__ VT, bf16* __restrict__ BR, LAS unsigned char* lds, int bh, int qb, int tid, int lane, int wave) {
    asm volatile("" : "+v"(lane), "+v"(tid));
    const int l31 = lane & 31, h5 = lane >> 5;
    const int qw0 = 256 * qb + 32 * wave, ntile = 4 * qb + 4, mytiles = 4 * qb + (wave >> 1) + 1;
    const bf16* Kg = K + (size_t)bh * S * 96; const bf16* Vg = VT + (size_t)bh * 64 * S;
    LAS unsigned char* kbuf = lds; LAS unsigned char* vbuf = lds + 2 * AT_KB;
    bf16x8 qf[6];
    { const bf16* qp = Q + ((size_t)bh * S + qw0 + l31) * 96 + 8 * h5;
#pragma unroll
      for (int ks = 0; ks < 6; ++ks) qf[ks] = *(const GAS bf16x8*)(qp + 16 * ks); }
    f32x16 o[2];
#pragma unroll
    for (int r = 0; r < 16; ++r) { o[0][r] = 0.f; o[1][r] = 0.f; }
    float mrow = -INFINITY, lrow = 0.f;
    const int kc0 = tid, kc1 = tid + 512; const bool k1 = kc1 < 768;
    const unsigned kl0 = (unsigned)((kc0 / 12) * AT_KS + (kc0 % 12) * 16), kl1 = (unsigned)((kc1 / 12) * AT_KS + (kc1 % 12) * 16), vl = (unsigned)((tid >> 3) * AT_VS + (tid & 7) * 16);
    v4u sk0, sk1 = (v4u){0u, 0u, 0u, 0u}, sv;
#define AT_GLOADK(j) do { const bf16* kp = Kg + (size_t)(j) * 64 * 96; sk0 = *(const GAS v4u*)(kp + (size_t)kc0 * 8); if (k1) sk1 = *(const GAS v4u*)(kp + (size_t)kc1 * 8); } while (0)
#define AT_GLOADV(j) do { sv = *(const GAS v4u*)(Vg + (size_t)(tid >> 3) * S + (size_t)(j) * 64 + (tid & 7) * 8); } while (0)
#define AT_LSTOREK(buf) do { LAS unsigned char* kb = kbuf + (buf) * AT_KB; *(LAS v4u*)(kb + kl0) = sk0; if (k1) *(LAS v4u*)(kb + kl1) = sk1; } while (0)
#define AT_LSTOREV(buf) do { LAS unsigned char* vb = vbuf + (buf) * AT_VB + vl; *(LAS v2u*)(vb) = (v2u){sv.x, sv.y}; *(LAS v2u*)(vb + 8) = (v2u){sv.z, sv.w}; } while (0)
#define AT_QK(dst, buf) do { const LAS unsigned char* kb = kbuf + (buf) * AT_KB; _Pragma("unroll") for (int kt = 0; kt < 2; ++kt) { _Pragma("unroll") for (int r = 0; r < 16; ++r) dst[kt][r] = 0.f; \
        _Pragma("unroll") for (int ks = 0; ks < 6; ++ks) { const bf16x8 kf = *(const LAS bf16x8*)(kb + (32 * kt + l31) * AT_KS + (16 * ks + 8 * h5) * 2); dst[kt] = MFMA32(kf, qf[ks], dst[kt]); } } } while (0)
    AT_GLOADK(0); AT_GLOADV(0); AT_LSTOREK(0); AT_LSTOREV(0);
    AT_GLOADK(1); AT_LSTOREK(1);
    __syncthreads();
    f32x16 sa[2], sb[2];
    AT_QK(sa, 0);
    __syncthreads();
#define AT_BODY(SC, SN, J) do { const int j = (J); \
        if (j + 2 < ntile) AT_GLOADK(j + 2); \
        if (j + 1 < ntile) AT_GLOADV(j + 1); \
        if (j + 1 < mytiles) AT_QK(SN, (j + 1) & 1); \
        if (j < mytiles) { \
            const LAS unsigned char* vb = vbuf + (j & 1) * AT_VB; \
            if (j == mytiles - 1) { const int qq = qw0 + l31 - 64 * j; asm volatile("; diagonal tile" ::: "memory");     \
                _Pragma("unroll") for (int kt = 0; kt < 2; ++kt) _Pragma("unroll") for (int r = 0; r < 16; ++r) { const int kk = 32 * kt + (r & 3) + 8 * (r >> 2) + 4 * h5; if (kk > qq) SC[kt][r] = -INFINITY; } } \
            float mx = SC[0][0]; \
            _Pragma("unroll") for (int kt = 0; kt < 2; ++kt) _Pragma("unroll") for (int r = 0; r < 16; ++r) mx = fmaxf(mx, SC[kt][r]); \
            mx = fmaxf(mx, __shfl_xor(mx, 32)); \
            const float mnew = fmaxf(mrow, mx * AT_C), alpha = __builtin_amdgcn_exp2f(mrow - mnew); \
            mrow = mnew; \
            f32x2 ls2 = {0.f, 0.f}; const f32x2 c2 = {AT_C, AT_C}, m2 = {mnew, mnew}; \
            _Pragma("unroll") for (int kt = 0; kt < 2; ++kt) _Pragma("unroll") for (int r = 0; r < 16; r += 2) { f32x2 x = {SC[kt][r], SC[kt][r + 1]}; x = x * c2 - m2; \
                f32x2 pp; pp.x = __builtin_amdgcn_exp2f(x.x); pp.y = __builtin_amdgcn_exp2f(x.y); SC[kt][r] = pp.x; SC[kt][r + 1] = pp.y; ls2 += pp; } \
            lrow = lrow * alpha + (ls2.x + ls2.y); \
            _Pragma("unroll") for (int r = 0; r < 16; ++r) { o[0][r] *= alpha; o[1][r] *= alpha; } \
            _Pragma("unroll") for (int kt = 0; kt < 2; ++kt) _Pragma("unroll") for (int s2 = 0; s2 < 2; ++s2) { \
                union { bf16x8 v; unsigned u[4]; } pf; \
                _Pragma("unroll") for (int q = 0; q < 4; ++q) pf.u[q] = pk2(SC[kt][8 * s2 + 2 * q], SC[kt][8 * s2 + 2 * q + 1]); \
                _Pragma("unroll") for (int dvt = 0; dvt < 2; ++dvt) { union { bf16x8 v; v2u h[2]; } vf; \
                    const LAS unsigned char* vp = vb + (32 * dvt + l31) * AT_VS + (32 * kt + 16 * s2 + 4 * h5) * 2; \
                    vf.h[0] = *(const LAS v2u*)(vp); vf.h[1] = *(const LAS v2u*)(vp + 16); \
                    o[dvt] = MFMA32(vf.v, pf.v, o[dvt]); } } \
        } \
        if (j + 2 < ntile) AT_LSTOREK(j & 1); \
        if (j + 1 < ntile) AT_LSTOREV((j + 1) & 1); \
        __syncthreads(); } while (0)
#pragma unroll 1
    for (int jj = 0; jj < ntile; jj += 2) { AT_BODY(sa, sb, jj); AT_BODY(sb, sa, jj + 1); }
#undef AT_BODY
#undef AT_GLOADK
#undef AT_GLOADV
#undef AT_LSTOREK
#undef AT_LSTOREV
#undef AT_QK
    lrow += __shfl_xor(lrow, 32);
    const float inv = __builtin_amdgcn_rcpf(lrow);
    const int b = bh >> 3, h = bh & 7;
    bf16* op = BR + (size_t)(b * S + qw0 + l31) * 1536 + 512 + h * 64;
#pragma unroll
    for (int dvt = 0; dvt < 2; ++dvt)
#pragma unroll
        for (int g = 0; g < 4; ++g) { v2u w; w.x = pk2(o[dvt][4 * g] * inv, o[dvt][4 * g + 1] * inv); w.y = pk2(o[dvt][4 * g + 2] * inv, o[dvt][4 * g + 3] * inv);
            *(GAS v2u*)(op + 32 * dvt + 8 * g + 4 * h5) = w; }
}
#define MFMA16(a, b, c) __builtin_amdgcn_mfma_f32_16x16x32_bf16((a), (b), (c), 0, 0, 0)
constexpr int HG_VS = 144;
constexpr int HG_QS = 272;
__device__ __forceinline__ void hgrn_gate(float z, float lbv, float l1, float l2, float& lf, float& kv) {
    const float e = __expf(-fabsf(z)), ls = fminf(z, 0.f) - __logf(1.f + e);
    const float rc = __builtin_amdgcn_rcpf(1.f + e), sg = (z >= 0.f) ? rc : e * rc;
    kv = (1.f - lbv) * (1.f - sg);
    const float a = l1 + ls;
    if (lbv > 0.f) { const float mx = fmaxf(a, l2), dd = -fabsf(a - l2); lf = mx + __logf(1.f + __expf(dd)); } else lf = a;
}
struct HgA { unsigned zz[8]; unsigned vp[8]; };
__device__ __forceinline__ void hgrn_a_load(const bf16* __restrict__ P, int unit, int tid, HgA& r) {
    asm volatile("" : "+v"(tid));
    const int bh = unit >> 5, c = unit & 31, b = bh >> 2, h = bh & 3, tok0 = b * S + c * 64, d = tid & 127, seg = tid >> 7;
    const bf16* pz = P + (size_t)(tok0 + seg * 16) * INP + C_HF + h * 128 + d;
    const bf16* pv = P + (size_t)(tok0 + seg * 16) * INP + C_HI + h * 128 + d;
#pragma unroll
    for (int t = 0; t < 8; ++t) { r.zz[t] = (unsigned)pz[(size_t)(2 * t) * INP] | ((unsigned)pz[(size_t)(2 * t + 1) * INP] << 16); r.vp[t] = (unsigned)pv[(size_t)(2 * t) * INP] | ((unsigned)pv[(size_t)(2 * t + 1) * INP] << 16); }
}
__device__ __forceinline__ void hgrn_a_compute(const HgA& r, const float* __restrict__ lb, bf16* __restrict__ SLOC, float* __restrict__ DEC, LAS unsigned char* lds, int unit, int tid, int lane, int wave) {
    asm volatile("" : "+v"(tid), "+v"(lane));
    const int bh = unit >> 5, h = bh & 3;
    LAS float* tot = (LAS float*)lds;
    LAS unsigned char* vT = lds + 2048;
    LAS unsigned char* kT = vT + 128 * HG_VS;
    const int d = tid & 127, seg = tid >> 7;
    const float lbv = lb[h * 128 + d], l1 = __logf(1.f - lbv), l2 = (lbv > 0.f) ? __logf(lbv) : -INFINITY;
    float cs[16], kv[16]; float run = 0.f;
#pragma unroll
    for (int t = 0; t < 16; ++t) { float lf; hgrn_gate((t & 1) ? bfhi(r.zz[t >> 1]) : bflo(r.zz[t >> 1]), lbv, l1, l2, lf, kv[t]); run += lf; cs[t] = run; }
    tot[seg * 128 + d] = run;
#pragma unroll
    for (int t = 0; t < 8; ++t) *(LAS unsigned*)(vT + d * HG_VS + (seg * 16 + 2 * t) * 2) = r.vp[t];
    __syncthreads();
    float off = 0.f, bl = 0.f;
#pragma unroll
    for (int s = 0; s < 4; ++s) { const float tv = tot[s * 128 + d]; bl += tv; if (s < seg) off += tv; }
#pragma unroll
    for (int t = 0; t < 8; ++t) { const float k0 = kv[2 * t] * __expf(bl - (cs[2 * t] + off)), k1 = kv[2 * t + 1] * __expf(bl - (cs[2 * t + 1] + off));
        *(LAS unsigned*)(kT + d * HG_VS + (seg * 16 + 2 * t) * 2) = pk2(k0, k1); }
    if (seg == 0) DEC[(size_t)unit * 128 + d] = __expf(bl);
    __syncthreads();
    const int l31 = lane & 31, h5 = lane >> 5, mt = wave >> 1;
    f32x16 acc[2];
#pragma unroll
    for (int r2 = 0; r2 < 16; ++r2) { acc[0][r2] = 0.f; acc[1][r2] = 0.f; }
#pragma unroll
    for (int ks = 0; ks < 4; ++ks) {
        const bf16x8 a = *(const LAS bf16x8*)(vT + (32 * mt + l31) * HG_VS + (16 * ks + 8 * h5) * 2);
#pragma unroll
        for (int q = 0; q < 2; ++q) { const int nt = 2 * (wave & 1) + q; const bf16x8 bb = *(const LAS bf16x8*)(kT + (32 * nt + l31) * HG_VS + (16 * ks + 8 * h5) * 2); acc[q] = MFMA32(a, bb, acc[q]); }
    }
    bf16* so = SLOC + (size_t)unit * 16384;
#pragma unroll
    for (int q = 0; q < 2; ++q) { const int nt = 2 * (wave & 1) + q;
#pragma unroll
        for (int r2 = 0; r2 < 16; ++r2) { const int v = 32 * mt + (r2 & 3) + 8 * (r2 >> 2) + 4 * h5; so[(size_t)v * 128 + 32 * nt + l31] = f2bf_hw(acc[q][r2]); } }
    __syncthreads();
}
__device__ __forceinline__ void hgrn_a_all(const bf16* __restrict__ P, const float* __restrict__ lb, bf16* __restrict__ SLOC, float* __restrict__ DEC, LAS unsigned char* lds, int bx, int G, int tid, int lane, int wave) {
    HgA ra, rb; int u = bx;
#define HGA_MAP(v) ((G == 256) ? ((((v) & 7) << 7) | ((((v) >> 3) & 31) << 2) | ((v) >> 8)) : (v))
    if (u < 1024) hgrn_a_load(P, HGA_MAP(u), tid, ra);
    while (u < 1024) {
        const int u2 = u + G, u3 = u2 + G;
        if (u2 < 1024) hgrn_a_load(P, HGA_MAP(u2), tid, rb);
        hgrn_a_compute(ra, lb, SLOC, DEC, lds, HGA_MAP(u), tid, lane, wave);
        if (u2 >= 1024) break;
        if (u3 < 1024) hgrn_a_load(P, HGA_MAP(u3), tid, ra);
        hgrn_a_compute(rb, lb, SLOC, DEC, lds, HGA_MAP(u2), tid, lane, wave);
        u = u3;
    }
#undef HGA_MAP
}
__device__ __forceinline__ void hgrn_scan_unit(const bf16* __restrict__ SLOC, const float* __restrict__ DEC, bf16* __restrict__ ST, int unit, int tid) {
    asm volatile("" : "+v"(tid));
    const int bh = unit >> 3, idx = (unit & 7) * 2048 + tid * 4, d = idx & 127;
    f32x4 st = {0.f, 0.f, 0.f, 0.f};
    const bf16* sp = SLOC + (size_t)bh * 32 * 16384 + idx; const float* dp = DEC + (size_t)bh * 32 * 128 + d; bf16* op = ST + (size_t)bh * 32 * 16384 + idx;
#pragma unroll 1
    for (int cb = 0; cb < 32; cb += 16) {
        v2u sl[16]; f32x4 dc[16];
#pragma unroll
        for (int c = 0; c < 16; ++c) { sl[c] = *(const GAS v2u*)(sp + (size_t)(cb + c) * 16384); dc[c] = *(const GAS f32x4*)(dp + (cb + c) * 128); }
#pragma unroll
        for (int c = 0; c < 16; ++c) {
            v2u o; o.x = pk2(st[0], st[1]); o.y = pk2(st[2], st[3]);
            *(GAS v2u*)(op + (size_t)(cb + c) * 16384) = o;
            st = dc[c] * st + (f32x4){__uint_as_float(sl[c].x << 16), __uint_as_float(sl[c].x & 0xffff0000u), __uint_as_float(sl[c].y << 16), __uint_as_float(sl[c].y & 0xffff0000u)};
        }
    }
}
__device__ __forceinline__ void hgrn_c_unit(const bf16* __restrict__ P, const float* __restrict__ lb, const bf16* __restrict__ ST, const float* __restrict__ og, bf16* __restrict__ BR, LAS unsigned char* lds, int unit, int tid, int lane, int wave) {
    asm volatile("" : "+v"(tid), "+v"(lane));
    const int bh = unit >> 5, c = unit & 31, b = bh >> 2, h = bh & 3, tok0 = b * S + c * 64;
    LAS float* bcum = (LAS float*)lds;
    LAS unsigned char* q0 = lds + 32768;
    LAS unsigned char* qi = q0 + 64 * HG_QS;
    LAS unsigned char* kr = qi + 64 * HG_QS;
    LAS unsigned char* vT = kr + 64 * HG_QS;
    LAS unsigned char* at = vT + 128 * HG_VS;
    LAS float* tot = (LAS float*)(at + 64 * HG_VS);
    LAS float* ob = (LAS float*)lds;
    const int d = tid & 127, seg = tid >> 7;
    const int l31 = lane & 31, h5 = lane >> 5, mtw = wave >> 2, ntw = wave & 3;
    unsigned zq[16], vp[8]; v4u gq0, gq1; bf16x8 stf[8];
    {
        const bf16* pz = P + (size_t)(tok0 + seg * 16) * INP + C_HF + h * 128 + d;
        const bf16* pq = P + (size_t)(tok0 + seg * 16) * INP + C_HQ + h * 128 + d;
        const bf16* pv = P + (size_t)(tok0 + seg * 16) * INP + C_HI + h * 128 + d;
#pragma unroll
        for (int t = 0; t < 16; ++t) zq[t] = (unsigned)pz[(size_t)t * INP] | ((unsigned)pq[(size_t)t * INP] << 16);
#pragma unroll
        for (int t = 0; t < 8; ++t) vp[t] = (unsigned)pv[(size_t)(2 * t) * INP] | ((unsigned)pv[(size_t)(2 * t + 1) * INP] << 16);
        const bf16* pg = P + (size_t)(tok0 + (tid >> 3)) * INP + C_HG + h * 128 + (tid & 7) * 16;
        gq0 = *(const GAS v4u*)pg; gq1 = *(const GAS v4u*)(pg + 8);
        if (c > 0) { const bf16* sp = ST + (size_t)unit * 16384 + (size_t)(32 * ntw + l31) * 128 + 8 * h5;
#pragma unroll
            for (int ks = 0; ks < 8; ++ks) stf[ks] = *(const GAS bf16x8*)(sp + 16 * ks); }
        else {
#pragma unroll
            for (int ks = 0; ks < 8; ++ks) stf[ks] = (bf16x8){0, 0, 0, 0, 0, 0, 0, 0}; }
    }
    {
        const float lbv = lb[h * 128 + d], l1 = __logf(1.f - lbv), l2 = (lbv > 0.f) ? __logf(lbv) : -INFINITY;
        float cs[16], kv[16]; float run = 0.f;
#pragma unroll
        for (int t = 0; t < 16; ++t) { float lf; hgrn_gate(bflo(zq[t]), lbv, l1, l2, lf, kv[t]); run += lf; cs[t] = run; }
        tot[seg * 128 + d] = run;
#pragma unroll
        for (int t = 0; t < 8; ++t) *(LAS unsigned*)(vT + d * HG_VS + (seg * 16 + 2 * t) * 2) = vp[t];
        for (int i = tid; i < 64 * HG_VS / 4; i += 512) ((LAS unsigned*)at)[i] = 0u;
        __syncthreads();
        float off = 0.f;
#pragma unroll
        for (int s = 0; s < 4; ++s) { const float tv = tot[s * 128 + d]; if (s < seg) off += tv; }
#pragma unroll
        for (int t = 0; t < 16; ++t) { const int tt = seg * 16 + t; const float qv = bfhi(zq[t]);
            bcum[tt * 128 + d] = cs[t] + off;
            *(LAS bf16*)(q0 + tt * HG_QS + d * 2) = f2bf_hw(qv * __expf(cs[t] + off));
            *(LAS bf16*)(qi + tt * HG_QS + d * 2) = f2bf_hw(qv * __expf(cs[t]));
            *(LAS bf16*)(kr + tt * HG_QS + d * 2) = f2bf_hw(kv[t]); }
    }
    __syncthreads();
    {
        const int l15 = lane & 15, g4 = lane >> 4;
#pragma unroll 1
        for (int blk = wave; blk < 10; blk += 8) {
            const int i = (blk >= 6) ? 3 : (blk >= 3) ? 2 : (blk >= 1) ? 1 : 0, j = blk - ((i * (i + 1)) >> 1);
            f32x4 acc = {0.f, 0.f, 0.f, 0.f};
#pragma unroll
            for (int ks = 0; ks < 4; ++ks) {
                const int dd = 32 * ks + 8 * g4;
                const bf16x8 a = *(const LAS bf16x8*)(qi + (16 * i + l15) * HG_QS + dd * 2);
                const v4u kw = *(const LAS v4u*)(kr + (16 * j + l15) * HG_QS + dd * 2);
                const f32x4 b0 = *(const LAS f32x4*)(bcum + (16 * j + l15) * 128 + dd), b1 = *(const LAS f32x4*)(bcum + (16 * j + l15) * 128 + dd + 4);
                f32x4 r0 = {0.f, 0.f, 0.f, 0.f}, r1 = {0.f, 0.f, 0.f, 0.f};
                if (i > 0) { r0 = *(const LAS f32x4*)(bcum + (16 * i - 1) * 128 + dd); r1 = *(const LAS f32x4*)(bcum + (16 * i - 1) * 128 + dd + 4); }
                union { bf16x8 v; unsigned u[4]; } kf;
                kf.u[0] = pk2(bflo(kw.x) * __expf(r0[0] - b0[0]), bfhi(kw.x) * __expf(r0[1] - b0[1])); kf.u[1] = pk2(bflo(kw.y) * __expf(r0[2] - b0[2]), bfhi(kw.y) * __expf(r0[3] - b0[3]));
                kf.u[2] = pk2(bflo(kw.z) * __expf(r1[0] - b1[0]), bfhi(kw.z) * __expf(r1[1] - b1[1])); kf.u[3] = pk2(bflo(kw.w) * __expf(r1[2] - b1[2]), bfhi(kw.w) * __expf(r1[3] - b1[3]));
                acc = MFMA16(a, kf.v, acc);
            }
#pragma unroll
            for (int r = 0; r < 4; ++r) { const int tl = 4 * g4 + r; float v = acc[r]; if (i == j && l15 > tl) v = 0.f; *(LAS bf16*)(at + (16 * i + tl) * HG_VS + (16 * j + l15) * 2) = f2bf_hw(v); }
        }
    }
    __syncthreads();
    {
        const int mt = mtw, nt = ntw;
        f32x16 acc;
#pragma unroll
        for (int r = 0; r < 16; ++r) acc[r] = 0.f;
#pragma unroll
        for (int ks = 0; ks < 4; ++ks) { const bf16x8 a = *(const LAS bf16x8*)(at + (32 * mt + l31) * HG_VS + (16 * ks + 8 * h5) * 2), bb = *(const LAS bf16x8*)(vT + (32 * nt + l31) * HG_VS + (16 * ks + 8 * h5) * 2); acc = MFMA32(a, bb, acc); }
        if (c > 0) {
#pragma unroll
            for (int ks = 0; ks < 8; ++ks) { const bf16x8 a = *(const LAS bf16x8*)(q0 + (32 * mt + l31) * HG_QS + (16 * ks + 8 * h5) * 2); acc = MFMA32(a, stf[ks], acc); } }
        __syncthreads();
#pragma unroll
        for (int r = 0; r < 16; ++r) { const int t = 32 * mt + (r & 3) + 8 * (r >> 2) + 4 * h5; ob[t * 132 + 32 * nt + l31] = acc[r]; }
    }
    __syncthreads();
    {
        const int t = tid >> 3, v0 = (tid & 7) * 16;
        f32x4 o4[4]; float ss = 0.f;
#pragma unroll
        for (int q = 0; q < 4; ++q) { o4[q] = *(const LAS f32x4*)(ob + t * 132 + v0 + 4 * q); ss += (o4[q][0] * o4[q][0] + o4[q][1] * o4[q][1]) + (o4[q][2] * o4[q][2] + o4[q][3] * o4[q][3]); }
        ss += __shfl_xor(ss, 1); ss += __shfl_xor(ss, 2); ss += __shfl_xor(ss, 4);
        const float rstd = rsqrtf(ss * (1.f / 128.f) + EPS);
        const v4u g0 = gq0, g1 = gq1;
        float gv[16]; gv[0] = bflo(g0.x); gv[1] = bfhi(g0.x); gv[2] = bflo(g0.y); gv[3] = bfhi(g0.y); gv[4] = bflo(g0.z); gv[5] = bfhi(g0.z); gv[6] = bflo(g0.w); gv[7] = bfhi(g0.w);
        gv[8] = bflo(g1.x); gv[9] = bfhi(g1.x); gv[10] = bflo(g1.y); gv[11] = bfhi(g1.y); gv[12] = bflo(g1.z); gv[13] = bfhi(g1.z); gv[14] = bflo(g1.w); gv[15] = bfhi(g1.w);
        float ov[16];
#pragma unroll
        for (int q = 0; q < 4; ++q) { const f32x4 gn = *(const GAS f32x4*)(og + v0 + 4 * q);
#pragma unroll
            for (int jj = 0; jj < 4; ++jj) { const float gg = gv[4 * q + jj]; ov[4 * q + jj] = o4[q][jj] * rstd * gn[jj] * gg * __builtin_amdgcn_rcpf(1.f + __expf(-gg)); } }
        v4u w0, w1; w0.x = pk2(ov[0], ov[1]); w0.y = pk2(ov[2], ov[3]); w0.z = pk2(ov[4], ov[5]); w0.w = pk2(ov[6], ov[7]); w1.x = pk2(ov[8], ov[9]); w1.y = pk2(ov[10], ov[11]); w1.z = pk2(ov[12], ov[13]); w1.w = pk2(ov[14], ov[15]);
        bf16* po = BR + (size_t)(tok0 + t) * 1536 + h * 128 + v0;
        *(GAS v4u*)po = w0; *(GAS v4u*)(po + 8) = w1;
    }
    __syncthreads();
}
constexpr int NWAVES = 8, NTHR = 512;
constexpr int RING_OFF = 0, RING_BYTES = 131072, LDSCTL_OFF = RING_BYTES, LDS_BYTES = 147456;
constexpr int LW_BAR = 0, LW_TP = 16, LW_CNT = 64, LW_LCNT = 96, LW_BASE = 128, LW_ENTE = 256, LW_ENTW = 512, LW_RANK = 768, LW_BIAS = 1024;
constexpr int CW_Q = 1024, CW_PD = 1088;
constexpr int LW_CONV = 8;
constexpr int CW_BAR = 4096;
constexpr int NPH_L = 10, PH_FINAL = 1 + L * NPH_L, NPH = PH_FINAL + 1;

struct MkArgs { const void* in[28]; float* out; unsigned char* ws; float invf[16]; int ph_lo, ph_hi, li, pad; };
typedef const MkArgs __attribute__((address_space(4))) CMkArgs;
#define KA_PTR(name) CMkArgs* name = (CMkArgs*)__builtin_amdgcn_kernarg_segment_ptr(); asm volatile("" : "+s"(name))

using pg8::Unit; using pg8::u32x4; using pg8::cvt_pk_bf16;
constexpr int GATE_TILE0 = 13;
__device__ __forceinline__ size_t gt_off(int g, int pm, int pn4, int chunk, int tid) { return ((((size_t)(g * 64 + pm) * 4 + pn4) * 16 + chunk) * 512 + tid) * 8; }
struct EpiP {
    static constexpr bool PERM = true; bf16* O; int ldc; bf16* GT;
    __device__ __forceinline__ void prefetch(const Unit&, int, int) const {}
    __device__ __forceinline__ void operator()(const f32x4 (&acc)[2][2][4][2], const Unit& u, int wr, int wc, int fr, int fq) const {
        const int row0 = u.pm * 256 + wr * 64 + fr, col0 = u.pn * 256 + wc * 32 + 8 * fq;
        const bool gate = (GT != nullptr) && u.pn >= GATE_TILE0; const int gi = (u.pn - GATE_TILE0) >> 2, pn4 = (u.pn - GATE_TILE0) & 3, tid = (wr * 4 + wc) * 64 + fq * 16 + fr;
#pragma unroll
        for (int ai = 0; ai < 2; ++ai)
#pragma unroll
            for (int m = 0; m < 4; ++m) { bf16* rowp = O + (size_t)(row0 + ai * 128 + m * 16) * ldc + col0;
#pragma unroll
                for (int bj = 0; bj < 2; ++bj) { f32x4 v0 = acc[ai][bj][m][0], v1 = acc[ai][bj][m][1];
                    if (gate) {
#pragma unroll
                        for (int j = 0; j < 4; ++j) { v0[j] = 1.f + __builtin_amdgcn_exp2f(__builtin_amdgcn_fmed3f(v0[j] * -1.4426950408889634f, -43.280851f, 43.280851f));
                                                      v1[j] = 1.f + __builtin_amdgcn_exp2f(__builtin_amdgcn_fmed3f(v1[j] * -1.4426950408889634f, -43.280851f, 43.280851f)); } }
                    u32x4 w; w.x = cvt_pk_bf16(v0[0], v0[1]); w.y = cvt_pk_bf16(v0[2], v0[3]); w.z = cvt_pk_bf16(v1[0], v1[1]); w.w = cvt_pk_bf16(v1[2], v1[3]);
                    if (gate) *(u32x4*)(GT + gt_off(gi, u.pm, pn4, (ai * 4 + m) * 2 + bj, tid)) = w; else *(u32x4*)(rowp + bj * 128) = w; } }
    }
};
struct EpiBranch {
    static constexpr bool PERM = true; const bf16* GT; bf16* MB;
    __device__ __forceinline__ void prefetch(const Unit&, int, int) const {}
    __device__ __forceinline__ static void unpack8(const u32x4 w, float (&g)[8]) { g[0] = __uint_as_float(w.x << 16); g[1] = __uint_as_float(w.x & 0xffff0000u); g[2] = __uint_as_float(w.y << 16); g[3] = __uint_as_float(w.y & 0xffff0000u);
        g[4] = __uint_as_float(w.z << 16); g[5] = __uint_as_float(w.z & 0xffff0000u); g[6] = __uint_as_float(w.w << 16); g[7] = __uint_as_float(w.w & 0xffff0000u); }
    __device__ __forceinline__ static float em(float x) { return __expf(-fminf(fmaxf(x, -30.f), 30.f)); }
#define GT_LD(dst, voff, base) asm volatile("s_nop 7\n\tglobal_load_dwordx4 %0, %1, %2" : "=&v"(dst) : "v"(voff), "s"(base) : "memory")
    __device__ __forceinline__ void mid(f32x4 (&acc)[2][2][4][2], const Unit& u, int wr, int wc, int fr, int fq, int t) const {
        asm volatile("" : "+v"(fr), "+v"(fq));
        const int gnum = (t == 8) ? 0 : 1, tid = (wr * 4 + wc) * 64 + fq * 16 + fr;
        const bf16* gn0 = GT + gt_off(gnum, u.pm, u.pn, 0, 0); const bf16* gd0 = GT + gt_off(gnum + 1, u.pm, u.pn, 0, 0); const unsigned voff = (unsigned)tid * 16u;
#pragma unroll
        for (int grp = 0; grp < 4; ++grp) {
            u32x4 wn[4], wd[4];
#pragma unroll
            for (int q = 0; q < 4; ++q) { GT_LD(wn[q], voff, gn0 + (size_t)(grp * 4 + q) * 4096); GT_LD(wd[q], voff, gd0 + (size_t)(grp * 4 + q) * 4096); }
            asm volatile("s_waitcnt vmcnt(0)" : "+v"(wn[0]), "+v"(wn[1]), "+v"(wn[2]), "+v"(wn[3]), "+v"(wd[0]), "+v"(wd[1]), "+v"(wd[2]), "+v"(wd[3]) :: "memory");
#pragma unroll
            for (int q = 0; q < 4; ++q) { const int ch = grp * 4 + q, ai = ch >> 3, m = (ch >> 1) & 3, bj = ch & 1; float gn[8], gd[8]; unpack8(wn[q], gn); unpack8(wd[q], gd);
#pragma unroll
                for (int j = 0; j < 4; ++j) { acc[ai][bj][m][0][j] *= gd[j] * __builtin_amdgcn_rcpf(gn[j]); acc[ai][bj][m][1][j] *= gd[4 + j] * __builtin_amdgcn_rcpf(gn[4 + j]); } }
        }
    }
    __device__ __forceinline__ void operator()(const f32x4 (&acc)[2][2][4][2], const Unit& u, int wr, int wc, int fr, int fq) const {
        const int row0 = u.pm * 256 + wr * 64 + fr, col0 = u.pn * 256 + wc * 32 + 8 * fq, tid = (wr * 4 + wc) * 64 + fq * 16 + fr;
        const bf16* gc0 = GT + gt_off(2, u.pm, u.pn, 0, 0); const unsigned voff = (unsigned)tid * 16u;
        u32x4 wa[4], wb[4];
#pragma unroll
        for (int q = 0; q < 4; ++q) GT_LD(wa[q], voff, gc0 + (size_t)q * 4096);
#pragma unroll
        for (int grp = 0; grp < 4; ++grp) {
            if (grp < 3) {
#pragma unroll
                for (int q = 0; q < 4; ++q) { if (grp & 1) GT_LD(wa[q], voff, gc0 + (size_t)((grp + 1) * 4 + q) * 4096); else GT_LD(wb[q], voff, gc0 + (size_t)((grp + 1) * 4 + q) * 4096); } }
            if (grp == 0) asm volatile("s_waitcnt vmcnt(4)" : "+v"(wa[0]), "+v"(wa[1]), "+v"(wa[2]), "+v"(wa[3]) :: "memory");
            else if (grp == 1) asm volatile("s_waitcnt vmcnt(4)" : "+v"(wb[0]), "+v"(wb[1]), "+v"(wb[2]), "+v"(wb[3]) :: "memory");
            else if (grp == 2) asm volatile("s_waitcnt vmcnt(4)" : "+v"(wa[0]), "+v"(wa[1]), "+v"(wa[2]), "+v"(wa[3]) :: "memory");
            else asm volatile("s_waitcnt vmcnt(0)" : "+v"(wb[0]), "+v"(wb[1]), "+v"(wb[2]), "+v"(wb[3]) :: "memory");
#pragma unroll
            for (int q = 0; q < 4; ++q) { const int ch = grp * 4 + q, ai = ch >> 3, m = (ch >> 1) & 3, bj = ch & 1; const size_t row = (size_t)(row0 + ai * 128 + m * 16); const int col = col0 + bj * 128;
                float gc[8]; unpack8((grp & 1) ? wb[q] : wa[q], gc);
                f32x4 v0 = acc[ai][bj][m][0], v1 = acc[ai][bj][m][1];
#pragma unroll
                for (int j = 0; j < 4; ++j) { v0[j] *= __builtin_amdgcn_rcpf(gc[j]); v1[j] *= __builtin_amdgcn_rcpf(gc[4 + j]); }
                u32x4 w; w.x = cvt_pk_bf16(v0[0], v0[1]); w.y = cvt_pk_bf16(v0[2], v0[3]); w.z = cvt_pk_bf16(v1[0], v1[1]); w.w = cvt_pk_bf16(v1[2], v1[3]);
                *(u32x4*)(MB + row * 1024 + col) = w; }
        }
    }
#undef GT_LD
};
template <bool XF32>
struct EpiOutT {
    static constexpr bool PERM = true; const void* xin; const float* gvec; bf16* out;
    __device__ __forceinline__ void prefetch(const Unit&, int, int) const {}
#define XO_LD(dst, voff, base) asm volatile("s_nop 7\n\tglobal_load_dwordx4 %0, %1, %2" : "=&v"(dst) : "v"(voff), "s"(base) : "memory")
#define XO_WAIT(buf, cnt) asm volatile("s_waitcnt vmcnt(" #cnt ")" : "+v"(buf[0]), "+v"(buf[1]), "+v"(buf[2]), "+v"(buf[3]), "+v"(buf[4]), "+v"(buf[5]), "+v"(buf[6]), "+v"(buf[7]) :: "memory")
    __device__ __forceinline__ void operator()(const f32x4 (&acc)[2][2][4][2], const Unit& u, int wr, int wc, int fr, int fq) const {
        const int row0 = u.pm * 256 + wr * 64 + fr, col0 = u.pn * 256 + wc * 32 + 8 * fq, b = (u.pm * 256) / S;
        f32x4 gv[2][2];
#pragma unroll
        for (int bj = 0; bj < 2; ++bj)
#pragma unroll
            for (int n = 0; n < 2; ++n) gv[bj][n] = *(const f32x4*)(gvec + b * 6144 + col0 + bj * 128 + 4 * n);
#define XO_STORE(ai_, m_, bj_, x0_, x1_) do { const f32x4 r0_ = (x0_) + gv[bj_][0] * acc[ai_][bj_][m_][0], r1_ = (x1_) + gv[bj_][1] * acc[ai_][bj_][m_][1]; \
            u32x4 w_; w_.x = cvt_pk_bf16(r0_[0], r0_[1]); w_.y = cvt_pk_bf16(r0_[2], r0_[3]); w_.z = cvt_pk_bf16(r1_[0], r1_[1]); w_.w = cvt_pk_bf16(r1_[2], r1_[3]); \
            *(u32x4*)(out + (size_t)(row0 + (ai_) * 128 + (m_) * 16) * 1024 + col0 + (bj_) * 128) = w_; } while (0)
        if constexpr (XF32) {
            const float* xf = (const float*)xin; const unsigned voff = (unsigned)(((size_t)row0 * 1024 + col0) * 4);
            f32x4 xa[8], xb[8];
#define XO_GROUP(buf, g_) do { _Pragma("unroll") for (int q_ = 0; q_ < 8; ++q_) { const int ai_ = (g_) >> 1, m_ = ((g_) & 1) * 2 + (q_ >> 2), bj_ = (q_ >> 1) & 1, n_ = q_ & 1; \
                XO_LD(buf[q_], voff, xf + (size_t)(ai_ * 128 + m_ * 16) * 1024 + bj_ * 128 + 4 * n_); } } while (0)
#define XO_OUT(buf, g_) do { _Pragma("unroll") for (int p_ = 0; p_ < 4; ++p_) { const int ai_ = (g_) >> 1, m_ = ((g_) & 1) * 2 + (p_ >> 1), bj_ = p_ & 1; XO_STORE(ai_, m_, bj_, buf[2 * p_], buf[2 * p_ + 1]); } } while (0)
            XO_GROUP(xa, 0);
            XO_GROUP(xb, 1); XO_WAIT(xa, 8); XO_OUT(xa, 0);
            XO_GROUP(xa, 2); XO_WAIT(xb, 8); XO_OUT(xb, 1);
            XO_GROUP(xb, 3); XO_WAIT(xa, 8); XO_OUT(xa, 2);
            XO_WAIT(xb, 0); XO_OUT(xb, 3);
#undef XO_GROUP
#undef XO_OUT
        } else {
            const bf16* xh = (const bf16*)xin; const unsigned voff = (unsigned)(((size_t)row0 * 1024 + col0) * 2);
            u32x4 xa[8], xb[8];
#define XO_GROUP(buf, g_) do { _Pragma("unroll") for (int q_ = 0; q_ < 8; ++q_) { const int m_ = q_ >> 1, bj_ = q_ & 1; XO_LD(buf[q_], voff, xh + (size_t)((g_) * 128 + m_ * 16) * 1024 + bj_ * 128); } } while (0)
#define XO_OUT(buf, g_) do { _Pragma("unroll") for (int q_ = 0; q_ < 8; ++q_) { const int m_ = q_ >> 1, bj_ = q_ & 1; const u32x4 h_ = buf[q_]; \
                const f32x4 x0_ = {__uint_as_float(h_.x << 16), __uint_as_float(h_.x & 0xffff0000u), __uint_as_float(h_.y << 16), __uint_as_float(h_.y & 0xffff0000u)}; \
                const f32x4 x1_ = {__uint_as_float(h_.z << 16), __uint_as_float(h_.z & 0xffff0000u), __uint_as_float(h_.w << 16), __uint_as_float(h_.w & 0xffff0000u)}; \
                XO_STORE(g_, m_, bj_, x0_, x1_); } } while (0)
            XO_GROUP(xa, 0);
            XO_GROUP(xb, 1); XO_WAIT(xa, 8); XO_OUT(xa, 0);
            XO_WAIT(xb, 0); XO_OUT(xb, 1);
#undef XO_GROUP
#undef XO_OUT
        }
#undef XO_STORE
    }
#undef XO_WAIT
#undef XO_LD
};
struct EpiMoe1 {
    static constexpr bool PERM = true; const float* b1; bf16* ACT; LAS float* bl;
    typedef float f2 __attribute__((ext_vector_type(2)));
    __device__ __forceinline__ void prefetch(const Unit& u, int wid, int lane) const {
        if (wid < 4) { const float* src = b1 + u.e * 2048 + (wid >> 1) * 1024 + u.aux * 128 + (wid & 1) * 64 + lane;
            __builtin_amdgcn_global_load_lds((const unsigned*)src, (LAS unsigned*)(bl + wid * 64), 4, 0, 0); } }
    __device__ __forceinline__ static f2 act2(f2 g, f2 l) {
        const f2 c7 = {7.f, 7.f}, cm7 = {-7.f, -7.f}, one = {1.f, 1.f}, ck = {-1.702f * 1.4426950408889634f, -1.702f * 1.4426950408889634f};
        g = __builtin_elementwise_min(g, c7); l = __builtin_elementwise_min(__builtin_elementwise_max(l, cm7), c7);
        const f2 x = g * ck; f2 ex; ex.x = __builtin_amdgcn_exp2f(x.x); ex.y = __builtin_amdgcn_exp2f(x.y);
        const f2 d = ex + one; f2 r; r.x = __builtin_amdgcn_rcpf(d.x); r.y = __builtin_amdgcn_rcpf(d.y);
        return (g * r) * (l + one);
    }
    __device__ __forceinline__ void operator()(const f32x4 (&acc)[2][2][4][2], const Unit& u, int wr, int wc, int fr, int fq) const {
        const int row0 = u.pm * 256 + wr * 64 + fr, lc = wc * 32 + 8 * fq, ccol = u.aux * 128 + lc;
        const f32x4 bg0 = *(const LAS f32x4*)(bl + lc), bg1 = *(const LAS f32x4*)(bl + lc + 4), bl0 = *(const LAS f32x4*)(bl + 128 + lc), bl1 = *(const LAS f32x4*)(bl + 128 + lc + 4);
#pragma unroll
        for (int ai = 0; ai < 2; ++ai)
#pragma unroll
            for (int m = 0; m < 4; ++m) { const size_t row = (size_t)(row0 + ai * 128 + m * 16);
                const f32x4 g0 = acc[ai][0][m][0] + bg0, g1 = acc[ai][0][m][1] + bg1, l0 = acc[ai][1][m][0] + bl0, l1 = acc[ai][1][m][1] + bl1;
                const f2 o0 = act2((f2){g0[0], g0[1]}, (f2){l0[0], l0[1]}), o1 = act2((f2){g0[2], g0[3]}, (f2){l0[2], l0[3]}), o2 = act2((f2){g1[0], g1[1]}, (f2){l1[0], l1[1]}), o3 = act2((f2){g1[2], g1[3]}, (f2){l1[2], l1[3]});
                u32x4 w; w.x = cvt_pk_bf16(o0.x, o0.y); w.y = cvt_pk_bf16(o1.x, o1.y); w.z = cvt_pk_bf16(o2.x, o2.y); w.w = cvt_pk_bf16(o3.x, o3.y);
                *(u32x4*)(ACT + row * 1024 + ccol) = w; }
    }
};
struct EpiMoe2 {
    static constexpr bool PERM = true; const float* b2; bf16* EO; LAS float* bl;
    __device__ __forceinline__ void prefetch(const Unit& u, int wid, int lane) const {
        if (wid < 4) __builtin_amdgcn_global_load_lds((const unsigned*)(b2 + u.e * 1024 + u.aux * 256 + wid * 64 + lane), (LAS unsigned*)(bl + wid * 64), 4, 0, 0); }
    __device__ __forceinline__ void operator()(const f32x4 (&acc)[2][2][4][2], const Unit& u, int wr, int wc, int fr, int fq) const {
        const int row0 = u.pm * 256 + wr * 64 + fr, lc = wc * 32 + 8 * fq, col0 = u.aux * 256 + lc;
        f32x4 bv[2][2];
#pragma unroll
        for (int bj = 0; bj < 2; ++bj) { bv[bj][0] = *(const LAS f32x4*)(bl + lc + bj * 128); bv[bj][1] = *(const LAS f32x4*)(bl + lc + bj * 128 + 4); }
#pragma unroll
        for (int ai = 0; ai < 2; ++ai)
#pragma unroll
            for (int m = 0; m < 4; ++m) { bf16* rowp = EO + (size_t)(row0 + ai * 128 + m * 16) * 1024 + col0;
#pragma unroll
                for (int bj = 0; bj < 2; ++bj) { const f32x4 v0 = acc[ai][bj][m][0] + bv[bj][0], v1 = acc[ai][bj][m][1] + bv[bj][1];
                    u32x4 w; w.x = cvt_pk_bf16(v0[0], v0[1]); w.y = cvt_pk_bf16(v0[2], v0[3]); w.z = cvt_pk_bf16(v1[0], v1[1]); w.w = cvt_pk_bf16(v1[2], v1[3]);
                    *(u32x4*)(rowp + bj * 128) = w; } }
    }
};
struct MoeOrder {
    const LAS int* tp; const LAS int* cn; int NTn, G, c, rev;
    __device__ __forceinline__ bool next(int i, Unit& u) const {
        const int total = tp[32] * NTn; int Lx;
        if ((G & 7) == 0) { const int x = c & 7, j = c >> 3, lo = (int)(((long)total * x) >> 3), hi = (int)(((long)total * (x + 1)) >> 3); Lx = lo + i * (G >> 3) + j; if (Lx >= hi) return false;
            if (rev) Lx = hi - 1 - (Lx - lo); }
        else { Lx = i * G + c; if (Lx >= total) return false; }
        const int lq = (int)mk_lane_id() & 31; const int e = __builtin_popcountll(__ballot(lq >= 1 && Lx >= tp[lq] * NTn)) >> 1;
        const int t0 = tp[e], r = Lx - t0 * NTn, mt = r / NTn, nt = r - mt * NTn;
        u.pm = __builtin_amdgcn_readfirstlane(t0 + mt); u.pn = __builtin_amdgcn_readfirstlane(e * NTn + nt); u.ka = 0; u.aux = __builtin_amdgcn_readfirstlane(nt); u.e = __builtin_amdgcn_readfirstlane(e);
        u.gbase = __builtin_amdgcn_readfirstlane(e * CAP + mt * 256); u.gcnt = __builtin_amdgcn_readfirstlane(cn[e] - mt * 256); u.pad = 0;
        return true;
    }
};
struct TrItem { const float* W; bf16* WT; int K, N, mode, row_off, ldk, koff, k0, n0; };
__device__ __forceinline__ void tr_load(const TrItem& t, float (&wv)[32], int lane) {
#pragma unroll
    for (int i = 0; i < 32; ++i) wv[i] = __builtin_nontemporal_load(t.W + (size_t)(t.k0 + 2 * i + (lane >> 5)) * t.N + t.n0 + (lane & 31));
}
__device__ __forceinline__ void tr_store(const TrItem& t, const float (&wv)[32], LAS float* scr, int lane) {
#pragma unroll
    for (int i = 0; i < 32; ++i) scr[(2 * i + (lane >> 5)) * 33 + (lane & 31)] = wv[i];
    LDS_WAIT(); asm volatile("" ::: "memory");
    const int c = lane & 7;
#pragma unroll
    for (int j = 0; j < 4; ++j) { const int n = (lane >> 3) + 8 * j; const LAS float* s = scr + (8 * c) * 33 + n;
        v4u o; o.x = pk2(s[0 * 33], s[1 * 33]); o.y = pk2(s[2 * 33], s[3 * 33]); o.z = pk2(s[4 * 33], s[5 * 33]); o.w = pk2(s[6 * 33], s[7 * 33]);
        const int nn = t.n0 + n; int r = nn; if (t.mode == 1) { const int half = nn >> 10, cc = nn & 1023; r = (cc >> 7) * 256 + half * 128 + (cc & 127); }
        if (t.mode == 2) r = (nn < 3232) ? nn : nn + 96;
        if (t.mode >= 3) {
            const int kk = t.k0 + 8 * c; size_t off;
            if (t.mode == 3) { const int hd = nn / 96, rr_ = nn - hd * 96; off = ((size_t)((hd * 3 + (rr_ >> 5)) * 24 + (kk >> 4)) * 64 + ((kk >> 3) & 1) * 32 + (rr_ & 31)) * 8; }
            else { const int hd = nn >> 7, rr_ = nn & 127; off = ((size_t)(((hd * 2 + (rr_ >> 6)) * 2 + ((rr_ >> 5) & 1)) * 16 + (kk >> 4)) * 64 + ((kk >> 3) & 1) * 32 + (rr_ & 31)) * 8; }
            __builtin_nontemporal_store(o, (GAS v4u*)(t.WT + off)); continue; }
        __builtin_nontemporal_store(o, (GAS v4u*)(t.WT + (size_t)(t.row_off + r) * t.ldk + t.koff + t.k0 + 8 * c)); }
    LDS_WAIT(); asm volatile("" ::: "memory");
}
constexpr int TI_IN = 16 * 197, TI_UQ = 6 * 24, TI_UKV = 4 * 32, TI_BR = 8 * 32, TI_OUT = 16 * 32, TI_E1 = 16 * 64, TI_E2 = 16 * 32;
constexpr int TA0 = TI_IN, TA1 = TA0 + TI_UQ, TA2 = TA1 + TI_UKV, TA3 = TA2 + TI_BR, TA4 = TA3 + TI_BR, TA5 = TA4 + TI_OUT, TA6 = TA5 + NE * TI_E1, TA7 = TA6 + NE * TI_E2, TR_NTOT = L * TA7, CONV_B = 16;
static_assert(L == 2 && TR_NTOT % CONV_B == 0 && TA5 % CONV_B == 0 && TA6 % CONV_B == 0 && TA7 % CONV_B == 0, "conversion queue layout");
__device__ __forceinline__ void tr_setup(CMkArgs* ap, int it, TrItem& t) {
    unsigned char* ws = ap->ws;
    const int l = it >= TA7 ? 1 : 0; int r = it - l * TA7, q;
    if (r < TA0) { q = r; t = TrItem{(const float*)ap->in[7] + (size_t)l * 1024 * INW, (bf16*)(ws + WS_WINT) + (size_t)l * INP * 1024, 1024, INW, 2, 0, 1024, 0, 0, 0}; }
    else if (r < TA1) { q = r - TA0; t = TrItem{(const float*)ap->in[12] + (size_t)l * 384 * 768, (bf16*)(ws + WS_WUQT) + (size_t)l * 768 * 384, 384, 768, 3, 0, 384, 0, 0, 0}; }
    else if (r < TA2) { q = r - TA1; t = TrItem{(const float*)ap->in[13] + (size_t)l * 256 * 1024, (bf16*)(ws + WS_WUKVT) + (size_t)l * 1024 * 256, 256, 1024, 4, 0, 256, 0, 0, 0}; }
    else if (r < TA3) { q = r - TA2; t = TrItem{(const float*)ap->in[18] + (size_t)l * 512 * 1024, (bf16*)(ws + WS_WBRT) + (size_t)l * 1024 * 1536, 512, 1024, 0, 0, 1536, 0, 0, 0}; }
    else if (r < TA4) { q = r - TA3; t = TrItem{(const float*)ap->in[19] + (size_t)l * 512 * 1024, (bf16*)(ws + WS_WBRT) + (size_t)l * 1024 * 1536, 512, 1024, 0, 0, 1536, 512, 0, 0}; }
    else if (r < TA5) { q = r - TA4; t = TrItem{(const float*)ap->in[21] + (size_t)l * 1024 * 1024, (bf16*)(ws + WS_WOUTT) + (size_t)l * 1024 * 1024, 1024, 1024, 0, 0, 1024, 0, 0, 0}; }
    else if (r < TA6) { r -= TA5; const int e = r / TI_E1; q = r - e * TI_E1; const int b = l * NE + e; t = TrItem{(const float*)ap->in[24] + (size_t)b * 1024 * 2048, (bf16*)(ws + WS_W1T) + (size_t)b * 2048 * 1024, 1024, 2048, 1, 0, 1024, 0, 0, 0}; }
    else { r -= TA6; const int e = r / TI_E2; q = r - e * TI_E2; const int b = l * NE + e; t = TrItem{(const float*)ap->in[26] + (size_t)b * 1024 * 1024, (bf16*)(ws + WS_W2T) + (size_t)b * 1024 * 1024, 1024, 1024, 0, 0, 1024, 0, 0, 0}; }
    const int nblk = t.N / 32, kb = q / nblk; t.k0 = 64 * kb; t.n0 = 32 * (q - kb * nblk);
}
#ifndef MK_INPROJ_W
#define MK_INPROJ_W 200
#endif
#ifndef MK_BG_CLAIM
#define MK_BG_CLAIM 32
#endif
__device__ __forceinline__ void conv_service(CMkArgs* ap, LAS unsigned char* lds, int tid, int lane, int wave, unsigned need, const unsigned* stop, unsigned stop_val) {
    asm volatile("" : "+v"(tid), "+v"(lane));
    unsigned* qh = (unsigned*)(ap->ws + WS_CTL) + CW_Q;
    LAS unsigned* slot = (LAS unsigned*)(lds + LDSCTL_OFF) + LW_CONV;
    LAS float* scr = (LAS float*)(lds + wave * 8448);
    const bool pre = (stop == nullptr);
    unsigned nxt = 0xFFFFFFFFu;
#define CONV_CLAIM() do { nxt = 0xFFFFFFFFu; \
        const bool go_ = stop != nullptr && __hip_atomic_load(stop, __ATOMIC_RELAXED, __HIP_MEMORY_SCOPE_AGENT) < stop_val; \
        if (go_ || __hip_atomic_load(qh, __ATOMIC_RELAXED, __HIP_MEMORY_SCOPE_AGENT) < need) { const unsigned i_ = __hip_atomic_fetch_add(qh, pre ? 16u : (unsigned)MK_BG_CLAIM, __ATOMIC_RELAXED, __HIP_MEMORY_SCOPE_AGENT); if (i_ < (unsigned)TR_NTOT) nxt = i_; } } while (0)
    if (tid == 0) CONV_CLAIM();
    for (int n = 0;; ++n) {
        if (tid == 0) slot[n & 1] = nxt;
        __syncthreads();
        const unsigned idx = __builtin_amdgcn_readfirstlane(slot[n & 1]);
        if (idx == 0xFFFFFFFFu) break;
        if (pre && tid == 0) CONV_CLAIM();
        { TrItem ta, tb; float va[32], vb[32];
          tr_setup(ap, (int)idx + wave, ta); tr_load(ta, va, lane);
          tr_setup(ap, (int)idx + 8 + wave, tb); tr_load(tb, vb, lane);
#if MK_BG_CLAIM > 16
          TrItem tc, td; float vc[32], vd[32]; const bool c_ok = !pre && (int)idx + 16 < TR_NTOT, d_ok = c_ok && MK_BG_CLAIM > 24;
          if (c_ok) { tr_setup(ap, (int)idx + 16 + wave, tc); tr_load(tc, vc, lane); }
          if (d_ok) { tr_setup(ap, (int)idx + 24 + wave, td); tr_load(td, vd, lane); }
#endif
          tr_store(ta, va, scr, lane); tr_store(tb, vb, scr, lane);
#if MK_BG_CLAIM > 16
          if (c_ok) tr_store(tc, vc, scr, lane);
          if (d_ok) tr_store(td, vd, scr, lane);
#endif
        }
        if (!pre && tid == 0) CONV_CLAIM();
    }
#undef CONV_CLAIM
}
__device__ __forceinline__ void phase_prologue(CMkArgs* ap, LAS unsigned char* lds, int tid, int lane, int wave, int G, int bx) {
    asm volatile("" : "+v"(tid), "+v"(lane));
    unsigned char* ws = ap->ws;
    const float* c = (const float*)ap->in[1]; const int* pos = (const int*)ap->in[2]; const float* ada_w = (const float*)ap->in[3]; const float* ada_b = (const float*)ap->in[4];
    const float* w_in = (const float*)ap->in[7]; const float* hgrn_lb = (const float*)ap->in[8]; const float* w_uq = (const float*)ap->in[12]; const float* w_ukv = (const float*)ap->in[13];
    const float* w_pool = (const float*)ap->in[16]; const float* pool_scale = (const float*)ap->in[17]; const float* w_br_a = (const float*)ap->in[18]; const float* w_br_b = (const float*)ap->in[19]; const float* w_br_c = (const float*)ap->in[20];
    const float* w_out = (const float*)ap->in[21]; const float* w_exp1 = (const float*)ap->in[24]; const float* w_exp2 = (const float*)ap->in[26];
    float* mod = (float*)(ws + WS_MOD); float* lb = (float*)(ws + WS_LB); float* rope = (float*)(ws + WS_ROPE);
    bf16 *WinT = (bf16*)(ws + WS_WINT), *WuqT = (bf16*)(ws + WS_WUQT), *WukvT = (bf16*)(ws + WS_WUKVT), *WbrT = (bf16*)(ws + WS_WBRT), *WoutT = (bf16*)(ws + WS_WOUTT), *W1T = (bf16*)(ws + WS_W1T), *W2T = (bf16*)(ws + WS_W2T);
    if (bx < 192) {
        LAS float* cs = (LAS float*)(lds + 67584);
        LAS float* part = (LAS float*)(lds + 100352);
        for (int i = tid; i < 8192; i += NTHR) { const float v = c[i]; cs[i] = v / (1.f + __expf(-v)); }
        __syncthreads();
        for (int u = bx; u < 192; u += G) {
            const int l = u / 96, j = (u - l * 96) * 64 + lane;
            const float* w = ada_w + (size_t)l * 1024 * 6144 + (size_t)(wave * 128) * 6144 + j;
            float acc[8];
#pragma unroll
            for (int b = 0; b < 8; ++b) acc[b] = 0.f;
#pragma unroll 16
            for (int k = 0; k < 128; ++k) { const float wv = w[(size_t)k * 6144];
#pragma unroll
                for (int b = 0; b < 8; ++b) acc[b] += cs[b * 1024 + wave * 128 + k] * wv; }
#pragma unroll
            for (int b = 0; b < 8; ++b) part[(wave * 8 + b) * 64 + lane] = acc[b];
            __syncthreads();
            { const int b = tid >> 6; float s = 0.f;
#pragma unroll
              for (int w8 = 0; w8 < 8; ++w8) s += part[(w8 * 8 + b) * 64 + lane];
              mod[(size_t)l * 8 * 6144 + b * 6144 + j] = s + ada_b[l * 6144 + j]; }
            __syncthreads();
        }
        if (tid == 0) __hip_atomic_fetch_add((unsigned*)(ws + WS_CTL) + CW_PD, 1u, __ATOMIC_RELAXED, __HIP_MEMORY_SCOPE_AGENT);
    }
    const int gw = bx * NWAVES + wave, NGW = G * NWAVES, gt = bx * NTHR + tid, NGT = G * NTHR;
    for (int i = gt; i < 512; i += NGT) { const float p = hgrn_lb[i], q = hgrn_lb[512 + i]; const float m = fmaxf(p, q); const float ea = __expf(p - m), eb = __expf(q - m); lb[i] = 0.f; lb[512 + i] = eb / (ea + eb); }
    for (int t = gt; t < NT; t += NGT) {
        const double pz = (double)pos[t];
#pragma unroll
        for (int q4 = 0; q4 < 4; ++q4) { float c_[4], s_[4];
#pragma unroll
            for (int q = 0; q < 4; ++q) { const double ang = pz * (double)ap->invf[4 * q4 + q]; double r = ang * 0.15915494309189535; r -= floor(r + 0.5); const float an = (float)(r * 6.283185307179586);
                c_[q] = __cosf(an); s_[q] = __sinf(an); }
            *(GAS f32x4*)(rope + (size_t)t * 16 + 4 * q4) = (f32x4){c_[0], c_[1], c_[2], c_[3]}; *(GAS f32x4*)(rope + (size_t)NT * 16 + (size_t)t * 16 + 4 * q4) = (f32x4){s_[0], s_[1], s_[2], s_[3]}; } }
    for (int i = gt; i < L * 96 * 128; i += NGT) { const int l = i / (96 * 128), r = i - l * 96 * 128; *(GAS v4u*)(WinT + (size_t)l * INP * 1024 + (size_t)3232 * 1024 + (size_t)r * 8) = (v4u){0u, 0u, 0u, 0u}; }
    for (int task = gw; task < L * 1024; task += NGW) {
        const int l = task >> 10, g = (task >> 8) & 3, nb = (task >> 4) & 15, c0 = (task & 15) * 8;
        const float* wb = w_br_c + (size_t)l * 512 * 1024 + (size_t)g * 128 * 1024 + nb * 64 + lane; const float* sc = pool_scale + l * 512 + g * 128;
        const float* wp = w_pool + ((size_t)l * 4 + g) * 128 * 128 + (size_t)c0 * 128;
        LAS float* wl = (LAS float*)(lds + wave * 4096);
#pragma unroll
        for (int h = 0; h < 2; ++h) { const float scv = sc[lane + 64 * h];
#pragma unroll
            for (int q = 0; q < 8; ++q) wl[q * 128 + lane + 64 * h] = wp[q * 128 + lane + 64 * h] * scv; }
        float acc[8];
#pragma unroll
        for (int q = 0; q < 8; ++q) acc[q] = 0.f;
#pragma unroll 4
        for (int d = 0; d < 128; d += 4) { const float w0 = wb[(size_t)d * 1024], w1 = wb[(size_t)(d + 1) * 1024], w2 = wb[(size_t)(d + 2) * 1024], w3 = wb[(size_t)(d + 3) * 1024];
#pragma unroll
            for (int q = 0; q < 8; ++q) { const f32x4 a = *(const LAS f32x4*)(wl + q * 128 + d); acc[q] += a[0] * w0; acc[q] += a[1] * w1; acc[q] += a[2] * w2; acc[q] += a[3] * w3; } }
        v4u o; o.x = pk2(acc[0], acc[1]); o.y = pk2(acc[2], acc[3]); o.z = pk2(acc[4], acc[5]); o.w = pk2(acc[6], acc[7]);
        *(GAS v4u*)(WbrT + (size_t)l * 1024 * 1536 + (size_t)(nb * 64 + lane) * 1536 + 1024 + g * 128 + c0) = o;
    }
    conv_service(ap, lds, tid, lane, wave, (unsigned)TA5, bx >= 192 ? (const unsigned*)(ws + WS_CTL) + CW_PD : nullptr, (unsigned)(G < 192 ? G : 192));
}

__device__ __forceinline__ int xcd_unit256(int v, int G) { return (G == 256) ? (((v & 7) << 5) | ((v >> 3) & 31)) : v; }
__device__ __forceinline__ int xcd_unit1024(int v, int G) { return (G == 256) ? (((v & 7) << 7) | (((v >> 3) & 31) << 2) | (v >> 8)) : v; }
template <int MODE>
__device__ __forceinline__ void phase_rows(const void* xin_, void* xout_, const float* gain, const float* mod_sh, const float* mod_sc, const float* mod_g2, bf16* HN,
                                           const bf16* EO, const int* tokE, const int* tokS, const float* tokW, const LAS int* tp, int lane, int gw, int NGW) {
    asm volatile("" : "+v"(lane));
    for (int row_ = gw; row_ < NT; row_ += NGW) {
        const int row = (NGW == 2048) ? ((((gw >> 3) & 7) << 11) | ((row_ >> 11) << 8) | ((gw >> 6) << 3) | (gw & 7)) : row_;
        const int b = row / S;
        f32x4 v[4];
        if (MODE == 0) { const GAS f32x4* xr = (const GAS f32x4*)((const float*)xin_ + (size_t)row * D);
#pragma unroll
            for (int j = 0; j < 4; ++j) v[j] = xr[lane + 64 * j]; }
        else { const GAS v2u* xr = (const GAS v2u*)((const bf16*)xin_ + (size_t)row * D);
#pragma unroll
            for (int j = 0; j < 4; ++j) { const v2u h = xr[lane + 64 * j]; v[j] = (f32x4){__uint_as_float(h.x << 16), __uint_as_float(h.x & 0xffff0000u), __uint_as_float(h.y << 16), __uint_as_float(h.y & 0xffff0000u)}; } }
        if (MODE != 0) {
            f32x4 acc[4];
#pragma unroll
            for (int j = 0; j < 4; ++j) acc[j] = (f32x4){0.f, 0.f, 0.f, 0.f};
#pragma unroll
            for (int k = 0; k < 4; ++k) { const int e = tokE[row * 4 + k]; const size_t r = (size_t)tp[e] * 256 + tokS[row * 4 + k]; const float w = tokW[row * 4 + k];
                const GAS v2u* er = (const GAS v2u*)(EO + r * 1024);
#pragma unroll
                for (int j = 0; j < 4; ++j) { const v2u ev = er[lane + 64 * j];
                    acc[j][0] += w * __uint_as_float(ev.x << 16); acc[j][1] += w * __uint_as_float(ev.x & 0xffff0000u); acc[j][2] += w * __uint_as_float(ev.y << 16); acc[j][3] += w * __uint_as_float(ev.y & 0xffff0000u); } }
#pragma unroll
            for (int j = 0; j < 4; ++j) { const f32x4 gg = *(const GAS f32x4*)(mod_g2 + b * 6144 + (lane + 64 * j) * 4); v[j] = v[j] + gg * acc[j];
                if (MODE == 2) *(GAS f32x4*)((float*)xout_ + (size_t)row * D + (lane + 64 * j) * 4) = v[j];
                else { v2u o; o.x = pk2(v[j][0], v[j][1]); o.y = pk2(v[j][2], v[j][3]); *(GAS v2u*)((bf16*)xout_ + (size_t)row * D + (lane + 64 * j) * 4) = o;
                    v[j] = (f32x4){__uint_as_float(o.x << 16), __uint_as_float(o.x & 0xffff0000u), __uint_as_float(o.y << 16), __uint_as_float(o.y & 0xffff0000u)}; } }
        }
        if (MODE != 2) {
            float ss = 0.f;
#pragma unroll
            for (int j = 0; j < 4; ++j) ss += (v[j][0] * v[j][0] + v[j][1] * v[j][1]) + (v[j][2] * v[j][2] + v[j][3] * v[j][3]);
            const float rstd = rsqrtf(wave_sum(ss) * (1.f / D) + EPS);
#pragma unroll
            for (int j = 0; j < 4; ++j) { const int cc = (lane + 64 * j) * 4; const f32x4 gg = *(const GAS f32x4*)(gain + cc), sh = *(const GAS f32x4*)(mod_sh + b * 6144 + cc), sc = *(const GAS f32x4*)(mod_sc + b * 6144 + cc);
                const f32x4 h = v[j] * rstd * gg * (sc + 1.f) + sh; v2u o; o.x = pk2(h[0], h[1]); o.y = pk2(h[2], h[3]);
                *(GAS v2u*)(HN + (size_t)row * D + cc) = o; }
        }
    }
}
__device__ __forceinline__ void load_tp(const int* cnt, LAS int* tp, LAS int* cn, int tid) {
    if (tid < 32) cn[tid] = __hip_atomic_load(cnt + tid, __ATOMIC_RELAXED, __HIP_MEMORY_SCOPE_AGENT);
    __syncthreads();
    if (tid == 0) { int acc = 0; tp[0] = 0;
        for (int q = 0; q < 32; ++q) { acc += (cn[q] + 255) >> 8; tp[q + 1] = acc; } }
    __syncthreads();
}

__device__ __forceinline__ void phase_router(const bf16* x1, const float* gain, const float* mod_sh, const float* mod_sc, const float* wr, const float* br, bf16* hn2, int* cnt, int* list, int* tokE, int* tokS, float* tokW,
                                             LAS unsigned char* lds, int tid, int lane, int wave, int G, int bx) {
    asm volatile("" : "+v"(tid), "+v"(lane));
    LAS float* tile = (LAS float*)(lds + RING_OFF);
    LAS int* lw = (LAS int*)(lds + LDSCTL_OFF);
    LAS int* entE = lw + LW_ENTE; LAS float* entW = (LAS float*)(lw + LW_ENTW); LAS int* rank = lw + LW_RANK; LAS int* lcnt = lw + LW_LCNT; LAS int* base = lw + LW_BASE;
    const int l31 = lane & 31, h5 = lane >> 5;
    float breg[64];
#pragma unroll
    for (int j = 0; j < 64; ++j) breg[j] = wr[(size_t)(128 * wave + 2 * j + h5) * 32 + l31];
    if (tid < 32) lcnt[tid] = 0;
    __syncthreads();
    for (int bt_ = bx; bt_ < NT / 64; bt_ += G) { const int bt = xcd_unit256(bt_, G);
#pragma unroll 1
      for (int hb = 0; hb < 2; ++hb) {
        const int row0 = bt * 64 + hb * 32 + wave * 4, b = row0 / S;
        int ln = lane; asm volatile("" : "+v"(ln));
#pragma unroll 1
        for (int rp = 0; rp < 2; ++rp) {
        f32x4 v[2][4];
#pragma unroll
        for (int rr = 0; rr < 2; ++rr)
#pragma unroll
            for (int j = 0; j < 4; ++j) { const v2u h = ((const GAS v2u*)(x1 + (size_t)(row0 + 2 * rp + rr) * D))[ln + 64 * j];
                v[rr][j] = (f32x4){__uint_as_float(h.x << 16), __uint_as_float(h.x & 0xffff0000u), __uint_as_float(h.y << 16), __uint_as_float(h.y & 0xffff0000u)}; }
#pragma unroll
        for (int rr = 0; rr < 2; ++rr) {
            const int lr = wave * 4 + 2 * rp + rr, row = row0 + 2 * rp + rr;
            int l2 = ln; asm volatile("" : "+v"(l2));
            float ss = 0.f;
#pragma unroll
            for (int j = 0; j < 4; ++j) ss += (v[rr][j][0] * v[rr][j][0] + v[rr][j][1] * v[rr][j][1]) + (v[rr][j][2] * v[rr][j][2] + v[rr][j][3] * v[rr][j][3]);
            const float rstd = rsqrtf(wave_sum(ss) * (1.f / D) + EPS);
#pragma unroll
            for (int j = 0; j < 4; ++j) { const int cc = (l2 + 64 * j) * 4; const f32x4 gg = *(const GAS f32x4*)(gain + cc), sh = *(const GAS f32x4*)(mod_sh + b * 6144 + cc), sc = *(const GAS f32x4*)(mod_sc + b * 6144 + cc);
                const f32x4 hv = v[rr][j] * rstd * gg * (sc + 1.f) + sh; v2u o; o.x = pk2(hv[0], hv[1]); o.y = pk2(hv[2], hv[3]);
                *(GAS v2u*)(hn2 + (size_t)row * D + cc) = o;
#pragma unroll
                for (int q = 0; q < 4; ++q) tile[lr * 1024 + ((cc + q) ^ lr)] = hv[q]; }
        }
        }
        __syncthreads();
        f32x16 acc;
#pragma unroll
        for (int r = 0; r < 16; ++r) acc[r] = 0.f;
#pragma unroll
        for (int j = 0; j < 64; ++j) { const float a = tile[l31 * 1024 + ((128 * wave + 2 * j + h5) ^ l31)]; acc = __builtin_amdgcn_mfma_f32_32x32x2f32(a, breg[j], acc, 0, 0, 0);
            if ((j & 7) == 7) __builtin_amdgcn_sched_barrier(0); }
        __syncthreads();
#pragma unroll
        for (int r = 0; r < 16; ++r) tile[(wave * 32 + (r & 3) + 8 * (r >> 2) + 4 * h5) * 32 + l31] = acc[r];
        __syncthreads();
#pragma unroll 1
        for (int rr = 0; rr < 4; ++rr) {
            const int lr = wave * 4 + rr, er = hb * 32 + lr; float cur = br[l31];
#pragma unroll
            for (int w8 = 0; w8 < 8; ++w8) cur += tile[(w8 * 32 + lr) * 32 + l31];
            float tv[4]; int ti[4];
#pragma unroll
            for (int k = 0; k < 4; ++k) { float mv = cur; int mi = l31;
#pragma unroll
                for (int o = 1; o < 32; o <<= 1) { const float ov = __shfl_xor(mv, o); const int oi = __shfl_xor(mi, o); if (ov > mv || (ov == mv && oi < mi)) { mv = ov; mi = oi; } }
                tv[k] = mv; ti[k] = mi; if (l31 == mi) cur = -INFINITY; }
            const float e1 = __expf(tv[1] - tv[0]), e2 = __expf(tv[2] - tv[0]), e3 = __expf(tv[3] - tv[0]), inv = 1.f / (1.f + e1 + e2 + e3);
            if (lane == 0) { entE[er * 4 + 0] = ti[0]; entE[er * 4 + 1] = ti[1]; entE[er * 4 + 2] = ti[2]; entE[er * 4 + 3] = ti[3];
                entW[er * 4 + 0] = inv; entW[er * 4 + 1] = e1 * inv; entW[er * 4 + 2] = e2 * inv; entW[er * 4 + 3] = e3 * inv; }
        }
        __syncthreads();
      }
        if (tid < 256) rank[tid] = __hip_atomic_fetch_add(lcnt + entE[tid], 1, __ATOMIC_RELAXED, __HIP_MEMORY_SCOPE_WORKGROUP);
        __syncthreads();
        if (tid < 32) { const int n = lcnt[tid]; base[tid] = n ? __hip_atomic_fetch_add(cnt + tid, n, __ATOMIC_RELAXED, __HIP_MEMORY_SCOPE_AGENT) : 0; lcnt[tid] = 0; }
        __syncthreads();
        if (tid < 256) { const int e = entE[tid], slot = base[e] + rank[tid], row = bt * 64 + (tid >> 2);
            list[(size_t)e * CAP + slot] = row; tokE[row * 4 + (tid & 3)] = e; tokS[row * 4 + (tid & 3)] = slot; tokW[row * 4 + (tid & 3)] = entW[tid]; }
        __syncthreads();
    }
}

__device__ __forceinline__ int moe_workers(int total, int G) { const int gx = G >> 3, nmax = (total + 7) >> 3, rounds = (nmax + gx - 1) / gx; int jw = rounds > 0 ? (nmax + rounds - 1) / rounds : gx; return jw < 1 ? 1 : (jw > gx ? gx : jw); }
__device__ __forceinline__ bool moe_early(int total, int jw, int bx) { const int x = bx & 7, j = bx >> 3, lo = (int)(((long)total * x) >> 3), hi = (int)(((long)total * (x + 1)) >> 3), nmax = (total + 7) >> 3;
    const int mine = (hi - lo - j + jw - 1) / jw, maxr = (nmax + jw - 1) / jw; return mine < maxr; }
__global__ void __launch_bounds__(NTHR, 2) mk_fwd(MkArgs a) {
    extern __shared__ __attribute__((aligned(16))) unsigned char lds_raw[];
    LAS unsigned char* lds = (LAS unsigned char*)lds_raw;
    const int G = gridDim.x, bx = blockIdx.x, wave_s = __builtin_amdgcn_readfirstlane((int)threadIdx.x >> 6);
#define PH_LOCALS int tid = wave_s * 64 + (int)mk_lane_id(); asm volatile("" : "+v"(tid)); const int lane = tid & 63, wave = __builtin_amdgcn_readfirstlane(tid >> 6), gw = bx * NWAVES + wave, NGW = G * NWAVES; (void)lane; (void)gw; (void)NGW
    { PH_LOCALS; for (int u = tid; u < (LDS_BYTES - LDSCTL_OFF) / 4; u += NTHR) ((LAS unsigned*)(lds + LDSCTL_OFF))[u] = 0u; }
    __syncthreads();
    int lo, hi; XcdBarrier bar;
    { PH_LOCALS; KA_PTR(ka); lo = ka->ph_lo; hi = ka->ph_hi; bar = xcd_barrier_post((unsigned*)(ka->ws + WS_CTL) + CW_BAR + ka->li * XCD_BAR_WORDS, (volatile LAS unsigned*)(lds + LDSCTL_OFF) + LW_BAR, wave_s); }
    LAS int* lw = (LAS int*)(lds + LDSCTL_OFF); LAS int* tp = lw + LW_TP; LAS int* cn = lw + LW_CNT;
#ifndef MK_PHMASK
#define MK_PHMASK 0xFFFFFFFFu
#endif
#ifndef MK_DUP
#define MK_DUP 0u
#endif
#define NREP(p) (((MK_DUP >> (p)) & 1u) ? 2 : 1)
#ifndef MK_DUPSUB
#define MK_DUPSUB 0xFFu
#endif
#define SUBEN(bit) (rep_ == 0 || ((MK_DUPSUB >> (bit)) & 1u))
#define PHEN(p) ((MK_PHMASK >> (p)) & 1u)
#define IN(k) (lo <= (k) && (k) < hi)
#ifndef MK_HOOKPROBE
#define MK_HOOKPROBE 0
#endif
#ifndef MK_DUPBAR
#define MK_DUPBAR 0
#endif
#define SEAM(k) do { if (IN(k) && IN((k) + 1)) { xcd_barrier(bar); if (MK_DUPBAR) xcd_barrier(bar); } } while (0)
#define WSP(T, off) ((T*)(ws + (off)))
    if (PHEN(31) && IN(0)) for (int rep_ = 0; rep_ < NREP(31); ++rep_) { PH_LOCALS; KA_PTR(ka); phase_prologue(ka, lds, tid, lane, wave, G, bx); VM_WAIT(); __syncthreads(); }
    SEAM(0);
    for (int l = 0; l < L; ++l) {
        const int pb = 1 + l * NPH_L;
        if (PHEN(0) && IN(pb + 0)) for (int rep_ = 0; rep_ < NREP(0); ++rep_) { PH_LOCALS; KA_PTR(ka); unsigned char* ws = ka->ws; const float* modl = WSP(float, WS_MOD) + (size_t)l * 8 * 6144; const float* norm1_g = (const float*)ka->in[5] + l * D;
            if (l == 0) phase_rows<0>((const float*)ka->in[0], nullptr, norm1_g, modl + 0, modl + 1024, nullptr, WSP(bf16, WS_HN), nullptr, nullptr, nullptr, nullptr, tp, lane, gw, NGW);
            else { load_tp(WSP(int, WS_CTL) + CW_CNT + (l - 1) * 64, tp, cn, tid); int* tokE = WSP(int, WS_TOK);
                phase_rows<1>(WSP(bf16, WS_XA), WSP(bf16, WS_XB), norm1_g, modl + 0, modl + 1024, modl - 8 * 6144 + 5120, WSP(bf16, WS_HN), WSP(bf16, WS_EO), tokE, tokE + NT * 4, (const float*)(tokE + NT * 8), tp, lane, gw, NGW); }
        }
        SEAM(pb + 0);
        if (PHEN(1) && IN(pb + 1)) for (int rep_ = 0; rep_ < NREP(1); ++rep_) { PH_LOCALS; KA_PTR(ka); unsigned char* ws = ka->ws;
#if defined(MK_DBG) && MK_DBG
            if (bx == 0 && tid == 0 && l == MK_DBG_L) WSP(unsigned, WS_CTL)[1030] = (MK_DBG == 1) ? __hip_atomic_load(WSP(unsigned, WS_CTL) + CW_Q, __ATOMIC_RELAXED, __HIP_MEMORY_SCOPE_AGENT) : (unsigned)__builtin_amdgcn_s_memrealtime();
#endif
            const int GW = (G >= 232 && (G & 7) == 0) ? MK_INPROJ_W : G; unsigned* pd = WSP(unsigned, WS_CTL) + CW_PD + 64 * (1 + 3 * l);
            if (bx < GW) {
                pg8::Gemm g{WSP(bf16, WS_HN), WSP(bf16, WS_WINT) + (size_t)l * INP * 1024, nullptr, 1024, 1024, 1024, 0}; pg8::StaticOrder So; So.init(NT, INP, GW, bx);
                EpiP E{WSP(bf16, WS_P), INP, WSP(bf16, WS_GT)};
                pg8::gemm_phase<EpiP, pg8::StaticOrder, false, true, false>(lds + RING_OFF, g, So, E, wave);
                if (tid == 0) __hip_atomic_fetch_add(pd, 1u, __ATOMIC_RELAXED, __HIP_MEMORY_SCOPE_AGENT);
                if (((NT / 256) * (INP / 256) - bx + GW - 1) / GW < ((NT / 256) * (INP / 256) + GW - 1) / GW) conv_service(ka, lds, tid, lane, wave, 0u, pd, (unsigned)GW);
            } else conv_service(ka, lds, tid, lane, wave, 0u, pd, (unsigned)GW);
        }
        SEAM(pb + 1);
#if defined(MK_DBG) && MK_DBG
        { PH_LOCALS; KA_PTR(ka); unsigned char* ws = ka->ws; if (bx == 0 && tid == 0 && l == MK_DBG_L) WSP(unsigned, WS_CTL)[1031] = (MK_DBG == 1) ? __hip_atomic_load(WSP(unsigned, WS_CTL) + CW_Q, __ATOMIC_RELAXED, __HIP_MEMORY_SCOPE_AGENT) : (unsigned)__builtin_amdgcn_s_memrealtime(); }
#endif
        if (PHEN(2) && IN(pb + 2)) for (int rep_ = 0; rep_ < NREP(2); ++rep_) { PH_LOCALS; KA_PTR(ka); unsigned char* ws = ka->ws;
#if MK_HGRN_IN
            if (SUBEN(2)) hgrn_a_all(WSP(bf16, WS_P), WSP(float, WS_LB) + l * 512, WSP(bf16, WS_SLOC), WSP(float, WS_DEC), lds + RING_OFF, bx, G, tid, lane, wave);
#endif
#if MK_MLA_IN
            if (SUBEN(3)) for (int u_ = bx; u_ < NT / 64; u_ += G) { const int u = xcd_unit256(u_, G);
                mla_unit(WSP(bf16, WS_P), (const float*)ka->in[10] + l * 384, (const float*)ka->in[11] + l * 256, WSP(bf16, WS_WUQT) + (size_t)l * 768 * 384, WSP(bf16, WS_WUKVT) + (size_t)l * 1024 * 256,
                         (const float*)ka->in[14] + l * 96, (const float*)ka->in[15] + l * 96, WSP(float, WS_ROPE), WSP(bf16, WS_Q), WSP(bf16, WS_K), WSP(bf16, WS_V), lds + RING_OFF, u, lane, wave); }
#endif
#if MK_POOL_IN
            if (SUBEN(4)) for (int u = bx; u < NT / 64; u += G) pool_unit(WSP(bf16, WS_P), WSP(bf16, WS_BR), xcd_unit256(u, G), tid);
#endif
        }
        SEAM(pb + 2);
        if (PHEN(3) && IN(pb + 3)) for (int rep_ = 0; rep_ < NREP(3); ++rep_) { PH_LOCALS; KA_PTR(ka); unsigned char* ws = ka->ws;
#if MK_HGRN_IN
            for (int u = bx; u < 256; u += G) hgrn_scan_unit(WSP(bf16, WS_SLOC), WSP(float, WS_DEC), WSP(bf16, WS_ST), xcd_unit256(u, G), tid);
#endif
        }
        SEAM(pb + 3);
        if (PHEN(4) && IN(pb + 4)) for (int rep_ = 0; rep_ < NREP(4); ++rep_) { PH_LOCALS; KA_PTR(ka); unsigned char* ws = ka->ws;
#if MK_ATTN_IN
            if (SUBEN(0)) for (int p = bx; p < 256; p += G) { const int abh = (G == 256) ? (((p & 7) << 3) | ((p >> 3) & 7)) : (p & 63);
                attn_unit(WSP(bf16, WS_Q), WSP(bf16, WS_K), WSP(bf16, WS_V), WSP(bf16, WS_BR), lds + RING_OFF, abh, 7 - (p >> 6), tid, lane, wave);
                attn_unit(WSP(bf16, WS_Q), WSP(bf16, WS_K), WSP(bf16, WS_V), WSP(bf16, WS_BR), lds + RING_OFF, abh, p >> 6, tid, lane, wave);
            }
#endif
#if MK_HGRN_IN
            if (SUBEN(1)) for (int u = bx; u < 1024; u += G) hgrn_c_unit(WSP(bf16, WS_P), WSP(float, WS_LB) + l * 512, WSP(bf16, WS_ST), (const float*)ka->in[9] + l * 128, WSP(bf16, WS_BR), lds + RING_OFF, xcd_unit1024(u, G), tid, lane, wave);
#endif
        }
        SEAM(pb + 4);
        if (PHEN(5) && IN(pb + 5)) for (int rep_ = 0; rep_ < NREP(5); ++rep_) { PH_LOCALS; KA_PTR(ka); unsigned char* ws = ka->ws;
            pg8::Gemm g{WSP(bf16, WS_BR), WSP(bf16, WS_WBRT) + (size_t)l * 1024 * 1536, nullptr, 1536, 1536, 1536, 0}; pg8::StaticOrder So; So.init(NT, 1024, G, bx);
#if MK_P5PROBE
            if (rep_ == 1) { EpiP E2{WSP(bf16, WS_MERGF), 1024, nullptr}; pg8::gemm_phase<EpiP, pg8::StaticOrder, false, true, false, 0>(lds + RING_OFF, g, So, E2, wave); } else
#endif
            { EpiBranch E{WSP(bf16, WS_GT), WSP(bf16, WS_MERGB)};
            pg8::gemm_phase<EpiBranch, pg8::StaticOrder, false, true, false, 8>(lds + RING_OFF, g, So, E, wave); }
        }
        SEAM(pb + 5);
        if (PHEN(6) && IN(pb + 6)) for (int rep_ = 0; rep_ < NREP(6); ++rep_) { PH_LOCALS; KA_PTR(ka); unsigned char* ws = ka->ws;
            pg8::Gemm g{WSP(bf16, WS_MERGB), WSP(bf16, WS_WOUTT) + (size_t)l * 1024 * 1024, nullptr, 1024, 1024, 1024, 0}; pg8::StaticOrder So; So.init(NT, 1024, G, bx);
            if (l == 0) { EpiOutT<true> E{ka->in[0], WSP(float, WS_MOD) + (size_t)l * 8 * 6144 + 2048, WSP(bf16, WS_XA)};
                pg8::gemm_phase<EpiOutT<true>, pg8::StaticOrder, false, true, false>(lds + RING_OFF, g, So, E, wave); }
            else { EpiOutT<false> E{WSP(bf16, WS_XB), WSP(float, WS_MOD) + (size_t)l * 8 * 6144 + 2048, WSP(bf16, WS_XA)};
                pg8::gemm_phase<EpiOutT<false>, pg8::StaticOrder, false, true, false>(lds + RING_OFF, g, So, E, wave); }
        }
        SEAM(pb + 6);
        if (PHEN(7) && IN(pb + 7)) for (int rep_ = 0; rep_ < NREP(7); ++rep_) { PH_LOCALS; KA_PTR(ka); unsigned char* ws = ka->ws; const float* modl = WSP(float, WS_MOD) + (size_t)l * 8 * 6144; int* tokE = WSP(int, WS_TOK);
            if (rep_ == 1) tokE = WSP(int, WS_KVRAW);
            phase_router(WSP(bf16, WS_XA), (const float*)ka->in[6] + l * D, modl + 3072, modl + 4096, (const float*)ka->in[22] + (size_t)l * 1024 * 32, (const float*)ka->in[23] + l * 32, WSP(bf16, WS_HN2),
                         WSP(int, WS_CTL) + (rep_ == 1 ? 2048 : CW_CNT) + l * 64, rep_ == 1 ? WSP(int, WS_QRAW) : WSP(int, WS_LIST), tokE, tokE + NT * 4, (float*)(tokE + NT * 8), lds, tid, lane, wave, G, bx);
            conv_service(ka, lds, tid, lane, wave, (unsigned)(l * TA7 + TA6), nullptr, 0u); }
        SEAM(pb + 7);
        if (PHEN(8) && IN(pb + 8)) for (int rep_ = 0; rep_ < NREP(8); ++rep_) { PH_LOCALS; KA_PTR(ka); unsigned char* ws = ka->ws;
            load_tp(WSP(int, WS_CTL) + CW_CNT + l * 64, tp, cn, tid);
            const int jw = moe_workers(tp[32] * 8, G); unsigned* pd = WSP(unsigned, WS_CTL) + CW_PD + 64 * (2 + 3 * l); const bool worker = (bx >> 3) < jw || (G & 7) != 0;
            if (worker) {
                pg8::Gemm g{WSP(bf16, WS_HN2), WSP(bf16, WS_W1T) + (size_t)l * NE * 2048 * 1024, WSP(int, WS_LIST), 1024, 1024, 1024, 0}; MoeOrder So{tp, cn, 8, (G & 7) ? G : 8 * jw, bx, 0};
                EpiMoe1 E{(const float*)ka->in[25] + (size_t)l * NE * 2048, WSP(bf16, WS_ACT), (LAS float*)(lw + LW_BIAS)};
                pg8::gemm_phase<EpiMoe1, MoeOrder, true, true, true>(lds + RING_OFF, g, So, E, wave);
                if (tid == 0) __hip_atomic_fetch_add(pd, 1u, __ATOMIC_RELAXED, __HIP_MEMORY_SCOPE_AGENT);
            }
            conv_service(ka, lds, tid, lane, wave, (unsigned)((l + 1) * TA7), (worker && !moe_early(tp[32] * 8, jw, bx)) ? nullptr : pd, (unsigned)(8 * jw));
        }
        SEAM(pb + 8);
        if (PHEN(9) && IN(pb + 9)) for (int rep_ = 0; rep_ < NREP(9); ++rep_) { PH_LOCALS; KA_PTR(ka); unsigned char* ws = ka->ws;
            load_tp(WSP(int, WS_CTL) + CW_CNT + l * 64, tp, cn, tid);
            const int jw = moe_workers(tp[32] * 4, G); unsigned* pd = WSP(unsigned, WS_CTL) + CW_PD + 64 * (3 + 3 * l); const bool worker = (bx >> 3) < jw || (G & 7) != 0;
            if (worker) {
                pg8::Gemm g{WSP(bf16, WS_ACT), WSP(bf16, WS_W2T) + (size_t)l * NE * 1024 * 1024, nullptr, 1024, 1024, 1024, 0}; MoeOrder So{tp, cn, 4, (G & 7) ? G : 8 * jw, bx, 1};
                EpiMoe2 E{(const float*)ka->in[27] + (size_t)l * NE * 1024, WSP(bf16, WS_EO), (LAS float*)(lw + LW_BIAS)};
                pg8::gemm_phase<EpiMoe2, MoeOrder, true, true, false>(lds + RING_OFF, g, So, E, wave);
                if (tid == 0) __hip_atomic_fetch_add(pd, 1u, __ATOMIC_RELAXED, __HIP_MEMORY_SCOPE_AGENT);
            }
            conv_service(ka, lds, tid, lane, wave, (unsigned)(l + 1 < L ? (l + 1) * TA7 + TA5 : 0), (worker && !moe_early(tp[32] * 4, jw, bx)) ? nullptr : pd, (unsigned)(8 * jw));
        }
        SEAM(pb + 9);
    }
    if (PHEN(30) && IN(PH_FINAL)) for (int rep_ = 0; rep_ < NREP(30); ++rep_) { PH_LOCALS; KA_PTR(ka); unsigned char* ws = ka->ws; load_tp(WSP(int, WS_CTL) + CW_CNT + (L - 1) * 64, tp, cn, tid); int* tokE = WSP(int, WS_TOK);
        phase_rows<2>(WSP(bf16, WS_XA), ka->out, nullptr, nullptr, nullptr, WSP(float, WS_MOD) + (size_t)(L - 1) * 8 * 6144 + 5120, nullptr, WSP(bf16, WS_EO), tokE, tokE + NT * 4, (const float*)(tokE + NT * 8), tp, lane, gw, NGW); }
#if defined(MK_DBG) && MK_DBG
    xcd_barrier(bar);
    { PH_LOCALS; KA_PTR(ka); unsigned char* ws = ka->ws; const unsigned d = __hip_atomic_load(WSP(unsigned, WS_CTL) + 1031, __ATOMIC_RELAXED, __HIP_MEMORY_SCOPE_AGENT) - __hip_atomic_load(WSP(unsigned, WS_CTL) + 1030, __ATOMIC_RELAXED, __HIP_MEMORY_SCOPE_AGENT);
      const unsigned K = d * (unsigned)MK_DBG_SCALE; for (unsigned i = bx * NTHR + tid; i < K && i < (unsigned)NT * 1024u; i += G * NTHR) ka->out[i] = 0.f; }
#endif
#undef IN
#undef SEAM
}
static void launch_mk(const MkArgs& base, int lo, int hi, int li, int grid, hipStream_t stream) {
    MkArgs a = base; a.ph_lo = lo; a.ph_hi = hi; a.li = li; a.pad = 0;
    hipLaunchKernelGGL(mk_fwd, dim3(grid), dim3(NTHR), LDS_BYTES, stream, a);
}
extern "C" void kernel_launch(void* const* d_in, const int* in_sizes, int n_in, void* d_out, int out_size, void* d_ws, size_t ws_size, hipStream_t stream) {
    static int grid = 0;
    if (grid == 0) {
        if (ws_size < WS_END || n_in != 28) { fprintf(stderr, "kernel_launch: bad ws/inputs: %zu < %zu, n_in %d\n", ws_size, (size_t)WS_END, n_in); grid = -1; return; }
        int dev = 0, cus = 0, per_cu = 0;
        if (hipGetDevice(&dev) != hipSuccess || hipDeviceGetAttribute(&cus, hipDeviceAttributeMultiprocessorCount, dev) != hipSuccess) { grid = -1; return; }
        if (hipFuncSetAttribute((const void*)mk_fwd, hipFuncAttributeMaxDynamicSharedMemorySize, LDS_BYTES) != hipSuccess) { fprintf(stderr, "kernel_launch: hipFuncSetAttribute failed\n"); grid = -1; return; }
        if (hipOccupancyMaxActiveBlocksPerMultiprocessor(&per_cu, (const void*)mk_fwd, NTHR, LDS_BYTES) != hipSuccess || per_cu < 1) { fprintf(stderr, "kernel_launch: occupancy query says %d\n", per_cu); (void)hipGetLastError(); grid = -1; return; }
        grid = cus;
    }
    if (grid < 0) return;
    unsigned char* ws = (unsigned char*)d_ws;
    (void)hipMemsetAsync(ws + WS_CTL, 0, 1 * MiB, stream);
    MkArgs a{};
    for (int i = 0; i < 28; ++i) a.in[i] = d_in[i];
    a.out = (float*)d_out; a.ws = ws;
    for (int j = 0; j < 16; ++j) a.invf[j] = (float)(1.0 / pow(10000.0, (double)j / 16.0));
#if MK_HYBRID
    const float* onorm_g = (const float*)d_in[9]; const float* qlat_g = (const float*)d_in[10]; const float* kvlat_g = (const float*)d_in[11]; const float* qn_g = (const float*)d_in[14]; const float* kn_g = (const float*)d_in[15];
    float* lb = (float*)(ws + WS_LB); float* rope = (float*)(ws + WS_ROPE);
    bf16 *WuqT = (bf16*)(ws + WS_WUQT), *WukvT = (bf16*)(ws + WS_WUKVT), *P = (bf16*)(ws + WS_P), *Qb = (bf16*)(ws + WS_Q), *Kb = (bf16*)(ws + WS_K), *Vb = (bf16*)(ws + WS_V), *BR = (bf16*)(ws + WS_BR), *QLN = (bf16*)(ws + WS_QLN), *KVN = (bf16*)(ws + WS_KVN);
    float *ORAW = (float*)(ws + WS_ORAW), *QRAW = (float*)(ws + WS_QRAW), *KVRAW = (float*)(ws + WS_KVRAW);
    int li = 0;
    for (int l = 0; l < L; ++l) {
        const int pb = 1 + l * NPH_L;
        launch_mk(a, l == 0 ? 0 : pb - 5, pb + 2, li++, grid, stream);
#if !MK_HGRN_IN
        k_hgrn_naive<<<NB * HH, 128, 0, stream>>>(P, lb + l * 512, ORAW);
        k_hgrn_out<<<NT * 4 / 4, 256, 0, stream>>>(ORAW, P, onorm_g + l * 128, BR);
#endif
#if !MK_MLA_IN
        k_mla_prep<<<NT / 4, 256, 0, stream>>>(P, qlat_g + l * 384, kvlat_g + l * 256, QLN, KVN);
        { GemmArgs g{}; g.A = QLN; g.Bt = WuqT + (size_t)l * 768 * 384; g.lda = 384; g.ldb = 384; g.K = 384; g.outf = QRAW; g.ldc = 768;
          k_gemm<1, 0><<<dim3(768 / 64, NT / 64), 256, 0, stream>>>(g); }
        { GemmArgs g{}; g.A = KVN; g.Bt = WukvT + (size_t)l * 1024 * 256; g.lda = 256; g.ldb = 256; g.K = 256; g.outf = KVRAW; g.ldc = 1024;
          k_gemm<1, 0><<<dim3(1024 / 64, NT / 64), 256, 0, stream>>>(g); }
        k_mla_post<<<NT * 8 / 4, 256, 0, stream>>>(QRAW, KVRAW, P, qn_g + l * 96, kn_g + l * 96, rope, Qb, Kb, Vb);
#endif
#if !MK_POOL_IN
        k_pool<<<NT * 512 / 256, 256, 0, stream>>>(P, BR);
#endif
#if MK_MLA_IN || MK_POOL_IN || MK_HGRN_IN
        launch_mk(a, pb + 2, pb + 3, li++, grid, stream);
#endif
#if MK_HGRN_IN
        launch_mk(a, pb + 3, pb + 4, li++, grid, stream);
#endif
#if MK_ATTN_IN || MK_HGRN_IN
        launch_mk(a, pb + 4, pb + 5, li++, grid, stream);
#else
        k_attn_naive<<<dim3(S / 64, NB * MH), 64, 0, stream>>>(Qb, Kb, Vb, BR);
#endif
    }
    launch_mk(a, 1 + (L - 1) * NPH_L + 5, NPH, li++, grid, stream);
#else
    launch_mk(a, 0, NPH, 0, grid, stream);
#endif
}
```
